# Optimizing an MI355X kernel written in HIP

```python
import math
import jax, jax.numpy as jnp
from jax import lax
import numpy as np

D_MODEL = 1024
BATCH = 32
SEQ = 2048
DEPTH = 2

CHUNK = 64
Q_BLOCK = 128
N_MIXERS = 2
HEAD_DIM = 64
SB_HEADS = D_MODEL // HEAD_DIM
DSA_HEADS = D_MODEL // HEAD_DIM
DSA_KV_HEADS = 2
DSA_GROUP = DSA_HEADS // DSA_KV_HEADS
IDX_HEADS = 8
IDX_DIM = 64
TOPK_MAX = 256
ROPE_THETA = 500000.0
ROPE_FRACTION = 4
N_EXPERTS = 32
TOP_K = 4
D_FF = D_MODEL
SWIGLU_ALPHA = 1.702
SWIGLU_LIMIT = 7.0
EPS = 1e-6
N_A = (DEPTH + 1) // 2
N_B = DEPTH // 2
DSA_SPLITS = (DSA_HEADS * HEAD_DIM, DSA_KV_HEADS * HEAD_DIM, DSA_KV_HEADS * HEAD_DIM,
              IDX_HEADS * IDX_DIM, IDX_DIM, IDX_HEADS)
DSA_PROJ = sum(DSA_SPLITS)

kernel_name = 'hybrid_stickbreak_dsa_moe_adaln'


def _rms(x, g):
    x32 = x.astype(jnp.float32)
    y = x32 * lax.rsqrt(jnp.mean(x32 * x32, axis=-1, keepdims=True) + EPS)
    return (y * g.astype(jnp.float32)).astype(x.dtype)


def _partial_rope(x, positions):
    d = x.shape[-1]
    rd = d // ROPE_FRACTION
    half = rd // 2
    inv = jnp.exp(-math.log(ROPE_THETA) * (2.0 * jnp.arange(half, dtype=jnp.float32) / rd))
    ang = positions.astype(jnp.float32)[:, :, None, None] * inv
    cos, sin = jnp.cos(ang), jnp.sin(ang)
    x32 = x.astype(jnp.float32)
    x1, x2, rest = x32[..., :half], x32[..., half:rd], x32[..., rd:]
    out = jnp.concatenate([x1 * cos - x2 * sin, x2 * cos + x1 * sin, rest], axis=-1)
    return out.astype(x.dtype)


def _stick_breaking(h, w_qkv, w_o):
    B, S, _ = h.shape
    qkv = (h @ w_qkv).reshape(B, S, 3, SB_HEADS, HEAD_DIM)
    q, k, v = qkv[:, :, 0], qkv[:, :, 1], qkv[:, :, 2]
    scale = HEAD_DIM ** -0.5
    outs = []
    for q0 in range(0, S, Q_BLOCK):
        kl = q0 + Q_BLOCK
        z = jnp.einsum('bqhd,bkhd->bhqk', q[:, q0:kl], k[:, :kl]).astype(jnp.float32) * scale
        qpos = q0 + jnp.arange(Q_BLOCK)
        kpos = jnp.arange(kl)
        before = kpos[None, :] < qpos[:, None]
        log_1m = jnp.where(before, jax.nn.log_sigmoid(-z), 0.0)
        tail = lax.cumsum(log_1m, axis=3, reverse=True) - log_1m
        a = jnp.where(before, jnp.exp(jax.nn.log_sigmoid(z) + tail), 0.0)
        outs.append(jnp.einsum('bhqk,bkhd->bqhd', a, v[:, :kl].astype(jnp.float32)))
    o = jnp.concatenate(outs, axis=1).astype(h.dtype).reshape(B, S, SB_HEADS * HEAD_DIM)
    return o @ w_o


def _dsa(h, positions, w_in, q_gain, k_gain, w_o):
    B, S, _ = h.shape
    topk = min(TOPK_MAX, S // 4)
    splits = np.cumsum(DSA_SPLITS)[:-1].tolist()
    q, k, v, qi, ki, wi = jnp.split(h @ w_in, splits, axis=-1)
    q = _partial_rope(_rms(q.reshape(B, S, DSA_HEADS, HEAD_DIM), q_gain), positions)
    k = _partial_rope(_rms(k.reshape(B, S, DSA_KV_HEADS, HEAD_DIM), k_gain), positions)
    v = v.reshape(B, S, DSA_KV_HEADS, HEAD_DIM)
    qi = _partial_rope(qi.reshape(B, S, IDX_HEADS, IDX_DIM), positions)
    ki = _partial_rope(ki.reshape(B, S, 1, IDX_DIM), positions)[:, :, 0]
    wi = wi.astype(jnp.float32) * (IDX_HEADS ** -0.5)
    q = q.reshape(B, S, DSA_KV_HEADS, DSA_GROUP, HEAD_DIM)
    kchunk = jnp.arange(S) // CHUNK
    gather = jax.vmap(lambda t, i: t[i])
    outs = []
    for q0 in range(0, S, Q_BLOCK):
        qe = q0 + Q_BLOCK
        qchunk = (q0 + jnp.arange(Q_BLOCK)) // CHUNK
        adm = kchunk[None, :] <= qchunk[:, None]
        rel = jax.nn.relu(jnp.einsum('bqhd,bsd->bqhs', qi[:, q0:qe], ki).astype(jnp.float32))
        score = jnp.einsum('bqhs,bqh->bqs', rel * (IDX_DIM ** -0.5), wi[:, q0:qe])
        score = jnp.where(adm[None], score, -jnp.inf)
        top_val, top_idx = lax.top_k(score, topk)
        valid = top_val > -jnp.inf
        kg = gather(k, top_idx)
        vg = gather(v, top_idx)
        s = jnp.einsum('bqgrd,bqkgd->bqgrk', q[:, q0:qe], kg).astype(jnp.float32) * (HEAD_DIM ** -0.5)
        s = jnp.where(valid[:, :, None, None, :], s, -jnp.inf)
        p = jax.nn.softmax(s, axis=-1)
        outs.append(jnp.einsum('bqgrk,bqkgd->bqgrd', p, vg.astype(jnp.float32)))
    o = jnp.concatenate(outs, axis=1).astype(h.dtype).reshape(B, S, DSA_HEADS * HEAD_DIM)
    return o @ w_o


def _moe(h, router_w, router_b, w_gu, b_gu, w_down, b_down):
    B, S, D = h.shape
    t = h.reshape(B * S, D)
    logits = (t @ router_w).astype(jnp.float32) + router_b.astype(jnp.float32)
    top_v, top_i = lax.top_k(logits, TOP_K)
    gates = jax.nn.softmax(top_v, axis=-1)
    comb = jnp.sum(jax.nn.one_hot(top_i, N_EXPERTS, dtype=jnp.float32) * gates[..., None], axis=1)
    out = jnp.zeros((B * S, D), jnp.float32)
    for e in range(N_EXPERTS):
        gu = t @ w_gu[e] + b_gu[e]
        g = jnp.minimum(gu[:, 0::2], SWIGLU_LIMIT)
        u = jnp.clip(gu[:, 1::2], -SWIGLU_LIMIT, SWIGLU_LIMIT)
        y = ((u + 1.0) * (g * jax.nn.sigmoid(g * SWIGLU_ALPHA))) @ w_down[e] + b_down[e]
        out = out + comb[:, e:e + 1] * y.astype(jnp.float32)
    return out.astype(h.dtype).reshape(B, S, D)


def setup_inputs(seed: int = 0) -> dict:
    key = jax.random.key(seed)
    ks = jax.random.split(key, 20)
    f32 = jnp.float32

    def nrm(k, shape, scale):
        return jax.random.normal(k, shape, f32) * scale

    x = nrm(ks[0], (BATCH, SEQ, D_MODEL), 1.0)
    c = nrm(ks[1], (BATCH, D_MODEL), 1.0)
    offs = jax.random.randint(ks[2], (BATCH, 1), 0, 64, dtype=jnp.int32) * CHUNK
    positions = (offs + jnp.arange(SEQ, dtype=jnp.int32)[None, :]).astype(jnp.int32)
    ds = D_MODEL ** -0.5
    return {
        'x': x,
        'c': c,
        'positions': positions,
        'ada_w': nrm(ks[3], (DEPTH, D_MODEL, 6 * D_MODEL), 0.5 * ds),
        'ada_b': nrm(ks[4], (DEPTH, 6 * D_MODEL), 0.01),
        'norm1_g': 1.0 + nrm(ks[5], (DEPTH, D_MODEL), 0.01),
        'norm2_g': 1.0 + nrm(ks[6], (DEPTH, D_MODEL), 0.01),
        'sb_w_qkv': nrm(ks[7], (N_A, D_MODEL, 3 * SB_HEADS * HEAD_DIM), ds),
        'sb_w_o': nrm(ks[8], (N_A, SB_HEADS * HEAD_DIM, D_MODEL), (SB_HEADS * HEAD_DIM) ** -0.5),
        'dsa_w_in': nrm(ks[9], (N_B, D_MODEL, DSA_PROJ), ds),
        'dsa_q_gain': 1.0 + nrm(ks[10], (N_B, HEAD_DIM), 0.01),
        'dsa_k_gain': 1.0 + nrm(ks[11], (N_B, HEAD_DIM), 0.01),
        'dsa_w_o': nrm(ks[12], (N_B, DSA_HEADS * HEAD_DIM, D_MODEL), (DSA_HEADS * HEAD_DIM) ** -0.5),
        'router_w': nrm(ks[13], (DEPTH, D_MODEL, N_EXPERTS), ds),
        'router_b': nrm(ks[14], (DEPTH, N_EXPERTS), 0.01),
        'exp_w_gu': nrm(ks[15], (DEPTH, N_EXPERTS, D_MODEL, 2 * D_FF), ds),
        'exp_b_gu': nrm(ks[16], (DEPTH, N_EXPERTS, 2 * D_FF), 0.01),
        'exp_w_down': nrm(ks[17], (DEPTH, N_EXPERTS, D_FF, D_MODEL), D_FF ** -0.5),
        'exp_b_down': nrm(ks[18], (DEPTH, N_EXPERTS, D_MODEL), 0.01),
    }


def reference(x, c, positions, ada_w, ada_b, norm1_g, norm2_g, sb_w_qkv, sb_w_o,
              dsa_w_in, dsa_q_gain, dsa_k_gain, dsa_w_o, router_w, router_b,
              exp_w_gu, exp_b_gu, exp_w_down, exp_b_down):
    cs = jax.nn.silu(c)
    for i in range(DEPTH):
        mod = cs @ ada_w[i] + ada_b[i]
        sh1, sc1, g1, sh2, sc2, g2 = [m[:, None, :] for m in jnp.split(mod, 6, axis=-1)]
        h = _rms(x, norm1_g[i]) * (1.0 + sc1) + sh1
        j = i // N_MIXERS
        if i % N_MIXERS == 0:
            y = _stick_breaking(h, sb_w_qkv[j], sb_w_o[j])
        else:
            y = _dsa(h, positions, dsa_w_in[j], dsa_q_gain[j], dsa_k_gain[j], dsa_w_o[j])
        x = x + g1 * y
        h = _rms(x, norm2_g[i]) * (1.0 + sc2) + sh2
        x = x + g2 * _moe(h, router_w[i], router_b[i], exp_w_gu[i], exp_b_gu[i],
                          exp_w_down[i], exp_b_down[i])
    return x
```

```cpp
#include <hip/hip_runtime.h>
#include <cstdio>
#include <cstdint>

#define GAS __attribute__((address_space(1)))
#define LAS __attribute__((address_space(3)))
typedef unsigned short bf16;
typedef short bf16x8 __attribute__((ext_vector_type(8)));
typedef float f32x4 __attribute__((ext_vector_type(4)));
typedef float f32x2 __attribute__((ext_vector_type(2)));
typedef unsigned u32x4 __attribute__((ext_vector_type(4)));
typedef unsigned u32x2 __attribute__((ext_vector_type(2)));
typedef GAS unsigned gu32;

constexpr int DM = 1024, NB = 32, SEQ = 2048, NTOK = NB * SEQ, NE = 32, TOPK = 4, HD = 64, NH = 16;
constexpr int NQKV = 3072, NPROJ = 2048, NPROJ_REAL = 1864;
constexpr int ECAP = 65536;
constexpr int MOE_ROWS = NTOK * TOPK + NE * 256;
constexpr float EPS = 1e-6f;
constexpr float LOG2E = 1.4426950408889634f;
constexpr float QSCALE = 0.125f * LOG2E;
constexpr int NWAVES = 8, NTHREADS = 512;

constexpr size_t MiB = (size_t)1 << 20;
constexpr size_t WS_CTL = 0, CTL_ZERO_BYTES = 1 * MiB;
constexpr size_t WS_MOD = 1 * MiB;
constexpr size_t WS_WQKV = 3 * MiB, WS_WO0 = 9 * MiB, WS_WIN = 11 * MiB, WS_WO1 = 15 * MiB, WS_WGU = 17 * MiB, WS_WD = 273 * MiB;
constexpr size_t WS_H = 402 * MiB;
constexpr size_t WS_A = 530 * MiB;
constexpr size_t WS_QKV = WS_A, WS_PRAW = WS_A, WS_Q1 = 786 * MiB, WS_K1 = 914 * MiB, WS_V1 = 930 * MiB, WS_QI = 946 * MiB, WS_KI = 1010 * MiB, WS_WI = 1018 * MiB;
constexpr size_t WS_B = 1058 * MiB;
constexpr size_t WS_O = WS_B, WS_MASK = 1186 * MiB, WS_SC = 1202 * MiB;
constexpr size_t WS_TOKE = 1720 * MiB, WS_TOKP = 1721 * MiB, WS_TOKG = 1722 * MiB, WS_LIST = 1724 * MiB, WS_GATE = 1732 * MiB, WS_END = 1740 * MiB;
static_assert(WS_A + (size_t)MOE_ROWS * DM * 2 <= WS_B && WS_B + (size_t)MOE_ROWS * DM * 2 <= WS_TOKE && WS_SC + (size_t)NTOK * SEQ * 4 <= WS_TOKE, "ws map");
constexpr int CW_TMO = 0, CW_BAR = 4096, CW_CNT = 8192;

constexpr int RING_BYTES = 131072;
constexpr int LDSCTL_OFF = RING_BYTES;
constexpr int EXTRA_OFF = RING_BYTES + 1024;
constexpr int LDS_BYTES = 163840;

#define LDS_WAIT() asm volatile("s_waitcnt lgkmcnt(0)" ::: "memory")
#define VM_WAIT() asm volatile("s_waitcnt vmcnt(0)" ::: "memory")
__device__ __forceinline__ unsigned f2bf(float f) { unsigned u = __builtin_bit_cast(unsigned, f); return (u + 0x7fffu + ((u >> 16) & 1u)) >> 16; }
__device__ __forceinline__ unsigned pk2(float lo, float hi) { return f2bf(lo) | (f2bf(hi) << 16); }
__device__ __forceinline__ float bflo(unsigned w) { return __uint_as_float(w << 16); }
__device__ __forceinline__ float bfhi(unsigned w) { return __uint_as_float(w & 0xffff0000u); }
__device__ __forceinline__ float wave_sum(float v) {
#pragma unroll
    for (int o = 1; o < 64; o <<= 1) v += __shfl_xor(v, o);
    return v;
}

namespace pg8 {
constexpr int BM = 256, BK = 64, HALF = 128, HTB = HALF * BK * 2, NXCD = 8, WGM = 8;
__host__ __device__ __forceinline__ int lds_byte(int r, int c) { const int st = (r >> 4) * 2 + (c >> 5), rr = r & 15, cc = c & 31, ob = rr * 64 + cc * 2; return st * 1024 + (ob ^ (((ob >> 9) & 1) << 5)); }
__host__ __device__ __forceinline__ void stage_rc(int b, int& R, int& C) { const int st = b / 1024, sb = b % 1024, swz = sb ^ (((sb >> 9) & 1) << 5); R = (st >> 1) * 16 + swz / 64; C = (st & 1) * 32 + (swz % 64) / 2; }
__host__ __device__ __forceinline__ int perm32(int rho) { const int n = rho >> 4, i = rho & 15; return 8 * (i >> 2) + 4 * n + (i & 3); }

struct Unit { int pm, pn, e; };
struct Gemm { const bf16* A; const bf16* Bt; int K; size_t bstride; };

struct StaticOrder {
    int nM, nN, nwg, G, c;
    __device__ void init(int M, int N, int G_, int c_) { nM = M / BM; nN = N / BM; nwg = nM * nN; G = G_; c = c_; }
    __device__ bool next(int i, Unit& u) const {
        const long L = (long)i * G + c; if (L >= nwg) return false;
        int wgid = (int)L; { const int q = nwg / NXCD, r = nwg % NXCD, xcd = wgid % NXCD, off = wgid / NXCD; wgid = (xcd < r ? xcd * (q + 1) : r * (q + 1) + (xcd - r) * q) + off; }
        const int nig = WGM * nN, gid = wgid / nig, fm = gid * WGM, gsz = (nM - fm) < WGM ? (nM - fm) : WGM;
        u.pm = fm + ((wgid % nig) % gsz); u.pn = (wgid % nig) / gsz; u.e = 0; return true;
    }
    __device__ __forceinline__ int arow(const Unit&, int) const { return 0; }
};
struct MoeOrder {
    const LAS int* tsum; const LAS int* cnt; const int* list; int nN, G, c, total;
    __device__ bool next(int i, Unit& u) const {
        const int L = i * G + (c & 7) * (G >> 3) + (c >> 3); if (L >= total) return false;
        const int tile = L / nN; u.pn = L - tile * nN;
        int e = 0; while (tile >= tsum[e + 1]) ++e;
        u.e = e; u.pm = tile; return true;
    }
    __device__ __forceinline__ int arow(const Unit& u, int r) const {
        int p = (u.pm - tsum[u.e]) * BM + r; const int c_ = cnt[u.e]; p = p < c_ ? p : c_ - 1; return list[(size_t)u.e * ECAP + p];
    }
};

__device__ __forceinline__ unsigned cvt_pk_bf16(float lo, float hi) { unsigned r; asm volatile("v_cvt_pk_bf16_f32 %0, %1, %2" : "=v"(r) : "v"(lo), "v"(hi)); return r; }

struct EpiBf16S {
    static constexpr bool PERM = true;
    bf16* O; int ldc; int scale_cols; float scale0;
    __device__ __forceinline__ void operator()(const f32x4 (&acc)[2][2][4][2], const Unit& u, int wr, int wc, int fr, int fq) const {
        const int row0 = u.pm * BM + wr * 64 + fr, col0 = u.pn * BM + wc * 32 + 8 * fq; const float sc = (u.pn * BM < scale_cols) ? scale0 : 1.f;
#pragma unroll
        for (int ai = 0; ai < 2; ++ai)
#pragma unroll
            for (int m = 0; m < 4; ++m) { bf16* rowp = O + (size_t)(row0 + ai * HALF + m * 16) * ldc + col0;
#pragma unroll
                for (int bj = 0; bj < 2; ++bj) { const f32x4 v0 = acc[ai][bj][m][0] * sc, v1 = acc[ai][bj][m][1] * sc;
                    u32x4 w; w.x = cvt_pk_bf16(v0[0], v0[1]); w.y = cvt_pk_bf16(v0[2], v0[3]); w.z = cvt_pk_bf16(v1[0], v1[1]); w.w = cvt_pk_bf16(v1[2], v1[3]);
                    *(GAS u32x4*)(rowp + bj * HALF) = w; } }
    }
};
struct EpiResid {
    static constexpr bool PERM = false;
    const float* xin; float* out; const float* gate;
    __device__ __forceinline__ void operator()(const f32x4 (&acc)[2][2][4][2], const Unit& u, int wr, int wc, int fr, int fq) const {
        const int row0 = u.pm * BM + wr * 64 + fr, b = u.pm >> 3, col0 = u.pn * BM + wc * 32 + 4 * fq;
#pragma unroll
        for (int bj = 0; bj < 2; ++bj)
#pragma unroll
            for (int n = 0; n < 2; ++n) { const int c = col0 + bj * HALF + 16 * n; const f32x4 g4 = *(const GAS f32x4*)(gate + (size_t)b * 6144 + c);
#pragma unroll
                for (int ai = 0; ai < 2; ++ai)
#pragma unroll
                    for (int m = 0; m < 4; ++m) { const size_t o = (size_t)(row0 + ai * HALF + m * 16) * DM + c; const f32x4 x4 = *(const GAS f32x4*)(xin + o); *(GAS f32x4*)(out + o) = x4 + g4 * acc[ai][bj][m][n]; } }
    }
};
__device__ __forceinline__ float swiglu1(float g, float u) {
    g = fminf(g, 7.0f); u = fminf(fmaxf(u, -7.0f), 7.0f);
    const float e = __builtin_amdgcn_exp2f(g * (-1.702f * LOG2E));
    return (u + 1.0f) * g * __builtin_amdgcn_rcpf(1.0f + e);
}
struct EpiSwiglu {
    static constexpr bool PERM = true;
    bf16* ACT; const float* bgu;
    __device__ __forceinline__ void operator()(const f32x4 (&acc)[2][2][4][2], const Unit& u, int wr, int wc, int fr, int fq) const {
        const int row0 = u.pm * BM + wr * 64 + fr, jl0 = wc * 32 + 8 * fq, colA = u.pn * HALF + jl0;
        const GAS f32x4* bp = (const GAS f32x4*)(bgu + (size_t)u.e * 2048 + 2 * (u.pn * HALF + jl0));
        const f32x4 b0 = bp[0], b1 = bp[1], b2 = bp[2], b3 = bp[3];
        const f32x4 bg[2] = {(f32x4){b0[0], b0[2], b1[0], b1[2]}, (f32x4){b2[0], b2[2], b3[0], b3[2]}};
        const f32x4 bu[2] = {(f32x4){b0[1], b0[3], b1[1], b1[3]}, (f32x4){b2[1], b2[3], b3[1], b3[3]}};
#pragma unroll
        for (int ai = 0; ai < 2; ++ai)
#pragma unroll
            for (int m = 0; m < 4; ++m) { float o[8];
#pragma unroll
                for (int n = 0; n < 2; ++n) { const f32x4 g4 = acc[ai][0][m][n] + bg[n], u4 = acc[ai][1][m][n] + bu[n];
#pragma unroll
                    for (int i = 0; i < 4; ++i) o[4 * n + i] = swiglu1(g4[i], u4[i]); }
                u32x4 w; w.x = cvt_pk_bf16(o[0], o[1]); w.y = cvt_pk_bf16(o[2], o[3]); w.z = cvt_pk_bf16(o[4], o[5]); w.w = cvt_pk_bf16(o[6], o[7]);
                *(GAS u32x4*)(ACT + (size_t)(row0 + ai * HALF + m * 16) * DM + colA) = w; }
    }
};
struct EpiDown {
    static constexpr bool PERM = true;
    bf16* Y; const float* bd; const float* gate_e; const LAS int* tsum;
    __device__ __forceinline__ void operator()(const f32x4 (&acc)[2][2][4][2], const Unit& u, int wr, int wc, int fr, int fq) const {
        const int row0 = u.pm * BM + wr * 64 + fr, col0 = u.pn * BM + wc * 32 + 8 * fq, lrow0 = (u.pm - tsum[u.e]) * BM + wr * 64 + fr;
        f32x4 bv[2][2];
#pragma unroll
        for (int bj = 0; bj < 2; ++bj)
#pragma unroll
            for (int n = 0; n < 2; ++n) bv[bj][n] = *(const GAS f32x4*)(bd + (size_t)u.e * DM + col0 + bj * HALF + 4 * n);
#pragma unroll
        for (int ai = 0; ai < 2; ++ai)
#pragma unroll
            for (int m = 0; m < 4; ++m) { const float gt = gate_e[(size_t)u.e * ECAP + lrow0 + ai * HALF + m * 16]; bf16* rowp = Y + (size_t)(row0 + ai * HALF + m * 16) * DM + col0;
#pragma unroll
                for (int bj = 0; bj < 2; ++bj) { const f32x4 v0 = (acc[ai][bj][m][0] + bv[bj][0]) * gt, v1 = (acc[ai][bj][m][1] + bv[bj][1]) * gt;
                    u32x4 w; w.x = cvt_pk_bf16(v0[0], v0[1]); w.y = cvt_pk_bf16(v0[2], v0[3]); w.z = cvt_pk_bf16(v1[0], v1[1]); w.w = cvt_pk_bf16(v1[2], v1[3]);
                    *(GAS u32x4*)(rowp + bj * HALF) = w; } }
    }
};

template <class Epi, class Sched, bool GATHER, bool ALIGN_EPI>
__device__ __forceinline__ void gemm_phase(LAS unsigned char* lds, const Gemm g, const Sched& S, const Epi& E) {
    const int tid = threadIdx.x, wid = __builtin_amdgcn_readfirstlane(tid >> 6), lane = tid & 63, wr = wid >> 2, wc = wid & 3, fr = lane & 15, fq = lane >> 4;
    const int K = g.K, nt = K / BK;
    int Rr[2], Cc[2]; unsigned voffB[2];
#pragma unroll
    for (int i = 0; i < 2; ++i) { stage_rc(tid * 16 + i * 8192, Rr[i], Cc[i]); const int Rb = Epi::PERM ? ((Rr[i] & ~31) + perm32(Rr[i] & 31)) : Rr[i]; voffB[i] = (unsigned)(Rb * K + Cc[i]) * 2u; }
    const size_t kstep = (size_t)(BK * 2), hstep = (size_t)HALF * K * 2, tstep = 2 * hstep;
    const unsigned ldsw = (unsigned)wid * 1024u;
    const int aoff = lds_byte(wr * 64 + fr, fq * 8), boff = lds_byte(wc * 32 + fr, fq * 8);
#define PG8_SA(b, h) (((b) * 2 + (h)) * HTB)
#define PG8_SB(b, h) ((4 + (b) * 2 + (h)) * HTB)
#define PG8_STAGE(bufoff, gbase, voff) do { _Pragma("unroll") for (int _i = 0; _i < 2; ++_i) \
        __builtin_amdgcn_global_load_lds((const GAS unsigned*)((const char*)(gbase) + (voff)[_i]), (LAS unsigned*)(lds + (bufoff) + ldsw + _i * 8192), 16, 0, 0); } while (0)
#define PG8_LDA(dst, b, h) do { _Pragma("unroll") for (int m = 0; m < 4; ++m) _Pragma("unroll") for (int k = 0; k < 2; ++k) dst[m][k] = *(const LAS bf16x8*)(lds + PG8_SA(b, h) + aoff + m * 2048 + k * 1024); } while (0)
#define PG8_LDB(dst, b, h) do { _Pragma("unroll") for (int n = 0; n < 2; ++n) _Pragma("unroll") for (int k = 0; k < 2; ++k) dst[n][k] = *(const LAS bf16x8*)(lds + PG8_SB(b, h) + boff + n * 2048 + k * 1024); } while (0)
#define PG8_MMA(ai, bj, At, Bt) do { __builtin_amdgcn_s_setprio(1); _Pragma("unroll") for (int m = 0; m < 4; ++m) _Pragma("unroll") for (int n = 0; n < 2; ++n) _Pragma("unroll") for (int k = 0; k < 2; ++k) \
        acc[ai][bj][m][n] = __builtin_amdgcn_mfma_f32_16x16x32_bf16(Bt[n][k], At[m][k], acc[ai][bj][m][n], 0, 0, 0); __builtin_amdgcn_s_setprio(0); } while (0)
#define PG8_WAIT_V(n) asm volatile("s_waitcnt vmcnt(" #n ")" ::: "memory")
#define PG8_WAIT_L(n) asm volatile("s_waitcnt lgkmcnt(" #n ")" ::: "memory")
#define PG8_BAR __builtin_amdgcn_s_barrier()
#define PG8_SCHED __builtin_amdgcn_sched_barrier(0)
    Unit cur, nxt; int ui = 0;
    if (!S.next(0, cur)) return;
    f32x4 acc[2][2][4][2];
#pragma unroll
    for (int a = 0; a < 2; ++a)
#pragma unroll
        for (int b = 0; b < 2; ++b)
#pragma unroll
            for (int m = 0; m < 4; ++m)
#pragma unroll
                for (int n = 0; n < 2; ++n) acc[a][b][m][n] = (f32x4){0.f, 0.f, 0.f, 0.f};
    bf16x8 At[4][2], B0[2][2], B1[2][2];
    unsigned vA0[2], vA1[2], nA0[2], nA1[2];
#pragma unroll
    for (int i = 0; i < 2; ++i) {
        if constexpr (GATHER) { vA0[i] = (unsigned)(S.arow(cur, Rr[i]) * K + Cc[i]) * 2u; vA1[i] = (unsigned)(S.arow(cur, HALF + Rr[i]) * K + Cc[i]) * 2u; }
        else { vA0[i] = (unsigned)(Rr[i] * K + Cc[i]) * 2u; vA1[i] = vA0[i] + (unsigned)hstep; }
        nA0[i] = vA0[i]; nA1[i] = vA1[i];
    }
    const char* cA = GATHER ? (const char*)g.A : (const char*)g.A + (size_t)cur.pm * tstep;
    const char* cB = (const char*)g.Bt + (size_t)cur.e * g.bstride + (size_t)cur.pn * tstep;
    PG8_STAGE(PG8_SB(0, 0), cB, voffB); PG8_STAGE(PG8_SB(0, 1), cB + hstep, voffB); PG8_STAGE(PG8_SA(0, 0), cA, vA0); PG8_STAGE(PG8_SA(0, 1), cA, vA1);
    if (wr == 1) PG8_BAR;
    PG8_WAIT_V(2); PG8_BAR;
    PG8_STAGE(PG8_SB(1, 0), cB + kstep, voffB); PG8_STAGE(PG8_SA(1, 0), cA + kstep, vA0); PG8_STAGE(PG8_SB(1, 1), cB + hstep + kstep, voffB);
    PG8_WAIT_V(6); PG8_BAR;
    for (;;) {
        const bool has_next = S.next(ui + 1, nxt);
        const char* nA = has_next ? (GATHER ? (const char*)g.A : (const char*)g.A + (size_t)nxt.pm * tstep) : cA;
        const char* nB = has_next ? (const char*)g.Bt + (size_t)nxt.e * g.bstride + (size_t)nxt.pn * tstep : cB;
        if constexpr (GATHER) { if (has_next) {
#pragma unroll
            for (int i = 0; i < 2; ++i) { nA0[i] = (unsigned)(S.arow(nxt, Rr[i]) * K + Cc[i]) * 2u; nA1[i] = (unsigned)(S.arow(nxt, HALF + Rr[i]) * K + Cc[i]) * 2u; } } }
        for (int t = 0; t < nt; t += 2) {
            const bool last = (t == nt - 2);
            const char* a1 = cA + (size_t)(t + 1) * kstep;
            const char* a2 = last ? nA : cA + (size_t)(t + 2) * kstep; const char* b2 = last ? nB : cB + (size_t)(t + 2) * kstep;
            const char* a3 = a2 + kstep; const char* b3 = b2 + kstep;
            unsigned w0[2], w1[2];
#pragma unroll
            for (int i = 0; i < 2; ++i) { w0[i] = last ? nA0[i] : vA0[i]; w1[i] = last ? nA1[i] : vA1[i]; }
            PG8_LDB(B0, 0, 0); PG8_LDB(B1, 0, 1); PG8_SCHED; PG8_LDA(At, 0, 0); PG8_STAGE(PG8_SA(1, 1), a1, vA1);
            PG8_WAIT_V(8); PG8_WAIT_L(0); PG8_BAR; PG8_MMA(0, 0, At, B0); PG8_MMA(0, 1, At, B1); PG8_BAR; PG8_SCHED;
            PG8_LDA(At, 0, 1); PG8_STAGE(PG8_SB(0, 0), b2, voffB); PG8_STAGE(PG8_SB(0, 1), b2 + hstep, voffB); PG8_STAGE(PG8_SA(0, 0), a2, w0);
            PG8_WAIT_V(8); PG8_WAIT_L(0); PG8_BAR; PG8_MMA(1, 0, At, B0); PG8_MMA(1, 1, At, B1); PG8_BAR; PG8_SCHED;
            PG8_LDB(B0, 1, 0); PG8_LDB(B1, 1, 1); PG8_SCHED; PG8_LDA(At, 1, 0); PG8_STAGE(PG8_SA(0, 1), a2, w1);
            PG8_WAIT_V(8); PG8_WAIT_L(0); PG8_BAR; PG8_MMA(0, 0, At, B0); PG8_MMA(0, 1, At, B1); PG8_BAR; PG8_SCHED;
            PG8_LDA(At, 1, 1); PG8_STAGE(PG8_SB(1, 0), b3, voffB); PG8_STAGE(PG8_SB(1, 1), b3 + hstep, voffB); PG8_STAGE(PG8_SA(1, 0), a3, w0);
            PG8_WAIT_V(8); PG8_WAIT_L(0); PG8_BAR; PG8_MMA(1, 0, At, B0); PG8_MMA(1, 1, At, B1); PG8_BAR; PG8_SCHED;
        }
        if constexpr (ALIGN_EPI) { if (wr == 0) PG8_BAR; }
        E(acc, cur, wr, wc, fr, fq);
        if (!has_next) break;
#pragma unroll
        for (int a = 0; a < 2; ++a)
#pragma unroll
            for (int b = 0; b < 2; ++b)
#pragma unroll
                for (int m = 0; m < 4; ++m)
#pragma unroll
                    for (int n = 0; n < 2; ++n) acc[a][b][m][n] = (f32x4){0.f, 0.f, 0.f, 0.f};
        cur = nxt; cA = nA; cB = nB; ++ui;
#pragma unroll
        for (int i = 0; i < 2; ++i) { vA0[i] = nA0[i]; vA1[i] = nA1[i]; }
        if constexpr (ALIGN_EPI) { if (wr == 1) PG8_BAR; }
    }
    PG8_WAIT_V(0);
    if constexpr (!ALIGN_EPI) { if (wr == 0) PG8_BAR; }
    PG8_BAR;
#undef PG8_SA
#undef PG8_SB
#undef PG8_STAGE
#undef PG8_LDA
#undef PG8_LDB
#undef PG8_MMA
#undef PG8_WAIT_V
#undef PG8_WAIT_L
#undef PG8_BAR
#undef PG8_SCHED
}
}

#define XB_TMO      128
#define XB_XCNT(j)  (256  + 64 * (j))
#define XB_XSUB(j)  (1280 + 64 * (j))
#define XB_XGEN(j)  (2304 + 64 * (j))
#define XB_TOP      3328
#define XB_TOPGEN   3392
#define XCD_BAR_WORDS 3456
#define XB_SPIN_CAP (1u << 22)
__device__ __forceinline__ unsigned xb_ld(unsigned* p)              { return __hip_atomic_load(p, __ATOMIC_RELAXED, __HIP_MEMORY_SCOPE_AGENT); }
__device__ __forceinline__ unsigned xb_add(unsigned* p, unsigned v) { return __hip_atomic_fetch_add(p, v, __ATOMIC_RELAXED, __HIP_MEMORY_SCOPE_AGENT); }
__device__ __forceinline__ unsigned xb_xcc_id() { return (unsigned)__builtin_amdgcn_s_getreg((3 << 11) | 20) & 0xFu; }
#define XB_SPIN(cond, bar) do { unsigned _sp = 0; while (cond) { __builtin_amdgcn_s_sleep(1); \
    if ((++_sp & 255u) == 0u) { if (xb_ld(&(bar)[XB_TMO])) break; if (_sp > XB_SPIN_CAP) { atomicAdd(&(bar)[XB_TMO], 1u); break; } } } } while (0)
struct XcdBarrier { unsigned* bar; unsigned x; volatile LAS unsigned* st; };
__device__ __forceinline__ XcdBarrier xcd_barrier_post(unsigned* bar, volatile LAS unsigned* st) {
    XcdBarrier b; b.bar = bar; b.x = xb_xcc_id(); b.st = st;
    if (threadIdx.x == 0) (void)xb_add(&bar[XB_XCNT(b.x)], 1u);
    return b;
}
__device__ __forceinline__ void xcd_barrier_complete(unsigned* bar, unsigned x, unsigned& nloc, unsigned& nx) {
    const unsigned G = gridDim.x * gridDim.y * gridDim.z;
    unsigned sum, cnt, mine, sp = 0u;
    for (;;) {
        sum = 0u; cnt = 0u; mine = 0u;
#pragma unroll
        for (unsigned j = 0; j < 16; ++j) { const unsigned c = xb_ld(&bar[XB_XCNT(j)]); sum += c; cnt += (c > 0u) ? 1u : 0u; mine = (j == x) ? c : mine; }
        if (sum == G) break;
        __builtin_amdgcn_s_sleep(1);
        if ((++sp & 255u) == 0u) { if (xb_ld(&bar[XB_TMO])) break; if (sp > XB_SPIN_CAP) { atomicAdd(&bar[XB_TMO], 1u); break; } }
    }
    nloc = mine > 0u ? mine : 1u; nx = cnt > 0u ? cnt : 1u;
}
__device__ __forceinline__ void xcd_barrier(const XcdBarrier& b) {
    asm volatile("s_waitcnt vmcnt(0)" ::: "memory");
    __syncthreads();
    if (threadIdx.x == 0) {
        unsigned* bar = b.bar;
        __builtin_amdgcn_s_waitcnt(0);
        unsigned nloc = b.st[0], nx = b.st[1];
        if (nloc == 0u) { xcd_barrier_complete(bar, b.x, nloc, nx); b.st[0] = nloc; b.st[1] = nx; }
        const unsigned old = xb_add(&bar[XB_XSUB(b.x)], 1u);
        const unsigned gen = old / nloc;
        if (old + 1u == (gen + 1u) * nloc) {
            __builtin_amdgcn_fence(__ATOMIC_RELEASE, "agent");
            asm volatile("s_waitcnt vmcnt(0)" ::: "memory");
            const unsigned og = xb_add(&bar[XB_TOP], 1u);
            const unsigned tg = og / nx;
            if (og + 1u == (tg + 1u) * nx) xb_add(&bar[XB_TOPGEN], 1u);
            else XB_SPIN(xb_ld(&bar[XB_TOPGEN]) == tg, bar);
            __builtin_amdgcn_fence(__ATOMIC_ACQUIRE, "agent");
            xb_add(&bar[XB_XGEN(b.x)], 1u);
            asm volatile("s_waitcnt vmcnt(0)" ::: "memory");
        } else {
            XB_SPIN(xb_ld(&bar[XB_XGEN(b.x)]) == gen, bar);
            __builtin_amdgcn_fence(__ATOMIC_ACQUIRE, "agent");
            asm volatile("s_waitcnt vmcnt(0)" ::: "memory");
        }
    }
    __syncthreads();
}

struct Ctx { LAS unsigned char* lds; int tid, lane, wave, G, vcu, gw, NGW; };

__device__ __forceinline__ void p0_transpose_item(const float* W, int Nsrc, int Ndst, int mode, bf16* WT, LAS float* scr, int item, int lane) {
    const int nblk = Ndst / 32, kb = item / nblk, nb = item - kb * nblk, k0 = 64 * kb, n0 = 32 * nb;
    const int nd = n0 + (lane & 31);
    const int sc = mode ? (2 * (128 * (nd >> 8) + (nd & 127)) + ((nd >> 7) & 1)) : nd;
    const bool ok = sc < Nsrc;
    const GAS float* Wg = (const GAS float*)W;
#pragma unroll 8
    for (int i = 0; i < 32; ++i) { const int kk = 2 * i + (lane >> 5); scr[kk * 33 + (lane & 31)] = ok ? Wg[(size_t)(k0 + kk) * Nsrc + sc] : 0.f; }
    LDS_WAIT(); asm volatile("" ::: "memory");
    const int c = lane & 7;
#pragma unroll
    for (int j = 0; j < 4; ++j) { const int n = (lane >> 3) + 8 * j; const LAS float* s = scr + (8 * c) * 33 + n;
        u32x4 o; o.x = pk2(s[0 * 33], s[1 * 33]); o.y = pk2(s[2 * 33], s[3 * 33]); o.z = pk2(s[4 * 33], s[5 * 33]); o.w = pk2(s[6 * 33], s[7 * 33]);
        *(GAS u32x4*)(WT + (size_t)(n0 + n) * DM + k0 + 8 * c) = o; }
    LDS_WAIT(); asm volatile("" ::: "memory");
}
__device__ __forceinline__ void phase_prologue(const Ctx& X, const float* c_in, const float* ada_w, const float* ada_b, float* mod,
                                               const float* w_qkv, const float* w_o0, const float* w_in, const float* w_o1, const float* w_gu, const float* w_down,
                                               bf16* Wqkv_t, bf16* Wo0_t, bf16* Win_t, bf16* Wo1_t, bf16* Wgu_t, bf16* Wd_t) {
    if (blockIdx.x < 192) {
        const int l = blockIdx.x / 96, j0 = (blockIdx.x % 96) * 64;
        LAS float* cs = (LAS float*)X.lds;
        for (int i = 0; i < 64; ++i) { const int idx = i * NTHREADS + X.tid, b = idx >> 10, k = idx & 1023; const float v = c_in[idx]; cs[k * 32 + b] = v / (1.0f + __expf(-v)); }
        __syncthreads();
        float acc[32];
#pragma unroll
        for (int b = 0; b < 32; ++b) acc[b] = 0.f;
        const GAS float* wp = (const GAS float*)ada_w + ((size_t)l * DM + X.wave * 128) * 6144 + j0 + X.lane;
#pragma unroll 4
        for (int k = 0; k < 128; ++k) { const float w = wp[(size_t)k * 6144]; const LAS f32x4* c4 = (const LAS f32x4*)(cs + (X.wave * 128 + k) * 32);
#pragma unroll
            for (int b4 = 0; b4 < 8; ++b4) { const f32x4 cv = c4[b4]; acc[4 * b4 + 0] += w * cv[0]; acc[4 * b4 + 1] += w * cv[1]; acc[4 * b4 + 2] += w * cv[2]; acc[4 * b4 + 3] += w * cv[3]; } }
        __syncthreads();
        LAS float* red = (LAS float*)X.lds;
#pragma unroll
        for (int b = 0; b < 32; ++b) red[(X.wave * 32 + b) * 64 + X.lane] = acc[b];
        __syncthreads();
        for (int i = 0; i < 4; ++i) { const int o = i * NTHREADS + X.tid, b = o >> 6, ln = o & 63; float s = 0.f;
#pragma unroll
            for (int w = 0; w < 8; ++w) s += red[(w * 32 + b) * 64 + ln];
            mod[((size_t)l * NB + b) * 6144 + j0 + ln] = s + ada_b[l * 6144 + j0 + ln]; }
        __syncthreads();
    }
    LAS float* scr = (LAS float*)(X.lds + X.wave * 16384);
    constexpr int I_QKV = 16 * (NQKV / 32), I_O = 16 * 32, I_IN = 16 * (NPROJ / 32), I_GU = 16 * 64, I_D = 16 * 32;
    constexpr int NITEMS = I_QKV + 2 * I_O + I_IN + 64 * I_GU + 64 * I_D;
    for (int it = X.gw; it < NITEMS; it += X.NGW) {
        int r = it;
        if (r < I_QKV) { p0_transpose_item(w_qkv, NQKV, NQKV, 0, Wqkv_t, scr, r, X.lane); continue; } r -= I_QKV;
        if (r < I_O) { p0_transpose_item(w_o0, DM, DM, 0, Wo0_t, scr, r, X.lane); continue; } r -= I_O;
        if (r < I_IN) { p0_transpose_item(w_in, NPROJ_REAL, NPROJ, 0, Win_t, scr, r, X.lane); continue; } r -= I_IN;
        if (r < I_O) { p0_transpose_item(w_o1, DM, DM, 0, Wo1_t, scr, r, X.lane); continue; } r -= I_O;
        if (r < 64 * I_GU) { const int mat = r / I_GU; p0_transpose_item(w_gu + (size_t)mat * DM * 2048, 2048, 2048, 1, Wgu_t + (size_t)mat * 2048 * DM, scr, r - mat * I_GU, X.lane); continue; } r -= 64 * I_GU;
        { const int mat = r / I_D; p0_transpose_item(w_down + (size_t)mat * DM * DM, DM, DM, 0, Wd_t + (size_t)mat * DM * DM, scr, r - mat * I_D, X.lane); }
    }
}

__device__ __forceinline__ void norm_mod_store(const f32x4 (&v)[4], const float* gnorm, const float* modb, int shi, int sci, bf16* hrow, int lane, f32x4 (&h)[4]) {
    float ss = 0.f;
#pragma unroll
    for (int j = 0; j < 4; ++j) ss += (v[j][0] * v[j][0] + v[j][1] * v[j][1]) + (v[j][2] * v[j][2] + v[j][3] * v[j][3]);
    const float rstd = 1.0f / sqrtf(wave_sum(ss) * (1.0f / DM) + EPS);
    GAS u32x2* o8 = (GAS u32x2*)hrow + lane;
#pragma unroll
    for (int j = 0; j < 4; ++j) {
        const f32x4 g4 = ((const GAS f32x4*)gnorm)[64 * j + lane], sc4 = ((const GAS f32x4*)(modb + sci * DM))[64 * j + lane], sh4 = ((const GAS f32x4*)(modb + shi * DM))[64 * j + lane];
        h[j] = (v[j] * rstd) * g4 * (1.0f + sc4) + sh4;
        o8[64 * j] = (u32x2){pk2(h[j][0], h[j][1]), pk2(h[j][2], h[j][3])};
    }
}
__device__ __forceinline__ void phase_norm1(const Ctx& X, const float* xin, const float* gnorm, const float* mod_l, bf16* H) {
    for (int m = X.gw; m < NTOK; m += X.NGW) {
        const GAS f32x4* xr = (const GAS f32x4*)(xin + (size_t)m * DM) + X.lane; f32x4 v[4], h[4];
#pragma unroll
        for (int j = 0; j < 4; ++j) v[j] = xr[64 * j];
        norm_mod_store(v, gnorm, mod_l + (size_t)(m >> 11) * 6144, 0, 1, H + (size_t)m * DM, X.lane, h);
    }
}
__device__ __forceinline__ void moe_tables(const Ctx& X, const unsigned* gcnt, LAS int* cntL, LAS int* tsum) {
    __syncthreads();
    if (X.tid < NE) cntL[X.tid] = (int)__hip_atomic_load(gcnt + X.tid, __ATOMIC_RELAXED, __HIP_MEMORY_SCOPE_AGENT);
    __syncthreads();
    if (X.tid == 0) { int s = 0; for (int e = 0; e < NE; ++e) { tsum[e] = s; s += (cntL[e] + 255) >> 8; } tsum[NE] = s; }
    __syncthreads();
}
__device__ __forceinline__ void phase_combine(const Ctx& X, float* xio, const bf16* Y, const int* tok_e, const int* tok_p, const unsigned* gcnt, const float* mod_l  ,
                                              bool do_norm, const float* gnorm_next, const float* mod_next, bf16* H) {
    LAS int* cntL = (LAS int*)(X.lds + EXTRA_OFF); LAS int* tsum = cntL + 32;
    moe_tables(X, gcnt, cntL, tsum);
    for (int m = X.gw; m < NTOK; m += X.NGW) {
        const int b = m >> 11;
        GAS f32x4* xr = (GAS f32x4*)(xio + (size_t)m * DM) + X.lane; f32x4 v[4], a[4], h[4];
#pragma unroll
        for (int j = 0; j < 4; ++j) { v[j] = xr[64 * j]; a[j] = (f32x4){0.f, 0.f, 0.f, 0.f}; }
#pragma unroll
        for (int k = 0; k < TOPK; ++k) { const int e = tok_e[m * 4 + k], p = tok_p[m * 4 + k]; const GAS u32x2* yr = (const GAS u32x2*)(Y + ((size_t)tsum[e] * 256 + p) * DM) + X.lane;
#pragma unroll
            for (int j = 0; j < 4; ++j) { const u32x2 w = yr[64 * j]; a[j][0] += bflo(w.x); a[j][1] += bfhi(w.x); a[j][2] += bflo(w.y); a[j][3] += bfhi(w.y); } }
#pragma unroll
        for (int j = 0; j < 4; ++j) { const f32x4 g4 = ((const GAS f32x4*)(mod_l + (size_t)b * 6144 + 5 * DM))[64 * j + X.lane]; v[j] = v[j] + g4 * a[j]; xr[64 * j] = v[j]; }
        if (do_norm) norm_mod_store(v, gnorm_next, mod_next + (size_t)b * 6144, 0, 1, H + (size_t)m * DM, X.lane, h);
    }
}
__device__ __forceinline__ void phase_norm2_router(const Ctx& X, const float* xin, const float* gnorm, const float* mod_l, const float* rw, const float* rb, bf16* H,
                                                   int* tok_e, int* tok_p, unsigned* gcnt, int* list, float* gate_e) {
    LAS float* rwT = (LAS float*)X.lds;
    LAS int* cntL = (LAS int*)(X.lds + EXTRA_OFF); LAS int* baseL = cntL + 32; LAS int* selE = baseL + 32; LAS int* selR = selE + 1024; LAS float* selG = (LAS float*)(selR + 1024);
    for (int i = 0; i < 64; ++i) { const int idx = i * NTHREADS + X.tid; rwT[(idx & 31) * DM + (idx >> 5)] = rw[idx]; }
    if (X.tid < NE) cntL[X.tid] = 0;
    __syncthreads();
    const int ntb = (NTOK + X.G - 1) / X.G, t0 = blockIdx.x * ntb;
    const int half = X.lane >> 5, l32 = X.lane & 31;
    for (int it = 0; it < ntb / 16; ++it) {
        const int lt = (it * 8 + X.wave) * 2;
        f32x4 hA[4], hB[4];
        { const int m = t0 + lt; const GAS f32x4* xr = (const GAS f32x4*)(xin + (size_t)m * DM) + X.lane; f32x4 v[4];
#pragma unroll
          for (int j = 0; j < 4; ++j) v[j] = xr[64 * j];
          norm_mod_store(v, gnorm, mod_l + (size_t)(m >> 11) * 6144, 3, 4, H + (size_t)m * DM, X.lane, hA); }
        { const int m = t0 + lt + 1; const GAS f32x4* xr = (const GAS f32x4*)(xin + (size_t)m * DM) + X.lane; f32x4 v[4];
#pragma unroll
          for (int j = 0; j < 4; ++j) v[j] = xr[64 * j];
          norm_mod_store(v, gnorm, mod_l + (size_t)(m >> 11) * 6144, 3, 4, H + (size_t)m * DM, X.lane, hB); }
        float val[64];
#pragma unroll
        for (int e = 0; e < 32; ++e) { float sa = 0.f, sb = 0.f;
#pragma unroll
            for (int j = 0; j < 4; ++j) { const f32x4 w = ((const LAS f32x4*)(rwT + e * DM))[64 * j + X.lane];
                sa += (hA[j][0] * w[0] + hA[j][1] * w[1]) + (hA[j][2] * w[2] + hA[j][3] * w[3]); sb += (hB[j][0] * w[0] + hB[j][1] * w[1]) + (hB[j][2] * w[2] + hB[j][3] * w[3]); }
            val[e] = sa; val[32 + e] = sb; }
#pragma unroll
        for (int s = 0; s < 6; ++s) { const int n = 32 >> s, o = 32 >> s; const bool up = (X.lane & o) != 0;
#pragma unroll
            for (int i = 0; i < n; ++i) { const float a = val[i], b2 = val[i + n]; const float send = up ? a : b2, keep = up ? b2 : a; val[i] = keep + __shfl_xor(send, o); } }
        float logit = val[0] + rb[l32];
        float tv[4]; int te[4]; float cur = logit;
#pragma unroll
        for (int k = 0; k < 4; ++k) { float mx = cur;
#pragma unroll
            for (int o = 16; o >= 1; o >>= 1) mx = fmaxf(mx, __shfl_xor(mx, o));
            const unsigned long long bal = __ballot(cur == mx); const unsigned mine = half ? (unsigned)(bal >> 32) : (unsigned)bal;
            const int e = __ffs(mine) - 1; tv[k] = mx; te[k] = e; if (l32 == e) cur = -INFINITY; }
        const float p1 = __expf(tv[1] - tv[0]), p2 = __expf(tv[2] - tv[0]), p3 = __expf(tv[3] - tv[0]); const float inv = 1.0f / (1.0f + p1 + p2 + p3);
        if (l32 < 4) { const int k = l32; const int e = k == 0 ? te[0] : k == 1 ? te[1] : k == 2 ? te[2] : te[3]; const float gk = (k == 0 ? 1.0f : k == 1 ? p1 : k == 2 ? p2 : p3) * inv;
            const int rank = __hip_atomic_fetch_add(cntL + e, 1, __ATOMIC_RELAXED, __HIP_MEMORY_SCOPE_WORKGROUP);
            const int si = (lt + half) * 4 + k; selE[si] = e; selR[si] = rank; selG[si] = gk; }
    }
    __syncthreads();
    if (X.tid < NE) baseL[X.tid] = (int)__hip_atomic_fetch_add(gcnt + X.tid, (unsigned)cntL[X.tid], __ATOMIC_RELAXED, __HIP_MEMORY_SCOPE_AGENT);
    __syncthreads();
    for (int si = X.tid; si < ntb * 4; si += NTHREADS) { const int e = selE[si], p = baseL[e] + selR[si], m = t0 + (si >> 2);
        tok_e[(size_t)m * 4 + (si & 3)] = e; tok_p[(size_t)m * 4 + (si & 3)] = p; list[(size_t)e * ECAP + p] = m; gate_e[(size_t)e * ECAP + p] = selG[si]; }
    __syncthreads();
}

__device__ __forceinline__ void phase_sb_naive(const Ctx& X, const bf16* QKV, bf16* O) {
    for (int item = blockIdx.x; item < NB * NH * 4; item += X.G) {
        const int b = item >> 6, h = (item >> 2) & 15, t = (item & 3) * 512 + X.tid;
        const GAS u32x4* qp = (const GAS u32x4*)(QKV + ((size_t)(b * SEQ + t)) * NQKV + h * HD);
        float q[64], o[64];
#pragma unroll
        for (int i = 0; i < 8; ++i) { const u32x4 w = qp[i]; q[8 * i] = bflo(w.x); q[8 * i + 1] = bfhi(w.x); q[8 * i + 2] = bflo(w.y); q[8 * i + 3] = bfhi(w.y); q[8 * i + 4] = bflo(w.z); q[8 * i + 5] = bfhi(w.z); q[8 * i + 6] = bflo(w.w); q[8 * i + 7] = bfhi(w.w); }
#pragma unroll
        for (int d = 0; d < 64; ++d) o[d] = 0.f;
        float L = 0.f;
        for (int s = t - 1; s >= 0; --s) {
            const GAS u32x4* kp = (const GAS u32x4*)(QKV + ((size_t)(b * SEQ + s)) * NQKV + DM + h * HD);
            float z = 0.f;
#pragma unroll
            for (int i = 0; i < 8; ++i) { const u32x4 w = kp[i]; z += q[8 * i] * bflo(w.x) + q[8 * i + 1] * bfhi(w.x) + q[8 * i + 2] * bflo(w.y) + q[8 * i + 3] * bfhi(w.y) + q[8 * i + 4] * bflo(w.z) + q[8 * i + 5] * bfhi(w.z) + q[8 * i + 6] * bflo(w.w) + q[8 * i + 7] * bfhi(w.w); }
            const float sp = fmaxf(z, 0.f) + __builtin_amdgcn_logf(1.0f + __builtin_amdgcn_exp2f(-fabsf(z)));
            const float a = __builtin_amdgcn_exp2f(z - sp + L);
            const GAS u32x4* vp = kp + (DM * 2 / 16);
#pragma unroll
            for (int i = 0; i < 8; ++i) { const u32x4 w = vp[i]; o[8 * i] += a * bflo(w.x); o[8 * i + 1] += a * bfhi(w.x); o[8 * i + 2] += a * bflo(w.y); o[8 * i + 3] += a * bfhi(w.y); o[8 * i + 4] += a * bflo(w.z); o[8 * i + 5] += a * bfhi(w.z); o[8 * i + 6] += a * bflo(w.w); o[8 * i + 7] += a * bfhi(w.w); }
            L -= sp;
            if (L < -160.f) break;
        }
        GAS u32x4* op = (GAS u32x4*)(O + ((size_t)(b * SEQ + t)) * DM + h * HD);
#pragma unroll
        for (int i = 0; i < 8; ++i) op[i] = (u32x4){pk2(o[8 * i], o[8 * i + 1]), pk2(o[8 * i + 2], o[8 * i + 3]), pk2(o[8 * i + 4], o[8 * i + 5]), pk2(o[8 * i + 6], o[8 * i + 7])};
    }
}

__device__ __forceinline__ void ld16(const bf16* p, float (&x)[16]) {
    const GAS u32x4* q = (const GAS u32x4*)p; const u32x4 a = q[0], b = q[1];
    x[0] = bflo(a.x); x[1] = bfhi(a.x); x[2] = bflo(a.y); x[3] = bfhi(a.y); x[4] = bflo(a.z); x[5] = bfhi(a.z); x[6] = bflo(a.w); x[7] = bfhi(a.w);
    x[8] = bflo(b.x); x[9] = bfhi(b.x); x[10] = bflo(b.y); x[11] = bfhi(b.y); x[12] = bflo(b.z); x[13] = bfhi(b.z); x[14] = bflo(b.w); x[15] = bfhi(b.w);
}
__device__ __forceinline__ void st16(bf16* p, const float (&x)[16]) {
    GAS u32x4* q = (GAS u32x4*)p;
    q[0] = (u32x4){pk2(x[0], x[1]), pk2(x[2], x[3]), pk2(x[4], x[5]), pk2(x[6], x[7])}; q[1] = (u32x4){pk2(x[8], x[9]), pk2(x[10], x[11]), pk2(x[12], x[13]), pk2(x[14], x[15])};
}
__device__ __forceinline__ void phase_dsa_post(const Ctx& X, const bf16* P, const int* positions, const float* qgain, const float* kgain, bf16* Q1, bf16* K1, bf16* V1, bf16* QI, bf16* KI, float* WI) {
    const int l4 = X.lane & 3;
    float gq[16], gk[16];
#pragma unroll
    for (int i = 0; i < 16; ++i) { gq[i] = qgain[l4 * 16 + i]; gk[i] = kgain[l4 * 16 + i]; }
    for (int m = X.gw; m < NTOK; m += X.NGW) {
        const bf16* pr = P + (size_t)m * NPROJ;
        const float posf = (float)positions[m];
        float cs = 1.f, sn = 0.f;
        { const int i = X.lane & 7; const float inv = expf(-logf(500000.0f) * (2.0f * (float)i / 16.0f)); sincosf(posf * inv, &sn, &cs); }
        float cz[8], sz[8];
#pragma unroll
        for (int i = 0; i < 8; ++i) { cz[i] = __shfl(cs, i); sz[i] = __shfl(sn, i); }
        float x[16];
        ld16(pr + X.lane * 16, x);
        { float ss = 0.f;
#pragma unroll
          for (int i = 0; i < 16; ++i) ss += x[i] * x[i];
          ss += __shfl_xor(ss, 1); ss += __shfl_xor(ss, 2);
          const float r = 1.0f / sqrtf(ss * (1.0f / 64.0f) + EPS);
#pragma unroll
          for (int i = 0; i < 16; ++i) x[i] = x[i] * r * gq[i];
          if (l4 == 0) {
#pragma unroll
              for (int i = 0; i < 8; ++i) { const float a = x[i], b2 = x[i + 8]; x[i] = a * cz[i] - b2 * sz[i]; x[i + 8] = b2 * cz[i] + a * sz[i]; } }
#pragma unroll
          for (int i = 0; i < 16; ++i) x[i] *= QSCALE;
          st16(Q1 + (size_t)m * DM + X.lane * 16, x); }
        if (X.lane < 16) { ld16(pr + DM + X.lane * 16, x);
            if (X.lane < 8) { float ss = 0.f;
#pragma unroll
                for (int i = 0; i < 16; ++i) ss += x[i] * x[i];
                ss += __shfl_xor(ss, 1); ss += __shfl_xor(ss, 2);
                const float r = 1.0f / sqrtf(ss * (1.0f / 64.0f) + EPS);
#pragma unroll
                for (int i = 0; i < 16; ++i) x[i] = x[i] * r * gk[i];
                if (l4 == 0) {
#pragma unroll
                    for (int i = 0; i < 8; ++i) { const float a = x[i], b2 = x[i + 8]; x[i] = a * cz[i] - b2 * sz[i]; x[i + 8] = b2 * cz[i] + a * sz[i]; } }
                st16(K1 + (size_t)m * 128 + X.lane * 16, x);
            } else st16(V1 + (size_t)m * 128 + (X.lane - 8) * 16, x); }
        if (X.lane < 36) { ld16(pr + 1280 + X.lane * 16, x);
            if (l4 == 0) {
#pragma unroll
                for (int i = 0; i < 8; ++i) { const float a = x[i], b2 = x[i + 8]; x[i] = a * cz[i] - b2 * sz[i]; x[i + 8] = b2 * cz[i] + a * sz[i]; } }
            if (X.lane < 32) st16(QI + (size_t)m * 512 + X.lane * 16, x); else st16(KI + (size_t)m * 64 + (X.lane - 32) * 16, x); }
        if (X.lane < 8) WI[(size_t)m * 8 + X.lane] = bflo((unsigned)pr[1856 + X.lane]) * (0.35355339059327373f * 0.125f);
    }
}
__device__ __forceinline__ void phase_idx_naive(const Ctx& X, const bf16* QI, const bf16* KI, const float* WI, float* SC) {
    LAS float* qs = (LAS float*)X.lds;
    const int ntb = NTOK / X.G;
    for (int i = 0; i < ntb; ++i) {
        const int m = blockIdx.x * ntb + i, b = m >> 11, t = m & 2047, nadm = 64 * ((t >> 6) + 1);
        __syncthreads();
        qs[X.tid] = bflo((unsigned)QI[(size_t)m * 512 + X.tid]); if (X.tid < 8) qs[512 + X.tid] = WI[(size_t)m * 8 + X.tid];
        __syncthreads();
        for (int s = X.tid; s < nadm; s += NTHREADS) {
            const GAS u32x4* kp = (const GAS u32x4*)(KI + ((size_t)(b * SEQ + s)) * 64); float k[64];
#pragma unroll
            for (int j = 0; j < 8; ++j) { const u32x4 w = kp[j]; k[8 * j] = bflo(w.x); k[8 * j + 1] = bfhi(w.x); k[8 * j + 2] = bflo(w.y); k[8 * j + 3] = bfhi(w.y); k[8 * j + 4] = bflo(w.z); k[8 * j + 5] = bfhi(w.z); k[8 * j + 6] = bflo(w.w); k[8 * j + 7] = bfhi(w.w); }
            float sc = 0.f;
#pragma unroll 1
            for (int hh = 0; hh < 8; ++hh) { float d = 0.f; asm volatile("" ::: "memory");
#pragma unroll
                for (int j = 0; j < 16; ++j) { const f32x4 q4 = ((const LAS f32x4*)(qs + hh * 64))[j]; d += (q4[0] * k[4 * j] + q4[1] * k[4 * j + 1]) + (q4[2] * k[4 * j + 2] + q4[3] * k[4 * j + 3]); }
                sc += qs[512 + hh] * fmaxf(d, 0.f); }
            SC[(size_t)m * SEQ + s] = sc;
        }
    }
}
__device__ __forceinline__ unsigned ord_key(float x) { const unsigned u = __float_as_uint(x); return (u & 0x80000000u) ? ~u : (u | 0x80000000u); }
__device__ __forceinline__ void topk_select_store(const unsigned (&key)[32], int c, unsigned long long* maskrow, int lane) {
    unsigned long long mine = ~0ull;
    if (c >= 4) {
        unsigned T = 0u;
        for (int bit = 31; bit >= 0; --bit) { const unsigned cand = T | (1u << bit); int cnt = 0;
#pragma unroll
            for (int m = 0; m < 32; ++m) if (m <= c) cnt += __popcll(__ballot(key[m] >= cand));
            if (cnt >= 256) T = cand; }
        int gt = 0;
#pragma unroll
        for (int m = 0; m < 32; ++m) if (m <= c) gt += __popcll(__ballot(key[m] > T));
        int need = 256 - gt;
#pragma unroll
        for (int m = 0; m < 32; ++m) if (m <= c) {
            unsigned long long eq = __ballot(key[m] == T); const unsigned long long g = __ballot(key[m] > T);
            int pe = __popcll(eq);
            while (pe > need) { eq &= ~(1ull << (63 - __clzll(eq))); --pe; }
            need -= pe;
            if (lane == m) mine = g | eq; }
    }
    if (lane <= c) maskrow[lane] = mine;
}
__device__ __forceinline__ void phase_topk_naive(const Ctx& X, const float* SC, unsigned long long* MASK) {
    for (int m = X.gw; m < NTOK; m += X.NGW) {
        const int c = (m & 2047) >> 6; unsigned key[32];
#pragma unroll
        for (int j = 0; j < 32; ++j) key[j] = (j <= c) ? ord_key(SC[(size_t)m * SEQ + j * 64 + X.lane]) : 0u;
        topk_select_store(key, c, MASK + (size_t)m * 32, X.lane);
    }
}
__device__ __forceinline__ void phase_sparse_naive(const Ctx& X, const bf16* Q1, const bf16* K1, const bf16* V1, const unsigned long long* MASK, bf16* O) {
    for (int item = blockIdx.x; item < NTOK / 32; item += X.G) {
        const int m = item * 32 + (X.tid >> 4), h = X.tid & 15, g = h >> 3, b = m >> 11, c = (m & 2047) >> 6;
        const GAS u32x4* qp = (const GAS u32x4*)(Q1 + (size_t)m * DM + h * HD);
        float q[64], o[64];
#pragma unroll
        for (int i = 0; i < 8; ++i) { const u32x4 w = qp[i]; q[8 * i] = bflo(w.x); q[8 * i + 1] = bfhi(w.x); q[8 * i + 2] = bflo(w.y); q[8 * i + 3] = bfhi(w.y); q[8 * i + 4] = bflo(w.z); q[8 * i + 5] = bfhi(w.z); q[8 * i + 6] = bflo(w.w); q[8 * i + 7] = bfhi(w.w); }
#pragma unroll
        for (int d = 0; d < 64; ++d) o[d] = 0.f;
        float mx = -1e30f, l = 0.f;
        for (int j = 0; j <= c; ++j) {
            unsigned long long bits = MASK[(size_t)m * 32 + j];
            while (bits) { const int s = j * 64 + __ffsll((long long)bits) - 1; bits &= bits - 1;
                const GAS u32x4* kp = (const GAS u32x4*)(K1 + ((size_t)(b * SEQ + s)) * 128 + g * HD); float z = 0.f;
#pragma unroll
                for (int i = 0; i < 8; ++i) { const u32x4 w = kp[i]; z += q[8 * i] * bflo(w.x) + q[8 * i + 1] * bfhi(w.x) + q[8 * i + 2] * bflo(w.y) + q[8 * i + 3] * bfhi(w.y) + q[8 * i + 4] * bflo(w.z) + q[8 * i + 5] * bfhi(w.z) + q[8 * i + 6] * bflo(w.w) + q[8 * i + 7] * bfhi(w.w); }
                const float mn = fmaxf(mx, z), f = __builtin_amdgcn_exp2f(mx - mn), p = __builtin_amdgcn_exp2f(z - mn); mx = mn; l = l * f + p;
                const GAS u32x4* vp = (const GAS u32x4*)(V1 + ((size_t)(b * SEQ + s)) * 128 + g * HD);
#pragma unroll
                for (int i = 0; i < 8; ++i) { const u32x4 w = vp[i]; o[8 * i] = o[8 * i] * f + p * bflo(w.x); o[8 * i + 1] = o[8 * i + 1] * f + p * bfhi(w.x); o[8 * i + 2] = o[8 * i + 2] * f + p * bflo(w.y); o[8 * i + 3] = o[8 * i + 3] * f + p * bfhi(w.y);
                    o[8 * i + 4] = o[8 * i + 4] * f + p * bflo(w.z); o[8 * i + 5] = o[8 * i + 5] * f + p * bfhi(w.z); o[8 * i + 6] = o[8 * i + 6] * f + p * bflo(w.w); o[8 * i + 7] = o[8 * i + 7] * f + p * bfhi(w.w); }
            }
        }
        const float il = 1.0f / l;
        GAS u32x4* op = (GAS u32x4*)(O + (size_t)m * DM + h * HD);
#pragma unroll
        for (int i = 0; i < 8; ++i) op[i] = (u32x4){pk2(o[8 * i] * il, o[8 * i + 1] * il), pk2(o[8 * i + 2] * il, o[8 * i + 3] * il), pk2(o[8 * i + 4] * il, o[8 * i + 5] * il), pk2(o[8 * i + 6] * il, o[8 * i + 7] * il)};
    }
}

#ifndef MK_N_LAUNCHES
#define MK_N_LAUNCHES 1
#endif
constexpr int NPHASES = 19;
struct Args { const void* in[19]; float* out; unsigned char* ws; int ph_lo, ph_hi; };
static_assert(sizeof(Args) == 19 * 8 + 8 + 8 + 8, "Args has no padding");

__device__ __forceinline__ void moe_gemms_gu(const Ctx& X, const bf16* H, const bf16* Wgu_l, const float* bgu_l, bf16* ACT, const unsigned* gcnt, const int* list) {
    LAS int* cntL = (LAS int*)(X.lds + EXTRA_OFF); LAS int* tsum = cntL + 32;
    moe_tables(X, gcnt, cntL, tsum);
    pg8::Gemm g{H, Wgu_l, DM, (size_t)2048 * DM * 2};
    pg8::MoeOrder S{tsum, cntL, list, 8, X.G, (int)blockIdx.x, tsum[NE] * 8};
    pg8::EpiSwiglu E{ACT, bgu_l};
    pg8::gemm_phase<pg8::EpiSwiglu, pg8::MoeOrder, true, true>(X.lds, g, S, E);
}
__device__ __forceinline__ void moe_gemms_down(const Ctx& X, const bf16* ACT, const bf16* Wd_l, const float* bd_l, bf16* Y, const unsigned* gcnt, const int* list, const float* gate_e) {
    LAS int* cntL = (LAS int*)(X.lds + EXTRA_OFF); LAS int* tsum = cntL + 32;
    moe_tables(X, gcnt, cntL, tsum);
    pg8::Gemm g{ACT, Wd_l, DM, (size_t)DM * DM * 2};
    pg8::MoeOrder S{tsum, cntL, list, 4, X.G, (int)blockIdx.x, tsum[NE] * 4};
    pg8::EpiDown E{Y, bd_l, gate_e, tsum};
    pg8::gemm_phase<pg8::EpiDown, pg8::MoeOrder, false, true>(X.lds, g, S, E);
}

__global__ void __launch_bounds__(NTHREADS, 2) mk_fwd(Args a) {
    extern __shared__ __attribute__((aligned(16))) unsigned char lds_raw[];
    Ctx X; X.lds = (LAS unsigned char*)lds_raw; X.tid = threadIdx.x; X.lane = X.tid & 63; X.wave = __builtin_amdgcn_readfirstlane(X.tid >> 6);
    X.G = gridDim.x; { const int bx = blockIdx.x; X.vcu = (X.G % 8 == 0) ? (bx % 8) * (X.G / 8) + bx / 8 : bx; }
    X.gw = X.vcu * NWAVES + X.wave; X.NGW = X.G * NWAVES;
    volatile LAS unsigned* MISC = (volatile LAS unsigned*)(X.lds + LDSCTL_OFF);
    for (int u = X.tid; u < 256; u += NTHREADS) MISC[u] = 0u;
    __syncthreads();
    unsigned char* ws = a.ws;
    unsigned* ctl = (unsigned*)(ws + WS_CTL);
    XcdBarrier bar = xcd_barrier_post(ctl + CW_BAR, MISC + 8);
    const int lo = a.ph_lo, hi = a.ph_hi;
#ifndef ONLY_PHASE
#define ONLY_PHASE -1
#endif
#define IN(k) ((ONLY_PHASE < 0 || ONLY_PHASE == (k)) && lo <= (k) && (k) < hi)
#define SEAM(k) do { if (IN(k) && IN((k) + 1)) xcd_barrier(bar); } while (0)
    const float* x_in = (const float*)a.in[0]; const float* c_in = (const float*)a.in[1]; const int* positions = (const int*)a.in[2];
    const float* ada_w = (const float*)a.in[3]; const float* ada_b = (const float*)a.in[4]; const float* norm1_g = (const float*)a.in[5]; const float* norm2_g = (const float*)a.in[6];
    const float* sb_w_qkv = (const float*)a.in[7]; const float* sb_w_o = (const float*)a.in[8]; const float* dsa_w_in = (const float*)a.in[9];
    const float* dsa_q_gain = (const float*)a.in[10]; const float* dsa_k_gain = (const float*)a.in[11]; const float* dsa_w_o = (const float*)a.in[12];
    const float* router_w = (const float*)a.in[13]; const float* router_b = (const float*)a.in[14];
    const float* exp_w_gu = (const float*)a.in[15]; const float* exp_b_gu = (const float*)a.in[16]; const float* exp_w_down = (const float*)a.in[17]; const float* exp_b_down = (const float*)a.in[18];
    float* out = a.out;
    float* mod = (float*)(ws + WS_MOD);
    bf16* Wqkv_t = (bf16*)(ws + WS_WQKV); bf16* Wo0_t = (bf16*)(ws + WS_WO0); bf16* Win_t = (bf16*)(ws + WS_WIN); bf16* Wo1_t = (bf16*)(ws + WS_WO1); bf16* Wgu_t = (bf16*)(ws + WS_WGU); bf16* Wd_t = (bf16*)(ws + WS_WD);
    bf16* H = (bf16*)(ws + WS_H); bf16* QKV = (bf16*)(ws + WS_QKV); bf16* ACT = (bf16*)(ws + WS_A); bf16* Y = (bf16*)(ws + WS_B); bf16* O = (bf16*)(ws + WS_O);
    bf16* PRAW = (bf16*)(ws + WS_PRAW); bf16* Q1 = (bf16*)(ws + WS_Q1); bf16* K1 = (bf16*)(ws + WS_K1); bf16* V1 = (bf16*)(ws + WS_V1); bf16* QI = (bf16*)(ws + WS_QI); bf16* KI = (bf16*)(ws + WS_KI); float* WI = (float*)(ws + WS_WI);
    unsigned long long* MASK = (unsigned long long*)(ws + WS_MASK); float* SC = (float*)(ws + WS_SC);
    int* tok_e = (int*)(ws + WS_TOKE); int* tok_p = (int*)(ws + WS_TOKP); int* list = (int*)(ws + WS_LIST); float* gate_e = (float*)(ws + WS_GATE);
    unsigned* gcnt0 = ctl + CW_CNT; unsigned* gcnt1 = ctl + CW_CNT + 32;
    const float* mod0 = mod; const float* mod1 = mod + (size_t)NB * 6144;

    if (IN(0)) { phase_prologue(X, c_in, ada_w, ada_b, mod, sb_w_qkv, sb_w_o, dsa_w_in, dsa_w_o, exp_w_gu, exp_w_down, Wqkv_t, Wo0_t, Win_t, Wo1_t, Wgu_t, Wd_t); SEAM(0); }
    if (IN(1)) { phase_norm1(X, x_in, norm1_g, mod0, H); SEAM(1); }
    if (IN(2)) { pg8::Gemm g{H, Wqkv_t, DM, 0}; pg8::StaticOrder S; S.init(NTOK, NQKV, X.G, (int)blockIdx.x); pg8::EpiBf16S E{QKV, NQKV, DM, QSCALE};
        pg8::gemm_phase<pg8::EpiBf16S, pg8::StaticOrder, false, true>(X.lds, g, S, E); SEAM(2); }
    if (IN(3)) { phase_sb_naive(X, QKV, O); SEAM(3); }
    if (IN(4)) { pg8::Gemm g{O, Wo0_t, DM, 0}; pg8::StaticOrder S; S.init(NTOK, DM, X.G, (int)blockIdx.x); pg8::EpiResid E{x_in, out, mod0 + 2 * DM};
        pg8::gemm_phase<pg8::EpiResid, pg8::StaticOrder, false, true>(X.lds, g, S, E); SEAM(4); }
    if (IN(5)) { phase_norm2_router(X, out, norm2_g, mod0, router_w, router_b, H, tok_e, tok_p, gcnt0, list, gate_e); SEAM(5); }
    if (IN(6)) { moe_gemms_gu(X, H, Wgu_t, exp_b_gu, ACT, gcnt0, list); SEAM(6); }
    if (IN(7)) { moe_gemms_down(X, ACT, Wd_t, exp_b_down, Y, gcnt0, list, gate_e); SEAM(7); }
    if (IN(8)) { phase_combine(X, out, Y, tok_e, tok_p, gcnt0, mod0, true, norm1_g + DM, mod1, H); SEAM(8); }
    if (IN(9)) { pg8::Gemm g{H, Win_t, DM, 0}; pg8::StaticOrder S; S.init(NTOK, NPROJ, X.G, (int)blockIdx.x); pg8::EpiBf16S E{PRAW, NPROJ, 0, 1.0f};
        pg8::gemm_phase<pg8::EpiBf16S, pg8::StaticOrder, false, true>(X.lds, g, S, E); SEAM(9); }
    if (IN(10)) { phase_dsa_post(X, PRAW, positions, dsa_q_gain, dsa_k_gain, Q1, K1, V1, QI, KI, WI); SEAM(10); }
    if (IN(11)) { phase_idx_naive(X, QI, KI, WI, SC); SEAM(11); }
    if (IN(12)) { phase_topk_naive(X, SC, MASK); SEAM(12); }
    if (IN(13)) { phase_sparse_naive(X, Q1, K1, V1, MASK, O); SEAM(13); }
    if (IN(14)) { pg8::Gemm g{O, Wo1_t, DM, 0}; pg8::StaticOrder S; S.init(NTOK, DM, X.G, (int)blockIdx.x); pg8::EpiResid E{out, out, mod1 + 2 * DM};
        pg8::gemm_phase<pg8::EpiResid, pg8::StaticOrder, false, true>(X.lds, g, S, E); SEAM(14); }
    if (IN(15)) { phase_norm2_router(X, out, norm2_g + DM, mod1, router_w + (size_t)DM * NE, router_b + NE, H, tok_e, tok_p, gcnt1, list, gate_e); SEAM(15); }
    if (IN(16)) { moe_gemms_gu(X, H, Wgu_t + (size_t)NE * 2048 * DM, exp_b_gu + (size_t)NE * 2048, ACT, gcnt1, list); SEAM(16); }
    if (IN(17)) { moe_gemms_down(X, ACT, Wd_t + (size_t)NE * DM * DM, exp_b_down + (size_t)NE * DM, Y, gcnt1, list, gate_e); SEAM(17); }
    if (IN(18)) { phase_combine(X, out, Y, tok_e, tok_p, gcnt1, mod1, false, nullptr, nullptr, nullptr); }
#undef IN
#undef SEAM
}

extern "C" void kernel_launch(void* const* d_in, const int* in_sizes, int n_in, void* d_out, int out_size, void* d_ws, size_t ws_size, hipStream_t stream) {
    static int grid = 0;
    if (grid == 0) {
        if (n_in != 19 || out_size != NTOK * DM || ws_size < WS_END) { fprintf(stderr, "kernel_launch: unexpected shapes (n_in %d, out %d, ws %zu < %zu)\n", n_in, out_size, ws_size, (size_t)WS_END); grid = -1; return; }
        int dev = 0, cus = 0, per_cu = 0;
        if (hipGetDevice(&dev) != hipSuccess || hipDeviceGetAttribute(&cus, hipDeviceAttributeMultiprocessorCount, dev) != hipSuccess) { grid = -1; return; }
        if (hipFuncSetAttribute((const void*)mk_fwd, hipFuncAttributeMaxDynamicSharedMemorySize, LDS_BYTES) != hipSuccess) { fprintf(stderr, "kernel_launch: hipFuncSetAttribute failed\n"); grid = -1; return; }
        if (hipOccupancyMaxActiveBlocksPerMultiprocessor(&per_cu, (const void*)mk_fwd, NTHREADS, LDS_BYTES) != hipSuccess || per_cu < 1)
            fprintf(stderr, "kernel_launch: occupancy query reports %d workgroups per CU\n", per_cu);
        (void)hipGetLastError();
        grid = cus;
    }
    if (grid < 0) return;
    if (hipMemsetAsync((char*)d_ws + WS_CTL, 0, CTL_ZERO_BYTES, stream) != hipSuccess) return;
    Args a{};
    for (int i = 0; i < 19; ++i) a.in[i] = d_in[i];
    a.out = (float*)d_out; a.ws = (unsigned char*)d_ws;
#if MK_N_LAUNCHES == 1
    a.ph_lo = 0; a.ph_hi = NPHASES;
    hipLaunchKernelGGL(mk_fwd, dim3(grid), dim3(NTHREADS), LDS_BYTES, stream, a);
#else
    for (int p = 0; p < NPHASES; ++p) { a.ph_lo = p; a.ph_hi = p + 1; hipLaunchKernelGGL(mk_fwd, dim3(grid), dim3(NTHREADS), LDS_BYTES, stream, a); }
#endif
}
```

```cpp
#include <hip/hip_runtime.h>
#include <cstdio>
#include <cstdint>

#define GAS __attribute__((address_space(1)))
#define LAS __attribute__((address_space(3)))
typedef unsigned short bf16;
typedef short bf16x8 __attribute__((ext_vector_type(8)));
typedef float f32x4 __attribute__((ext_vector_type(4)));
typedef float f32x2 __attribute__((ext_vector_type(2)));
typedef unsigned u32x4 __attribute__((ext_vector_type(4)));
typedef unsigned u32x2 __attribute__((ext_vector_type(2)));
typedef GAS unsigned gu32;

constexpr int DM = 1024, NB = 32, SEQ = 2048, NTOK = NB * SEQ, NE = 32, TOPK = 4, HD = 64, NH = 16;
constexpr int NQKV = 3072, NPROJ = 2048, NPROJ_REAL = 1864;
constexpr int ECAP = 65536;
constexpr int MOE_ROWS = NTOK * TOPK + NE * 256;
constexpr float EPS = 1e-6f;
constexpr float LOG2E = 1.4426950408889634f;
constexpr float QSCALE = 0.125f * LOG2E;
constexpr int NWAVES = 8, NTHREADS = 512;

constexpr size_t MiB = (size_t)1 << 20;
constexpr size_t WS_CTL = 0, CTL_ZERO_BYTES = 1 * MiB;
constexpr size_t WS_MOD = 1 * MiB;
constexpr size_t WS_WQKV = 3 * MiB, WS_WO0 = 9 * MiB, WS_WIN = 11 * MiB, WS_WO1 = 15 * MiB, WS_WGU = 17 * MiB, WS_WD = 273 * MiB;
constexpr size_t WS_H = 402 * MiB;
constexpr size_t WS_A = 530 * MiB;
constexpr size_t WS_QKV = WS_A, WS_PRAW = WS_A, WS_Q1 = 786 * MiB, WS_K1 = 914 * MiB, WS_V1 = 930 * MiB, WS_QI = 946 * MiB, WS_KI = 1010 * MiB, WS_WI = 1018 * MiB;
constexpr size_t WS_B = 1058 * MiB;
constexpr size_t WS_O = WS_B, WS_MASK = 1186 * MiB, WS_SC = 1202 * MiB;
constexpr size_t WS_TOKE = 1720 * MiB, WS_TOKP = 1721 * MiB, WS_TOKG = 1722 * MiB, WS_LIST = 1724 * MiB, WS_GATE = 1732 * MiB, WS_END = 1740 * MiB;
static_assert(WS_A + (size_t)MOE_ROWS * DM * 2 <= WS_B && WS_B + (size_t)MOE_ROWS * DM * 2 <= WS_TOKE && WS_SC + (size_t)NTOK * SEQ * 4 <= WS_TOKE, "ws map");
constexpr int CW_TMO = 0, CW_BAR = 4096, CW_CNT = 8192;

constexpr int RING_BYTES = 131072;
constexpr int LDSCTL_OFF = RING_BYTES;
constexpr int EXTRA_OFF = RING_BYTES + 1024;
constexpr int LDS_BYTES = 163840;

#define LDS_WAIT() asm volatile("s_waitcnt lgkmcnt(0)" ::: "memory")
#define VM_WAIT() asm volatile("s_waitcnt vmcnt(0)" ::: "memory")
__device__ __forceinline__ unsigned f2bf(float f) { unsigned u = __builtin_bit_cast(unsigned, f); return (u + 0x7fffu + ((u >> 16) & 1u)) >> 16; }
__device__ __forceinline__ unsigned pk2(float lo, float hi) { return f2bf(lo) | (f2bf(hi) << 16); }
__device__ __forceinline__ float bflo(unsigned w) { return __uint_as_float(w << 16); }
__device__ __forceinline__ float bfhi(unsigned w) { return __uint_as_float(w & 0xffff0000u); }
__device__ __forceinline__ float wave_sum(float v) {
#pragma unroll
    for (int o = 1; o < 64; o <<= 1) v += __shfl_xor(v, o);
    return v;
}

namespace pg8 {
constexpr int BM = 256, BK = 64, HALF = 128, HTB = HALF * BK * 2, NXCD = 8, WGM = 8;
__host__ __device__ __forceinline__ int lds_byte(int r, int c) { const int st = (r >> 4) * 2 + (c >> 5), rr = r & 15, cc = c & 31, ob = rr * 64 + cc * 2; return st * 1024 + (ob ^ (((ob >> 9) & 1) << 5)); }
__host__ __device__ __forceinline__ void stage_rc(int b, int& R, int& C) { const int st = b / 1024, sb = b % 1024, swz = sb ^ (((sb >> 9) & 1) << 5); R = (st >> 1) * 16 + swz / 64; C = (st & 1) * 32 + (swz % 64) / 2; }
__host__ __device__ __forceinline__ int perm32(int rho) { const int n = rho >> 4, i = rho & 15; return 8 * (i >> 2) + 4 * n + (i & 3); }

struct Unit { int pm, pn, e; };
struct Gemm { const bf16* A; const bf16* Bt; int K; size_t bstride; };

struct StaticOrder {
    int nM, nN, nwg, G, c;
    __device__ void init(int M, int N, int G_, int c_) { nM = M / BM; nN = N / BM; nwg = nM * nN; G = G_; c = c_; }
    __device__ bool next(int i, Unit& u) const {
        const long L = (long)i * G + c; if (L >= nwg) return false;
        int wgid = (int)L; { const int q = nwg / NXCD, r = nwg % NXCD, xcd = wgid % NXCD, off = wgid / NXCD; wgid = (xcd < r ? xcd * (q + 1) : r * (q + 1) + (xcd - r) * q) + off; }
        const int nig = WGM * nN, gid = wgid / nig, fm = gid * WGM, gsz = (nM - fm) < WGM ? (nM - fm) : WGM;
        u.pm = fm + ((wgid % nig) % gsz); u.pn = (wgid % nig) / gsz; u.e = 0; return true;
    }
    __device__ __forceinline__ int arow(const Unit&, int) const { return 0; }
};
struct MoeOrder {
    const LAS int* tsum; const LAS int* cnt; const int* list; int nN, G, c, total;
    __device__ bool next(int i, Unit& u) const {
        const int L = i * G + (c & 7) * (G >> 3) + (c >> 3); if (L >= total) return false;
        const int tile = L / nN; u.pn = L - tile * nN;
        int e = 0; while (tile >= tsum[e + 1]) ++e;
        u.e = e; u.pm = tile; return true;
    }
    __device__ __forceinline__ int arow(const Unit& u, int r) const {
        int p = (u.pm - tsum[u.e]) * BM + r; const int c_ = cnt[u.e]; p = p < c_ ? p : c_ - 1; return list[(size_t)u.e * ECAP + p];
    }
};

__device__ __forceinline__ unsigned cvt_pk_bf16(float lo, float hi) { unsigned r; asm volatile("v_cvt_pk_bf16_f32 %0, %1, %2" : "=v"(r) : "v"(lo), "v"(hi)); return r; }

struct EpiBf16S {
    static constexpr bool PERM = true;
    bf16* O; int ldc; int scale_cols; float scale0;
    __device__ __forceinline__ void operator()(const f32x4 (&acc)[2][2][4][2], const Unit& u, int wr, int wc, int fr, int fq) const {
        const int row0 = u.pm * BM + wr * 64 + fr, col0 = u.pn * BM + wc * 32 + 8 * fq; const float sc = (u.pn * BM < scale_cols) ? scale0 : 1.f;
#pragma unroll
        for (int ai = 0; ai < 2; ++ai)
#pragma unroll
            for (int m = 0; m < 4; ++m) { bf16* rowp = O + (size_t)(row0 + ai * HALF + m * 16) * ldc + col0;
#pragma unroll
                for (int bj = 0; bj < 2; ++bj) { const f32x4 v0 = acc[ai][bj][m][0] * sc, v1 = acc[ai][bj][m][1] * sc;
                    u32x4 w; w.x = cvt_pk_bf16(v0[0], v0[1]); w.y = cvt_pk_bf16(v0[2], v0[3]); w.z = cvt_pk_bf16(v1[0], v1[1]); w.w = cvt_pk_bf16(v1[2], v1[3]);
                    *(GAS u32x4*)(rowp + bj * HALF) = w; } }
    }
};
struct EpiResid {
    static constexpr bool PERM = false;
    const float* xin; float* out; const float* gate;
    __device__ __forceinline__ void operator()(const f32x4 (&acc)[2][2][4][2], const Unit& u, int wr, int wc, int fr, int fq) const {
        const int row0 = u.pm * BM + wr * 64 + fr, b = u.pm >> 3, col0 = u.pn * BM + wc * 32 + 4 * fq;
#pragma unroll
        for (int bj = 0; bj < 2; ++bj)
#pragma unroll
            for (int n = 0; n < 2; ++n) { const int c = col0 + bj * HALF + 16 * n; const f32x4 g4 = *(const GAS f32x4*)(gate + (size_t)b * 6144 + c);
#pragma unroll
                for (int ai = 0; ai < 2; ++ai)
#pragma unroll
                    for (int m = 0; m < 4; ++m) { const size_t o = (size_t)(row0 + ai * HALF + m * 16) * DM + c; const f32x4 x4 = *(const GAS f32x4*)(xin + o); *(GAS f32x4*)(out + o) = x4 + g4 * acc[ai][bj][m][n]; } }
    }
};
__device__ __forceinline__ float swiglu1(float g, float u) {
    g = fminf(g, 7.0f); u = fminf(fmaxf(u, -7.0f), 7.0f);
    const float e = __builtin_amdgcn_exp2f(g * (-1.702f * LOG2E));
    return (u + 1.0f) * g * __builtin_amdgcn_rcpf(1.0f + e);
}
struct EpiSwiglu {
    static constexpr bool PERM = true;
    bf16* ACT; const float* bgu;
    __device__ __forceinline__ void operator()(const f32x4 (&acc)[2][2][4][2], const Unit& u, int wr, int wc, int fr, int fq) const {
        const int row0 = u.pm * BM + wr * 64 + fr, jl0 = wc * 32 + 8 * fq, colA = u.pn * HALF + jl0;
        const GAS f32x4* bp = (const GAS f32x4*)(bgu + (size_t)u.e * 2048 + 2 * (u.pn * HALF + jl0));
        const f32x4 b0 = bp[0], b1 = bp[1], b2 = bp[2], b3 = bp[3];
        const f32x4 bg[2] = {(f32x4){b0[0], b0[2], b1[0], b1[2]}, (f32x4){b2[0], b2[2], b3[0], b3[2]}};
        const f32x4 bu[2] = {(f32x4){b0[1], b0[3], b1[1], b1[3]}, (f32x4){b2[1], b2[3], b3[1], b3[3]}};
#pragma unroll
        for (int ai = 0; ai < 2; ++ai)
#pragma unroll
            for (int m = 0; m < 4; ++m) { float o[8];
#pragma unroll
                for (int n = 0; n < 2; ++n) { const f32x4 g4 = acc[ai][0][m][n] + bg[n], u4 = acc[ai][1][m][n] + bu[n];
#pragma unroll
                    for (int i = 0; i < 4; ++i) o[4 * n + i] = swiglu1(g4[i], u4[i]); }
                u32x4 w; w.x = cvt_pk_bf16(o[0], o[1]); w.y = cvt_pk_bf16(o[2], o[3]); w.z = cvt_pk_bf16(o[4], o[5]); w.w = cvt_pk_bf16(o[6], o[7]);
                *(GAS u32x4*)(ACT + (size_t)(row0 + ai * HALF + m * 16) * DM + colA) = w; }
    }
};
struct EpiDown {
    static constexpr bool PERM = true;
    bf16* Y; const float* bd; const float* gate_e; const LAS int* tsum;
    __device__ __forceinline__ void operator()(const f32x4 (&acc)[2][2][4][2], const Unit& u, int wr, int wc, int fr, int fq) const {
        const int row0 = u.pm * BM + wr * 64 + fr, col0 = u.pn * BM + wc * 32 + 8 * fq, lrow0 = (u.pm - tsum[u.e]) * BM + wr * 64 + fr;
        f32x4 bv[2][2];
#pragma unroll
        for (int bj = 0; bj < 2; ++bj)
#pragma unroll
            for (int n = 0; n < 2; ++n) bv[bj][n] = *(const GAS f32x4*)(bd + (size_t)u.e * DM + col0 + bj * HALF + 4 * n);
#pragma unroll
        for (int ai = 0; ai < 2; ++ai)
#pragma unroll
            for (int m = 0; m < 4; ++m) { const float gt = gate_e[(size_t)u.e * ECAP + lrow0 + ai * HALF + m * 16]; bf16* rowp = Y + (size_t)(row0 + ai * HALF + m * 16) * DM + col0;
#pragma unroll
                for (int bj = 0; bj < 2; ++bj) { const f32x4 v0 = (acc[ai][bj][m][0] + bv[bj][0]) * gt, v1 = (acc[ai][bj][m][1] + bv[bj][1]) * gt;
                    u32x4 w; w.x = cvt_pk_bf16(v0[0], v0[1]); w.y = cvt_pk_bf16(v0[2], v0[3]); w.z = cvt_pk_bf16(v1[0], v1[1]); w.w = cvt_pk_bf16(v1[2], v1[3]);
                    *(GAS u32x4*)(rowp + bj * HALF) = w; } }
    }
};

template <class Epi, class Sched, bool GATHER, bool ALIGN_EPI>
__device__ __forceinline__ void gemm_phase(LAS unsigned char* lds, const Gemm g, const Sched& S, const Epi& E) {
    const int tid = threadIdx.x, wid = __builtin_amdgcn_readfirstlane(tid >> 6), lane = tid & 63, wr = wid >> 2, wc = wid & 3, fr = lane & 15, fq = lane >> 4;
    const int K = g.K, nt = K / BK;
    int Rr[2], Cc[2]; unsigned voffB[2];
#pragma unroll
    for (int i = 0; i < 2; ++i) { stage_rc(tid * 16 + i * 8192, Rr[i], Cc[i]); const int Rb = Epi::PERM ? ((Rr[i] & ~31) + perm32(Rr[i] & 31)) : Rr[i]; voffB[i] = (unsigned)(Rb * K + Cc[i]) * 2u; }
    const size_t kstep = (size_t)(BK * 2), hstep = (size_t)HALF * K * 2, tstep = 2 * hstep;
    const unsigned ldsw = (unsigned)wid * 1024u;
    const int aoff = lds_byte(wr * 64 + fr, fq * 8), boff = lds_byte(wc * 32 + fr, fq * 8);
#define PG8_SA(b, h) (((b) * 2 + (h)) * HTB)
#define PG8_SB(b, h) ((4 + (b) * 2 + (h)) * HTB)
#define PG8_STAGE(bufoff, gbase, voff) do { _Pragma("unroll") for (int _i = 0; _i < 2; ++_i) \
        __builtin_amdgcn_global_load_lds((const GAS unsigned*)((const char*)(gbase) + (voff)[_i]), (LAS unsigned*)(lds + (bufoff) + ldsw + _i * 8192), 16, 0, 0); } while (0)
#define PG8_LDA(dst, b, h) do { _Pragma("unroll") for (int m = 0; m < 4; ++m) _Pragma("unroll") for (int k = 0; k < 2; ++k) dst[m][k] = *(const LAS bf16x8*)(lds + PG8_SA(b, h) + aoff + m * 2048 + k * 1024); } while (0)
#define PG8_LDB(dst, b, h) do { _Pragma("unroll") for (int n = 0; n < 2; ++n) _Pragma("unroll") for (int k = 0; k < 2; ++k) dst[n][k] = *(const LAS bf16x8*)(lds + PG8_SB(b, h) + boff + n * 2048 + k * 1024); } while (0)
#define PG8_MMA(ai, bj, At, Bt) do { __builtin_amdgcn_s_setprio(1); _Pragma("unroll") for (int m = 0; m < 4; ++m) _Pragma("unroll") for (int n = 0; n < 2; ++n) _Pragma("unroll") for (int k = 0; k < 2; ++k) \
        acc[ai][bj][m][n] = __builtin_amdgcn_mfma_f32_16x16x32_bf16(Bt[n][k], At[m][k], acc[ai][bj][m][n], 0, 0, 0); __builtin_amdgcn_s_setprio(0); } while (0)
#define PG8_WAIT_V(n) asm volatile("s_waitcnt vmcnt(" #n ")" ::: "memory")
#define PG8_WAIT_L(n) asm volatile("s_waitcnt lgkmcnt(" #n ")" ::: "memory")
#define PG8_BAR __builtin_amdgcn_s_barrier()
#define PG8_SCHED __builtin_amdgcn_sched_barrier(0)
    Unit cur, nxt; int ui = 0;
    if (!S.next(0, cur)) return;
    f32x4 acc[2][2][4][2];
#pragma unroll
    for (int a = 0; a < 2; ++a)
#pragma unroll
        for (int b = 0; b < 2; ++b)
#pragma unroll
            for (int m = 0; m < 4; ++m)
#pragma unroll
                for (int n = 0; n < 2; ++n) acc[a][b][m][n] = (f32x4){0.f, 0.f, 0.f, 0.f};
    bf16x8 At[4][2], B0[2][2], B1[2][2];
    unsigned vA0[2], vA1[2], nA0[2], nA1[2];
#pragma unroll
    for (int i = 0; i < 2; ++i) {
        if constexpr (GATHER) { vA0[i] = (unsigned)(S.arow(cur, Rr[i]) * K + Cc[i]) * 2u; vA1[i] = (unsigned)(S.arow(cur, HALF + Rr[i]) * K + Cc[i]) * 2u; }
        else { vA0[i] = (unsigned)(Rr[i] * K + Cc[i]) * 2u; vA1[i] = vA0[i] + (unsigned)hstep; }
        nA0[i] = vA0[i]; nA1[i] = vA1[i];
    }
    const char* cA = GATHER ? (const char*)g.A : (const char*)g.A + (size_t)cur.pm * tstep;
    const char* cB = (const char*)g.Bt + (size_t)cur.e * g.bstride + (size_t)cur.pn * tstep;
    PG8_STAGE(PG8_SB(0, 0), cB, voffB); PG8_STAGE(PG8_SB(0, 1), cB + hstep, voffB); PG8_STAGE(PG8_SA(0, 0), cA, vA0); PG8_STAGE(PG8_SA(0, 1), cA, vA1);
    if (wr == 1) PG8_BAR;
    PG8_WAIT_V(2); PG8_BAR;
    PG8_STAGE(PG8_SB(1, 0), cB + kstep, voffB); PG8_STAGE(PG8_SA(1, 0), cA + kstep, vA0); PG8_STAGE(PG8_SB(1, 1), cB + hstep + kstep, voffB);
    PG8_WAIT_V(6); PG8_BAR;
    for (;;) {
        const bool has_next = S.next(ui + 1, nxt);
        const char* nA = has_next ? (GATHER ? (const char*)g.A : (const char*)g.A + (size_t)nxt.pm * tstep) : cA;
        const char* nB = has_next ? (const char*)g.Bt + (size_t)nxt.e * g.bstride + (size_t)nxt.pn * tstep : cB;
        if constexpr (GATHER) { if (has_next) {
#pragma unroll
            for (int i = 0; i < 2; ++i) { nA0[i] = (unsigned)(S.arow(nxt, Rr[i]) * K + Cc[i]) * 2u; nA1[i] = (unsigned)(S.arow(nxt, HALF + Rr[i]) * K + Cc[i]) * 2u; } } }
        for (int t = 0; t < nt; t += 2) {
            const bool last = (t == nt - 2);
            const char* a1 = cA + (size_t)(t + 1) * kstep;
            const char* a2 = last ? nA : cA + (size_t)(t + 2) * kstep; const char* b2 = last ? nB : cB + (size_t)(t + 2) * kstep;
            const char* a3 = a2 + kstep; const char* b3 = b2 + kstep;
            unsigned w0[2], w1[2];
#pragma unroll
            for (int i = 0; i < 2; ++i) { w0[i] = last ? nA0[i] : vA0[i]; w1[i] = last ? nA1[i] : vA1[i]; }
            PG8_LDB(B0, 0, 0); PG8_LDB(B1, 0, 1); PG8_SCHED; PG8_LDA(At, 0, 0); PG8_STAGE(PG8_SA(1, 1), a1, vA1);
            PG8_WAIT_V(8); PG8_WAIT_L(0); PG8_BAR; PG8_MMA(0, 0, At, B0); PG8_MMA(0, 1, At, B1); PG8_BAR; PG8_SCHED;
            PG8_LDA(At, 0, 1); PG8_STAGE(PG8_SB(0, 0), b2, voffB); PG8_STAGE(PG8_SB(0, 1), b2 + hstep, voffB); PG8_STAGE(PG8_SA(0, 0), a2, w0);
            PG8_WAIT_V(8); PG8_WAIT_L(0); PG8_BAR; PG8_MMA(1, 0, At, B0); PG8_MMA(1, 1, At, B1); PG8_BAR; PG8_SCHED;
            PG8_LDB(B0, 1, 0); PG8_LDB(B1, 1, 1); PG8_SCHED; PG8_LDA(At, 1, 0); PG8_STAGE(PG8_SA(0, 1), a2, w1);
            PG8_WAIT_V(8); PG8_WAIT_L(0); PG8_BAR; PG8_MMA(0, 0, At, B0); PG8_MMA(0, 1, At, B1); PG8_BAR; PG8_SCHED;
            PG8_LDA(At, 1, 1); PG8_STAGE(PG8_SB(1, 0), b3, voffB); PG8_STAGE(PG8_SB(1, 1), b3 + hstep, voffB); PG8_STAGE(PG8_SA(1, 0), a3, w0);
            PG8_WAIT_V(8); PG8_WAIT_L(0); PG8_BAR; PG8_MMA(1, 0, At, B0); PG8_MMA(1, 1, At, B1); PG8_BAR; PG8_SCHED;
        }
        if constexpr (ALIGN_EPI) { if (wr == 0) PG8_BAR; }
        E(acc, cur, wr, wc, fr, fq);
        if (!has_next) break;
#pragma unroll
        for (int a = 0; a < 2; ++a)
#pragma unroll
            for (int b = 0; b < 2; ++b)
#pragma unroll
                for (int m = 0; m < 4; ++m)
#pragma unroll
                    for (int n = 0; n < 2; ++n) acc[a][b][m][n] = (f32x4){0.f, 0.f, 0.f, 0.f};
        cur = nxt; cA = nA; cB = nB; ++ui;
#pragma unroll
        for (int i = 0; i < 2; ++i) { vA0[i] = nA0[i]; vA1[i] = nA1[i]; }
        if constexpr (ALIGN_EPI) { if (wr == 1) PG8_BAR; }
    }
    PG8_WAIT_V(0);
    if constexpr (!ALIGN_EPI) { if (wr == 0) PG8_BAR; }
    PG8_BAR;
#undef PG8_SA
#undef PG8_SB
#undef PG8_STAGE
#undef PG8_LDA
#undef PG8_LDB
#undef PG8_MMA
#undef PG8_WAIT_V
#undef PG8_WAIT_L
#undef PG8_BAR
#undef PG8_SCHED
}
}

#define XB_TMO      128
#define XB_XCNT(j)  (256  + 64 * (j))
#define XB_XSUB(j)  (1280 + 64 * (j))
#define XB_XGEN(j)  (2304 + 64 * (j))
#define XB_TOP      3328
#define XB_TOPGEN   3392
#define XCD_BAR_WORDS 3456
#define XB_SPIN_CAP (1u << 22)
__device__ __forceinline__ unsigned xb_ld(unsigned* p)              { return __hip_atomic_load(p, __ATOMIC_RELAXED, __HIP_MEMORY_SCOPE_AGENT); }
__device__ __forceinline__ unsigned xb_add(unsigned* p, unsigned v) { return __hip_atomic_fetch_add(p, v, __ATOMIC_RELAXED, __HIP_MEMORY_SCOPE_AGENT); }
__device__ __forceinline__ unsigned xb_xcc_id() { return (unsigned)__builtin_amdgcn_s_getreg((3 << 11) | 20) & 0xFu; }
#define XB_SPIN(cond, bar) do { unsigned _sp = 0; while (cond) { __builtin_amdgcn_s_sleep(1); \
    if ((++_sp & 255u) == 0u) { if (xb_ld(&(bar)[XB_TMO])) break; if (_sp > XB_SPIN_CAP) { atomicAdd(&(bar)[XB_TMO], 1u); break; } } } } while (0)
struct XcdBarrier { unsigned* bar; unsigned x; volatile LAS unsigned* st; };
__device__ __forceinline__ XcdBarrier xcd_barrier_post(unsigned* bar, volatile LAS unsigned* st) {
    XcdBarrier b; b.bar = bar; b.x = xb_xcc_id(); b.st = st;
    if (threadIdx.x == 0) (void)xb_add(&bar[XB_XCNT(b.x)], 1u);
    return b;
}
__device__ __forceinline__ void xcd_barrier_complete(unsigned* bar, unsigned x, unsigned& nloc, unsigned& nx) {
    const unsigned G = gridDim.x * gridDim.y * gridDim.z;
    unsigned sum, cnt, mine, sp = 0u;
    for (;;) {
        sum = 0u; cnt = 0u; mine = 0u;
#pragma unroll
        for (unsigned j = 0; j < 16; ++j) { const unsigned c = xb_ld(&bar[XB_XCNT(j)]); sum += c; cnt += (c > 0u) ? 1u : 0u; mine = (j == x) ? c : mine; }
        if (sum == G) break;
        __builtin_amdgcn_s_sleep(1);
        if ((++sp & 255u) == 0u) { if (xb_ld(&bar[XB_TMO])) break; if (sp > XB_SPIN_CAP) { atomicAdd(&bar[XB_TMO], 1u); break; } }
    }
    nloc = mine > 0u ? mine : 1u; nx = cnt > 0u ? cnt : 1u;
}
__device__ __forceinline__ void xcd_barrier(const XcdBarrier& b) {
    asm volatile("s_waitcnt vmcnt(0)" ::: "memory");
    __syncthreads();
    if (threadIdx.x == 0) {
        unsigned* bar = b.bar;
        __builtin_amdgcn_s_waitcnt(0);
        unsigned nloc = b.st[0], nx = b.st[1];
        if (nloc == 0u) { xcd_barrier_complete(bar, b.x, nloc, nx); b.st[0] = nloc; b.st[1] = nx; }
        const unsigned old = xb_add(&bar[XB_XSUB(b.x)], 1u);
        const unsigned gen = old / nloc;
        if (old + 1u == (gen + 1u) * nloc) {
            __builtin_amdgcn_fence(__ATOMIC_RELEASE, "agent");
            asm volatile("s_waitcnt vmcnt(0)" ::: "memory");
            const unsigned og = xb_add(&bar[XB_TOP], 1u);
            const unsigned tg = og / nx;
            if (og + 1u == (tg + 1u) * nx) xb_add(&bar[XB_TOPGEN], 1u);
            else XB_SPIN(xb_ld(&bar[XB_TOPGEN]) == tg, bar);
            __builtin_amdgcn_fence(__ATOMIC_ACQUIRE, "agent");
            xb_add(&bar[XB_XGEN(b.x)], 1u);
            asm volatile("s_waitcnt vmcnt(0)" ::: "memory");
        } else {
            XB_SPIN(xb_ld(&bar[XB_XGEN(b.x)]) == gen, bar);
            __builtin_amdgcn_fence(__ATOMIC_ACQUIRE, "agent");
            asm volatile("s_waitcnt vmcnt(0)" ::: "memory");
        }
    }
    __syncthreads();
}

struct Ctx { LAS unsigned char* lds; int tid, lane, wave, G, vcu, gw, NGW; };

__device__ __forceinline__ void p0_transpose_item(const float* W, int Nsrc, int Ndst, int mode, bf16* WT, LAS float* scr, int item, int lane) {
    const int nblk = Ndst / 32, kb = item / nblk, nb = item - kb * nblk, k0 = 64 * kb, n0 = 32 * nb;
    const int nd = n0 + (lane & 31);
    const int sc = mode ? (2 * (128 * (nd >> 8) + (nd & 127)) + ((nd >> 7) & 1)) : nd;
    const bool ok = sc < Nsrc;
    const GAS float* Wg = (const GAS float*)W;
#pragma unroll 8
    for (int i = 0; i < 32; ++i) { const int kk = 2 * i + (lane >> 5); scr[kk * 33 + (lane & 31)] = ok ? Wg[(size_t)(k0 + kk) * Nsrc + sc] : 0.f; }
    LDS_WAIT(); asm volatile("" ::: "memory");
    const int c = lane & 7;
#pragma unroll
    for (int j = 0; j < 4; ++j) { const int n = (lane >> 3) + 8 * j; const LAS float* s = scr + (8 * c) * 33 + n;
        u32x4 o; o.x = pk2(s[0 * 33], s[1 * 33]); o.y = pk2(s[2 * 33], s[3 * 33]); o.z = pk2(s[4 * 33], s[5 * 33]); o.w = pk2(s[6 * 33], s[7 * 33]);
        *(GAS u32x4*)(WT + (size_t)(n0 + n) * DM + k0 + 8 * c) = o; }
    LDS_WAIT(); asm volatile("" ::: "memory");
}
__device__ __forceinline__ void phase_prologue(const Ctx& X, const float* c_in, const float* ada_w, const float* ada_b, float* mod,
                                               const float* w_qkv, const float* w_o0, const float* w_in, const float* w_o1, const float* w_gu, const float* w_down,
                                               bf16* Wqkv_t, bf16* Wo0_t, bf16* Win_t, bf16* Wo1_t, bf16* Wgu_t, bf16* Wd_t) {
    if (blockIdx.x < 192) {
        const int l = blockIdx.x / 96, j0 = (blockIdx.x % 96) * 64;
        LAS float* cs = (LAS float*)X.lds;
        for (int i = 0; i < 64; ++i) { const int idx = i * NTHREADS + X.tid, b = idx >> 10, k = idx & 1023; const float v = c_in[idx]; cs[k * 32 + b] = v / (1.0f + __expf(-v)); }
        __syncthreads();
        float acc[32];
#pragma unroll
        for (int b = 0; b < 32; ++b) acc[b] = 0.f;
        const GAS float* wp = (const GAS float*)ada_w + ((size_t)l * DM + X.wave * 128) * 6144 + j0 + X.lane;
#pragma unroll 4
        for (int k = 0; k < 128; ++k) { const float w = wp[(size_t)k * 6144]; const LAS f32x4* c4 = (const LAS f32x4*)(cs + (X.wave * 128 + k) * 32);
#pragma unroll
            for (int b4 = 0; b4 < 8; ++b4) { const f32x4 cv = c4[b4]; acc[4 * b4 + 0] += w * cv[0]; acc[4 * b4 + 1] += w * cv[1]; acc[4 * b4 + 2] += w * cv[2]; acc[4 * b4 + 3] += w * cv[3]; } }
        __syncthreads();
        LAS float* red = (LAS float*)X.lds;
#pragma unroll
        for (int b = 0; b < 32; ++b) red[(X.wave * 32 + b) * 64 + X.lane] = acc[b];
        __syncthreads();
        for (int i = 0; i < 4; ++i) { const int o = i * NTHREADS + X.tid, b = o >> 6, ln = o & 63; float s = 0.f;
#pragma unroll
            for (int w = 0; w < 8; ++w) s += red[(w * 32 + b) * 64 + ln];
            mod[((size_t)l * NB + b) * 6144 + j0 + ln] = s + ada_b[l * 6144 + j0 + ln]; }
        __syncthreads();
    }
    LAS float* scr = (LAS float*)(X.lds + X.wave * 16384);
    constexpr int I_QKV = 16 * (NQKV / 32), I_O = 16 * 32, I_IN = 16 * (NPROJ / 32), I_GU = 16 * 64, I_D = 16 * 32;
    constexpr int NITEMS = I_QKV + 2 * I_O + I_IN + 64 * I_GU + 64 * I_D;
    for (int it = X.gw; it < NITEMS; it += X.NGW) {
        int r = it;
        if (r < I_QKV) { p0_transpose_item(w_qkv, NQKV, NQKV, 0, Wqkv_t, scr, r, X.lane); continue; } r -= I_QKV;
        if (r < I_O) { p0_transpose_item(w_o0, DM, DM, 0, Wo0_t, scr, r, X.lane); continue; } r -= I_O;
        if (r < I_IN) { p0_transpose_item(w_in, NPROJ_REAL, NPROJ, 0, Win_t, scr, r, X.lane); continue; } r -= I_IN;
        if (r < I_O) { p0_transpose_item(w_o1, DM, DM, 0, Wo1_t, scr, r, X.lane); continue; } r -= I_O;
        if (r < 64 * I_GU) { const int mat = r / I_GU; p0_transpose_item(w_gu + (size_t)mat * DM * 2048, 2048, 2048, 1, Wgu_t + (size_t)mat * 2048 * DM, scr, r - mat * I_GU, X.lane); continue; } r -= 64 * I_GU;
        { const int mat = r / I_D; p0_transpose_item(w_down + (size_t)mat * DM * DM, DM, DM, 0, Wd_t + (size_t)mat * DM * DM, scr, r - mat * I_D, X.lane); }
    }
}

__device__ __forceinline__ void norm_mod_store(const f32x4 (&v)[4], const float* gnorm, const float* modb, int shi, int sci, bf16* hrow, int lane, f32x4 (&h)[4]) {
    float ss = 0.f;
#pragma unroll
    for (int j = 0; j < 4; ++j) ss += (v[j][0] * v[j][0] + v[j][1] * v[j][1]) + (v[j][2] * v[j][2] + v[j][3] * v[j][3]);
    const float rstd = 1.0f / sqrtf(wave_sum(ss) * (1.0f / DM) + EPS);
    GAS u32x2* o8 = (GAS u32x2*)hrow + lane;
#pragma unroll
    for (int j = 0; j < 4; ++j) {
        const f32x4 g4 = ((const GAS f32x4*)gnorm)[64 * j + lane], sc4 = ((const GAS f32x4*)(modb + sci * DM))[64 * j + lane], sh4 = ((const GAS f32x4*)(modb + shi * DM))[64 * j + lane];
        h[j] = (v[j] * rstd) * g4 * (1.0f + sc4) + sh4;
        o8[64 * j] = (u32x2){pk2(h[j][0], h[j][1]), pk2(h[j][2], h[j][3])};
    }
}
__device__ __forceinline__ void phase_norm1(const Ctx& X, const float* xin, const float* gnorm, const float* mod_l, bf16* H) {
    for (int m = X.gw; m < NTOK; m += X.NGW) {
        const GAS f32x4* xr = (const GAS f32x4*)(xin + (size_t)m * DM) + X.lane; f32x4 v[4], h[4];
#pragma unroll
        for (int j = 0; j < 4; ++j) v[j] = xr[64 * j];
        norm_mod_store(v, gnorm, mod_l + (size_t)(m >> 11) * 6144, 0, 1, H + (size_t)m * DM, X.lane, h);
    }
}
__device__ __forceinline__ void moe_tables(const Ctx& X, const unsigned* gcnt, LAS int* cntL, LAS int* tsum) {
    __syncthreads();
    if (X.tid < NE) cntL[X.tid] = (int)__hip_atomic_load(gcnt + X.tid, __ATOMIC_RELAXED, __HIP_MEMORY_SCOPE_AGENT);
    __syncthreads();
    if (X.tid == 0) { int s = 0; for (int e = 0; e < NE; ++e) { tsum[e] = s; s += (cntL[e] + 255) >> 8; } tsum[NE] = s; }
    __syncthreads();
}
__device__ __forceinline__ void phase_combine(const Ctx& X, float* xio, const bf16* Y, const int* tok_e, const int* tok_p, const unsigned* gcnt, const float* mod_l  ,
                                              bool do_norm, const float* gnorm_next, const float* mod_next, bf16* H) {
    LAS int* cntL = (LAS int*)(X.lds + EXTRA_OFF); LAS int* tsum = cntL + 32;
    moe_tables(X, gcnt, cntL, tsum);
    for (int m = X.gw; m < NTOK; m += X.NGW) {
        const int b = m >> 11;
        GAS f32x4* xr = (GAS f32x4*)(xio + (size_t)m * DM) + X.lane; f32x4 v[4], a[4], h[4];
#pragma unroll
        for (int j = 0; j < 4; ++j) { v[j] = xr[64 * j]; a[j] = (f32x4){0.f, 0.f, 0.f, 0.f}; }
#pragma unroll
        for (int k = 0; k < TOPK; ++k) { const int e = tok_e[m * 4 + k], p = tok_p[m * 4 + k]; const GAS u32x2* yr = (const GAS u32x2*)(Y + ((size_t)tsum[e] * 256 + p) * DM) + X.lane;
#pragma unroll
            for (int j = 0; j < 4; ++j) { const u32x2 w = yr[64 * j]; a[j][0] += bflo(w.x); a[j][1] += bfhi(w.x); a[j][2] += bflo(w.y); a[j][3] += bfhi(w.y); } }
#pragma unroll
        for (int j = 0; j < 4; ++j) { const f32x4 g4 = ((const GAS f32x4*)(mod_l + (size_t)b * 6144 + 5 * DM))[64 * j + X.lane]; v[j] = v[j] + g4 * a[j]; xr[64 * j] = v[j]; }
        if (do_norm) norm_mod_store(v, gnorm_next, mod_next + (size_t)b * 6144, 0, 1, H + (size_t)m * DM, X.lane, h);
    }
}
__device__ __forceinline__ void phase_norm2_router(const Ctx& X, const float* xin, const float* gnorm, const float* mod_l, const float* rw, const float* rb, bf16* H,
                                                   int* tok_e, int* tok_p, unsigned* gcnt, int* list, float* gate_e) {
    LAS float* rwT = (LAS float*)X.lds;
    LAS int* cntL = (LAS int*)(X.lds + EXTRA_OFF); LAS int* baseL = cntL + 32; LAS int* selE = baseL + 32; LAS int* selR = selE + 1024; LAS float* selG = (LAS float*)(selR + 1024);
    for (int i = 0; i < 64; ++i) { const int idx = i * NTHREADS + X.tid; rwT[(idx & 31) * DM + (idx >> 5)] = rw[idx]; }
    if (X.tid < NE) cntL[X.tid] = 0;
    __syncthreads();
    const int ntb = (NTOK + X.G - 1) / X.G, t0 = blockIdx.x * ntb;
    const int half = X.lane >> 5, l32 = X.lane & 31;
    for (int it = 0; it < ntb / 16; ++it) {
        const int lt = (it * 8 + X.wave) * 2;
        f32x4 hA[4], hB[4];
        { const int m = t0 + lt; const GAS f32x4* xr = (const GAS f32x4*)(xin + (size_t)m * DM) + X.lane; f32x4 v[4];
#pragma unroll
          for (int j = 0; j < 4; ++j) v[j] = xr[64 * j];
          norm_mod_store(v, gnorm, mod_l + (size_t)(m >> 11) * 6144, 3, 4, H + (size_t)m * DM, X.lane, hA); }
        { const int m = t0 + lt + 1; const GAS f32x4* xr = (const GAS f32x4*)(xin + (size_t)m * DM) + X.lane; f32x4 v[4];
#pragma unroll
          for (int j = 0; j < 4; ++j) v[j] = xr[64 * j];
          norm_mod_store(v, gnorm, mod_l + (size_t)(m >> 11) * 6144, 3, 4, H + (size_t)m * DM, X.lane, hB); }
        float val[64];
#pragma unroll
        for (int e = 0; e < 32; ++e) { float sa = 0.f, sb = 0.f;
#pragma unroll
            for (int j = 0; j < 4; ++j) { const f32x4 w = ((const LAS f32x4*)(rwT + e * DM))[64 * j + X.lane];
                sa += (hA[j][0] * w[0] + hA[j][1] * w[1]) + (hA[j][2] * w[2] + hA[j][3] * w[3]); sb += (hB[j][0] * w[0] + hB[j][1] * w[1]) + (hB[j][2] * w[2] + hB[j][3] * w[3]); }
            val[e] = sa; val[32 + e] = sb; }
#pragma unroll
        for (int s = 0; s < 6; ++s) { const int n = 32 >> s, o = 32 >> s; const bool up = (X.lane & o) != 0;
#pragma unroll
            for (int i = 0; i < n; ++i) { const float a = val[i], b2 = val[i + n]; const float send = up ? a : b2, keep = up ? b2 : a; val[i] = keep + __shfl_xor(send, o); } }
        float logit = val[0] + rb[l32];
        float tv[4]; int te[4]; float cur = logit;
#pragma unroll
        for (int k = 0; k < 4; ++k) { float mx = cur;
#pragma unroll
            for (int o = 16; o >= 1; o >>= 1) mx = fmaxf(mx, __shfl_xor(mx, o));
            const unsigned long long bal = __ballot(cur == mx); const unsigned mine = half ? (unsigned)(bal >> 32) : (unsigned)bal;
            const int e = __ffs(mine) - 1; tv[k] = mx; te[k] = e; if (l32 == e) cur = -INFINITY; }
        const float p1 = __expf(tv[1] - tv[0]), p2 = __expf(tv[2] - tv[0]), p3 = __expf(tv[3] - tv[0]); const float inv = 1.0f / (1.0f + p1 + p2 + p3);
        if (l32 < 4) { const int k = l32; const int e = k == 0 ? te[0] : k == 1 ? te[1] : k == 2 ? te[2] : te[3]; const float gk = (k == 0 ? 1.0f : k == 1 ? p1 : k == 2 ? p2 : p3) * inv;
            const int rank = __hip_atomic_fetch_add(cntL + e, 1, __ATOMIC_RELAXED, __HIP_MEMORY_SCOPE_WORKGROUP);
            const int si = (lt + half) * 4 + k; selE[si] = e; selR[si] = rank; selG[si] = gk; }
    }
    __syncthreads();
    if (X.tid < NE) baseL[X.tid] = (int)__hip_atomic_fetch_add(gcnt + X.tid, (unsigned)cntL[X.tid], __ATOMIC_RELAXED, __HIP_MEMORY_SCOPE_AGENT);
    __syncthreads();
    for (int si = X.tid; si < ntb * 4; si += NTHREADS) { const int e = selE[si], p = baseL[e] + selR[si], m = t0 + (si >> 2);
        tok_e[(size_t)m * 4 + (si & 3)] = e; tok_p[(size_t)m * 4 + (si & 3)] = p; list[(size_t)e * ECAP + p] = m; gate_e[(size_t)e * ECAP + p] = selG[si]; }
    __syncthreads();
}

__device__ __forceinline__ void phase_sb_naive(const Ctx& X, const bf16* QKV, bf16* O) {
    for (int item = blockIdx.x; item < NB * NH * 4; item += X.G) {
        const int b = item >> 6, h = (item >> 2) & 15, t = (item & 3) * 512 + X.tid;
        const GAS u32x4* qp = (const GAS u32x4*)(QKV + ((size_t)(b * SEQ + t)) * NQKV + h * HD);
        float q[64], o[64];
#pragma unroll
        for (int i = 0; i < 8; ++i) { const u32x4 w = qp[i]; q[8 * i] = bflo(w.x); q[8 * i + 1] = bfhi(w.x); q[8 * i + 2] = bflo(w.y); q[8 * i + 3] = bfhi(w.y); q[8 * i + 4] = bflo(w.z); q[8 * i + 5] = bfhi(w.z); q[8 * i + 6] = bflo(w.w); q[8 * i + 7] = bfhi(w.w); }
#pragma unroll
        for (int d = 0; d < 64; ++d) o[d] = 0.f;
        float L = 0.f;
        for (int s = t - 1; s >= 0; --s) {
            const GAS u32x4* kp = (const GAS u32x4*)(QKV + ((size_t)(b * SEQ + s)) * NQKV + DM + h * HD);
            float z = 0.f;
#pragma unroll
            for (int i = 0; i < 8; ++i) { const u32x4 w = kp[i]; z += q[8 * i] * bflo(w.x) + q[8 * i + 1] * bfhi(w.x) + q[8 * i + 2] * bflo(w.y) + q[8 * i + 3] * bfhi(w.y) + q[8 * i + 4] * bflo(w.z) + q[8 * i + 5] * bfhi(w.z) + q[8 * i + 6] * bflo(w.w) + q[8 * i + 7] * bfhi(w.w); }
            const float sp = fmaxf(z, 0.f) + __builtin_amdgcn_logf(1.0f + __builtin_amdgcn_exp2f(-fabsf(z)));
            const float a = __builtin_amdgcn_exp2f(z - sp + L);
            const GAS u32x4* vp = kp + (DM * 2 / 16);
#pragma unroll
            for (int i = 0; i < 8; ++i) { const u32x4 w = vp[i]; o[8 * i] += a * bflo(w.x); o[8 * i + 1] += a * bfhi(w.x); o[8 * i + 2] += a * bflo(w.y); o[8 * i + 3] += a * bfhi(w.y); o[8 * i + 4] += a * bflo(w.z); o[8 * i + 5] += a * bfhi(w.z); o[8 * i + 6] += a * bflo(w.w); o[8 * i + 7] += a * bfhi(w.w); }
            L -= sp;
            if (L < -160.f) break;
        }
        GAS u32x4* op = (GAS u32x4*)(O + ((size_t)(b * SEQ + t)) * DM + h * HD);
#pragma unroll
        for (int i = 0; i < 8; ++i) op[i] = (u32x4){pk2(o[8 * i], o[8 * i + 1]), pk2(o[8 * i + 2], o[8 * i + 3]), pk2(o[8 * i + 4], o[8 * i + 5]), pk2(o[8 * i + 6], o[8 * i + 7])};
    }
}

__device__ __forceinline__ void ld16(const bf16* p, float (&x)[16]) {
    const GAS u32x4* q = (const GAS u32x4*)p; const u32x4 a = q[0], b = q[1];
    x[0] = bflo(a.x); x[1] = bfhi(a.x); x[2] = bflo(a.y); x[3] = bfhi(a.y); x[4] = bflo(a.z); x[5] = bfhi(a.z); x[6] = bflo(a.w); x[7] = bfhi(a.w);
    x[8] = bflo(b.x); x[9] = bfhi(b.x); x[10] = bflo(b.y); x[11] = bfhi(b.y); x[12] = bflo(b.z); x[13] = bfhi(b.z); x[14] = bflo(b.w); x[15] = bfhi(b.w);
}
__device__ __forceinline__ void st16(bf16* p, const float (&x)[16]) {
    GAS u32x4* q = (GAS u32x4*)p;
    q[0] = (u32x4){pk2(x[0], x[1]), pk2(x[2], x[3]), pk2(x[4], x[5]), pk2(x[6], x[7])}; q[1] = (u32x4){pk2(x[8], x[9]), pk2(x[10], x[11]), pk2(x[12], x[13]), pk2(x[14], x[15])};
}
__device__ __forceinline__ void phase_dsa_post(const Ctx& X, const bf16* P, const int* positions, const float* qgain, const float* kgain, bf16* Q1, bf16* K1, bf16* V1, bf16* QI, bf16* KI, float* WI) {
    const int l4 = X.lane & 3;
    float gq[16], gk[16];
#pragma unroll
    for (int i = 0; i < 16; ++i) { gq[i] = qgain[l4 * 16 + i]; gk[i] = kgain[l4 * 16 + i]; }
    for (int m = X.gw; m < NTOK; m += X.NGW) {
        const bf16* pr = P + (size_t)m * NPROJ;
        const float posf = (float)positions[m];
        float cs = 1.f, sn = 0.f;
        { const int i = X.lane & 7; const float inv = expf(-logf(500000.0f) * (2.0f * (float)i / 16.0f)); sincosf(posf * inv, &sn, &cs); }
        float cz[8], sz[8];
#pragma unroll
        for (int i = 0; i < 8; ++i) { cz[i] = __shfl(cs, i); sz[i] = __shfl(sn, i); }
        float x[16];
        ld16(pr + X.lane * 16, x);
        { float ss = 0.f;
#pragma unroll
          for (int i = 0; i < 16; ++i) ss += x[i] * x[i];
          ss += __shfl_xor(ss, 1); ss += __shfl_xor(ss, 2);
          const float r = 1.0f / sqrtf(ss * (1.0f / 64.0f) + EPS);
#pragma unroll
          for (int i = 0; i < 16; ++i) x[i] = x[i] * r * gq[i];
          if (l4 == 0) {
#pragma unroll
              for (int i = 0; i < 8; ++i) { const float a = x[i], b2 = x[i + 8]; x[i] = a * cz[i] - b2 * sz[i]; x[i + 8] = b2 * cz[i] + a * sz[i]; } }
#pragma unroll
          for (int i = 0; i < 16; ++i) x[i] *= QSCALE;
          st16(Q1 + (size_t)m * DM + X.lane * 16, x); }
        if (X.lane < 16) { ld16(pr + DM + X.lane * 16, x);
            if (X.lane < 8) { float ss = 0.f;
#pragma unroll
                for (int i = 0; i < 16; ++i) ss += x[i] * x[i];
                ss += __shfl_xor(ss, 1); ss += __shfl_xor(ss, 2);
                const float r = 1.0f / sqrtf(ss * (1.0f / 64.0f) + EPS);
#pragma unroll
                for (int i = 0; i < 16; ++i) x[i] = x[i] * r * gk[i];
                if (l4 == 0) {
#pragma unroll
                    for (int i = 0; i < 8; ++i) { const float a = x[i], b2 = x[i + 8]; x[i] = a * cz[i] - b2 * sz[i]; x[i + 8] = b2 * cz[i] + a * sz[i]; } }
                st16(K1 + (size_t)m * 128 + X.lane * 16, x);
            } else st16(V1 + (size_t)m * 128 + (X.lane - 8) * 16, x); }
        if (X.lane < 36) { ld16(pr + 1280 + X.lane * 16, x);
            if (l4 == 0) {
#pragma unroll
                for (int i = 0; i < 8; ++i) { const float a = x[i], b2 = x[i + 8]; x[i] = a * cz[i] - b2 * sz[i]; x[i + 8] = b2 * cz[i] + a * sz[i]; } }
            if (X.lane < 32) st16(QI + (size_t)m * 512 + X.lane * 16, x); else st16(KI + (size_t)m * 64 + (X.lane - 32) * 16, x); }
        if (X.lane < 8) WI[(size_t)m * 8 + X.lane] = bflo((unsigned)pr[1856 + X.lane]) * (0.35355339059327373f * 0.125f);
    }
}
__device__ __forceinline__ void phase_idx_naive(const Ctx& X, const bf16* QI, const bf16* KI, const float* WI, float* SC) {
    LAS float* qs = (LAS float*)X.lds;
    const int ntb = NTOK / X.G;
    for (int i = 0; i < ntb; ++i) {
        const int m = blockIdx.x * ntb + i, b = m >> 11, t = m & 2047, nadm = 64 * ((t >> 6) + 1);
        __syncthreads();
        qs[X.tid] = bflo((unsigned)QI[(size_t)m * 512 + X.tid]); if (X.tid < 8) qs[512 + X.tid] = WI[(size_t)m * 8 + X.tid];
        __syncthreads();
        for (int s = X.tid; s < nadm; s += NTHREADS) {
            const GAS u32x4* kp = (const GAS u32x4*)(KI + ((size_t)(b * SEQ + s)) * 64); float k[64];
#pragma unroll
            for (int j = 0; j < 8; ++j) { const u32x4 w = kp[j]; k[8 * j] = bflo(w.x); k[8 * j + 1] = bfhi(w.x); k[8 * j + 2] = bflo(w.y); k[8 * j + 3] = bfhi(w.y); k[8 * j + 4] = bflo(w.z); k[8 * j + 5] = bfhi(w.z); k[8 * j + 6] = bflo(w.w); k[8 * j + 7] = bfhi(w.w); }
            float sc = 0.f;
#pragma unroll 1
            for (int hh = 0; hh < 8; ++hh) { float d = 0.f; asm volatile("" ::: "memory");
#pragma unroll
                for (int j = 0; j < 16; ++j) { const f32x4 q4 = ((const LAS f32x4*)(qs + hh * 64))[j]; d += (q4[0] * k[4 * j] + q4[1] * k[4 * j + 1]) + (q4[2] * k[4 * j + 2] + q4[3] * k[4 * j + 3]); }
                sc += qs[512 + hh] * fmaxf(d, 0.f); }
            SC[(size_t)m * SEQ + s] = sc;
        }
    }
}
__device__ __forceinline__ unsigned ord_key(float x) { const unsigned u = __float_as_uint(x); return (u & 0x80000000u) ? ~u : (u | 0x80000000u); }
__device__ __forceinline__ void topk_select_store(const unsigned (&key)[32], int c, unsigned long long* maskrow, int lane) {
    unsigned long long mine = ~0ull;
    if (c >= 4) {
        unsigned T = 0u;
        for (int bit = 31; bit >= 0; --bit) { const unsigned cand = T | (1u << bit); int cnt = 0;
#pragma unroll
            for (int m = 0; m < 32; ++m) if (m <= c) cnt += __popcll(__ballot(key[m] >= cand));
            if (cnt >= 256) T = cand; }
        int gt = 0;
#pragma unroll
        for (int m = 0; m < 32; ++m) if (m <= c) gt += __popcll(__ballot(key[m] > T));
        int need = 256 - gt;
#pragma unroll
        for (int m = 0; m < 32; ++m) if (m <= c) {
            unsigned long long eq = __ballot(key[m] == T); const unsigned long long g = __ballot(key[m] > T);
            int pe = __popcll(eq);
            while (pe > need) { eq &= ~(1ull << (63 - __clzll(eq))); --pe; }
            need -= pe;
            if (lane == m) mine = g | eq; }
    }
    if (lane <= c) maskrow[lane] = mine;
}
__device__ __forceinline__ void phase_topk_naive(const Ctx& X, const float* SC, unsigned long long* MASK) {
    for (int m = X.gw; m < NTOK; m += X.NGW) {
        const int c = (m & 2047) >> 6; unsigned key[32];
#pragma unroll
        for (int j = 0; j < 32; ++j) key[j] = (j <= c) ? ord_key(SC[(size_t)m * SEQ + j * 64 + X.lane]) : 0u;
        topk_select_store(key, c, MASK + (size_t)m * 32, X.lane);
    }
}
__device__ __forceinline__ void phase_sparse_naive(const Ctx& X, const bf16* Q1, const bf16* K1, const bf16* V1, const unsigned long long* MASK, bf16* O) {
    for (int item = blockIdx.x; item < NTOK / 32; item += X.G) {
        const int m = item * 32 + (X.tid >> 4), h = X.tid & 15, g = h >> 3, b = m >> 11, c = (m & 2047) >> 6;
        const GAS u32x4* qp = (const GAS u32x4*)(Q1 + (size_t)m * DM + h * HD);
        float q[64], o[64];
#pragma unroll
        for (int i = 0; i < 8; ++i) { const u32x4 w = qp[i]; q[8 * i] = bflo(w.x); q[8 * i + 1] = bfhi(w.x); q[8 * i + 2] = bflo(w.y); q[8 * i + 3] = bfhi(w.y); q[8 * i + 4] = bflo(w.z); q[8 * i + 5] = bfhi(w.z); q[8 * i + 6] = bflo(w.w); q[8 * i + 7] = bfhi(w.w); }
#pragma unroll
        for (int d = 0; d < 64; ++d) o[d] = 0.f;
        float mx = -1e30f, l = 0.f;
        for (int j = 0; j <= c; ++j) {
            unsigned long long bits = MASK[(size_t)m * 32 + j];
            while (bits) { const int s = j * 64 + __ffsll((long long)bits) - 1; bits &= bits - 1;
                const GAS u32x4* kp = (const GAS u32x4*)(K1 + ((size_t)(b * SEQ + s)) * 128 + g * HD); float z = 0.f;
#pragma unroll
                for (int i = 0; i < 8; ++i) { const u32x4 w = kp[i]; z += q[8 * i] * bflo(w.x) + q[8 * i + 1] * bfhi(w.x) + q[8 * i + 2] * bflo(w.y) + q[8 * i + 3] * bfhi(w.y) + q[8 * i + 4] * bflo(w.z) + q[8 * i + 5] * bfhi(w.z) + q[8 * i + 6] * bflo(w.w) + q[8 * i + 7] * bfhi(w.w); }
                const float mn = fmaxf(mx, z), f = __builtin_amdgcn_exp2f(mx - mn), p = __builtin_amdgcn_exp2f(z - mn); mx = mn; l = l * f + p;
                const GAS u32x4* vp = (const GAS u32x4*)(V1 + ((size_t)(b * SEQ + s)) * 128 + g * HD);
#pragma unroll
                for (int i = 0; i < 8; ++i) { const u32x4 w = vp[i]; o[8 * i] = o[8 * i] * f + p * bflo(w.x); o[8 * i + 1] = o[8 * i + 1] * f + p * bfhi(w.x); o[8 * i + 2] = o[8 * i + 2] * f + p * bflo(w.y); o[8 * i + 3] = o[8 * i + 3] * f + p * bfhi(w.y);
                    o[8 * i + 4] = o[8 * i + 4] * f + p * bflo(w.z); o[8 * i + 5] = o[8 * i + 5] * f + p * bfhi(w.z); o[8 * i + 6] = o[8 * i + 6] * f + p * bflo(w.w); o[8 * i + 7] = o[8 * i + 7] * f + p * bfhi(w.w); }
            }
        }
        const float il = 1.0f / l;
        GAS u32x4* op = (GAS u32x4*)(O + (size_t)m * DM + h * HD);
#pragma unroll
        for (int i = 0; i < 8; ++i) op[i] = (u32x4){pk2(o[8 * i] * il, o[8 * i + 1] * il), pk2(o[8 * i + 2] * il, o[8 * i + 3] * il), pk2(o[8 * i + 4] * il, o[8 * i + 5] * il), pk2(o[8 * i + 6] * il, o[8 * i + 7] * il)};
    }
}


typedef float f32x16 __attribute__((ext_vector_type(16)));
typedef short v4i16_t __attribute__((ext_vector_type(4)));
__device__ __forceinline__ int crow16(int r, int hi) { return (r & 3) + 8 * (r >> 2) + 4 * hi; }
__device__ __forceinline__ float half_sum(float v) { const auto rr = __builtin_amdgcn_permlane32_swap(__float_as_uint(v), __float_as_uint(v), false, false); return __uint_as_float(rr[0]) + __uint_as_float(rr[1]); }
__device__ __forceinline__ float half_max(float v) { const auto rr = __builtin_amdgcn_permlane32_swap(__float_as_uint(v), __float_as_uint(v), false, false); return fmaxf(__uint_as_float(rr[0]), __uint_as_float(rr[1])); }
__device__ __forceinline__ bf16x8 pack8(const f32x16& v, int s) {
    u32x4 w; w.x = pg8::cvt_pk_bf16(v[8 * s + 0], v[8 * s + 1]); w.y = pg8::cvt_pk_bf16(v[8 * s + 2], v[8 * s + 3]); w.z = pg8::cvt_pk_bf16(v[8 * s + 4], v[8 * s + 5]); w.w = pg8::cvt_pk_bf16(v[8 * s + 6], v[8 * s + 7]);
    return __builtin_bit_cast(bf16x8, w);
}
__device__ __forceinline__ void vtile_write(LAS unsigned char* vl, const u32x4 (&vr)[4], int lane) {
#pragma unroll
    for (int i = 0; i < 4; ++i) *(LAS u32x4*)(vl + (i * 2 + ((lane & 7) >> 2)) * 512 + (lane >> 3) * 64 + (lane & 3) * 16) = vr[i];
}
__device__ __forceinline__ bf16x8 vtile_frag(const LAS unsigned char* vl, int trbase, int s, int d0) {
    const v4i16_t lo = __builtin_amdgcn_ds_read_tr16_b64_v4i16((LAS v4i16_t*)(vl + trbase + ((2 * s + 0) * 2 + d0) * 512));
    const v4i16_t hi = __builtin_amdgcn_ds_read_tr16_b64_v4i16((LAS v4i16_t*)(vl + trbase + ((2 * s + 1) * 2 + d0) * 512));
    return (bf16x8){lo[0], lo[1], lo[2], lo[3], hi[0], hi[1], hi[2], hi[3]};
}
__device__ __forceinline__ void store_ot(bf16* orow, const f32x16& o0, const f32x16& o1, float sc, int hi) {
#pragma unroll
    for (int rg = 0; rg < 4; ++rg) {
        *(GAS u32x2*)(orow + 8 * rg + 4 * hi) = (u32x2){pg8::cvt_pk_bf16(o0[4 * rg] * sc, o0[4 * rg + 1] * sc), pg8::cvt_pk_bf16(o0[4 * rg + 2] * sc, o0[4 * rg + 3] * sc)};
        *(GAS u32x2*)(orow + 32 + 8 * rg + 4 * hi) = (u32x2){pg8::cvt_pk_bf16(o1[4 * rg] * sc, o1[4 * rg + 1] * sc), pg8::cvt_pk_bf16(o1[4 * rg + 2] * sc, o1[4 * rg + 3] * sc)};
    }
}

__device__ __forceinline__ void phase_sb_fast(const Ctx& X, const bf16* QKV, bf16* O) {
    const int lane = X.lane, r32 = lane & 31, hi = lane >> 5;
    LAS unsigned char* vl = X.lds + X.wave * 4096;
    const int trbase = (4 * hi + ((lane & 15) >> 2)) * 64 + (16 * ((lane >> 4) & 1) + 4 * (lane & 3)) * 2;
    bf16x8 uf[2];
#pragma unroll
    for (int s = 0; s < 2; ++s)
#pragma unroll
        for (int j = 0; j < 8; ++j) uf[s][j] = ((16 * s + 8 * (j >> 2) + 4 * hi + (j & 3)) > r32) ? (short)0x3F80 : (short)0;
    for (int u = X.gw; u < NB * NH * 64; u += X.NGW) {
        const int b = u >> 10, h = (u >> 6) & 15, qb = u & 63, t0 = qb * 32;
        const bf16* base = QKV + (size_t)b * SEQ * NQKV + h * HD;
        bf16x8 qf[4];
#pragma unroll
        for (int d0 = 0; d0 < 4; ++d0) qf[d0] = *(const GAS bf16x8*)(base + (size_t)(t0 + r32) * NQKV + 16 * d0 + 8 * hi);
        f32x16 o0 = {}, o1 = {}; float run = 0.f;
        for (int kt = qb; kt >= 0; --kt) {
            const int key0 = kt * 32;
            bf16x8 kf[4]; u32x4 vr[4];
#pragma unroll
            for (int d0 = 0; d0 < 4; ++d0) kf[d0] = *(const GAS bf16x8*)(base + (size_t)(key0 + r32) * NQKV + DM + 16 * d0 + 8 * hi);
#pragma unroll
            for (int i = 0; i < 4; ++i) vr[i] = *(const GAS u32x4*)(base + (size_t)(key0 + i * 8 + (lane >> 3)) * NQKV + 2 * DM + 8 * (lane & 7));
            asm volatile("" ::: "memory");
            vtile_write(vl, vr, lane);
            f32x16 S = {};
#pragma unroll
            for (int d0 = 0; d0 < 4; ++d0) S = __builtin_amdgcn_mfma_f32_32x32x16_bf16(kf[d0], qf[d0], S, 0, 0, 0);
            const bool diag = (kt == qb);
            f32x16 xm, ls; float cs = 0.f;
#pragma unroll
            for (int r = 0; r < 16; ++r) { const float z = S[r]; const float sp = fmaxf(z, 0.f) + __builtin_amdgcn_logf(1.0f + __builtin_amdgcn_exp2f(-fabsf(z)));
                const bool valid = !diag || (crow16(r, hi) < r32);
                xm[r] = valid ? -sp : 0.f; ls[r] = valid ? z - sp : -INFINITY; cs += xm[r]; }
            cs = half_sum(cs);
            f32x16 T;
#pragma unroll
            for (int r = 0; r < 16; ++r) T[r] = run;
            T = __builtin_amdgcn_mfma_f32_32x32x16_bf16(uf[0], pack8(xm, 0), T, 0, 0, 0);
            T = __builtin_amdgcn_mfma_f32_32x32x16_bf16(uf[1], pack8(xm, 1), T, 0, 0, 0);
            f32x16 a;
#pragma unroll
            for (int r = 0; r < 16; ++r) a[r] = __builtin_amdgcn_exp2f(ls[r] + T[r]);
            const bf16x8 p0 = pack8(a, 0), p1 = pack8(a, 1);
            asm volatile("" ::: "memory");
            o0 = __builtin_amdgcn_mfma_f32_32x32x16_bf16(vtile_frag(vl, trbase, 0, 0), p0, o0, 0, 0, 0);
            o1 = __builtin_amdgcn_mfma_f32_32x32x16_bf16(vtile_frag(vl, trbase, 0, 1), p0, o1, 0, 0, 0);
            o0 = __builtin_amdgcn_mfma_f32_32x32x16_bf16(vtile_frag(vl, trbase, 1, 0), p1, o0, 0, 0, 0);
            o1 = __builtin_amdgcn_mfma_f32_32x32x16_bf16(vtile_frag(vl, trbase, 1, 1), p1, o1, 0, 0, 0);
            asm volatile("" ::: "memory");
            run += cs;
            if (__all(run < -160.f)) break;
        }
        store_ot(O + (size_t)(b * SEQ + t0 + r32) * DM + h * HD, o0, o1, 1.0f, hi);
    }
}

__device__ __forceinline__ void phase_sparse_fast(const Ctx& X, const bf16* Q1, const bf16* K1, const bf16* V1, const unsigned* MASK32, bf16* O) {
    const int lane = X.lane, r32 = lane & 31, hi = lane >> 5;
    LAS unsigned char* vl = X.lds + X.wave * 4096;
    const int trbase = (4 * hi + ((lane & 15) >> 2)) * 64 + (16 * ((lane >> 4) & 1) + 4 * (lane & 3)) * 2;
    for (int u = X.gw; u < NB * 64 * NH; u += X.NGW) {
        const int h = u & 15, tb = (u >> 4) & 63, b = u >> 10, g = h >> 3, t0 = tb * 32, ntile = 2 * ((t0 >> 6) + 1);
        const size_t tok = (size_t)b * SEQ + t0 + r32;
        bf16x8 qf[4];
#pragma unroll
        for (int d0 = 0; d0 < 4; ++d0) qf[d0] = *(const GAS bf16x8*)(Q1 + tok * DM + h * HD + 16 * d0 + 8 * hi);
        const bf16* kb = K1 + (size_t)b * SEQ * 128 + g * HD; const bf16* vb = V1 + (size_t)b * SEQ * 128 + g * HD;
        f32x16 o0 = {}, o1 = {}; float mrun = -1e30f, l = 0.f;
        for (int kt = 0; kt < ntile; ++kt) {
            const int key0 = kt * 32;
            bf16x8 kf[4]; u32x4 vr[4];
#pragma unroll
            for (int d0 = 0; d0 < 4; ++d0) kf[d0] = *(const GAS bf16x8*)(kb + (size_t)(key0 + r32) * 128 + 16 * d0 + 8 * hi);
#pragma unroll
            for (int i = 0; i < 4; ++i) vr[i] = *(const GAS u32x4*)(vb + (size_t)(key0 + i * 8 + (lane >> 3)) * 128 + 8 * (lane & 7));
            const unsigned mw = MASK32[tok * 64 + kt] >> (4 * hi);
            asm volatile("" ::: "memory");
            vtile_write(vl, vr, lane);
            f32x16 S = {};
#pragma unroll
            for (int d0 = 0; d0 < 4; ++d0) S = __builtin_amdgcn_mfma_f32_32x32x16_bf16(kf[d0], qf[d0], S, 0, 0, 0);
            float mx = -INFINITY;
#pragma unroll
            for (int r = 0; r < 16; ++r) { const unsigned msk = (unsigned)__builtin_amdgcn_sbfe((int)mw, (r & 3) + 8 * (r >> 2), 1);
                S[r] = __uint_as_float((__float_as_uint(S[r]) & msk) | (0xFF800000u & ~msk)); mx = fmaxf(mx, S[r]); }
            mx = half_max(mx);
            const float mnew = fmaxf(mrun, mx), f = __builtin_amdgcn_exp2f(mrun - mnew); mrun = mnew;
            f32x16 p; float ps = 0.f;
#pragma unroll
            for (int r = 0; r < 16; ++r) { p[r] = __builtin_amdgcn_exp2f(S[r] - mnew); ps += p[r]; }
            l = l * f + ps;
            if (__any(f != 1.0f)) {
#pragma unroll
                for (int r = 0; r < 16; ++r) { o0[r] *= f; o1[r] *= f; } }
            const bf16x8 p0 = pack8(p, 0), p1 = pack8(p, 1);
            asm volatile("" ::: "memory");
            o0 = __builtin_amdgcn_mfma_f32_32x32x16_bf16(vtile_frag(vl, trbase, 0, 0), p0, o0, 0, 0, 0);
            o1 = __builtin_amdgcn_mfma_f32_32x32x16_bf16(vtile_frag(vl, trbase, 0, 1), p0, o1, 0, 0, 0);
            o0 = __builtin_amdgcn_mfma_f32_32x32x16_bf16(vtile_frag(vl, trbase, 1, 0), p1, o0, 0, 0, 0);
            o1 = __builtin_amdgcn_mfma_f32_32x32x16_bf16(vtile_frag(vl, trbase, 1, 1), p1, o1, 0, 0, 0);
            asm volatile("" ::: "memory");
        }
        l = half_sum(l);
        store_ot(O + tok * DM + h * HD, o0, o1, 1.0f / l, hi);
    }
}

__device__ __forceinline__ void phase_idx_topk_fast(const Ctx& X, const bf16* QI, const bf16* KI, const float* WI, unsigned long long* MASK) {
    const int lane = X.lane, r32 = lane & 31, hi = lane >> 5;
    const int tkr = 2 * ((r32 >> 2) & 1) + (r32 >> 4), hdr = (r32 & 3) + 4 * ((r32 >> 3) & 1);
    int round = 0;
    for (int u0 = X.gw; u0 < NTOK / 4; u0 += X.NGW, ++round) {
        const int b = u0 >> 9; int tg = u0 & 511; if (round & 1) tg = 511 - tg;
        const int t0 = tg * 4, c = t0 >> 6; const size_t tok0 = (size_t)b * SEQ + t0;
        bf16x8 qf[4];
#pragma unroll
        for (int d0 = 0; d0 < 4; ++d0) qf[d0] = *(const GAS bf16x8*)(QI + (tok0 + tkr) * 512 + hdr * 64 + 16 * d0 + 8 * hi);
        float w0[8], w1[8];
#pragma unroll
        for (int hh = 0; hh < 8; ++hh) { w0[hh] = WI[(tok0 + 2 * hi) * 8 + hh]; w1[hh] = WI[(tok0 + 2 * hi + 1) * 8 + hh]; }
        unsigned k0[32], k1[32], k2[32], k3[32];
        const bf16* kib = KI + (size_t)b * SEQ * 64;
#pragma unroll
        for (int m = 0; m < 32; ++m) {
            if (m <= c) {
                float sa[2], sb[2];
#pragma unroll
                for (int half = 0; half < 2; ++half) {
                    const int key0 = 64 * m + 32 * half; f32x16 R = {};
#pragma unroll
                    for (int d0 = 0; d0 < 4; ++d0) { const bf16x8 kf = *(const GAS bf16x8*)(kib + (size_t)(key0 + r32) * 64 + 16 * d0 + 8 * hi); R = __builtin_amdgcn_mfma_f32_32x32x16_bf16(qf[d0], kf, R, 0, 0, 0); }
                    float s0 = 0.f, s1 = 0.f;
#pragma unroll
                    for (int hh = 0; hh < 8; ++hh) { s0 += w0[hh] * fmaxf(R[hh], 0.f); s1 += w1[hh] * fmaxf(R[8 + hh], 0.f); }
                    sa[half] = s0; sb[half] = s1;
                }
                const auto ra = __builtin_amdgcn_permlane32_swap(ord_key(sa[0]), ord_key(sa[1]), false, false);
                const auto rb = __builtin_amdgcn_permlane32_swap(ord_key(sb[0]), ord_key(sb[1]), false, false);
                k0[m] = ra[0]; k2[m] = ra[1]; k1[m] = rb[0]; k3[m] = rb[1];
            } else { k0[m] = 0u; k1[m] = 0u; k2[m] = 0u; k3[m] = 0u; }
        }
        topk_select_store(k0, c, MASK + (tok0 + 0) * 32, lane);
        topk_select_store(k1, c, MASK + (tok0 + 1) * 32, lane);
        topk_select_store(k2, c, MASK + (tok0 + 2) * 32, lane);
        topk_select_store(k3, c, MASK + (tok0 + 3) * 32, lane);
    }
}

#ifndef MK_N_LAUNCHES
#define MK_N_LAUNCHES 1
#endif
constexpr int NPHASES = 19;
struct Args { const void* in[19]; float* out; unsigned char* ws; int ph_lo, ph_hi; };
static_assert(sizeof(Args) == 19 * 8 + 8 + 8 + 8, "Args has no padding");

__device__ __forceinline__ void moe_gemms_gu(const Ctx& X, const bf16* H, const bf16* Wgu_l, const float* bgu_l, bf16* ACT, const unsigned* gcnt, const int* list) {
    LAS int* cntL = (LAS int*)(X.lds + EXTRA_OFF); LAS int* tsum = cntL + 32;
    moe_tables(X, gcnt, cntL, tsum);
    pg8::Gemm g{H, Wgu_l, DM, (size_t)2048 * DM * 2};
    pg8::MoeOrder S{tsum, cntL, list, 8, X.G, (int)blockIdx.x, tsum[NE] * 8};
    pg8::EpiSwiglu E{ACT, bgu_l};
    pg8::gemm_phase<pg8::EpiSwiglu, pg8::MoeOrder, true, true>(X.lds, g, S, E);
}
__device__ __forceinline__ void moe_gemms_down(const Ctx& X, const bf16* ACT, const bf16* Wd_l, const float* bd_l, bf16* Y, const unsigned* gcnt, const int* list, const float* gate_e) {
    LAS int* cntL = (LAS int*)(X.lds + EXTRA_OFF); LAS int* tsum = cntL + 32;
    moe_tables(X, gcnt, cntL, tsum);
    pg8::Gemm g{ACT, Wd_l, DM, (size_t)DM * DM * 2};
    pg8::MoeOrder S{tsum, cntL, list, 4, X.G, (int)blockIdx.x, tsum[NE] * 4};
    pg8::EpiDown E{Y, bd_l, gate_e, tsum};
    pg8::gemm_phase<pg8::EpiDown, pg8::MoeOrder, false, true>(X.lds, g, S, E);
}

__global__ void __launch_bounds__(NTHREADS, 2) mk_fwd(Args a) {
    extern __shared__ __attribute__((aligned(16))) unsigned char lds_raw[];
    Ctx X; X.lds = (LAS unsigned char*)lds_raw; X.tid = threadIdx.x; X.lane = X.tid & 63; X.wave = __builtin_amdgcn_readfirstlane(X.tid >> 6);
    X.G = gridDim.x; { const int bx = blockIdx.x; X.vcu = (X.G % 8 == 0) ? (bx % 8) * (X.G / 8) + bx / 8 : bx; }
    X.gw = X.vcu * NWAVES + X.wave; X.NGW = X.G * NWAVES;
    volatile LAS unsigned* MISC = (volatile LAS unsigned*)(X.lds + LDSCTL_OFF);
    for (int u = X.tid; u < 256; u += NTHREADS) MISC[u] = 0u;
    __syncthreads();
    unsigned char* ws = a.ws;
    unsigned* ctl = (unsigned*)(ws + WS_CTL);
    XcdBarrier bar = xcd_barrier_post(ctl + CW_BAR, MISC + 8);
    const int lo = a.ph_lo, hi = a.ph_hi;
#ifndef ONLY_PHASE
#define ONLY_PHASE -1
#endif
#define IN(k) ((ONLY_PHASE < 0 || ONLY_PHASE == (k)) && lo <= (k) && (k) < hi)
#define SEAM(k) do { if (IN(k) && IN((k) + 1)) xcd_barrier(bar); } while (0)
    const float* x_in = (const float*)a.in[0]; const float* c_in = (const float*)a.in[1]; const int* positions = (const int*)a.in[2];
    const float* ada_w = (const float*)a.in[3]; const float* ada_b = (const float*)a.in[4]; const float* norm1_g = (const float*)a.in[5]; const float* norm2_g = (const float*)a.in[6];
    const float* sb_w_qkv = (const float*)a.in[7]; const float* sb_w_o = (const float*)a.in[8]; const float* dsa_w_in = (const float*)a.in[9];
    const float* dsa_q_gain = (const float*)a.in[10]; const float* dsa_k_gain = (const float*)a.in[11]; const float* dsa_w_o = (const float*)a.in[12];
    const float* router_w = (const float*)a.in[13]; const float* router_b = (const float*)a.in[14];
    const float* exp_w_gu = (const float*)a.in[15]; const float* exp_b_gu = (const float*)a.in[16]; const float* exp_w_down = (const float*)a.in[17]; const float* exp_b_down = (const float*)a.in[18];
    float* out = a.out;
    float* mod = (float*)(ws + WS_MOD);
    bf16* Wqkv_t = (bf16*)(ws + WS_WQKV); bf16* Wo0_t = (bf16*)(ws + WS_WO0); bf16* Win_t = (bf16*)(ws + WS_WIN); bf16* Wo1_t = (bf16*)(ws + WS_WO1); bf16* Wgu_t = (bf16*)(ws + WS_WGU); bf16* Wd_t = (bf16*)(ws + WS_WD);
    bf16* H = (bf16*)(ws + WS_H); bf16* QKV = (bf16*)(ws + WS_QKV); bf16* ACT = (bf16*)(ws + WS_A); bf16* Y = (bf16*)(ws + WS_B); bf16* O = (bf16*)(ws + WS_O);
    bf16* PRAW = (bf16*)(ws + WS_PRAW); bf16* Q1 = (bf16*)(ws + WS_Q1); bf16* K1 = (bf16*)(ws + WS_K1); bf16* V1 = (bf16*)(ws + WS_V1); bf16* QI = (bf16*)(ws + WS_QI); bf16* KI = (bf16*)(ws + WS_KI); float* WI = (float*)(ws + WS_WI);
    unsigned long long* MASK = (unsigned long long*)(ws + WS_MASK); float* SC = (float*)(ws + WS_SC);
    int* tok_e = (int*)(ws + WS_TOKE); int* tok_p = (int*)(ws + WS_TOKP); int* list = (int*)(ws + WS_LIST); float* gate_e = (float*)(ws + WS_GATE);
    unsigned* gcnt0 = ctl + CW_CNT; unsigned* gcnt1 = ctl + CW_CNT + 32;
    const float* mod0 = mod; const float* mod1 = mod + (size_t)NB * 6144;

    if (IN(0)) { phase_prologue(X, c_in, ada_w, ada_b, mod, sb_w_qkv, sb_w_o, dsa_w_in, dsa_w_o, exp_w_gu, exp_w_down, Wqkv_t, Wo0_t, Win_t, Wo1_t, Wgu_t, Wd_t); SEAM(0); }
    if (IN(1)) { phase_norm1(X, x_in, norm1_g, mod0, H); SEAM(1); }
    if (IN(2)) { pg8::Gemm g{H, Wqkv_t, DM, 0}; pg8::StaticOrder S; S.init(NTOK, NQKV, X.G, (int)blockIdx.x); pg8::EpiBf16S E{QKV, NQKV, DM, QSCALE};
        pg8::gemm_phase<pg8::EpiBf16S, pg8::StaticOrder, false, true>(X.lds, g, S, E); SEAM(2); }
#if defined(NAIVE_SB)
    if (IN(3)) { phase_sb_naive(X, QKV, O); SEAM(3); }
#else
    if (IN(3)) { phase_sb_fast(X, QKV, O); SEAM(3); }
#endif
    if (IN(4)) { pg8::Gemm g{O, Wo0_t, DM, 0}; pg8::StaticOrder S; S.init(NTOK, DM, X.G, (int)blockIdx.x); pg8::EpiResid E{x_in, out, mod0 + 2 * DM};
        pg8::gemm_phase<pg8::EpiResid, pg8::StaticOrder, false, true>(X.lds, g, S, E); SEAM(4); }
    if (IN(5)) { phase_norm2_router(X, out, norm2_g, mod0, router_w, router_b, H, tok_e, tok_p, gcnt0, list, gate_e); SEAM(5); }
    if (IN(6)) { moe_gemms_gu(X, H, Wgu_t, exp_b_gu, ACT, gcnt0, list); SEAM(6); }
    if (IN(7)) { moe_gemms_down(X, ACT, Wd_t, exp_b_down, Y, gcnt0, list, gate_e); SEAM(7); }
    if (IN(8)) { phase_combine(X, out, Y, tok_e, tok_p, gcnt0, mod0, true, norm1_g + DM, mod1, H); SEAM(8); }
    if (IN(9)) { pg8::Gemm g{H, Win_t, DM, 0}; pg8::StaticOrder S; S.init(NTOK, NPROJ, X.G, (int)blockIdx.x); pg8::EpiBf16S E{PRAW, NPROJ, 0, 1.0f};
        pg8::gemm_phase<pg8::EpiBf16S, pg8::StaticOrder, false, true>(X.lds, g, S, E); SEAM(9); }
    if (IN(10)) { phase_dsa_post(X, PRAW, positions, dsa_q_gain, dsa_k_gain, Q1, K1, V1, QI, KI, WI); SEAM(10); }
#if defined(NAIVE_IDX)
    if (IN(11)) { phase_idx_naive(X, QI, KI, WI, SC); SEAM(11); }
    if (IN(12)) { phase_topk_naive(X, SC, MASK); SEAM(12); }
#else
    if (IN(11)) { phase_idx_topk_fast(X, QI, KI, WI, MASK); if (IN(13)) xcd_barrier(bar); }
#endif
#if defined(NAIVE_SPARSE)
    if (IN(13)) { phase_sparse_naive(X, Q1, K1, V1, MASK, O); SEAM(13); }
#else
    if (IN(13)) { phase_sparse_fast(X, Q1, K1, V1, (const unsigned*)MASK, O); SEAM(13); }
#endif
    if (IN(14)) { pg8::Gemm g{O, Wo1_t, DM, 0}; pg8::StaticOrder S; S.init(NTOK, DM, X.G, (int)blockIdx.x); pg8::EpiResid E{out, out, mod1 + 2 * DM};
        pg8::gemm_phase<pg8::EpiResid, pg8::StaticOrder, false, true>(X.lds, g, S, E); SEAM(14); }
    if (IN(15)) { phase_norm2_router(X, out, norm2_g + DM, mod1, router_w + (size_t)DM * NE, router_b + NE, H, tok_e, tok_p, gcnt1, list, gate_e); SEAM(15); }
    if (IN(16)) { moe_gemms_gu(X, H, Wgu_t + (size_t)NE * 2048 * DM, exp_b_gu + (size_t)NE * 2048, ACT, gcnt1, list); SEAM(16); }
    if (IN(17)) { moe_gemms_down(X, ACT, Wd_t + (size_t)NE * DM * DM, exp_b_down + (size_t)NE * DM, Y, gcnt1, list, gate_e); SEAM(17); }
    if (IN(18)) { phase_combine(X, out, Y, tok_e, tok_p, gcnt1, mod1, false, nullptr, nullptr, nullptr); }
#undef IN
#undef SEAM
}

extern "C" void kernel_launch(void* const* d_in, const int* in_sizes, int n_in, void* d_out, int out_size, void* d_ws, size_t ws_size, hipStream_t stream) {
    static int grid = 0;
    if (grid == 0) {
        if (n_in != 19 || out_size != NTOK * DM || ws_size < WS_END) { fprintf(stderr, "kernel_launch: unexpected shapes (n_in %d, out %d, ws %zu < %zu)\n", n_in, out_size, ws_size, (size_t)WS_END); grid = -1; return; }
        int dev = 0, cus = 0, per_cu = 0;
        if (hipGetDevice(&dev) != hipSuccess || hipDeviceGetAttribute(&cus, hipDeviceAttributeMultiprocessorCount, dev) != hipSuccess) { grid = -1; return; }
        if (hipFuncSetAttribute((const void*)mk_fwd, hipFuncAttributeMaxDynamicSharedMemorySize, LDS_BYTES) != hipSuccess) { fprintf(stderr, "kernel_launch: hipFuncSetAttribute failed\n"); grid = -1; return; }
        if (hipOccupancyMaxActiveBlocksPerMultiprocessor(&per_cu, (const void*)mk_fwd, NTHREADS, LDS_BYTES) != hipSuccess || per_cu < 1)
            fprintf(stderr, "kernel_launch: occupancy query reports %d workgroups per CU\n", per_cu);
        (void)hipGetLastError();
        grid = cus;
    }
    if (grid < 0) return;
    if (hipMemsetAsync((char*)d_ws + WS_CTL, 0, CTL_ZERO_BYTES, stream) != hipSuccess) return;
    Args a{};
    for (int i = 0; i < 19; ++i) a.in[i] = d_in[i];
    a.out = (float*)d_out; a.ws = (unsigned char*)d_ws;
#if MK_N_LAUNCHES == 1
    a.ph_lo = 0; a.ph_hi = NPHASES;
    hipLaunchKernelGGL(mk_fwd, dim3(grid), dim3(NTHREADS), LDS_BYTES, stream, a);
#else
    for (int p = 0; p < NPHASES; ++p) { a.ph_lo = p; a.ph_hi = p + 1; hipLaunchKernelGGL(mk_fwd, dim3(grid), dim3(NTHREADS), LDS_BYTES, stream, a); }
#endif
}
```

```cpp
#include <hip/hip_runtime.h>
#include <cstdio>
#include <cstdint>

#define GAS __attribute__((address_space(1)))
#define LAS __attribute__((address_space(3)))
typedef unsigned short bf16;
typedef short bf16x8 __attribute__((ext_vector_type(8)));
typedef float f32x4 __attribute__((ext_vector_type(4)));
typedef float f32x2 __attribute__((ext_vector_type(2)));
__device__ __forceinline__ float relu1(float z) { const int b = __float_as_int(z); return __int_as_float(b > 0 ? b : 0); }
typedef unsigned u32x4 __attribute__((ext_vector_type(4)));
typedef unsigned u32x2 __attribute__((ext_vector_type(2)));
typedef GAS unsigned gu32;

constexpr int DM = 1024, NB = 32, SEQ = 2048, NTOK = NB * SEQ, NE = 32, TOPK = 4, HD = 64, NH = 16;
constexpr int NQKV = 3072, NPROJ = 2048, NPROJ_REAL = 1864;
constexpr int ECAP = 65536;
constexpr int MOE_ROWS = NTOK * TOPK + NE * 256;
constexpr float EPS = 1e-6f;
constexpr float LOG2E = 1.4426950408889634f;
constexpr float QSCALE = 0.125f * LOG2E;
constexpr int NWAVES = 8, NTHREADS = 512;

constexpr size_t MiB = (size_t)1 << 20;
constexpr size_t WS_CTL = 0, CTL_ZERO_BYTES = 1 * MiB;
constexpr size_t WS_MOD = 1 * MiB;
constexpr size_t WS_WQKV = 3 * MiB, WS_WO0 = 9 * MiB, WS_WIN = 11 * MiB, WS_WO1 = 15 * MiB, WS_WGU = 17 * MiB, WS_WD = 273 * MiB;
constexpr size_t WS_H = 402 * MiB;
constexpr size_t WS_HS = WS_H + 64 * MiB, WS_WSC = 6 * MiB;
constexpr size_t WS_A = 530 * MiB;
constexpr size_t WS_QKV = WS_A, WS_PRAW = WS_A, WS_Q1 = 786 * MiB, WS_K1 = 914 * MiB, WS_V1 = 930 * MiB, WS_QI = 946 * MiB, WS_KI = 1010 * MiB, WS_WI = 1018 * MiB, WS_QN = 1020 * MiB, WS_ROPE = 1022 * MiB;
constexpr size_t WS_B = 1058 * MiB;
constexpr size_t WS_O = WS_B, WS_MASK = 1186 * MiB, WS_SC = 1202 * MiB;
constexpr size_t WS_TOKE = 1720 * MiB, WS_TOKP = 1721 * MiB, WS_TOKG = 1722 * MiB, WS_LIST = 1724 * MiB, WS_GATE = 1732 * MiB, WS_HSE = 1740 * MiB, WS_XR = 1748 * MiB, WS_END = 1876 * MiB;
static_assert(WS_A + (size_t)MOE_ROWS * DM * 2 <= WS_B && WS_B + (size_t)MOE_ROWS * DM * 2 <= WS_TOKE && WS_SC + (size_t)NTOK * SEQ * 4 <= WS_TOKE, "ws map");
constexpr int CW_TMO = 0, CW_BAR = 4096, CW_CNT = 8192, CW_KMAX = 8320, CW_ADA = 8448, CW_ITEM = 8456;

constexpr int RING_BYTES = 131072;
constexpr int LDSCTL_OFF = RING_BYTES;
constexpr int EXTRA_OFF = RING_BYTES + 1024;
constexpr int LDS_BYTES = 163840;

#define WAITV(n) asm volatile("s_waitcnt vmcnt(" #n ")" ::: "memory")
#define SBAR() do { asm volatile("" ::: "memory"); __builtin_amdgcn_s_barrier(); asm volatile("" ::: "memory"); } while (0)
#define LDS_WAIT() asm volatile("s_waitcnt lgkmcnt(0)" ::: "memory")
#define VM_WAIT() asm volatile("s_waitcnt vmcnt(0)" ::: "memory")
__device__ __forceinline__ unsigned f2bf(float f) { unsigned u = __builtin_bit_cast(unsigned, f); return (u + 0x7fffu + ((u >> 16) & 1u)) >> 16; }
typedef __bf16 bf16x2n __attribute__((ext_vector_type(2)));
__device__ __forceinline__ unsigned cvt_pk_bf16(float lo, float hi) { return __builtin_bit_cast(unsigned, __builtin_convertvector((f32x2){lo, hi}, bf16x2n)); }
__device__ __forceinline__ unsigned pk2(float lo, float hi) { return cvt_pk_bf16(lo, hi); }
__device__ __forceinline__ float bflo(unsigned w) { return __uint_as_float(w << 16); }
__device__ __forceinline__ float bfhi(unsigned w) { return __uint_as_float(w & 0xffff0000u); }
__device__ __forceinline__ unsigned pack4i(float a, float b, float c, float d) { return ((unsigned)(int)a & 0xffu) | (((unsigned)(int)b & 0xffu) << 8) | (((unsigned)(int)c & 0xffu) << 16) | (((unsigned)(int)d & 0xffu) << 24); }
template <int CTRL> __device__ __forceinline__ float dpp_mov(float v) { return __uint_as_float((unsigned)__builtin_amdgcn_update_dpp(0, (int)__float_as_uint(v), CTRL, 0xF, 0xF, true)); }
__device__ __forceinline__ float row_sum16(float v) { v += dpp_mov<0xB1>(v); v += dpp_mov<0x4E>(v); v += dpp_mov<0x141>(v); v += dpp_mov<0x140>(v); return v; }
__device__ __forceinline__ float row_max16(float v) { v = fmaxf(v, dpp_mov<0xB1>(v)); v = fmaxf(v, dpp_mov<0x4E>(v)); v = fmaxf(v, dpp_mov<0x141>(v)); v = fmaxf(v, dpp_mov<0x140>(v)); return v; }
__device__ __forceinline__ float quad_sum(float v) { v += dpp_mov<0xB1>(v); v += dpp_mov<0x4E>(v); return v; }
__device__ __forceinline__ float wave_sum(float v) {
    v = row_sum16(v);
    { const auto r = __builtin_amdgcn_permlane16_swap(__float_as_uint(v), __float_as_uint(v), false, false); v = __uint_as_float(r[0]) + __uint_as_float(r[1]); }
    { const auto r = __builtin_amdgcn_permlane32_swap(__float_as_uint(v), __float_as_uint(v), false, false); v = __uint_as_float(r[0]) + __uint_as_float(r[1]); }
    return v;
}
__device__ __forceinline__ float half_max32(float v) {
    v = row_max16(v);
    { const auto r = __builtin_amdgcn_permlane16_swap(__float_as_uint(v), __float_as_uint(v), false, false); v = fmaxf(__uint_as_float(r[0]), __uint_as_float(r[1])); }
    return v;
}
__device__ __forceinline__ float wave_max(float v) {
    v = half_max32(v);
    { const auto r = __builtin_amdgcn_permlane32_swap(__float_as_uint(v), __float_as_uint(v), false, false); v = fmaxf(__uint_as_float(r[0]), __uint_as_float(r[1])); }
    return v;
}

#if defined(PROBE_SEC)
#define SEC_BEGIN2(tag) unsigned long long _s2_t0 = ((tag) == PROBE_SEC) ? __builtin_amdgcn_s_memrealtime() : 0ull
#define SEC_END2(tag) do { if ((tag) == PROBE_SEC && blockIdx.x == 0 && threadIdx.x == 0) { volatile LAS unsigned long long* _acc = (volatile LAS unsigned long long*)(lds + LDSCTL_OFF + 64); *_acc = *_acc + (__builtin_amdgcn_s_memrealtime() - _s2_t0); } } while (0)
#define SEC_BEGIN3(tag) unsigned long long _s3_t0 = ((tag) == PROBE_SEC) ? __builtin_amdgcn_s_memrealtime() : 0ull
#define SEC_END3(tag) do { asm volatile("s_waitcnt vmcnt(0)" ::: "memory"); if ((tag) == PROBE_SEC && blockIdx.x == 0 && threadIdx.x == 0) { volatile LAS unsigned long long* _acc = (volatile LAS unsigned long long*)(lds + LDSCTL_OFF + 64); *_acc = *_acc + (__builtin_amdgcn_s_memrealtime() - _s3_t0); } } while (0)
#else
#define SEC_BEGIN2(tag) do {} while (0)
#define SEC_END2(tag) do {} while (0)
#define SEC_BEGIN3(tag) do {} while (0)
#define SEC_END3(tag) do {} while (0)
#endif
namespace pg8 {
constexpr int BM = 256, BK = 64, HALF = 128, HTB = HALF * BK * 2, NXCD = 8, WGM = 8;
__host__ __device__ __forceinline__ int lds_byte(int r, int c) { const int st = (r >> 4) * 2 + (c >> 5), rr = r & 15, cc = c & 31, ob = rr * 64 + cc * 2; return st * 1024 + (ob ^ (((ob >> 9) & 1) << 5)); }
__host__ __device__ __forceinline__ void stage_rc(int b, int& R, int& C) { const int st = b / 1024, sb = b % 1024, swz = sb ^ (((sb >> 9) & 1) << 5); R = (st >> 1) * 16 + swz / 64; C = (st & 1) * 32 + (swz % 64) / 2; }
__host__ __device__ __forceinline__ int perm32(int rho) { const int n = rho >> 4, i = rho & 15; return 8 * (i >> 2) + 4 * n + (i & 3); }

constexpr float ACT_PRESCALE = 4.0f, Y_PRESCALE = 4.0f;
struct Unit { int pm, pn, e; };
struct Gemm { const bf16* A; const bf16* Bt; int K; size_t bstride; };

struct StaticOrder {
    int nM, nN, nwg, G, c;
    __device__ void init(int M, int N, int G_, int c_) { nM = M / BM; nN = N / BM; nwg = nM * nN; G = G_; c = c_; }
    __device__ bool next(int i, Unit& u) const {
        const long L = (long)i * G + c; if (L >= nwg) return false;
        int wgid = (int)L; { const int q = nwg / NXCD, r = nwg % NXCD, xcd = wgid % NXCD, off = wgid / NXCD; wgid = (xcd < r ? xcd * (q + 1) : r * (q + 1) + (xcd - r) * q) + off; }
        const int nig = WGM * nN, gid = wgid / nig, fm = gid * WGM, gsz = (nM - fm) < WGM ? (nM - fm) : WGM;
        u.pm = fm + ((wgid % nig) % gsz); u.pn = (wgid % nig) / gsz; u.e = 0; return true;
    }
    __device__ __forceinline__ int arow(const Unit&, int) const { return 0; }
};
struct MoeOrder {
    const LAS int* tsum; const LAS int* cnt; const int* list; int nN, G, c, total; mutable int ehint;
    __device__ bool next(int i, Unit& u) const {
        const int L = i * G + (c & 7) * (G >> 3) + (c >> 3); if (L >= total) return false;
        const int tile = L / nN; u.pn = L - tile * nN;
        int e = ehint; while (tile >= tsum[e + 1]) ++e;
        ehint = e; u.e = e; u.pm = tile; return true;
    }
    __device__ __forceinline__ int arow(const Unit& u, int r) const {
        int p = (u.pm - tsum[u.e]) * BM + r; const int c_ = cnt[u.e]; p = p < c_ ? p : c_ - 1; return list[(size_t)u.e * ECAP + p];
    }
};

using ::cvt_pk_bf16;

struct EpiBf16S {
    typedef f32x4 AccT; static constexpr int SEC = 50;
    static constexpr bool PERM = true;
    bf16* O; int ldc; int scale_cols; float scale0;
    __device__ __forceinline__ void operator()(const f32x4 (&acc)[2][2][4][2], const Unit& u, int wr, int wc, int fr, int fq) const {
        const int row0 = u.pm * BM + wr * 64 + fr, col0 = u.pn * BM + wc * 32 + 8 * fq; const float sc = (u.pn * BM < scale_cols) ? scale0 : 1.f;
#pragma unroll
        for (int ai = 0; ai < 2; ++ai)
#pragma unroll
            for (int m = 0; m < 4; ++m) { bf16* rowp = O + (size_t)(row0 + ai * HALF + m * 16) * ldc + col0;
#pragma unroll
                for (int bj = 0; bj < 2; ++bj) { const f32x4 v0 = acc[ai][bj][m][0] * sc, v1 = acc[ai][bj][m][1] * sc;
                    u32x4 w; w.x = cvt_pk_bf16(v0[0], v0[1]); w.y = cvt_pk_bf16(v0[2], v0[3]); w.z = cvt_pk_bf16(v1[0], v1[1]); w.w = cvt_pk_bf16(v1[2], v1[3]);
                    *(GAS u32x4*)(rowp + bj * HALF) = w; } }
    }
};
template <bool IN_BF16>
struct EpiResid {
    typedef f32x4 AccT; static constexpr int SEC = 40;
    static constexpr bool PERM = false;
    const void* xin; bf16* out; const float* gate;
    __device__ __forceinline__ void operator()(const f32x4 (&acc)[2][2][4][2], const Unit& u, int wr, int wc, int fr, int fq) const {
        const int row0 = u.pm * BM + wr * 64 + fr, b = u.pm >> 3, col0 = u.pn * BM + wc * 32 + 4 * fq;
#pragma unroll
        for (int bj = 0; bj < 2; ++bj)
#pragma unroll
            for (int n = 0; n < 2; ++n) { const int c = col0 + bj * HALF + 16 * n; const f32x4 g4 = *(const GAS f32x4*)(gate + (size_t)b * 6144 + c);
#pragma unroll
                for (int ai = 0; ai < 2; ++ai)
#pragma unroll
                    for (int m = 0; m < 4; ++m) { const size_t o = (size_t)(row0 + ai * HALF + m * 16) * DM + c; f32x4 x4;
                        if constexpr (IN_BF16) { const u32x2 w = *(const GAS u32x2*)((const bf16*)xin + o); x4 = (f32x4){bflo(w.x), bfhi(w.x), bflo(w.y), bfhi(w.y)}; }
                        else x4 = *(const GAS f32x4*)((const float*)xin + o);
                        const f32x4 r = x4 + g4 * acc[ai][bj][m][n];
                        *(GAS u32x2*)(out + o) = (u32x2){cvt_pk_bf16(r[0], r[1]), cvt_pk_bf16(r[2], r[3])}; } }
    }
};

__device__ __forceinline__ float swiglu1(float g, float u) {
    g = fminf(g, 7.0f); u = fminf(fmaxf(u, -7.0f), 7.0f);
    const float e = __builtin_amdgcn_exp2f(g * (-1.702f * LOG2E));
    return (u + 1.0f) * g * __builtin_amdgcn_rcpf(1.0f + e);
}
__device__ __forceinline__ f32x2 swiglu_pk(f32x2 g, f32x2 u) {
    g.x = fminf(g.x, 7.0f); g.y = fminf(g.y, 7.0f); u.x = __builtin_amdgcn_fmed3f(u.x, -6.0f, 8.0f); u.y = __builtin_amdgcn_fmed3f(u.y, -6.0f, 8.0f);
    const f32x2 t = g * (-1.702f * LOG2E);
    f32x2 e; e.x = __builtin_amdgcn_exp2f(t.x); e.y = __builtin_amdgcn_exp2f(t.y);
    const f32x2 d = e * (1.0f / ACT_PRESCALE) + (1.0f / ACT_PRESCALE);
    f32x2 r; r.x = __builtin_amdgcn_rcpf(d.x); r.y = __builtin_amdgcn_rcpf(d.y);
    return u * (g * r);
}
struct EpiSwiglu {
    typedef f32x4 AccT; static constexpr int SEC = 60;
    static constexpr bool PERM = true;
    bf16* ACT; const float* bgu;
    __device__ __forceinline__ void operator()(const f32x4 (&acc)[2][2][4][2], const Unit& u, int wr, int wc, int fr, int fq) const {
        const int row0 = u.pm * BM + wr * 64 + fr, jl0 = wc * 32 + 8 * fq, colA = u.pn * HALF + jl0;
        const GAS f32x4* bp = (const GAS f32x4*)(bgu + (size_t)u.e * 2048 + 2 * (u.pn * HALF + jl0));
        const f32x4 b0 = bp[0], b1 = bp[1], b2 = bp[2], b3 = bp[3];
        const f32x4 bg[2] = {(f32x4){b0[0], b0[2], b1[0], b1[2]}, (f32x4){b2[0], b2[2], b3[0], b3[2]}};
        const f32x4 bu[2] = {(f32x4){b0[1], b0[3], b1[1], b1[3]}, (f32x4){b2[1], b2[3], b3[1], b3[3]}};
#pragma unroll
        for (int ai = 0; ai < 2; ++ai)
#pragma unroll
            for (int m = 0; m < 4; ++m) { float o[8];
#pragma unroll
                for (int n = 0; n < 2; ++n) { const f32x4 g4 = acc[ai][0][m][n] + bg[n], u4 = acc[ai][1][m][n] + bu[n];
#pragma unroll
                    for (int i = 0; i < 4; ++i) o[4 * n + i] = swiglu1(g4[i], u4[i]); }
                u32x4 w; w.x = cvt_pk_bf16(o[0], o[1]); w.y = cvt_pk_bf16(o[2], o[3]); w.z = cvt_pk_bf16(o[4], o[5]); w.w = cvt_pk_bf16(o[6], o[7]);
                *(GAS u32x4*)(ACT + (size_t)(row0 + ai * HALF + m * 16) * DM + colA) = w; }
    }
};
struct EpiDown {
    typedef f32x4 AccT; static constexpr int SEC = 20;
    static constexpr bool PERM = true;
    bf16* Y; const float* bd; const float* gate_e; const LAS int* tsum;
    __device__ __forceinline__ void operator()(const f32x4 (&acc)[2][2][4][2], const Unit& u, int wr, int wc, int fr, int fq) const {
        const int row0 = u.pm * BM + wr * 64 + fr, col0 = u.pn * BM + wc * 32 + 8 * fq, lrow0 = (u.pm - tsum[u.e]) * BM + wr * 64 + fr;
        f32x4 bv[2][2];
#pragma unroll
        for (int bj = 0; bj < 2; ++bj)
#pragma unroll
            for (int n = 0; n < 2; ++n) bv[bj][n] = *(const GAS f32x4*)(bd + (size_t)u.e * DM + col0 + bj * HALF + 4 * n);
#pragma unroll
        for (int ai = 0; ai < 2; ++ai)
#pragma unroll
            for (int m = 0; m < 4; ++m) { const float gt = gate_e[(size_t)u.e * ECAP + lrow0 + ai * HALF + m * 16]; bf16* rowp = Y + (size_t)(row0 + ai * HALF + m * 16) * DM + col0;
#pragma unroll
                for (int bj = 0; bj < 2; ++bj) { const f32x4 v0 = (acc[ai][bj][m][0] + bv[bj][0]) * gt, v1 = (acc[ai][bj][m][1] + bv[bj][1]) * gt;
                    u32x4 w; w.x = cvt_pk_bf16(v0[0], v0[1]); w.y = cvt_pk_bf16(v0[2], v0[3]); w.z = cvt_pk_bf16(v1[0], v1[1]); w.w = cvt_pk_bf16(v1[2], v1[3]);
                    *(GAS u32x4*)(rowp + bj * HALF) = w; } }
    }
};
struct EpiDownF8 {
    typedef f32x4 AccT; static constexpr int SEC = 22;
    static constexpr bool PERM = true;
    unsigned char* Y; const float* bd; const float* gate_e; const LAS int* tsum; const float* wsd;
    __device__ __forceinline__ void operator()(const f32x4 (&acc)[2][2][4][2], const Unit& u, int wr, int wc, int fr, int fq) const {
        const int row0 = u.pm * BM + wr * 64 + fr, col0 = u.pn * BM + wc * 32 + 8 * fq, lrow0 = (u.pm - tsum[u.e]) * BM + wr * 64 + fr;
        float gt[2][4];
#pragma unroll
        for (int ai = 0; ai < 2; ++ai)
#pragma unroll
            for (int m = 0; m < 4; ++m) gt[ai][m] = gate_e[(size_t)u.e * ECAP + lrow0 + ai * HALF + m * 16] * Y_PRESCALE;
#pragma unroll
        for (int bj = 0; bj < 2; ++bj) {
            const GAS f32x4* bp = (const GAS f32x4*)(bd + (size_t)u.e * DM + col0 + bj * HALF); const GAS f32x4* sp = (const GAS f32x4*)(wsd + (size_t)u.e * DM + col0 + bj * HALF);
            const f32x4 b0 = bp[0], b1 = bp[1], s0 = sp[0] * (1.0f / ACT_PRESCALE), s1 = sp[1] * (1.0f / ACT_PRESCALE);
#pragma unroll
            for (int ai = 0; ai < 2; ++ai)
#pragma unroll
                for (int m = 0; m < 4; ++m) { const f32x4 a0 = acc[ai][bj][m][0], a1 = acc[ai][bj][m][1]; const float g4 = gt[ai][m];
                    const f32x2 p0 = ((f32x2){a0[0], a0[1]} * (f32x2){s0[0], s0[1]} + (f32x2){b0[0], b0[1]}) * g4, p1 = ((f32x2){a0[2], a0[3]} * (f32x2){s0[2], s0[3]} + (f32x2){b0[2], b0[3]}) * g4;
                    const f32x2 p2 = ((f32x2){a1[0], a1[1]} * (f32x2){s1[0], s1[1]} + (f32x2){b1[0], b1[1]}) * g4, p3 = ((f32x2){a1[2], a1[3]} * (f32x2){s1[2], s1[3]} + (f32x2){b1[2], b1[3]}) * g4;
#define MK_CL(x) __builtin_amdgcn_fmed3f((x), -448.f, 448.f)
                    unsigned w0 = 0u, w1 = 0u;
                    w0 = __builtin_amdgcn_cvt_pk_fp8_f32(MK_CL(p0.x), MK_CL(p0.y), w0, false); w0 = __builtin_amdgcn_cvt_pk_fp8_f32(MK_CL(p1.x), MK_CL(p1.y), w0, true);
                    w1 = __builtin_amdgcn_cvt_pk_fp8_f32(MK_CL(p2.x), MK_CL(p2.y), w1, false); w1 = __builtin_amdgcn_cvt_pk_fp8_f32(MK_CL(p3.x), MK_CL(p3.y), w1, true);
#undef MK_CL
                    *(GAS u32x2*)(Y + (size_t)(row0 + ai * HALF + m * 16) * DM + col0 + bj * HALF) = (u32x2){w0, w1}; }
        }
    }
};


typedef int i32x4e __attribute__((ext_vector_type(4)));
__device__ __forceinline__ f32x4 cvt4(const i32x4e v) { return (f32x4){(float)v[0], (float)v[1], (float)v[2], (float)v[3]}; }
struct EpiBf16S8 {   static constexpr int SEC = 30;
    typedef i32x4e AccT;
    static constexpr bool PERM = true;
    bf16* O; int ldc; int scale_cols; float scale0; const float* sa; const float* sb;
    __device__ __forceinline__ void operator()(const i32x4e (&acc)[2][2][4][2], const Unit& u, int wr, int wc, int fr, int fq) const {
        const int row0 = u.pm * BM + wr * 64 + fr, col0 = u.pn * BM + wc * 32 + 8 * fq; const float sc = (u.pn * BM < scale_cols) ? scale0 : 1.f;
        f32x4 bs[2][2];
#pragma unroll
        for (int bj = 0; bj < 2; ++bj)
#pragma unroll
            for (int n = 0; n < 2; ++n) bs[bj][n] = *(const GAS f32x4*)(sb + col0 + bj * HALF + 4 * n) * sc;
#pragma unroll
        for (int ai = 0; ai < 2; ++ai)
#pragma unroll
            for (int m = 0; m < 4; ++m) { const int r = row0 + ai * HALF + m * 16; const float ra = sa[r]; bf16* rowp = O + (size_t)r * ldc + col0;
#pragma unroll
                for (int bj = 0; bj < 2; ++bj) { const f32x4 v0 = cvt4(acc[ai][bj][m][0]) * bs[bj][0] * ra, v1 = cvt4(acc[ai][bj][m][1]) * bs[bj][1] * ra;
                    u32x4 w; w.x = cvt_pk_bf16(v0[0], v0[1]); w.y = cvt_pk_bf16(v0[2], v0[3]); w.z = cvt_pk_bf16(v1[0], v1[1]); w.w = cvt_pk_bf16(v1[2], v1[3]);
                    *(GAS u32x4*)(rowp + bj * HALF) = w; } }
    }
};
struct EpiSwiglu8 {   static constexpr int SEC = 10;
    typedef i32x4e AccT;
    static constexpr bool PERM = true;
    unsigned char* ACT; const float* bgu; const float* hs; const float* ws  ; const MoeOrder* S;
    __device__ __forceinline__ void operator()(const i32x4e (&acc)[2][2][4][2], const Unit& u, int wr, int wc, int fr, int fq) const {
        const int row0 = u.pm * BM + wr * 64 + fr, jl0 = wc * 32 + 8 * fq, colA = u.pn * HALF + jl0, lrow0 = (u.pm - S->tsum[u.e]) * BM + wr * 64 + fr;
        const GAS f32x4* bp = (const GAS f32x4*)(bgu + (size_t)u.e * 2048 + 2 * (u.pn * HALF + jl0));
        const f32x4 b0 = bp[0], b1 = bp[1], b2 = bp[2], b3 = bp[3];
        const f32x4 bg[2] = {(f32x4){b0[0], b0[2], b1[0], b1[2]}, (f32x4){b2[0], b2[2], b3[0], b3[2]}};
        const f32x4 bu[2] = {(f32x4){b0[1], b0[3], b1[1], b1[3]} + 1.0f, (f32x4){b2[1], b2[3], b3[1], b3[3]} + 1.0f};
        const GAS f32x4* wp = (const GAS f32x4*)(ws + (size_t)u.e * 2048 + u.pn * BM + jl0);
        const f32x4 wg[2] = {wp[0], wp[1]}, wu[2] = {wp[32], wp[33]};
#pragma unroll
        for (int ai = 0; ai < 2; ++ai)
#pragma unroll
            for (int m = 0; m < 4; ++m) { const float ra = hs[(size_t)u.e * ECAP + lrow0 + ai * HALF + m * 16]; f32x2 o[4];
#pragma unroll
                for (int n = 0; n < 2; ++n)
#pragma unroll
                    for (int h = 0; h < 2; ++h) { const i32x4e ag = acc[ai][0][m][n], au = acc[ai][1][m][n];
                        const f32x2 cg = {(float)ag[2 * h], (float)ag[2 * h + 1]}, cu = {(float)au[2 * h], (float)au[2 * h + 1]};
                        const f32x2 wgp = {wg[n][2 * h], wg[n][2 * h + 1]}, wup = {wu[n][2 * h], wu[n][2 * h + 1]}, bgp = {bg[n][2 * h], bg[n][2 * h + 1]}, bup = {bu[n][2 * h], bu[n][2 * h + 1]};
                        o[2 * n + h] = swiglu_pk((cg * wgp) * ra + bgp, (cu * wup) * ra + bup); }
                unsigned w0 = 0u, w1 = 0u;
                w0 = __builtin_amdgcn_cvt_pk_fp8_f32(o[0].x, o[0].y, w0, false); w0 = __builtin_amdgcn_cvt_pk_fp8_f32(o[1].x, o[1].y, w0, true);
                w1 = __builtin_amdgcn_cvt_pk_fp8_f32(o[2].x, o[2].y, w1, false); w1 = __builtin_amdgcn_cvt_pk_fp8_f32(o[3].x, o[3].y, w1, true);
                *(GAS u32x2*)(ACT + (size_t)(row0 + ai * HALF + m * 16) * DM + colA) = (u32x2){w0, w1}; }
    }
};
typedef int i32x4 __attribute__((ext_vector_type(4)));
typedef int i32x8 __attribute__((ext_vector_type(8)));
template <class Epi, class Sched, bool GATHER, bool ALIGN_EPI, int MODE = 0>
__device__ __forceinline__ void gemm_phase(LAS unsigned char* lds, const Gemm g, const Sched& S, const Epi& E) {
    const int tid = threadIdx.x, wid = __builtin_amdgcn_readfirstlane(tid >> 6), lane = tid & 63, wr = wid >> 2, wc = wid & 3, fr = lane & 15, fq = lane >> 4;
    constexpr int ESZ = MODE ? 1 : 2; constexpr bool INT8 = (MODE == 1);
    const int K = g.K, KB = K * ESZ  , nt = KB / (BK * 2);
    int Rr[2], Cc[2]; unsigned voffB[2];
#pragma unroll
    for (int i = 0; i < 2; ++i) { stage_rc(tid * 16 + i * 8192, Rr[i], Cc[i]); const int Rb = Epi::PERM ? ((Rr[i] & ~31) + perm32(Rr[i] & 31)) : Rr[i]; voffB[i] = (unsigned)(Rb * KB + Cc[i] * 2); }
    const size_t kstep = (size_t)(BK * 2), hstep = (size_t)HALF * KB, tstep = 2 * hstep;
    const unsigned ldsw = (unsigned)wid * 1024u;
    const int aoff = lds_byte(wr * 64 + fr, fq * 8), boff = lds_byte(wc * 32 + fr, fq * 8);
#define PG8_SA(b, h) (((b) * 2 + (h)) * HTB)
#define PG8_SB(b, h) ((4 + (b) * 2 + (h)) * HTB)
#define PG8_STAGE(bufoff, gbase, voff) do { _Pragma("unroll") for (int _i = 0; _i < 2; ++_i) \
        __builtin_amdgcn_global_load_lds((const GAS unsigned*)((const char*)(gbase) + (voff)[_i]), (LAS unsigned*)(lds + (bufoff) + ldsw + _i * 8192), 16, 0, 0); } while (0)
#define PG8_RD(off) (*(const LAS i32x4*)(lds + (off)))
#define PG8_LDA(dst, b, h) do { _Pragma("unroll") for (int m = 0; m < 4; ++m) { const i32x4 r0_ = PG8_RD(PG8_SA(b, h) + aoff + m * 2048), r1_ = PG8_RD(PG8_SA(b, h) + aoff + m * 2048 + 1024); \
        if constexpr (MODE == 2) dst##8[m] = __builtin_shufflevector(r0_, r1_, 0, 1, 2, 3, 4, 5, 6, 7); else { dst[m][0] = __builtin_bit_cast(bf16x8, r0_); dst[m][1] = __builtin_bit_cast(bf16x8, r1_); } } } while (0)
#define PG8_LDB(dst, b, h) do { _Pragma("unroll") for (int n = 0; n < 2; ++n) { const i32x4 r0_ = PG8_RD(PG8_SB(b, h) + boff + n * 2048), r1_ = PG8_RD(PG8_SB(b, h) + boff + n * 2048 + 1024); \
        if constexpr (MODE == 2) dst##8[n] = __builtin_shufflevector(r0_, r1_, 0, 1, 2, 3, 4, 5, 6, 7); else { dst[n][0] = __builtin_bit_cast(bf16x8, r0_); dst[n][1] = __builtin_bit_cast(bf16x8, r1_); } } } while (0)
#define PG8_CAT(lo, hi) __builtin_shufflevector(__builtin_bit_cast(i32x4, lo), __builtin_bit_cast(i32x4, hi), 0, 1, 2, 3, 4, 5, 6, 7)
#define PG8_MMA(ai, bj, At, Bt) do { __builtin_amdgcn_s_setprio(1); _Pragma("unroll") for (int m = 0; m < 4; ++m) _Pragma("unroll") for (int n = 0; n < 2; ++n) _Pragma("unroll") for (int k = 0; k < 2; ++k) { \
        if constexpr (MODE == 2) { if (k == 0) asm volatile("v_mfma_scale_f32_16x16x128_f8f6f4 %0, %1, %2, %0, %3, %3 op_sel_hi:[0,0,0]" : "+v"(acc[ai][bj][m][n]) : "v"(Bt##8[n]), "v"(At##8[m]), "v"(f8scale)); } \
        else if constexpr (INT8) acc[ai][bj][m][n] = __builtin_bit_cast(AccT, __builtin_amdgcn_mfma_i32_16x16x64_i8(__builtin_bit_cast(i32x4, Bt[n][k]), __builtin_bit_cast(i32x4, At[m][k]), __builtin_bit_cast(i32x4, acc[ai][bj][m][n]), 0, 0, 0)); \
        else acc[ai][bj][m][n] = __builtin_bit_cast(AccT, __builtin_amdgcn_mfma_f32_16x16x32_bf16(Bt[n][k], At[m][k], __builtin_bit_cast(f32x4, acc[ai][bj][m][n]), 0, 0, 0)); } __builtin_amdgcn_s_setprio(0); } while (0)
#define PG8_WAIT_V(n) asm volatile("s_waitcnt vmcnt(" #n ")" ::: "memory")
#define PG8_WAIT_L(n) asm volatile("s_waitcnt lgkmcnt(" #n ")" ::: "memory")
#define PG8_BAR __builtin_amdgcn_s_barrier()
#define PG8_SCHED __builtin_amdgcn_sched_barrier(0)
    Unit cur, nxt; int ui = 0;
    if (!S.next(0, cur)) return;
    typedef typename Epi::AccT AccT;
    AccT acc[2][2][4][2];
#pragma unroll
    for (int a = 0; a < 2; ++a)
#pragma unroll
        for (int b = 0; b < 2; ++b)
#pragma unroll
            for (int m = 0; m < 4; ++m)
#pragma unroll
                for (int n = 0; n < 2; ++n) acc[a][b][m][n] = AccT{};
    const int f8scale = 0x7F7F7F7F;
    bf16x8 At[4][2], B0[2][2], B1[2][2]; i32x8 At8[4], B08[2], B18[2];
    unsigned vA0[2], vA1[2];
#pragma unroll
    for (int i = 0; i < 2; ++i) {
        if constexpr (GATHER) { vA0[i] = (unsigned)(S.arow(cur, Rr[i]) * KB + Cc[i] * 2); vA1[i] = (unsigned)(S.arow(cur, HALF + Rr[i]) * KB + Cc[i] * 2); }
        else { vA0[i] = (unsigned)(Rr[i] * KB + Cc[i] * 2); vA1[i] = vA0[i] + (unsigned)hstep; }
    }
    const char* cA = GATHER ? (const char*)g.A : (const char*)g.A + (size_t)cur.pm * tstep;
    const char* cB = (const char*)g.Bt + (size_t)cur.e * g.bstride + (size_t)cur.pn * tstep;
    PG8_STAGE(PG8_SB(0, 0), cB, voffB); PG8_STAGE(PG8_SB(0, 1), cB + hstep, voffB); PG8_STAGE(PG8_SA(0, 0), cA, vA0); PG8_STAGE(PG8_SA(0, 1), cA, vA1);
    if (wr == 1) PG8_BAR;
    PG8_WAIT_V(2); PG8_BAR;
    PG8_STAGE(PG8_SB(1, 0), cB + kstep, voffB); PG8_STAGE(PG8_SA(1, 0), cA + kstep, vA0); PG8_STAGE(PG8_SB(1, 1), cB + hstep + kstep, voffB);
    PG8_WAIT_V(6); PG8_BAR;
    for (;;) {
        const bool has_next = S.next(ui + 1, nxt);
        const char* nA = has_next ? (GATHER ? (const char*)g.A : (const char*)g.A + (size_t)nxt.pm * tstep) : cA;
        const char* nB = has_next ? (const char*)g.Bt + (size_t)nxt.e * g.bstride + (size_t)nxt.pn * tstep : cB;
        int nr0[2] = {0, 0}, nr1[2] = {0, 0};
        if constexpr (GATHER) { if (has_next) {
#pragma unroll
            for (int i = 0; i < 2; ++i) { nr0[i] = S.arow(nxt, Rr[i]); nr1[i] = S.arow(nxt, HALF + Rr[i]); } } }
        SEC_BEGIN2(Epi::SEC);
        for (int t = 0; t < nt; t += 2) {
            const bool last = (t == nt - 2);
            const char* a1 = cA + (size_t)(t + 1) * kstep;
            const char* a2 = last ? nA : cA + (size_t)(t + 2) * kstep; const char* b2 = last ? nB : cB + (size_t)(t + 2) * kstep;
            const char* a3 = a2 + kstep; const char* b3 = b2 + kstep;
            if constexpr (GATHER) { if (last && has_next) {
                asm volatile("" : "+v"(nr0[0]), "+v"(nr0[1]), "+v"(nr1[0]), "+v"(nr1[1]));
#pragma unroll
                for (int i = 0; i < 2; ++i) { vA0[i] = (unsigned)(nr0[i] * KB + Cc[i] * 2); nr1[i] = (int)(unsigned)(nr1[i] * KB + Cc[i] * 2); } } }
            unsigned w0[2], w1[2];
#pragma unroll
            for (int i = 0; i < 2; ++i) { w0[i] = vA0[i]; w1[i] = (GATHER && last && has_next) ? (unsigned)nr1[i] : vA1[i]; }
            PG8_LDB(B0, 0, 0); PG8_LDB(B1, 0, 1); PG8_SCHED; PG8_LDA(At, 0, 0); PG8_STAGE(PG8_SA(1, 1), a1, vA1);
            PG8_WAIT_V(8); PG8_WAIT_L(0); PG8_BAR; PG8_MMA(0, 0, At, B0); PG8_MMA(0, 1, At, B1); PG8_BAR; PG8_SCHED;
            PG8_LDA(At, 0, 1); PG8_STAGE(PG8_SB(0, 0), b2, voffB); PG8_STAGE(PG8_SB(0, 1), b2 + hstep, voffB); PG8_STAGE(PG8_SA(0, 0), a2, w0);
            PG8_WAIT_V(8); PG8_WAIT_L(0); PG8_BAR; PG8_MMA(1, 0, At, B0); PG8_MMA(1, 1, At, B1); PG8_BAR; PG8_SCHED;
            PG8_LDB(B0, 1, 0); PG8_LDB(B1, 1, 1); PG8_SCHED; PG8_LDA(At, 1, 0); PG8_STAGE(PG8_SA(0, 1), a2, w1);
            PG8_WAIT_V(8); PG8_WAIT_L(0); PG8_BAR; PG8_MMA(0, 0, At, B0); PG8_MMA(0, 1, At, B1); PG8_BAR; PG8_SCHED;
            PG8_LDA(At, 1, 1); PG8_STAGE(PG8_SB(1, 0), b3, voffB); PG8_STAGE(PG8_SB(1, 1), b3 + hstep, voffB); PG8_STAGE(PG8_SA(1, 0), a3, w0);
            PG8_WAIT_V(8); PG8_WAIT_L(0); PG8_BAR; PG8_MMA(1, 0, At, B0); PG8_MMA(1, 1, At, B1); PG8_BAR; PG8_SCHED;
        }
        if constexpr (ALIGN_EPI) { if (wr == 0) PG8_BAR; }
        SEC_END2(Epi::SEC);
        SEC_BEGIN3(Epi::SEC + 1);
        if constexpr (MODE == 2) {
            asm volatile("s_nop 15\n\ts_nop 15" : "+v"(acc[0][0][0][0]), "+v"(acc[0][0][0][1]), "+v"(acc[0][0][1][0]), "+v"(acc[0][0][1][1]), "+v"(acc[0][0][2][0]), "+v"(acc[0][0][2][1]), "+v"(acc[0][0][3][0]), "+v"(acc[0][0][3][1]),
                         "+v"(acc[0][1][0][0]), "+v"(acc[0][1][0][1]), "+v"(acc[0][1][1][0]), "+v"(acc[0][1][1][1]), "+v"(acc[0][1][2][0]), "+v"(acc[0][1][2][1]), "+v"(acc[0][1][3][0]), "+v"(acc[0][1][3][1]) :: "memory");
            asm volatile("" : "+v"(acc[1][0][0][0]), "+v"(acc[1][0][0][1]), "+v"(acc[1][0][1][0]), "+v"(acc[1][0][1][1]), "+v"(acc[1][0][2][0]), "+v"(acc[1][0][2][1]), "+v"(acc[1][0][3][0]), "+v"(acc[1][0][3][1]),
                         "+v"(acc[1][1][0][0]), "+v"(acc[1][1][0][1]), "+v"(acc[1][1][1][0]), "+v"(acc[1][1][1][1]), "+v"(acc[1][1][2][0]), "+v"(acc[1][1][2][1]), "+v"(acc[1][1][3][0]), "+v"(acc[1][1][3][1]) :: "memory");
        }
        E(acc, cur, wr, wc, fr, fq);
        SEC_END3(Epi::SEC + 1);
        if (!has_next) break;
#pragma unroll
        for (int a = 0; a < 2; ++a)
#pragma unroll
            for (int b = 0; b < 2; ++b)
#pragma unroll
                for (int m = 0; m < 4; ++m)
#pragma unroll
                    for (int n = 0; n < 2; ++n) acc[a][b][m][n] = AccT{};
        cur = nxt; cA = nA; cB = nB; ++ui;
        if constexpr (GATHER) {
#pragma unroll
            for (int i = 0; i < 2; ++i) vA1[i] = (unsigned)nr1[i]; }
        if constexpr (ALIGN_EPI) { if (wr == 1) PG8_BAR; }
    }
    PG8_WAIT_V(0);
    if constexpr (!ALIGN_EPI) { if (wr == 0) PG8_BAR; }
    PG8_BAR;
#undef PG8_SA
#undef PG8_SB
#undef PG8_STAGE
#undef PG8_LDA
#undef PG8_RD
#undef PG8_LDB
#undef PG8_MMA
#undef PG8_CAT
#undef PG8_WAIT_V
#undef PG8_WAIT_L
#undef PG8_BAR
#undef PG8_SCHED
}
}

#define XB_TMO      128
#define XB_XCNT(j)  (256  + 64 * (j))
#define XB_XSUB(j)  (1280 + 64 * (j))
#define XB_XGEN(j)  (2304 + 64 * (j))
#define XB_TOP      3328
#define XB_TOPGEN   3392
#define XCD_BAR_WORDS 3456
#define XB_SPIN_CAP (1u << 22)
__device__ __forceinline__ unsigned xb_ld(unsigned* p)              { return __hip_atomic_load(p, __ATOMIC_RELAXED, __HIP_MEMORY_SCOPE_AGENT); }
__device__ __forceinline__ unsigned xb_add(unsigned* p, unsigned v) { return __hip_atomic_fetch_add(p, v, __ATOMIC_RELAXED, __HIP_MEMORY_SCOPE_AGENT); }
__device__ __forceinline__ unsigned xb_xcc_id() { return (unsigned)__builtin_amdgcn_s_getreg((3 << 11) | 20) & 0xFu; }
#define XB_SPIN(cond, bar) do { unsigned _sp = 0; while (cond) { __builtin_amdgcn_s_sleep(1); \
    if ((++_sp & 255u) == 0u) { if (xb_ld(&(bar)[XB_TMO])) break; if (_sp > XB_SPIN_CAP) { atomicAdd(&(bar)[XB_TMO], 1u); break; } } } } while (0)
struct XcdBarrier { unsigned* bar; unsigned x; volatile LAS unsigned* st; };
__device__ __forceinline__ XcdBarrier xcd_barrier_post(unsigned* bar, volatile LAS unsigned* st) {
    XcdBarrier b; b.bar = bar; b.x = xb_xcc_id(); b.st = st;
    if (threadIdx.x == 0) (void)xb_add(&bar[XB_XCNT(b.x)], 1u);
    return b;
}
__device__ __forceinline__ void xcd_barrier_complete(unsigned* bar, unsigned x, unsigned& nloc, unsigned& nx) {
    const unsigned G = gridDim.x * gridDim.y * gridDim.z;
    unsigned sum, cnt, mine, sp = 0u;
    for (;;) {
        sum = 0u; cnt = 0u; mine = 0u;
#pragma unroll
        for (unsigned j = 0; j < 16; ++j) { const unsigned c = xb_ld(&bar[XB_XCNT(j)]); sum += c; cnt += (c > 0u) ? 1u : 0u; mine = (j == x) ? c : mine; }
        if (sum == G) break;
        __builtin_amdgcn_s_sleep(1);
        if ((++sp & 255u) == 0u) { if (xb_ld(&bar[XB_TMO])) break; if (sp > XB_SPIN_CAP) { atomicAdd(&bar[XB_TMO], 1u); break; } }
    }
    nloc = mine > 0u ? mine : 1u; nx = cnt > 0u ? cnt : 1u;
}
__device__ __forceinline__ void xcd_barrier(const XcdBarrier& b) {
    asm volatile("s_waitcnt vmcnt(0)" ::: "memory");
    __syncthreads();
    if (threadIdx.x == 0) {
        unsigned* bar = b.bar;
        __builtin_amdgcn_s_waitcnt(0);
        unsigned nloc = b.st[0], nx = b.st[1];
        if (nloc == 0u) { xcd_barrier_complete(bar, b.x, nloc, nx); b.st[0] = nloc; b.st[1] = nx; }
        const unsigned old = xb_add(&bar[XB_XSUB(b.x)], 1u);
        const unsigned gen = old / nloc;
        if (old + 1u == (gen + 1u) * nloc) {
            __builtin_amdgcn_fence(__ATOMIC_RELEASE, "agent");
            asm volatile("s_waitcnt vmcnt(0)" ::: "memory");
            const unsigned og = xb_add(&bar[XB_TOP], 1u);
            const unsigned tg = og / nx;
            if (og + 1u == (tg + 1u) * nx) xb_add(&bar[XB_TOPGEN], 1u);
            else XB_SPIN(xb_ld(&bar[XB_TOPGEN]) == tg, bar);
            __builtin_amdgcn_fence(__ATOMIC_ACQUIRE, "agent");
            xb_add(&bar[XB_XGEN(b.x)], 1u);
            asm volatile("s_waitcnt vmcnt(0)" ::: "memory");
        } else {
            XB_SPIN(xb_ld(&bar[XB_XGEN(b.x)]) == gen, bar);
            __builtin_amdgcn_fence(__ATOMIC_ACQUIRE, "agent");
            asm volatile("s_waitcnt vmcnt(0)" ::: "memory");
        }
    }
    __syncthreads();
}


#if defined(PROBE_SEC)
#define SEC_BEGIN(tag) unsigned long long _sec_t0_##tag = ((tag) == PROBE_SEC) ? __builtin_amdgcn_s_memrealtime() : 0ull
#define SEC_END(tag) do { if ((tag) == PROBE_SEC && blockIdx.x == 0 && threadIdx.x == 0) { volatile LAS unsigned long long* _acc = (volatile LAS unsigned long long*)(X.lds + LDSCTL_OFF + 64); *_acc = *_acc + (__builtin_amdgcn_s_memrealtime() - _sec_t0_##tag); } } while (0)
#else
#define SEC_BEGIN(tag) do {} while (0)
#define SEC_END(tag) do {} while (0)
#endif
struct Ctx { LAS unsigned char* lds; int tid, lane, wave, G, vcu, gw, NGW; };

__device__ __forceinline__ void p0_transpose_item(const float* W, int Nsrc, int Ndst, int mode, bf16* WT, LAS float* scr, int item, int lane) {
    const int nblk = Ndst / 32, kb = item / nblk, nb = item - kb * nblk, k0 = 64 * kb, n0 = 32 * nb;
    const int nd = n0 + (lane & 31);
    const int sc = mode ? (2 * (128 * (nd >> 8) + (nd & 127)) + ((nd >> 7) & 1)) : nd;
    const bool ok = sc < Nsrc;
    const GAS float* Wg = (const GAS float*)W;
#pragma unroll 8
    for (int i = 0; i < 32; ++i) { const int kk = 2 * i + (lane >> 5); scr[kk * 33 + (lane & 31)] = ok ? Wg[(size_t)(k0 + kk) * Nsrc + sc] : 0.f; }
    LDS_WAIT(); asm volatile("" ::: "memory");
    const int c = lane & 7;
#pragma unroll
    for (int j = 0; j < 4; ++j) { const int n = (lane >> 3) + 8 * j; const LAS float* s = scr + (8 * c) * 33 + n;
        u32x4 o; o.x = pk2(s[0 * 33], s[1 * 33]); o.y = pk2(s[2 * 33], s[3 * 33]); o.z = pk2(s[4 * 33], s[5 * 33]); o.w = pk2(s[6 * 33], s[7 * 33]);
        *(GAS u32x4*)(WT + (size_t)(n0 + n) * DM + k0 + 8 * c) = o; }
    LDS_WAIT(); asm volatile("" ::: "memory");
}
struct P0Item { const float* W; int Nsrc, c0, mode, q; signed char* W8; float* wsc; };
__device__ __forceinline__ void p0_item_dma(const Ctx& X, const P0Item& d) {
    const int tid = X.tid, chunk = tid & 7; int sc = d.c0 + 4 * chunk; if (sc > d.Nsrc - 4) sc = d.Nsrc - 4;
    const GAS float* src = (const GAS float*)d.W + (size_t)(tid >> 3) * d.Nsrc + sc;
#pragma unroll
    for (int r = 0; r < 16; ++r) __builtin_amdgcn_global_load_lds((const GAS unsigned*)(src + (size_t)(64 * r) * d.Nsrc), (LAS unsigned*)(X.lds + r * 8192 + X.wave * 1024), 16, 0, 0);
}
template <int Q>
__device__ __forceinline__ void p0_item_process(const Ctx& X, const P0Item& d, const P0Item* next) {
    LAS float* T = (LAS float*)X.lds;
    LAS float* part = (LAS float*)(X.lds + EXTRA_OFF);
    const int tid = X.tid, col = tid & 31, kg = tid >> 5;
    WAITV(0); __syncthreads();
    const bool ok = (d.c0 + col) < d.Nsrc;
    float v[64]; float am = 0.f;
#pragma unroll
    for (int i = 0; i < 64; ++i) { v[i] = T[(kg * 64 + i) * 32 + col]; am = fmaxf(am, fabsf(v[i])); }
    part[kg * 32 + col] = ok ? am : 0.f;
    asm volatile("s_waitcnt lgkmcnt(0)" ::: "memory");
    __syncthreads();
    if (next) p0_item_dma(X, *next);
    const int cs = d.c0 + col, j = cs >> 1, nd = d.mode ? (256 * (j >> 7) + 128 * (cs & 1) + (j & 127)) : cs;
    if (tid < 32) { float a = 0.f;
#pragma unroll
        for (int g = 0; g < 16; ++g) a = fmaxf(a, part[g * 32 + tid]);
        constexpr float QMAX = (Q == 2) ? 384.0f : 127.0f; part[512 + tid] = a > 0.f ? QMAX / a : 0.f; d.wsc[nd] = a * (1.0f / QMAX); }
    __syncthreads();
    const float inv = part[512 + col];
    GAS u32x4* dst = (GAS u32x4*)(d.W8 + (size_t)nd * DM + kg * 64);
    if constexpr (Q == 2) {
#pragma unroll
        for (int q = 0; q < 4; ++q) { unsigned w[4];
#pragma unroll
            for (int e = 0; e < 4; ++e) { unsigned x = 0u; x = __builtin_amdgcn_cvt_pk_fp8_f32(v[16 * q + 4 * e] * inv, v[16 * q + 4 * e + 1] * inv, x, false); x = __builtin_amdgcn_cvt_pk_fp8_f32(v[16 * q + 4 * e + 2] * inv, v[16 * q + 4 * e + 3] * inv, x, true); w[e] = x; }
            dst[q] = (u32x4){w[0], w[1], w[2], w[3]}; }
    } else {
#pragma unroll
        for (int q = 0; q < 4; ++q) { u32x4 w;
            w.x = pack4i(rintf(v[16 * q + 0] * inv), rintf(v[16 * q + 1] * inv), rintf(v[16 * q + 2] * inv), rintf(v[16 * q + 3] * inv));
            w.y = pack4i(rintf(v[16 * q + 4] * inv), rintf(v[16 * q + 5] * inv), rintf(v[16 * q + 6] * inv), rintf(v[16 * q + 7] * inv));
            w.z = pack4i(rintf(v[16 * q + 8] * inv), rintf(v[16 * q + 9] * inv), rintf(v[16 * q + 10] * inv), rintf(v[16 * q + 11] * inv));
            w.w = pack4i(rintf(v[16 * q + 12] * inv), rintf(v[16 * q + 13] * inv), rintf(v[16 * q + 14] * inv), rintf(v[16 * q + 15] * inv));
            dst[q] = w; }
    }
    __syncthreads();
}
__device__ __forceinline__ void phase_prologue(const Ctx& X, const float* c_in, const float* ada_w, const float* ada_b, float* mod,
                                               const float* w_qkv, const float* w_o0, const float* w_in, const float* w_o1, const float* w_gu, const float* w_down,
                                               signed char* Wqkv8, bf16* Wo0_t, signed char* Win8, bf16* Wo1_t, signed char* Wgu8, bf16* Wd_t, float* wsc, unsigned* ada_flag, unsigned* item_ctr) {
    if (blockIdx.x < 192) {
        const int l = blockIdx.x / 96, j0 = (blockIdx.x % 96) * 64;
        LAS float* cs = (LAS float*)X.lds;
        for (int i = 0; i < 64; ++i) { const int idx = i * NTHREADS + X.tid, b = idx >> 10, k = idx & 1023; const float v = c_in[idx]; cs[k * 32 + b] = v / (1.0f + __expf(-v)); }
        __syncthreads();
        float acc[32];
#pragma unroll
        for (int b = 0; b < 32; ++b) acc[b] = 0.f;
        const GAS float* wp = (const GAS float*)ada_w + ((size_t)l * DM + X.wave * 128) * 6144 + j0 + X.lane;
#pragma unroll 4
        for (int k = 0; k < 128; ++k) { const float w = wp[(size_t)k * 6144]; const LAS f32x4* c4 = (const LAS f32x4*)(cs + (X.wave * 128 + k) * 32);
#pragma unroll
            for (int b4 = 0; b4 < 8; ++b4) { const f32x4 cv = c4[b4]; acc[4 * b4 + 0] += w * cv[0]; acc[4 * b4 + 1] += w * cv[1]; acc[4 * b4 + 2] += w * cv[2]; acc[4 * b4 + 3] += w * cv[3]; } }
        __syncthreads();
        LAS float* red = (LAS float*)X.lds;
#pragma unroll
        for (int b = 0; b < 32; ++b) red[(X.wave * 32 + b) * 64 + X.lane] = acc[b];
        __syncthreads();
        for (int i = 0; i < 4; ++i) { const int o = i * NTHREADS + X.tid, b = o >> 6, ln = o & 63; float s = 0.f;
#pragma unroll
            for (int w = 0; w < 8; ++w) s += red[(w * 32 + b) * 64 + ln];
            mod[((size_t)l * NB + b) * 6144 + j0 + ln] = s + ada_b[l * 6144 + j0 + ln]; }
        asm volatile("s_waitcnt vmcnt(0)" ::: "memory");
        __syncthreads();
        if (X.tid == 0) { __builtin_amdgcn_fence(__ATOMIC_RELEASE, "agent"); asm volatile("s_waitcnt vmcnt(0)" ::: "memory"); (void)xb_add(ada_flag, 1u); }
    }
    LAS float* scr = (LAS float*)(X.lds + X.wave * 16384);
    constexpr int Q_GU = 64 * 64, Q_QKV = NQKV / 32, Q_IN = NPROJ / 32, N_ITEMS = Q_GU + Q_QKV + Q_IN + 64 * 32;
    auto describe = [&](int it) -> P0Item {
        int r = it;
        if (r < Q_GU) { const int mat = r >> 6; return P0Item{w_gu + (size_t)mat * DM * 2048, 2048, 32 * (r & 63), 1, 1, Wgu8 + (size_t)mat * 2048 * DM, wsc + NQKV + NPROJ + mat * 2048}; } r -= Q_GU;
        if (r < Q_QKV) return P0Item{w_qkv, NQKV, 32 * r, 0, 1, Wqkv8, wsc}; r -= Q_QKV;
        if (r < Q_IN) return P0Item{w_in, NPROJ_REAL, 32 * r, 0, 1, Win8, wsc + NQKV}; r -= Q_IN;
        const int mat = r >> 5; return P0Item{w_down + (size_t)mat * DM * DM, DM, 32 * (r & 31), 0, 2, (signed char*)Wd_t + (size_t)mat * DM * DM, wsc + NQKV + NPROJ + 64 * 2048 + mat * DM};
    };
    SEC_BEGIN(6);
    { volatile LAS int* slot = (volatile LAS int*)(X.lds + LDSCTL_OFF + 128);
      auto fetch = [&](int par) -> int { if (X.tid == 0) slot[par] = (int)xb_add(item_ctr, 1u); __syncthreads(); return __builtin_amdgcn_readfirstlane(slot[par]); };
      int par = 0;
      int it = fetch(par); par ^= 1;
      P0Item cur = describe(it < N_ITEMS ? it : 0);
      if (it < N_ITEMS) p0_item_dma(X, cur);
      while (it < N_ITEMS) {
          const int nxt = fetch(par); par ^= 1;
          const bool hn = nxt < N_ITEMS; const P0Item nx = describe(hn ? nxt : it);
          if (cur.q == 2) p0_item_process<2>(X, cur, hn ? &nx : nullptr); else p0_item_process<1>(X, cur, hn ? &nx : nullptr);
          cur = nx; it = nxt; } }
    { LAS float* scr = (LAS float*)(X.lds + X.wave * 16384);
      for (int r = X.gw; r < 2 * 16 * 32; r += X.NGW) { if (r < 512) p0_transpose_item(w_o0, DM, DM, 0, Wo0_t, scr, r, X.lane); else p0_transpose_item(w_o1, DM, DM, 0, Wo1_t, scr, r - 512, X.lane); } }
    SEC_END(6);

}

__device__ __forceinline__ void norm_mod_store(const f32x4 (&v)[4], const float* gnorm, const float* modb, int shi, int sci, bf16* hrow, int lane, f32x4 (&h)[4]) {
    float ss = 0.f;
#pragma unroll
    for (int j = 0; j < 4; ++j) ss += (v[j][0] * v[j][0] + v[j][1] * v[j][1]) + (v[j][2] * v[j][2] + v[j][3] * v[j][3]);
    const float rstd = 1.0f / sqrtf(wave_sum(ss) * (1.0f / DM) + EPS);
#pragma unroll
    for (int j = 0; j < 4; ++j) {
        const f32x4 g4 = ((const GAS f32x4*)gnorm)[64 * j + lane], sc4 = ((const GAS f32x4*)(modb + sci * DM))[64 * j + lane], sh4 = ((const GAS f32x4*)(modb + shi * DM))[64 * j + lane];
        h[j] = (v[j] * rstd) * g4 * (1.0f + sc4) + sh4;
    }
    (void)hrow;
}
__device__ __forceinline__ void norm_mod_coef(const float* gnorm, const float* modb, int shi, int sci, int lane, f32x4 (&A)[4], f32x4 (&B)[4]) {
#pragma unroll
    for (int j = 0; j < 4; ++j) { const f32x4 g4 = ((const GAS f32x4*)gnorm)[64 * j + lane], sc4 = ((const GAS f32x4*)(modb + sci * DM))[64 * j + lane]; A[j] = g4 * (1.0f + sc4); B[j] = ((const GAS f32x4*)(modb + shi * DM))[64 * j + lane]; }
}
__device__ __forceinline__ void norm_mod_apply(const f32x4 (&v)[4], const f32x4 (&A)[4], const f32x4 (&B)[4], f32x4 (&h)[4]) {
    float ss = 0.f;
#pragma unroll
    for (int j = 0; j < 4; ++j) ss += (v[j][0] * v[j][0] + v[j][1] * v[j][1]) + (v[j][2] * v[j][2] + v[j][3] * v[j][3]);
    const float rstd = 1.0f / sqrtf(wave_sum(ss) * (1.0f / DM) + EPS);
#pragma unroll
    for (int j = 0; j < 4; ++j) h[j] = (v[j] * rstd) * A[j] + B[j];
}
__device__ __forceinline__ float quant_row_store(const f32x4 (&h)[4], signed char* qrow, float* hs, int lane) {
    float am = 0.f;
#pragma unroll
    for (int j = 0; j < 4; ++j) am = fmaxf(am, fmaxf(fmaxf(fabsf(h[j][0]), fabsf(h[j][1])), fmaxf(fabsf(h[j][2]), fabsf(h[j][3]))));
    am = wave_max(am);
    const float inv = am > 0.f ? 127.0f / am : 0.f;
    GAS unsigned* q4 = (GAS unsigned*)qrow + lane;
#pragma unroll
    for (int j = 0; j < 4; ++j) q4[64 * j] = pack4i(rintf(h[j][0] * inv), rintf(h[j][1] * inv), rintf(h[j][2] * inv), rintf(h[j][3] * inv));
    if (lane == 0) *hs = am * (1.0f / 127.0f);
    return am * (1.0f / 127.0f);
}

__device__ __forceinline__ void load_row_f32(const float* p, int lane, f32x4 (&v)[4]) { const GAS f32x4* xr = (const GAS f32x4*)p + lane;
#pragma unroll
    for (int j = 0; j < 4; ++j) v[j] = xr[64 * j]; }
__device__ __forceinline__ void load_row_bf16(const bf16* p, int lane, f32x4 (&v)[4]) { const GAS u32x2* xr = (const GAS u32x2*)p + lane;
#pragma unroll
    for (int j = 0; j < 4; ++j) { const u32x2 w = xr[64 * j]; v[j] = (f32x4){bflo(w.x), bfhi(w.x), bflo(w.y), bfhi(w.y)}; } }
__device__ __forceinline__ void store_row_bf16(bf16* p, int lane, const f32x4 (&v)[4]) { GAS u32x2* xr = (GAS u32x2*)p + lane;
#pragma unroll
    for (int j = 0; j < 4; ++j) xr[64 * j] = (u32x2){pk2(v[j][0], v[j][1]), pk2(v[j][2], v[j][3])}; }
__device__ __forceinline__ void phase_norm1(const Ctx& X, const float* xin, const float* gnorm, const float* mod_l, signed char* H8, float* HS) {
    const int per = NTOK / X.NGW, m0 = X.gw * per;
    f32x4 A[4], B[4]; norm_mod_coef(gnorm, mod_l + (size_t)(m0 >> 11) * 6144, 0, 1, X.lane, A, B);
    f32x4 v[4], vn[4], h[4];
    load_row_f32(xin + (size_t)m0 * DM, X.lane, v);
    for (int m = m0; m < m0 + per; ++m) {
        load_row_f32(xin + (size_t)((m + 1 < m0 + per) ? m + 1 : m) * DM, X.lane, vn);
        norm_mod_apply(v, A, B, h);
        quant_row_store(h, H8 + (size_t)m * DM, HS + m, X.lane);
#pragma unroll
        for (int j = 0; j < 4; ++j) v[j] = vn[j];
    }
}
__device__ __forceinline__ void moe_tables(const Ctx& X, const unsigned* gcnt, LAS int* cntL, LAS int* tsum) {
    __syncthreads();
    if (X.tid < NE) cntL[X.tid] = (int)__hip_atomic_load(gcnt + X.tid, __ATOMIC_RELAXED, __HIP_MEMORY_SCOPE_AGENT);
    __syncthreads();
    if (X.tid == 0) { int s = 0; for (int e = 0; e < NE; ++e) { tsum[e] = s; s += (cntL[e] + 255) >> 8; } tsum[NE] = s; }
    __syncthreads();
}
__device__ __forceinline__ void phase_combine(const Ctx& X, bf16* xr_io, float* out_f32  , const unsigned char* Y, const int* tok_e, const int* tok_p, const unsigned* gcnt, const float* mod_l  ,
                                              bool do_norm, const float* gnorm_next, const float* mod_next, signed char* H8, float* HS) {
    LAS int* cntL = (LAS int*)(X.lds + EXTRA_OFF); LAS int* tsum = cntL + 32;
    moe_tables(X, gcnt, cntL, tsum);
    const int per = NTOK / X.NGW, m0 = X.gw * per, b = m0 >> 11;
    f32x4 G2[4], A[4], B[4];
#pragma unroll
    for (int j = 0; j < 4; ++j) { G2[j] = ((const GAS f32x4*)(mod_l + (size_t)b * 6144 + 5 * DM))[64 * j + X.lane] * (1.0f / pg8::Y_PRESCALE); A[j] = G2[j]; B[j] = G2[j]; }
    if (do_norm) norm_mod_coef(gnorm_next, mod_next + (size_t)b * 6144, 0, 1, X.lane, A, B);
    for (int m = m0; m < m0 + per; ++m) {
        f32x4 v[4], a[4], h[4];
        load_row_bf16(xr_io + (size_t)m * DM, X.lane, v);
#pragma unroll
        for (int j = 0; j < 4; ++j) a[j] = (f32x4){0.f, 0.f, 0.f, 0.f};
#pragma unroll
        for (int k = 0; k < TOPK; ++k) { const int e = tok_e[m * 4 + k], p = tok_p[m * 4 + k]; const GAS unsigned* yr = (const GAS unsigned*)(Y + ((size_t)tsum[e] * 256 + p) * DM) + X.lane;
#pragma unroll
            for (int j = 0; j < 4; ++j) { const unsigned w = yr[64 * j]; const f32x2 lo = __builtin_amdgcn_cvt_pk_f32_fp8(w, false), hi = __builtin_amdgcn_cvt_pk_f32_fp8(w, true);
                a[j][0] += lo[0]; a[j][1] += lo[1]; a[j][2] += hi[0]; a[j][3] += hi[1]; } }
#pragma unroll
        for (int j = 0; j < 4; ++j) v[j] = v[j] + G2[j] * a[j];
        if (out_f32) { GAS f32x4* orow = (GAS f32x4*)(out_f32 + (size_t)m * DM) + X.lane;
#pragma unroll
            for (int j = 0; j < 4; ++j) orow[64 * j] = v[j]; }
        else store_row_bf16(xr_io + (size_t)m * DM, X.lane, v);
        if (do_norm) { norm_mod_apply(v, A, B, h); quant_row_store(h, H8 + (size_t)m * DM, HS + m, X.lane); }
    }
}
__device__ __forceinline__ void phase_norm2_router(const Ctx& X, const bf16* xin, const float* gnorm, const float* mod_l, const float* rw, const float* rb, signed char* H8, float* HS,
                                                   int* tok_e, int* tok_p, unsigned* gcnt, int* list, float* gate_e, float* hs_e) {
    constexpr int HROW = 2064;
    LAS unsigned char* hhi = X.lds; LAS unsigned char* hlo = X.lds + 16 * HROW; LAS float* part = (LAS float*)(X.lds + 2 * 16 * HROW);
    LAS int* cntL = (LAS int*)(X.lds + EXTRA_OFF); LAS int* baseL = cntL + 32; LAS int* selE = baseL + 32; LAS int* selR = selE + 1024; LAS float* selG = (LAS float*)(selR + 1024); LAS float* selH = selG + 1024;
    const int lane = X.lane, fr = lane & 15, fq = lane >> 4, half = lane >> 5, l32 = lane & 31, wave = X.wave;
    bf16x8 bhi[4][2], blo[4][2];
#pragma unroll
    for (int s4 = 0; s4 < 4; ++s4)
#pragma unroll
        for (int nt = 0; nt < 2; ++nt)
#pragma unroll
            for (int j = 0; j < 8; ++j) { const float w = rw[(size_t)(128 * wave + 32 * s4 + 8 * fq + j) * NE + 16 * nt + fr]; const unsigned hb = f2bf(w); const float lo = w - __uint_as_float(hb << 16);
                bhi[s4][nt][j] = (short)hb; blo[s4][nt][j] = (short)f2bf(lo); }
    if (X.tid < NE) cntL[X.tid] = 0;
    const float rbias = rb[l32];
    __syncthreads();
    const int t0 = blockIdx.x * 256;
    f32x4 nA[4], nB[4]; norm_mod_coef(gnorm, mod_l + (size_t)(t0 >> 11) * 6144, 3, 4, lane, nA, nB);
    f32x4 xv[2][4], xn[2][4];
#pragma unroll
    for (int q = 0; q < 2; ++q) load_row_bf16(xin + (size_t)(t0 + 2 * wave + q) * DM, lane, xv[q]);
    for (int it = 0; it < 16; ++it) {
        { const int itn = it < 15 ? it + 1 : it;
#pragma unroll
          for (int q = 0; q < 2; ++q) load_row_bf16(xin + (size_t)(t0 + itn * 16 + 2 * wave + q) * DM, lane, xn[q]); }
#pragma unroll
        for (int q = 0; q < 2; ++q) {
            const int lt = it * 16 + 2 * wave + q, m = t0 + lt; f32x4 v[4], h[4];
#pragma unroll
            for (int j = 0; j < 4; ++j) v[j] = xv[q][j];
            norm_mod_apply(v, nA, nB, h);
            const float hsv = quant_row_store(h, H8 + (size_t)m * DM, HS + m, lane); if (lane == 0) selH[lt] = hsv;
#pragma unroll
            for (int j = 0; j < 4; ++j) { const unsigned w01 = pk2(h[j][0], h[j][1]), w23 = pk2(h[j][2], h[j][3]);
                const int off = (2 * wave + q) * HROW + (256 * j + 4 * lane) * 2;
                *(LAS u32x2*)(hhi + off) = (u32x2){w01, w23};
                *(LAS u32x2*)(hlo + off) = (u32x2){pk2(h[j][0] - bflo(w01), h[j][1] - bfhi(w01)), pk2(h[j][2] - bflo(w23), h[j][3] - bfhi(w23))}; }
        }
        __syncthreads();
        f32x4 acc0 = {0.f, 0.f, 0.f, 0.f}, acc1 = {0.f, 0.f, 0.f, 0.f};
#pragma unroll
        for (int s4 = 0; s4 < 4; ++s4) { const int off = fr * HROW + (128 * wave + 32 * s4 + 8 * fq) * 2;
            const bf16x8 ah = *(const LAS bf16x8*)(hhi + off), al = *(const LAS bf16x8*)(hlo + off);
            acc0 = __builtin_amdgcn_mfma_f32_16x16x32_bf16(ah, bhi[s4][0], acc0, 0, 0, 0); acc1 = __builtin_amdgcn_mfma_f32_16x16x32_bf16(ah, bhi[s4][1], acc1, 0, 0, 0);
            acc0 = __builtin_amdgcn_mfma_f32_16x16x32_bf16(al, bhi[s4][0], acc0, 0, 0, 0); acc1 = __builtin_amdgcn_mfma_f32_16x16x32_bf16(al, bhi[s4][1], acc1, 0, 0, 0);
            acc0 = __builtin_amdgcn_mfma_f32_16x16x32_bf16(ah, blo[s4][0], acc0, 0, 0, 0); acc1 = __builtin_amdgcn_mfma_f32_16x16x32_bf16(ah, blo[s4][1], acc1, 0, 0, 0); }
#pragma unroll
        for (int i = 0; i < 4; ++i) { part[(wave * 16 + 4 * fq + i) * 32 + fr] = acc0[i]; part[(wave * 16 + 4 * fq + i) * 32 + 16 + fr] = acc1[i]; }
        __syncthreads();
        const int lt = it * 16 + 2 * wave + half;
        float logit = rbias;
#pragma unroll
        for (int w8 = 0; w8 < 8; ++w8) logit += part[(w8 * 16 + 2 * wave + half) * 32 + l32];
        float tv[4]; int te[4]; float cur = logit;
#pragma unroll
        for (int k = 0; k < 4; ++k) { const float mx = half_max32(cur);
            const unsigned long long bal = __ballot(cur == mx); const unsigned mine = half ? (unsigned)(bal >> 32) : (unsigned)bal;
            const int e = __ffs(mine) - 1; tv[k] = mx; te[k] = e; if (l32 == e) cur = -INFINITY; }
        const float p1 = __expf(tv[1] - tv[0]), p2 = __expf(tv[2] - tv[0]), p3 = __expf(tv[3] - tv[0]); const float inv = 1.0f / (1.0f + p1 + p2 + p3);
        if (l32 < 4) { const int k = l32; const int e = k == 0 ? te[0] : k == 1 ? te[1] : k == 2 ? te[2] : te[3]; const float gk = (k == 0 ? 1.0f : k == 1 ? p1 : k == 2 ? p2 : p3) * inv;
            const int rank = __hip_atomic_fetch_add(cntL + e, 1, __ATOMIC_RELAXED, __HIP_MEMORY_SCOPE_WORKGROUP);
            const int si = lt * 4 + k; selE[si] = e; selR[si] = rank; selG[si] = gk; }
#pragma unroll
        for (int q = 0; q < 2; ++q)
#pragma unroll
            for (int j = 0; j < 4; ++j) xv[q][j] = xn[q][j];
    }
    __syncthreads();
    if (X.tid < NE) baseL[X.tid] = (int)__hip_atomic_fetch_add(gcnt + X.tid, (unsigned)cntL[X.tid], __ATOMIC_RELAXED, __HIP_MEMORY_SCOPE_AGENT);
    __syncthreads();
    for (int si = X.tid; si < 256 * 4; si += NTHREADS) { const int e = selE[si], p = baseL[e] + selR[si], m = t0 + (si >> 2);
        tok_e[(size_t)m * 4 + (si & 3)] = e; tok_p[(size_t)m * 4 + (si & 3)] = p; list[(size_t)e * ECAP + p] = m; gate_e[(size_t)e * ECAP + p] = selG[si]; hs_e[(size_t)e * ECAP + p] = selH[si >> 2]; }
    __syncthreads();
}

__device__ __forceinline__ void phase_sb_naive(const Ctx& X, const bf16* QKV, bf16* O) {
    for (int item = blockIdx.x; item < NB * NH * 4; item += X.G) {
        const int b = item >> 6, h = (item >> 2) & 15, t = (item & 3) * 512 + X.tid;
        const GAS u32x4* qp = (const GAS u32x4*)(QKV + ((size_t)(b * SEQ + t)) * NQKV + h * HD);
        float q[64], o[64];
#pragma unroll
        for (int i = 0; i < 8; ++i) { const u32x4 w = qp[i]; q[8 * i] = bflo(w.x); q[8 * i + 1] = bfhi(w.x); q[8 * i + 2] = bflo(w.y); q[8 * i + 3] = bfhi(w.y); q[8 * i + 4] = bflo(w.z); q[8 * i + 5] = bfhi(w.z); q[8 * i + 6] = bflo(w.w); q[8 * i + 7] = bfhi(w.w); }
#pragma unroll
        for (int d = 0; d < 64; ++d) o[d] = 0.f;
        float L = 0.f;
        for (int s = t - 1; s >= 0; --s) {
            const GAS u32x4* kp = (const GAS u32x4*)(QKV + ((size_t)(b * SEQ + s)) * NQKV + DM + h * HD);
            float z = 0.f;
#pragma unroll
            for (int i = 0; i < 8; ++i) { const u32x4 w = kp[i]; z += q[8 * i] * bflo(w.x) + q[8 * i + 1] * bfhi(w.x) + q[8 * i + 2] * bflo(w.y) + q[8 * i + 3] * bfhi(w.y) + q[8 * i + 4] * bflo(w.z) + q[8 * i + 5] * bfhi(w.z) + q[8 * i + 6] * bflo(w.w) + q[8 * i + 7] * bfhi(w.w); }
            const float sp = fmaxf(z, 0.f) + __builtin_amdgcn_logf(1.0f + __builtin_amdgcn_exp2f(-fabsf(z)));
            const float a = __builtin_amdgcn_exp2f(z - sp + L);
            const GAS u32x4* vp = kp + (DM * 2 / 16);
#pragma unroll
            for (int i = 0; i < 8; ++i) { const u32x4 w = vp[i]; o[8 * i] += a * bflo(w.x); o[8 * i + 1] += a * bfhi(w.x); o[8 * i + 2] += a * bflo(w.y); o[8 * i + 3] += a * bfhi(w.y); o[8 * i + 4] += a * bflo(w.z); o[8 * i + 5] += a * bfhi(w.z); o[8 * i + 6] += a * bflo(w.w); o[8 * i + 7] += a * bfhi(w.w); }
            L -= sp;
            if (L < -160.f) break;
        }
        GAS u32x4* op = (GAS u32x4*)(O + ((size_t)(b * SEQ + t)) * DM + h * HD);
#pragma unroll
        for (int i = 0; i < 8; ++i) op[i] = (u32x4){pk2(o[8 * i], o[8 * i + 1]), pk2(o[8 * i + 2], o[8 * i + 3]), pk2(o[8 * i + 4], o[8 * i + 5]), pk2(o[8 * i + 6], o[8 * i + 7])};
    }
}

__device__ __forceinline__ void ld16(const bf16* p, float (&x)[16]) {
    const GAS u32x4* q = (const GAS u32x4*)p; const u32x4 a = q[0], b = q[1];
    x[0] = bflo(a.x); x[1] = bfhi(a.x); x[2] = bflo(a.y); x[3] = bfhi(a.y); x[4] = bflo(a.z); x[5] = bfhi(a.z); x[6] = bflo(a.w); x[7] = bfhi(a.w);
    x[8] = bflo(b.x); x[9] = bfhi(b.x); x[10] = bflo(b.y); x[11] = bfhi(b.y); x[12] = bflo(b.z); x[13] = bfhi(b.z); x[14] = bflo(b.w); x[15] = bfhi(b.w);
}
__device__ __forceinline__ void st16(bf16* p, const float (&x)[16]) {
    GAS u32x4* q = (GAS u32x4*)p;
    q[0] = (u32x4){pk2(x[0], x[1]), pk2(x[2], x[3]), pk2(x[4], x[5]), pk2(x[6], x[7])}; q[1] = (u32x4){pk2(x[8], x[9]), pk2(x[10], x[11]), pk2(x[12], x[13]), pk2(x[14], x[15])};
}
__device__ __forceinline__ void up16(const u32x4 a, const u32x4 b, float (&x)[16]) {
    x[0] = bflo(a.x); x[1] = bfhi(a.x); x[2] = bflo(a.y); x[3] = bfhi(a.y); x[4] = bflo(a.z); x[5] = bfhi(a.z); x[6] = bflo(a.w); x[7] = bfhi(a.w);
    x[8] = bflo(b.x); x[9] = bfhi(b.x); x[10] = bflo(b.y); x[11] = bfhi(b.y); x[12] = bflo(b.z); x[13] = bfhi(b.z); x[14] = bflo(b.w); x[15] = bfhi(b.w);
}
struct PostRaw { u32x4 q0, q1, k0, k1, i0, i1; unsigned wi; int pos; };
__device__ __forceinline__ PostRaw post_load(const bf16* P, const int* positions, int m, int lane) {
    PostRaw r; const GAS u32x4* pr = (const GAS u32x4*)(P + (size_t)m * NPROJ);
    r.q0 = pr[2 * lane]; r.q1 = pr[2 * lane + 1];
    const int lk = lane & 15; r.k0 = pr[128 + 2 * lk]; r.k1 = pr[128 + 2 * lk + 1];
    const int li = lane < 36 ? lane : 35; r.i0 = pr[160 + 2 * li]; r.i1 = pr[160 + 2 * li + 1];
    r.wi = (unsigned)P[(size_t)m * NPROJ + 1856 + (lane & 7)]; r.pos = positions[m];
    return r;
}
__device__ __forceinline__ void phase_dsa_post(const Ctx& X, const bf16* P, const int* positions, const float* qgain, const float* kgain, bf16* Q1, bf16* K1, bf16* V1, bf16* QI, bf16* KI, float* WI, float* QN, unsigned* kmax_bits) {
    const int l4 = X.lane & 3;
    float gq[16], gk[16];
#pragma unroll
    for (int i = 0; i < 16; ++i) { gq[i] = qgain[l4 * 16 + i]; gk[i] = kgain[l4 * 16 + i]; }
    const float inv_i = expf(-logf(500000.0f) * (2.0f * (float)(X.lane & 7) / 16.0f));
    const int per = NTOK / X.NGW, m0 = X.gw * per;
    float kmx = 0.f, qmx = 0.f;
    PostRaw cur = post_load(P, positions, m0, X.lane);
    for (int m = m0; m < m0 + per; ++m) {
        const int mn = (m + 1 < m0 + per) ? m + 1 : m;
        const PostRaw nxt = post_load(P, positions, mn, X.lane);
        float cs = 1.f, sn = 0.f;
        sincosf((float)cur.pos * inv_i, &sn, &cs);
        float cz[8], sz[8];
#pragma unroll
        for (int i = 0; i < 8; ++i) { cz[i] = __shfl(cs, i); sz[i] = __shfl(sn, i); }
        float x[16];
        up16(cur.q0, cur.q1, x);
        { float ss = 0.f;
#pragma unroll
          for (int i = 0; i < 16; ++i) ss += x[i] * x[i];
          ss += __shfl_xor(ss, 1); ss += __shfl_xor(ss, 2);
          const float r = 1.0f / sqrtf(ss * (1.0f / 64.0f) + EPS);
#pragma unroll
          for (int i = 0; i < 16; ++i) x[i] = x[i] * r * gq[i];
          if (l4 == 0) {
#pragma unroll
              for (int i = 0; i < 8; ++i) { const float a = x[i], b2 = x[i + 8]; x[i] = a * cz[i] - b2 * sz[i]; x[i + 8] = b2 * cz[i] + a * sz[i]; } }
          float n2 = 0.f;
#pragma unroll
          for (int i = 0; i < 16; ++i) { x[i] *= QSCALE; n2 += x[i] * x[i]; }
#pragma unroll
          for (int o = 1; o < 4; o <<= 1) n2 += __shfl_xor(n2, o);
#pragma unroll
          for (int o = 4; o < 64; o <<= 1) n2 = fmaxf(n2, __shfl_xor(n2, o));
          qmx = fmaxf(qmx, n2);
          if (X.lane == 0) QN[m] = sqrtf(n2) * 1.01f;
          st16(Q1 + (size_t)m * DM + X.lane * 16, x); }
        { up16(cur.k0, cur.k1, x);
          float ss = 0.f;
#pragma unroll
          for (int i = 0; i < 16; ++i) ss += x[i] * x[i];
          ss += __shfl_xor(ss, 1); ss += __shfl_xor(ss, 2);
          if (X.lane < 8) { const float r = 1.0f / sqrtf(ss * (1.0f / 64.0f) + EPS);
#pragma unroll
              for (int i = 0; i < 16; ++i) x[i] = x[i] * r * gk[i];
              if (l4 == 0) {
#pragma unroll
                  for (int i = 0; i < 8; ++i) { const float a = x[i], b2 = x[i + 8]; x[i] = a * cz[i] - b2 * sz[i]; x[i + 8] = b2 * cz[i] + a * sz[i]; } }
              st16(K1 + (size_t)m * 128 + X.lane * 16, x);
          } else if (X.lane < 16) st16(V1 + (size_t)m * 128 + (X.lane - 8) * 16, x);
          float k2 = 0.f;
#pragma unroll
          for (int i = 0; i < 16; ++i) k2 += x[i] * x[i];
          k2 += __shfl_xor(k2, 1); k2 += __shfl_xor(k2, 2); k2 = fmaxf(k2, __shfl_xor(k2, 4));
          kmx = fmaxf(kmx, k2); }
        if (X.lane < 36) { up16(cur.i0, cur.i1, x);
            if (l4 == 0) {
#pragma unroll
                for (int i = 0; i < 8; ++i) { const float a = x[i], b2 = x[i + 8]; x[i] = a * cz[i] - b2 * sz[i]; x[i + 8] = b2 * cz[i] + a * sz[i]; } }
            if (X.lane < 32) st16(QI + (size_t)m * 512 + X.lane * 16, x); else st16(KI + (size_t)m * 64 + (X.lane - 32) * 16, x); }
        if (X.lane < 8) WI[(size_t)m * 8 + X.lane] = bflo(cur.wi) * (0.35355339059327373f * 0.125f);
        cur = nxt;
    }
    if (X.lane == 0) { atomicMax(kmax_bits + (m0 >> 11), __float_as_uint(sqrtf(kmx) * 1.01f)); atomicMax(kmax_bits + 32 + (m0 >> 11), __float_as_uint(sqrtf(qmx) * 1.01f)); }
}
__device__ __forceinline__ void phase_dsa_post2(const Ctx& X, const bf16* P, const int* positions, const float* kgain, bf16* K1, bf16* V1, bf16* KI, float* WI, float* ROPE) {
    const int l16 = X.lane & 15, grp = X.lane >> 4, l4 = X.lane & 3, gbase = X.lane & 48;
    float gk[16];
#pragma unroll
    for (int i = 0; i < 16; ++i) gk[i] = kgain[l4 * 16 + i];
    const float inv_i = expf(-logf(500000.0f) * (2.0f * (float)(l16 & 7) / 16.0f));
    const int per = NTOK / X.NGW, m0 = X.gw * per;
    for (int mm = m0; mm < m0 + per; mm += 4) {
        const int m = mm + grp;
        const GAS u32x4* pr = (const GAS u32x4*)(P + (size_t)m * NPROJ);
        const u32x4 k0 = pr[128 + 2 * l16], k1 = pr[128 + 2 * l16 + 1];
        const int li = l16 & 3; const u32x4 i0 = pr[224 + 2 * li], i1 = pr[224 + 2 * li + 1];
        const unsigned wiw = (unsigned)P[(size_t)m * NPROJ + 1856 + (l16 & 7)];
        float sn, cs; sincosf((float)positions[m] * inv_i, &sn, &cs);
        ROPE[(size_t)m * 16 + l16] = (l16 & 8) ? sn : cs;
        float cz[8], sz[8];
#pragma unroll
        for (int i = 0; i < 8; ++i) { cz[i] = __shfl(cs, gbase + i); sz[i] = __shfl(sn, gbase + i); }
        float x[16];
        up16(k0, k1, x);
        float ss = 0.f;
#pragma unroll
        for (int i = 0; i < 16; ++i) ss += x[i] * x[i];
        ss = quad_sum(ss);
        if (l16 < 8) { const float r = 1.0f / sqrtf(ss * (1.0f / 64.0f) + EPS);
#pragma unroll
            for (int i = 0; i < 16; ++i) x[i] = x[i] * r * gk[i];
            if (l4 == 0) {
#pragma unroll
                for (int i = 0; i < 8; ++i) { const float a = x[i], b2 = x[i + 8]; x[i] = a * cz[i] - b2 * sz[i]; x[i + 8] = b2 * cz[i] + a * sz[i]; } }
            st16(K1 + (size_t)m * 128 + l16 * 16, x);
        } else st16(V1 + (size_t)m * 128 + (l16 - 8) * 16, x);
        if (l16 < 4) { up16(i0, i1, x);
            if (l16 == 0) {
#pragma unroll
                for (int i = 0; i < 8; ++i) { const float a = x[i], b2 = x[i + 8]; x[i] = a * cz[i] - b2 * sz[i]; x[i + 8] = b2 * cz[i] + a * sz[i]; } }
            st16(KI + (size_t)m * 64 + l16 * 16, x); }
        if (l16 < 8) WI[(size_t)m * 8 + l16] = bflo(wiw) * (0.35355339059327373f * 0.125f);
    }
}
__device__ __forceinline__ void phase_idx_naive(const Ctx& X, const bf16* QI, const bf16* KI, const float* WI, float* SC) {
    LAS float* qs = (LAS float*)X.lds;
    const int ntb = NTOK / X.G;
    for (int i = 0; i < ntb; ++i) {
        const int m = blockIdx.x * ntb + i, b = m >> 11, t = m & 2047, nadm = 64 * ((t >> 6) + 1);
        __syncthreads();
        qs[X.tid] = bflo((unsigned)QI[(size_t)m * 512 + X.tid]); if (X.tid < 8) qs[512 + X.tid] = WI[(size_t)m * 8 + X.tid];
        __syncthreads();
        for (int s = X.tid; s < nadm; s += NTHREADS) {
            const GAS u32x4* kp = (const GAS u32x4*)(KI + ((size_t)(b * SEQ + s)) * 64); float k[64];
#pragma unroll
            for (int j = 0; j < 8; ++j) { const u32x4 w = kp[j]; k[8 * j] = bflo(w.x); k[8 * j + 1] = bfhi(w.x); k[8 * j + 2] = bflo(w.y); k[8 * j + 3] = bfhi(w.y); k[8 * j + 4] = bflo(w.z); k[8 * j + 5] = bfhi(w.z); k[8 * j + 6] = bflo(w.w); k[8 * j + 7] = bfhi(w.w); }
            float sc = 0.f;
#pragma unroll 1
            for (int hh = 0; hh < 8; ++hh) { float d = 0.f; asm volatile("" ::: "memory");
#pragma unroll
                for (int j = 0; j < 16; ++j) { const f32x4 q4 = ((const LAS f32x4*)(qs + hh * 64))[j]; d += (q4[0] * k[4 * j] + q4[1] * k[4 * j + 1]) + (q4[2] * k[4 * j + 2] + q4[3] * k[4 * j + 3]); }
                sc += qs[512 + hh] * fmaxf(d, 0.f); }
            SC[(size_t)m * SEQ + s] = sc;
        }
    }
}
__device__ __forceinline__ unsigned ord_key(float x) { const unsigned u = __float_as_uint(x); return (u & 0x80000000u) ? ~u : (u | 0x80000000u); }
__device__ __forceinline__ int wave_count_sum(unsigned v) {
    int t = 0;
#pragma unroll
    for (int b = 0; b < 6; ++b) t += __popcll(__ballot((v >> b) & 1u)) << b;
    return t;
}
template <int NR>
__device__ __forceinline__ void topk_select_nr(const unsigned (&key)[32], int c, unsigned long long* maskrow, int lane) {
    unsigned long long mine = ~0ull;
    if (c >= 4) {
        unsigned T = 0u;
        for (int bit = 31; bit >= 0; --bit) { const unsigned cand = T | (1u << bit); unsigned cl = 0u;
#pragma unroll
            for (int m = 0; m < NR; ++m) cl += (key[m] >= cand) ? 1u : 0u;
            const int cnt = wave_count_sum(cl);
            if (cnt >= 256) { T = cand; if (cnt == 256) break; } }
        unsigned gl = 0u;
#pragma unroll
        for (int m = 0; m < NR; ++m) gl += (key[m] > T) ? 1u : 0u;
        const int gt = wave_count_sum(gl);
        int need = 256 - gt;
        {
#pragma unroll
        for (int m = 0; m < NR; ++m) {
            unsigned long long eq = __ballot(key[m] == T); const unsigned long long g = __ballot(key[m] > T);
            int pe = __popcll(eq);
            while (pe > need) { eq &= ~(1ull << (63 - __clzll(eq))); --pe; }
            need -= pe;
            if (lane == m) mine = g | eq; }
        }
    }
    if (lane <= c) maskrow[lane] = mine;
}
__device__ __forceinline__ void topk_select_store(const unsigned (&key)[32], int c, unsigned long long* maskrow, int lane) {
    if (c < 8) topk_select_nr<8>(key, c, maskrow, lane); else if (c < 16) topk_select_nr<16>(key, c, maskrow, lane); else if (c < 24) topk_select_nr<24>(key, c, maskrow, lane); else topk_select_nr<32>(key, c, maskrow, lane);
}
__device__ __forceinline__ void phase_topk_naive(const Ctx& X, const float* SC, unsigned long long* MASK) {
    for (int m = X.gw; m < NTOK; m += X.NGW) {
        const int c = (m & 2047) >> 6; unsigned key[32];
#pragma unroll
        for (int j = 0; j < 32; ++j) key[j] = (j <= c) ? ord_key(SC[(size_t)m * SEQ + j * 64 + X.lane]) : 0u;
        topk_select_store(key, c, MASK + (size_t)m * 32, X.lane);
    }
}
__device__ __forceinline__ void phase_sparse_naive(const Ctx& X, const bf16* Q1, const bf16* K1, const bf16* V1, const unsigned long long* MASK, bf16* O) {
    for (int item = blockIdx.x; item < NTOK / 32; item += X.G) {
        const int m = item * 32 + (X.tid >> 4), h = X.tid & 15, g = h >> 3, b = m >> 11, c = (m & 2047) >> 6;
        const GAS u32x4* qp = (const GAS u32x4*)(Q1 + (size_t)m * DM + h * HD);
        float q[64], o[64];
#pragma unroll
        for (int i = 0; i < 8; ++i) { const u32x4 w = qp[i]; q[8 * i] = bflo(w.x); q[8 * i + 1] = bfhi(w.x); q[8 * i + 2] = bflo(w.y); q[8 * i + 3] = bfhi(w.y); q[8 * i + 4] = bflo(w.z); q[8 * i + 5] = bfhi(w.z); q[8 * i + 6] = bflo(w.w); q[8 * i + 7] = bfhi(w.w); }
#pragma unroll
        for (int d = 0; d < 64; ++d) o[d] = 0.f;
        float mx = -1e30f, l = 0.f;
        for (int j = 0; j <= c; ++j) {
            unsigned long long bits = MASK[(size_t)m * 32 + j];
            while (bits) { const int s = j * 64 + __ffsll((long long)bits) - 1; bits &= bits - 1;
                const GAS u32x4* kp = (const GAS u32x4*)(K1 + ((size_t)(b * SEQ + s)) * 128 + g * HD); float z = 0.f;
#pragma unroll
                for (int i = 0; i < 8; ++i) { const u32x4 w = kp[i]; z += q[8 * i] * bflo(w.x) + q[8 * i + 1] * bfhi(w.x) + q[8 * i + 2] * bflo(w.y) + q[8 * i + 3] * bfhi(w.y) + q[8 * i + 4] * bflo(w.z) + q[8 * i + 5] * bfhi(w.z) + q[8 * i + 6] * bflo(w.w) + q[8 * i + 7] * bfhi(w.w); }
                const float mn = fmaxf(mx, z), f = __builtin_amdgcn_exp2f(mx - mn), p = __builtin_amdgcn_exp2f(z - mn); mx = mn; l = l * f + p;
                const GAS u32x4* vp = (const GAS u32x4*)(V1 + ((size_t)(b * SEQ + s)) * 128 + g * HD);
#pragma unroll
                for (int i = 0; i < 8; ++i) { const u32x4 w = vp[i]; o[8 * i] = o[8 * i] * f + p * bflo(w.x); o[8 * i + 1] = o[8 * i + 1] * f + p * bfhi(w.x); o[8 * i + 2] = o[8 * i + 2] * f + p * bflo(w.y); o[8 * i + 3] = o[8 * i + 3] * f + p * bfhi(w.y);
                    o[8 * i + 4] = o[8 * i + 4] * f + p * bflo(w.z); o[8 * i + 5] = o[8 * i + 5] * f + p * bfhi(w.z); o[8 * i + 6] = o[8 * i + 6] * f + p * bflo(w.w); o[8 * i + 7] = o[8 * i + 7] * f + p * bfhi(w.w); }
            }
        }
        const float il = 1.0f / l;
        GAS u32x4* op = (GAS u32x4*)(O + (size_t)m * DM + h * HD);
#pragma unroll
        for (int i = 0; i < 8; ++i) op[i] = (u32x4){pk2(o[8 * i] * il, o[8 * i + 1] * il), pk2(o[8 * i + 2] * il, o[8 * i + 3] * il), pk2(o[8 * i + 4] * il, o[8 * i + 5] * il), pk2(o[8 * i + 6] * il, o[8 * i + 7] * il)};
    }
}


typedef float f32x16 __attribute__((ext_vector_type(16)));
typedef short v4i16_t __attribute__((ext_vector_type(4)));
__device__ __forceinline__ int crow16(int r, int hi) { return (r & 3) + 8 * (r >> 2) + 4 * hi; }
__device__ __forceinline__ float half_sum(float v) { const auto rr = __builtin_amdgcn_permlane32_swap(__float_as_uint(v), __float_as_uint(v), false, false); return __uint_as_float(rr[0]) + __uint_as_float(rr[1]); }
__device__ __forceinline__ float half_max(float v) { const auto rr = __builtin_amdgcn_permlane32_swap(__float_as_uint(v), __float_as_uint(v), false, false); return fmaxf(__uint_as_float(rr[0]), __uint_as_float(rr[1])); }
__device__ __forceinline__ float qk_bound(const float* qgain, const float* kgain, int lane) {
    float a = fabsf(qgain[lane]), b = fabsf(kgain[lane]);
    a = wave_max(a); b = wave_max(b);
    return 64.0f * a * b * QSCALE * 1.02f;
}
__device__ __forceinline__ void rope_frag0(float (&x)[8], const f32x4 (&cs)[2], const f32x4 (&sn)[2], int hi) {
#pragma unroll
    for (int j = 0; j < 8; ++j) { const auto rr = __builtin_amdgcn_permlane32_swap(__float_as_uint(x[j]), __float_as_uint(x[j]), false, false);
        const float p = __uint_as_float(hi ? rr[0] : rr[1]); const float c = cs[j >> 2][j & 3], s_ = sn[j >> 2][j & 3];
        x[j] = hi ? (x[j] * c + p * s_) : (x[j] * c - p * s_); }
}
__device__ __forceinline__ void unpack8(const u32x4 w, float (&x)[8]) { x[0] = bflo(w.x); x[1] = bfhi(w.x); x[2] = bflo(w.y); x[3] = bfhi(w.y); x[4] = bflo(w.z); x[5] = bfhi(w.z); x[6] = bflo(w.w); x[7] = bfhi(w.w); }
__device__ __forceinline__ bf16x8 packf8(const float (&x)[8]) { u32x4 w; w.x = pg8::cvt_pk_bf16(x[0], x[1]); w.y = pg8::cvt_pk_bf16(x[2], x[3]); w.z = pg8::cvt_pk_bf16(x[4], x[5]); w.w = pg8::cvt_pk_bf16(x[6], x[7]); return __builtin_bit_cast(bf16x8, w); }
struct RawFr { u32x4 w[4]; };
__device__ __forceinline__ RawFr raw_frags(const bf16* prow, int hi) { RawFr r;
#pragma unroll
    for (int d0 = 0; d0 < 4; ++d0) r.w[d0] = *(const GAS u32x4*)(prow + 16 * d0 + 8 * hi);
    return r; }
__device__ __forceinline__ void q_frags_from_raw(const RawFr& raw, const float* gq, const f32x4 (&cs)[2], const f32x4 (&sn)[2], int hi, bf16x8 (&qf)[4]) {
    float x[4][8]; float ss = 0.f;
#pragma unroll
    for (int d0 = 0; d0 < 4; ++d0) { unpack8(raw.w[d0], x[d0]);
#pragma unroll
        for (int j = 0; j < 8; ++j) ss += x[d0][j] * x[d0][j]; }
    ss = half_sum(ss);
    const float r = QSCALE / sqrtf(ss * (1.0f / 64.0f) + EPS);
#pragma unroll
    for (int d0 = 0; d0 < 4; ++d0) { const f32x4 g0 = *(const GAS f32x4*)(gq + 16 * d0 + 8 * hi), g1 = *(const GAS f32x4*)(gq + 16 * d0 + 8 * hi + 4);
#pragma unroll
        for (int j = 0; j < 4; ++j) { x[d0][j] *= r * g0[j]; x[d0][4 + j] *= r * g1[j]; } }
    rope_frag0(x[0], cs, sn, hi);
#pragma unroll
    for (int d0 = 0; d0 < 4; ++d0) qf[d0] = packf8(x[d0]);
}
__device__ __forceinline__ void load_q_frags(const bf16* prow, const float* gq, const f32x4 (&cs)[2], const f32x4 (&sn)[2], int hi, bf16x8 (&qf)[4]) { const RawFr raw = raw_frags(prow, hi); q_frags_from_raw(raw, gq, cs, sn, hi, qf); }
__device__ __forceinline__ void qi_frags_from_raw(const RawFr& raw, const f32x4 (&cs)[2], const f32x4 (&sn)[2], int hi, bf16x8 (&qf)[4]) {
    float x0[8]; unpack8(raw.w[0], x0);
    rope_frag0(x0, cs, sn, hi);
    qf[0] = packf8(x0);
#pragma unroll
    for (int d0 = 1; d0 < 4; ++d0) qf[d0] = __builtin_bit_cast(bf16x8, raw.w[d0]);
}
__device__ __forceinline__ bf16x8 pack8(const f32x16& v, int s) {
    u32x4 w; w.x = pg8::cvt_pk_bf16(v[8 * s + 0], v[8 * s + 1]); w.y = pg8::cvt_pk_bf16(v[8 * s + 2], v[8 * s + 3]); w.z = pg8::cvt_pk_bf16(v[8 * s + 4], v[8 * s + 5]); w.w = pg8::cvt_pk_bf16(v[8 * s + 6], v[8 * s + 7]);
    return __builtin_bit_cast(bf16x8, w);
}
__device__ __forceinline__ void vtile_write(LAS unsigned char* vl, const u32x4 (&vr)[4], int lane) {
#pragma unroll
    for (int i = 0; i < 4; ++i) *(LAS u32x4*)(vl + (i * 2 + ((lane & 7) >> 2)) * 512 + (lane >> 3) * 64 + (lane & 3) * 16) = vr[i];
}
__device__ __forceinline__ bf16x8 vtile_frag(const LAS unsigned char* vl, int trbase, int s, int d0) {
    const v4i16_t lo = __builtin_amdgcn_ds_read_tr16_b64_v4i16((LAS v4i16_t*)(vl + trbase + ((2 * s + 0) * 2 + d0) * 512));
    const v4i16_t hi = __builtin_amdgcn_ds_read_tr16_b64_v4i16((LAS v4i16_t*)(vl + trbase + ((2 * s + 1) * 2 + d0) * 512));
    return (bf16x8){lo[0], lo[1], lo[2], lo[3], hi[0], hi[1], hi[2], hi[3]};
}
__device__ __forceinline__ void store_ot(bf16* orow, const f32x16& o0, const f32x16& o1, float sc, int hi) {
#pragma unroll
    for (int rg = 0; rg < 4; ++rg) {
        *(GAS u32x2*)(orow + 8 * rg + 4 * hi) = (u32x2){pg8::cvt_pk_bf16(o0[4 * rg] * sc, o0[4 * rg + 1] * sc), pg8::cvt_pk_bf16(o0[4 * rg + 2] * sc, o0[4 * rg + 3] * sc)};
        *(GAS u32x2*)(orow + 32 + 8 * rg + 4 * hi) = (u32x2){pg8::cvt_pk_bf16(o1[4 * rg] * sc, o1[4 * rg + 1] * sc), pg8::cvt_pk_bf16(o1[4 * rg + 2] * sc, o1[4 * rg + 3] * sc)};
    }
}

__device__ __forceinline__ void phase_sb_fast(const Ctx& X, const bf16* QKV, bf16* O) {
    const int lane = X.lane, r32 = lane & 31, hi = lane >> 5;
    LAS unsigned char* vl = X.lds + X.wave * 4096;
    const int trbase = (4 * hi + ((lane & 15) >> 2)) * 64 + (16 * ((lane >> 4) & 1) + 4 * (lane & 3)) * 2;
    bf16x8 uf[2];
#pragma unroll
    for (int s = 0; s < 2; ++s)
#pragma unroll
        for (int j = 0; j < 8; ++j) uf[s][j] = ((16 * s + 8 * (j >> 2) + 4 * hi + (j & 3)) > r32) ? (short)0x3F80 : (short)0;
    for (int u = X.gw; u < NB * NH * 64; u += X.NGW) {
        const int b = u >> 10, h = (u >> 6) & 15, qb = u & 63, t0 = qb * 32;
        const bf16* base = QKV + (size_t)b * SEQ * NQKV + h * HD;
        bf16x8 qf[4];
#pragma unroll
        for (int d0 = 0; d0 < 4; ++d0) qf[d0] = *(const GAS bf16x8*)(base + (size_t)(t0 + r32) * NQKV + 16 * d0 + 8 * hi);
        f32x16 o0 = {}, o1 = {}; float run = 0.f;
        bf16x8 kf[4], kn[4]; u32x4 vr[4], vn[4];
#pragma unroll
        for (int d0 = 0; d0 < 4; ++d0) kf[d0] = *(const GAS bf16x8*)(base + (size_t)(t0 + r32) * NQKV + DM + 16 * d0 + 8 * hi);
#pragma unroll
        for (int i = 0; i < 4; ++i) vr[i] = *(const GAS u32x4*)(base + (size_t)(t0 + i * 8 + (lane >> 3)) * NQKV + 2 * DM + 8 * (lane & 7));
        for (int kt = qb; kt >= 0; --kt) {
            { const int keyn = (kt > 0 ? kt - 1 : 0) * 32;
#pragma unroll
              for (int d0 = 0; d0 < 4; ++d0) kn[d0] = *(const GAS bf16x8*)(base + (size_t)(keyn + r32) * NQKV + DM + 16 * d0 + 8 * hi);
#pragma unroll
              for (int i = 0; i < 4; ++i) vn[i] = *(const GAS u32x4*)(base + (size_t)(keyn + i * 8 + (lane >> 3)) * NQKV + 2 * DM + 8 * (lane & 7)); }
            asm volatile("" ::: "memory");
            vtile_write(vl, vr, lane);
            f32x16 S = {};
#pragma unroll
            for (int d0 = 0; d0 < 4; ++d0) S = __builtin_amdgcn_mfma_f32_32x32x16_bf16(kf[d0], qf[d0], S, 0, 0, 0);
            const bool diag = (kt == qb);
            f32x16 xm, ls; float cs = 0.f;
#pragma unroll
            for (int r = 0; r < 16; ++r) { const float z = S[r]; const float sp = fmaxf(z, 0.f) + __builtin_amdgcn_logf(1.0f + __builtin_amdgcn_exp2f(-fabsf(z)));
                const bool valid = !diag || (crow16(r, hi) < r32);
                xm[r] = valid ? -sp : 0.f; ls[r] = valid ? z - sp : -INFINITY; cs += xm[r]; }
            cs = half_sum(cs);
            f32x16 T;
#pragma unroll
            for (int r = 0; r < 16; ++r) T[r] = run;
            T = __builtin_amdgcn_mfma_f32_32x32x16_bf16(uf[0], pack8(xm, 0), T, 0, 0, 0);
            T = __builtin_amdgcn_mfma_f32_32x32x16_bf16(uf[1], pack8(xm, 1), T, 0, 0, 0);
            f32x16 a;
#pragma unroll
            for (int r = 0; r < 16; ++r) a[r] = __builtin_amdgcn_exp2f(ls[r] + T[r]);
            const bf16x8 p0 = pack8(a, 0), p1 = pack8(a, 1);
            asm volatile("" ::: "memory");
            o0 = __builtin_amdgcn_mfma_f32_32x32x16_bf16(vtile_frag(vl, trbase, 0, 0), p0, o0, 0, 0, 0);
            o1 = __builtin_amdgcn_mfma_f32_32x32x16_bf16(vtile_frag(vl, trbase, 0, 1), p0, o1, 0, 0, 0);
            o0 = __builtin_amdgcn_mfma_f32_32x32x16_bf16(vtile_frag(vl, trbase, 1, 0), p1, o0, 0, 0, 0);
            o1 = __builtin_amdgcn_mfma_f32_32x32x16_bf16(vtile_frag(vl, trbase, 1, 1), p1, o1, 0, 0, 0);
            asm volatile("" ::: "memory");
            run += cs;
            if (__all(run < -160.f)) break;
#pragma unroll
            for (int d0 = 0; d0 < 4; ++d0) { kf[d0] = kn[d0]; vr[d0] = vn[d0]; }
        }
        store_ot(O + (size_t)(b * SEQ + t0 + r32) * DM + h * HD, o0, o1, 1.0f, hi);
    }
}

__device__ __forceinline__ void phase_sparse_fast(const Ctx& X, const bf16* Q1, const bf16* K1, const bf16* V1, const unsigned* MASK32, bf16* O) {
    const int lane = X.lane, r32 = lane & 31, hi = lane >> 5;
    LAS unsigned char* vl = X.lds + X.wave * 4096;
    const int trbase = (4 * hi + ((lane & 15) >> 2)) * 64 + (16 * ((lane >> 4) & 1) + 4 * (lane & 3)) * 2;
    for (int u = X.gw; u < NB * 64 * NH; u += X.NGW) {
        const int h = u & 15, tb = (u >> 4) & 63, b = u >> 10, g = h >> 3, t0 = tb * 32, ntile = 2 * ((t0 >> 6) + 1);
        const size_t tok = (size_t)b * SEQ + t0 + r32;
        bf16x8 qf[4];
#pragma unroll
        for (int d0 = 0; d0 < 4; ++d0) qf[d0] = *(const GAS bf16x8*)(Q1 + tok * DM + h * HD + 16 * d0 + 8 * hi);
        const bf16* kb = K1 + (size_t)b * SEQ * 128 + g * HD; const bf16* vb = V1 + (size_t)b * SEQ * 128 + g * HD;
        f32x16 o0 = {}, o1 = {}; float mrun = -1e30f, l = 0.f;
        for (int kt = 0; kt < ntile; ++kt) {
            const int key0 = kt * 32;
            bf16x8 kf[4]; u32x4 vr[4];
#pragma unroll
            for (int d0 = 0; d0 < 4; ++d0) kf[d0] = *(const GAS bf16x8*)(kb + (size_t)(key0 + r32) * 128 + 16 * d0 + 8 * hi);
#pragma unroll
            for (int i = 0; i < 4; ++i) vr[i] = *(const GAS u32x4*)(vb + (size_t)(key0 + i * 8 + (lane >> 3)) * 128 + 8 * (lane & 7));
            const unsigned mw = MASK32[tok * 64 + kt] >> (4 * hi);
            asm volatile("" ::: "memory");
            vtile_write(vl, vr, lane);
            f32x16 S = {};
#pragma unroll
            for (int d0 = 0; d0 < 4; ++d0) S = __builtin_amdgcn_mfma_f32_32x32x16_bf16(kf[d0], qf[d0], S, 0, 0, 0);
            float mx = -INFINITY;
#pragma unroll
            for (int r = 0; r < 16; ++r) { const unsigned msk = (unsigned)__builtin_amdgcn_sbfe((int)mw, (r & 3) + 8 * (r >> 2), 1);
                S[r] = __uint_as_float((__float_as_uint(S[r]) & msk) | (0xFF800000u & ~msk)); mx = fmaxf(mx, S[r]); }
            mx = half_max(mx);
            const float mnew = fmaxf(mrun, mx), f = __builtin_amdgcn_exp2f(mrun - mnew); mrun = mnew;
            f32x16 p; float ps = 0.f;
#pragma unroll
            for (int r = 0; r < 16; ++r) { p[r] = __builtin_amdgcn_exp2f(S[r] - mnew); ps += p[r]; }
            l = l * f + ps;
            if (__any(f != 1.0f)) {
#pragma unroll
                for (int r = 0; r < 16; ++r) { o0[r] *= f; o1[r] *= f; } }
            const bf16x8 p0 = pack8(p, 0), p1 = pack8(p, 1);
            asm volatile("" ::: "memory");
            o0 = __builtin_amdgcn_mfma_f32_32x32x16_bf16(vtile_frag(vl, trbase, 0, 0), p0, o0, 0, 0, 0);
            o1 = __builtin_amdgcn_mfma_f32_32x32x16_bf16(vtile_frag(vl, trbase, 0, 1), p0, o1, 0, 0, 0);
            o0 = __builtin_amdgcn_mfma_f32_32x32x16_bf16(vtile_frag(vl, trbase, 1, 0), p1, o0, 0, 0, 0);
            o1 = __builtin_amdgcn_mfma_f32_32x32x16_bf16(vtile_frag(vl, trbase, 1, 1), p1, o1, 0, 0, 0);
            asm volatile("" ::: "memory");
        }
        l = half_sum(l);
        store_ot(O + tok * DM + h * HD, o0, o1, 1.0f / l, hi);
    }
}

__device__ __forceinline__ void phase_idx_topk_fast(const Ctx& X, const bf16* QI, const bf16* KI, const float* WI, unsigned long long* MASK) {
    const int lane = X.lane, r32 = lane & 31, hi = lane >> 5;
    const int tkr = 2 * ((r32 >> 2) & 1) + (r32 >> 4), hdr = (r32 & 3) + 4 * ((r32 >> 3) & 1);
    int round = 0;
    for (int u0 = X.gw; u0 < NTOK / 4; u0 += X.NGW, ++round) {
        const int b = u0 >> 9; int tg = u0 & 511; if (round & 1) tg = 511 - tg;
        const int t0 = tg * 4, c = t0 >> 6; const size_t tok0 = (size_t)b * SEQ + t0;
        bf16x8 qf[4];
#pragma unroll
        for (int d0 = 0; d0 < 4; ++d0) qf[d0] = *(const GAS bf16x8*)(QI + (tok0 + tkr) * 512 + hdr * 64 + 16 * d0 + 8 * hi);
        float w0[8], w1[8];
#pragma unroll
        for (int hh = 0; hh < 8; ++hh) { w0[hh] = WI[(tok0 + 2 * hi) * 8 + hh]; w1[hh] = WI[(tok0 + 2 * hi + 1) * 8 + hh]; }
        unsigned k0[32], k1[32], k2[32], k3[32];
        const bf16* kib = KI + (size_t)b * SEQ * 64;
#pragma unroll
        for (int m = 0; m < 32; ++m) {
            if (m <= c) {
                float sa[2], sb[2];
#pragma unroll
                for (int half = 0; half < 2; ++half) {
                    const int key0 = 64 * m + 32 * half; f32x16 R = {};
#pragma unroll
                    for (int d0 = 0; d0 < 4; ++d0) { const bf16x8 kf = *(const GAS bf16x8*)(kib + (size_t)(key0 + r32) * 64 + 16 * d0 + 8 * hi); R = __builtin_amdgcn_mfma_f32_32x32x16_bf16(qf[d0], kf, R, 0, 0, 0); }
                    float s0 = 0.f, s1 = 0.f;
#pragma unroll
                    for (int hh = 0; hh < 8; ++hh) { s0 += w0[hh] * fmaxf(R[hh], 0.f); s1 += w1[hh] * fmaxf(R[8 + hh], 0.f); }
                    sa[half] = s0; sb[half] = s1;
                }
                const auto ra = __builtin_amdgcn_permlane32_swap(ord_key(sa[0]), ord_key(sa[1]), false, false);
                const auto rb = __builtin_amdgcn_permlane32_swap(ord_key(sb[0]), ord_key(sb[1]), false, false);
                k0[m] = ra[0]; k2[m] = ra[1]; k1[m] = rb[0]; k3[m] = rb[1];
            } else { k0[m] = 0u; k1[m] = 0u; k2[m] = 0u; k3[m] = 0u; }
        }
        topk_select_store(k0, c, MASK + (tok0 + 0) * 32, lane);
        topk_select_store(k1, c, MASK + (tok0 + 1) * 32, lane);
        topk_select_store(k2, c, MASK + (tok0 + 2) * 32, lane);
        topk_select_store(k3, c, MASK + (tok0 + 3) * 32, lane);
    }
}


__device__ __forceinline__ void wait_vm_le(int n) {
    switch (n) { case 0: WAITV(0); break; case 1: WAITV(1); break; case 2: WAITV(2); break; case 3: WAITV(3); break; case 4: WAITV(4); break; case 5: WAITV(5); break; case 6: WAITV(6); break;
                 case 7: WAITV(7); break; case 8: WAITV(8); break; case 9: WAITV(9); break; case 10: WAITV(10); break; case 11: WAITV(11); break; case 12: WAITV(12); break; default: WAITV(12); break; }
}
__device__ __forceinline__ void ktile_dma(LAS unsigned char* slot, const bf16* rows  , int pitch, int tid, int wave) {
    const int key = tid >> 3, cpos = tid & 7, src = cpos ^ ((key >> 1) & 7);
    __builtin_amdgcn_global_load_lds((const GAS unsigned*)(rows + (size_t)key * pitch + src * 8), (LAS unsigned*)(slot + wave * 1024), 16, 0, 0);
}
__device__ __forceinline__ bf16x8 ktile_frag(const LAS unsigned char* slot, int key, int d0, int hi) {
    return *(const LAS bf16x8*)(slot + key * 128 + (((2 * d0 + hi) ^ ((key >> 1) & 7)) << 4));
}
__device__ __forceinline__ void vtile_dma(LAS unsigned char* slot, const bf16* rows, int pitch, int tid, int wave) {
    const int st = tid >> 5, row = (tid & 31) >> 2, ch = tid & 3, key = (st >> 1) * 8 + row, d = (st & 1) * 32 + ch * 8;
    __builtin_amdgcn_global_load_lds((const GAS unsigned*)(rows + (size_t)key * pitch + d), (LAS unsigned*)(slot + wave * 1024), 16, 0, 0);
}

__device__ __forceinline__ void phase_sparse_coop(const Ctx& X, const bf16* PRAW, const float* ROPE, const float* qgain, float Mb, const bf16* K1, const bf16* V1, const unsigned char* MASKB, bf16* O) {
    const int lane = X.lane, r32 = lane & 31, hi = lane >> 5, tid = X.tid, wave = X.wave;
    constexpr int SP_NS = 6, SP_D = 5;
    LAS unsigned char* kring = X.lds; LAS unsigned char* vring = X.lds + SP_NS * 8192; LAS unsigned char* mlds = X.lds + 2 * SP_NS * 8192;
    const int trbase = (4 * hi + ((lane & 15) >> 2)) * 64 + (16 * ((lane >> 4) & 1) + 4 * (lane & 3)) * 2;
    for (int i = 0; i < 16; ++i) {
        const int P = blockIdx.x + 256 * i; if (P >= NB * 2 * 64) break;
        int tb = P & 63; const int g = (P >> 6) & 1, b = P >> 7; if (i & 1) tb = 63 - tb;
        const int t0 = tb * 32, c = t0 >> 6, h = 8 * g + wave;
        const size_t tokb = (size_t)b * SEQ, tok = tokb + t0 + r32;
        const bf16* kb = K1 + tokb * 128 + g * HD; const bf16* vb = V1 + tokb * 128 + g * HD;
        __builtin_amdgcn_global_load_lds((const GAS unsigned*)(MASKB + (tokb + t0 + (tid >> 4)) * 256 + (tid & 15) * 16), (LAS unsigned*)(mlds + wave * 1024), 16, 0, 0);
        bf16x8 qf[4];
        { const GAS f32x4* rp = (const GAS f32x4*)(ROPE + tok * 16); const f32x4 cs[2] = {rp[0], rp[1]}, sn[2] = {rp[2], rp[3]};
          load_q_frags(PRAW + tok * NPROJ + h * HD, qgain, cs, sn, hi, qf); }
#pragma unroll
        for (int p = 0; p < SP_D; ++p) if (p <= c) { ktile_dma(kring + p * 8192, kb + (size_t)p * 64 * 128, 128, tid, wave); vtile_dma(vring + p * 8192, vb + (size_t)p * 64 * 128, 128, tid, wave); }
        f32x16 o0 = {}, o1 = {}; float mrun = -1e30f, l = 0.f;
        const float Mrow = Mb;
        const bool fast = !__any(!(Mrow <= 60.f));
        const float cinit = fast ? -Mrow : 0.f;
#define SP_QK(SA_, SB_, slot_) do { const LAS unsigned char* ks_ = kring + (slot_) * 8192; \
            _Pragma("unroll") for (int r = 0; r < 16; ++r) { SA_[r] = cinit; SB_[r] = cinit; } \
            _Pragma("unroll") for (int d0 = 0; d0 < 4; ++d0) { SA_ = __builtin_amdgcn_mfma_f32_32x32x16_bf16(ktile_frag(ks_, r32, d0, hi), qf[d0], SA_, 0, 0, 0); SB_ = __builtin_amdgcn_mfma_f32_32x32x16_bf16(ktile_frag(ks_, 32 + r32, d0, hi), qf[d0], SB_, 0, 0, 0); } } while (0)
#define SP_PV(C0_, C1_) do { \
            { const bf16x8 pa = pack8(C0_, 0), pb = pack8(C0_, 1); \
              o0 = __builtin_amdgcn_mfma_f32_32x32x16_bf16(vtile_frag(vs, trbase, 0, 0), pa, o0, 0, 0, 0); o1 = __builtin_amdgcn_mfma_f32_32x32x16_bf16(vtile_frag(vs, trbase, 0, 1), pa, o1, 0, 0, 0); \
              o0 = __builtin_amdgcn_mfma_f32_32x32x16_bf16(vtile_frag(vs, trbase, 1, 0), pb, o0, 0, 0, 0); o1 = __builtin_amdgcn_mfma_f32_32x32x16_bf16(vtile_frag(vs, trbase, 1, 1), pb, o1, 0, 0, 0); } \
            { const bf16x8 pc = pack8(C1_, 0), pd = pack8(C1_, 1); \
              o0 = __builtin_amdgcn_mfma_f32_32x32x16_bf16(vtile_frag(vs, trbase, 2, 0), pc, o0, 0, 0, 0); o1 = __builtin_amdgcn_mfma_f32_32x32x16_bf16(vtile_frag(vs, trbase, 2, 1), pc, o1, 0, 0, 0); \
              o0 = __builtin_amdgcn_mfma_f32_32x32x16_bf16(vtile_frag(vs, trbase, 3, 0), pd, o0, 0, 0, 0); o1 = __builtin_amdgcn_mfma_f32_32x32x16_bf16(vtile_frag(vs, trbase, 3, 1), pd, o1, 0, 0, 0); } } while (0)
        if (fast) {
            f32x16 S0, S1, N0, N1;
            { const int ahead = c < (SP_D - 1) ? c : (SP_D - 1); wait_vm_le(2 * ahead); }
            SBAR();
            SP_QK(S0, S1, 0);
            int slot = 0;
#define SP_STEP(C0_, C1_, X0_, X1_, m_) do { const int m = (m_); \
                const int slotn = (slot == SP_NS - 1) ? 0 : slot + 1; \
                { int ahead = (c - m - 1) < (SP_D - 2) ? (c - m - 1) : (SP_D - 2); if (ahead < 0) ahead = 0; wait_vm_le(2 * ahead); } \
                SBAR(); \
                if (m + SP_D <= c) { const int s2 = (slot == 0) ? SP_NS - 1 : slot - 1; ktile_dma(kring + s2 * 8192, kb + (size_t)(m + SP_D) * 64 * 128, 128, tid, wave); vtile_dma(vring + s2 * 8192, vb + (size_t)(m + SP_D) * 64 * 128, 128, tid, wave); } \
                if (m + 1 <= c) SP_QK(X0_, X1_, slotn); \
                const LAS unsigned char* vs = vring + slot * 8192; \
                const u32x2 mw2 = *(const LAS u32x2*)(mlds + r32 * 256 + m * 8); \
                const unsigned mwa = mw2.x >> (4 * hi), mwb = mw2.y >> (4 * hi); \
                float ps = 0.f; \
                _Pragma("unroll") for (int r = 0; r < 16; ++r) { const int pos = (r & 3) + 8 * (r >> 2); \
                    const unsigned ma = (unsigned)__builtin_amdgcn_sbfe((int)mwa, pos, 1), mb = (unsigned)__builtin_amdgcn_sbfe((int)mwb, pos, 1); \
                    C0_[r] = __uint_as_float(__float_as_uint(__builtin_amdgcn_exp2f(C0_[r])) & ma); C1_[r] = __uint_as_float(__float_as_uint(__builtin_amdgcn_exp2f(C1_[r])) & mb); ps += C0_[r] + C1_[r]; } \
                l += ps; \
                SP_PV(C0_, C1_); \
                slot = slotn; } while (0)
            for (int mm = 0; mm <= c; mm += 2) {
                SP_STEP(S0, S1, N0, N1, mm);
                if (mm + 1 <= c) SP_STEP(N0, N1, S0, S1, mm + 1);
            }
#undef SP_STEP
        } else {
            int slot = 0;
            for (int m = 0; m <= c; ++m) {
                { const int ahead = (c - m) < (SP_D - 1) ? (c - m) : (SP_D - 1); wait_vm_le(2 * ahead); }
                SBAR();
                if (m + SP_D <= c) { const int s2 = (slot == 0) ? SP_NS - 1 : slot - 1; ktile_dma(kring + s2 * 8192, kb + (size_t)(m + SP_D) * 64 * 128, 128, tid, wave); vtile_dma(vring + s2 * 8192, vb + (size_t)(m + SP_D) * 64 * 128, 128, tid, wave); }
                const LAS unsigned char* vs = vring + slot * 8192;
                f32x16 S0, S1;
                SP_QK(S0, S1, slot);
                const u32x2 mw2 = *(const LAS u32x2*)(mlds + r32 * 256 + m * 8);
                const unsigned mwa = mw2.x >> (4 * hi), mwb = mw2.y >> (4 * hi);
                float mx = -INFINITY;
#pragma unroll
                for (int r = 0; r < 16; ++r) { const int pos = (r & 3) + 8 * (r >> 2);
                    const unsigned ma = (unsigned)__builtin_amdgcn_sbfe((int)mwa, pos, 1), mb = (unsigned)__builtin_amdgcn_sbfe((int)mwb, pos, 1);
                    S0[r] = __uint_as_float((__float_as_uint(S0[r]) & ma) | (0xFF800000u & ~ma)); S1[r] = __uint_as_float((__float_as_uint(S1[r]) & mb) | (0xFF800000u & ~mb));
                    mx = fmaxf(mx, fmaxf(S0[r], S1[r])); }
                mx = half_max(mx);
                const float mnew = fmaxf(mrun, mx), f = __builtin_amdgcn_exp2f(mrun - mnew); mrun = mnew;
                float ps = 0.f;
#pragma unroll
                for (int r = 0; r < 16; ++r) { S0[r] = __builtin_amdgcn_exp2f(S0[r] - mnew); S1[r] = __builtin_amdgcn_exp2f(S1[r] - mnew); ps += S0[r] + S1[r]; }
                l = l * f + ps;
                if (__any(f != 1.0f)) {
#pragma unroll
                    for (int r = 0; r < 16; ++r) { o0[r] *= f; o1[r] *= f; } }
                SP_PV(S0, S1);
                slot = (slot == SP_NS - 1) ? 0 : slot + 1;
            }
        }
#undef SP_QK
#undef SP_PV
        l = half_sum(l);
        store_ot(O + tok * DM + h * HD, o0, o1, 1.0f / l, hi);
        asm volatile("s_waitcnt lgkmcnt(0)" ::: "memory");
        SBAR();
    }
}


__device__ __forceinline__ void phase_sparse_coop2(const Ctx& X, const bf16* PRAW, const float* ROPE, const float* qgain, float Mb, const bf16* K1, const bf16* V1, const unsigned char* MASKB, bf16* O) {
    const int lane = X.lane, r32 = lane & 31, hi = lane >> 5, tid = X.tid, wave = X.wave, g = wave >> 2, hA = 8 * g + 2 * (wave & 3);
    constexpr int NS = 3, D = 2;
    LAS unsigned char* kring = X.lds; LAS unsigned char* vring = X.lds + NS * 16384; LAS unsigned char* mlds = X.lds + 2 * NS * 16384;
    const int trbase = (4 * hi + ((lane & 15) >> 2)) * 64 + (16 * ((lane >> 4) & 1) + 4 * (lane & 3)) * 2;
    for (int i = 0; i < 8; ++i) {
        const int P = blockIdx.x + 256 * i; if (P >= NB * 64) break;
        int tb = P & 63; const int b = P >> 6; if (i & 1) tb = 63 - tb;
        const int t0 = tb * 32, c = t0 >> 6;
        const size_t tokb = (size_t)b * SEQ, tok = tokb + t0 + r32;
        const bf16* kb0 = K1 + tokb * 128; const bf16* vb0 = V1 + tokb * 128;
#define SP2_DMA(slot_, tile_) do { LAS unsigned char* ks_ = kring + (slot_) * 16384; LAS unsigned char* vs_ = vring + (slot_) * 16384; const size_t ro_ = (size_t)(tile_) * 64 * 128; \
            ktile_dma(ks_, kb0 + ro_, 128, tid, wave); ktile_dma(ks_ + 8192, kb0 + ro_ + HD, 128, tid, wave); vtile_dma(vs_, vb0 + ro_, 128, tid, wave); vtile_dma(vs_ + 8192, vb0 + ro_ + HD, 128, tid, wave); } while (0)
        __builtin_amdgcn_global_load_lds((const GAS unsigned*)(MASKB + (tokb + t0 + (tid >> 4)) * 256 + (tid & 15) * 16), (LAS unsigned*)(mlds + wave * 1024), 16, 0, 0);
        const RawFr rwA = raw_frags(PRAW + tok * NPROJ + hA * HD, hi), rwB = raw_frags(PRAW + tok * NPROJ + (hA + 1) * HD, hi);
        const GAS f32x4* rp = (const GAS f32x4*)(ROPE + tok * 16); const f32x4 cs[2] = {rp[0], rp[1]}, sn[2] = {rp[2], rp[3]};
        asm volatile("" ::: "memory");
#pragma unroll
        for (int p = 0; p < D; ++p) if (p <= c) SP2_DMA(p, p);
        asm volatile("" ::: "memory");
        bf16x8 qa[4], qb[4];
        q_frags_from_raw(rwA, qgain, cs, sn, hi, qa); q_frags_from_raw(rwB, qgain, cs, sn, hi, qb);
        f32x16 a0 = {}, a1 = {}, b0 = {}, b1 = {}; float lA = 0.f, lB = 0.f;
        const float cinit = -Mb;
        int slot = 0;
        for (int m = 0; m <= c; ++m) {
            { const int ahead = (c - m) < (D - 1) ? (c - m) : (D - 1); wait_vm_le(4 * ahead); }
            SBAR();
            if (m + D <= c) { const int s2 = (slot == 0) ? NS - 1 : slot - 1; SP2_DMA(s2, m + D); }
            const LAS unsigned char* ks = kring + slot * 16384 + g * 8192; const LAS unsigned char* vs = vring + slot * 16384 + g * 8192;
            f32x16 A0, A1, B0, B1;
            { const u32x2 mw2 = *(const LAS u32x2*)(mlds + r32 * 256 + m * 8);
              const unsigned mwa = mw2.x >> (4 * hi), mwb = mw2.y >> (4 * hi), cb = __float_as_uint(cinit);
#pragma unroll
              for (int r = 0; r < 16; ++r) { const int pos = (r & 3) + 8 * (r >> 2);
                  const unsigned ma = (unsigned)__builtin_amdgcn_sbfe((int)mwa, pos, 1), mb = (unsigned)__builtin_amdgcn_sbfe((int)mwb, pos, 1);
                  const float ia = __uint_as_float((ma & cb) | (~ma & 0xFF800000u)), ib = __uint_as_float((mb & cb) | (~mb & 0xFF800000u));
                  A0[r] = ia; B0[r] = ia; A1[r] = ib; B1[r] = ib; } }
#pragma unroll
            for (int d0 = 0; d0 < 4; ++d0) { const bf16x8 k0 = ktile_frag(ks, r32, d0, hi), k1 = ktile_frag(ks, 32 + r32, d0, hi);
                A0 = __builtin_amdgcn_mfma_f32_32x32x16_bf16(k0, qa[d0], A0, 0, 0, 0); B0 = __builtin_amdgcn_mfma_f32_32x32x16_bf16(k0, qb[d0], B0, 0, 0, 0);
                A1 = __builtin_amdgcn_mfma_f32_32x32x16_bf16(k1, qa[d0], A1, 0, 0, 0); B1 = __builtin_amdgcn_mfma_f32_32x32x16_bf16(k1, qb[d0], B1, 0, 0, 0); }
            f32x2 pA0 = {0.f, 0.f}, pA1 = {0.f, 0.f}, pB0 = {0.f, 0.f}, pB1 = {0.f, 0.f};
#pragma unroll
            for (int r = 0; r < 16; ++r) { A0[r] = __builtin_amdgcn_exp2f(A0[r]); A1[r] = __builtin_amdgcn_exp2f(A1[r]); B0[r] = __builtin_amdgcn_exp2f(B0[r]); B1[r] = __builtin_amdgcn_exp2f(B1[r]); }
#pragma unroll
            for (int r = 0; r < 16; r += 2) { pA0 += (f32x2){A0[r], A0[r + 1]}; pA1 += (f32x2){A1[r], A1[r + 1]}; pB0 += (f32x2){B0[r], B0[r + 1]}; pB1 += (f32x2){B1[r], B1[r + 1]}; }
            { const f32x2 sa2 = pA0 + pA1, sb2 = pB0 + pB1; lA += sa2.x + sa2.y; lB += sb2.x + sb2.y; }
#define SP2_PV(s4_, PA_, PB_) do { const bf16x8 v0_ = vtile_frag(vs, trbase, s4_, 0), v1_ = vtile_frag(vs, trbase, s4_, 1); \
                a0 = __builtin_amdgcn_mfma_f32_32x32x16_bf16(v0_, PA_, a0, 0, 0, 0); a1 = __builtin_amdgcn_mfma_f32_32x32x16_bf16(v1_, PA_, a1, 0, 0, 0); \
                b0 = __builtin_amdgcn_mfma_f32_32x32x16_bf16(v0_, PB_, b0, 0, 0, 0); b1 = __builtin_amdgcn_mfma_f32_32x32x16_bf16(v1_, PB_, b1, 0, 0, 0); } while (0)
            { const bf16x8 pa = pack8(A0, 0), pb = pack8(B0, 0); SP2_PV(0, pa, pb); }
            { const bf16x8 pa = pack8(A0, 1), pb = pack8(B0, 1); SP2_PV(1, pa, pb); }
            { const bf16x8 pa = pack8(A1, 0), pb = pack8(B1, 0); SP2_PV(2, pa, pb); }
            { const bf16x8 pa = pack8(A1, 1), pb = pack8(B1, 1); SP2_PV(3, pa, pb); }
#undef SP2_PV
            slot = (slot == NS - 1) ? 0 : slot + 1;
        }
#undef SP2_DMA
        lA = half_sum(lA); lB = half_sum(lB);
        store_ot(O + tok * DM + hA * HD, a0, a1, 1.0f / lA, hi);
        store_ot(O + tok * DM + (hA + 1) * HD, b0, b1, 1.0f / lB, hi);
        asm volatile("s_waitcnt lgkmcnt(0)" ::: "memory");
        SBAR();
    }
}

__device__ __forceinline__ void phase_idx_topk_coop(const Ctx& X, const bf16* PRAW, const float* ROPE, const bf16* KI, const float* WI, unsigned long long* MASK) {
    const int lane = X.lane, r32 = lane & 31, hi = lane >> 5, tid = X.tid, wave = X.wave;
    const int tkr = 2 * ((r32 >> 2) & 1) + (r32 >> 4), hdr = (r32 & 3) + 4 * ((r32 >> 3) & 1);
    LAS unsigned char* kring = X.lds;
    for (int i = 0; i < 8; ++i) {
        const int P = blockIdx.x + 256 * i; if (P >= NB * 64) break;
        int tb = P & 63; const int b = P >> 6; if (i & 1) tb = 63 - tb;
        const int t0 = tb * 32 + 4 * wave, c = tb >> 1; const size_t tokb = (size_t)b * SEQ, tok0 = tokb + t0;
        const bf16* kib = KI + tokb * 64;
        const RawFr rwq = raw_frags(PRAW + (tok0 + tkr) * NPROJ + 1280 + hdr * 64, hi);
        const GAS f32x4* rp = (const GAS f32x4*)(ROPE + (tok0 + tkr) * 16); const f32x4 cs[2] = {rp[0], rp[1]}, sn[2] = {rp[2], rp[3]};
        float w0[8], w1[8];
        { const GAS f32x4* wp = (const GAS f32x4*)(WI + (tok0 + 2 * hi) * 8); const f32x4 a = wp[0], b4 = wp[1], c4 = wp[2], d4 = wp[3];
#pragma unroll
          for (int hh = 0; hh < 4; ++hh) { w0[hh] = a[hh]; w0[4 + hh] = b4[hh]; w1[hh] = c4[hh]; w1[4 + hh] = d4[hh]; } }
        asm volatile("" ::: "memory");
#pragma unroll
        for (int p = 0; p < 7; ++p) if (p <= c) ktile_dma(kring + p * 8192, kib + (size_t)p * 64 * 64, 64, tid, wave);
        asm volatile("" ::: "memory");
        bf16x8 qf[4];
        qi_frags_from_raw(rwq, cs, sn, hi, qf);
        unsigned k0[32], k1[32], k2[32], k3[32];
        SEC_BEGIN(1);
#pragma unroll
        for (int m = 0; m < 32; ++m) {
            if (m <= c) {
                { SEC_BEGIN(3);
                { const int ahead = (c - m) < 6 ? (c - m) : 6; wait_vm_le(ahead); }
                SEC_END(3); }
                { SEC_BEGIN(4);
                SBAR();
                SEC_END(4); }
                if (m + 7 <= c) ktile_dma(kring + ((m + 7) % 8) * 8192, kib + (size_t)(m + 7) * 64 * 64, 64, tid, wave);
                const LAS unsigned char* ks = kring + (m % 8) * 8192;
                float sa[2], sb[2];
                { bf16x8 kfa[4], kfb[4];
#pragma unroll
                  for (int d0 = 0; d0 < 4; ++d0) { kfa[d0] = ktile_frag(ks, r32, d0, hi); kfb[d0] = ktile_frag(ks, 32 + r32, d0, hi); }
                  f32x16 Ra = {}, Rb = {};
#pragma unroll
                  for (int d0 = 0; d0 < 4; ++d0) { Ra = __builtin_amdgcn_mfma_f32_32x32x16_bf16(qf[d0], kfa[d0], Ra, 0, 0, 0); Rb = __builtin_amdgcn_mfma_f32_32x32x16_bf16(qf[d0], kfb[d0], Rb, 0, 0, 0); }
                  f32x2 sA = {0.f, 0.f}, sB = {0.f, 0.f};
#pragma unroll
                  for (int hh = 0; hh < 8; ++hh) { sA = (f32x2){relu1(Ra[hh]), relu1(Rb[hh])} * w0[hh] + sA; sB = (f32x2){relu1(Ra[8 + hh]), relu1(Rb[8 + hh])} * w1[hh] + sB; }
                  sa[0] = sA.x; sb[0] = sB.x; sa[1] = sA.y; sb[1] = sB.y; }
                const auto ra = __builtin_amdgcn_permlane32_swap(ord_key(sa[0]), ord_key(sa[1]), false, false);
                const auto rb = __builtin_amdgcn_permlane32_swap(ord_key(sb[0]), ord_key(sb[1]), false, false);
                k0[m] = ra[0]; k2[m] = ra[1]; k1[m] = rb[0]; k3[m] = rb[1];
            } else { k0[m] = 0u; k1[m] = 0u; k2[m] = 0u; k3[m] = 0u; }
        }
        asm volatile("s_waitcnt lgkmcnt(0)" ::: "memory");
        SBAR();
        SEC_END(1);
        SEC_BEGIN(2);
        topk_select_store(k0, c, MASK + (tok0 + 0) * 32, lane);
        topk_select_store(k1, c, MASK + (tok0 + 1) * 32, lane);
        topk_select_store(k2, c, MASK + (tok0 + 2) * 32, lane);
        topk_select_store(k3, c, MASK + (tok0 + 3) * 32, lane);
        SEC_END(2);
    }
}


#define SB_TILE(S_, qf_, diag_, run_, o0_, o1_) do { \
        f32x16 S_ = {}; \
        _Pragma("unroll") for (int d0 = 0; d0 < 4; ++d0) S_ = __builtin_amdgcn_mfma_f32_32x32x16_bf16(ktile_frag(ks, r32, d0, hi), qf_[d0], S_, 0, 0, 0); \
        f32x16 xm_, ls_; float cs_ = 0.f; \
        _Pragma("unroll") for (int r = 0; r < 16; ++r) { const float z = S_[r]; const float sp = relu1(z) + __builtin_amdgcn_logf(1.0f + __builtin_amdgcn_exp2f(-fabsf(z))); \
            const bool valid = !(diag_) || (crow16(r, hi) < r32); xm_[r] = valid ? sp : 0.f; ls_[r] = valid ? z - sp : -INFINITY; cs_ += xm_[r]; } \
        cs_ = half_sum(cs_); \
        f32x16 T_; _Pragma("unroll") for (int r = 0; r < 16; ++r) T_[r] = run_; \
        T_ = __builtin_amdgcn_mfma_f32_32x32x16_bf16(uf[0], pack8(xm_, 0), T_, 0, 0, 0); \
        T_ = __builtin_amdgcn_mfma_f32_32x32x16_bf16(uf[1], pack8(xm_, 1), T_, 0, 0, 0); \
        _Pragma("unroll") for (int r = 0; r < 16; ++r) T_[r] = __builtin_amdgcn_exp2f(ls_[r] + T_[r]); \
        const bf16x8 p0_ = pack8(T_, 0), p1_ = pack8(T_, 1); \
        o0_ = __builtin_amdgcn_mfma_f32_32x32x16_bf16(vtile_frag(vs, trbase, 0, 0), p0_, o0_, 0, 0, 0); o1_ = __builtin_amdgcn_mfma_f32_32x32x16_bf16(vtile_frag(vs, trbase, 0, 1), p0_, o1_, 0, 0, 0); \
        o0_ = __builtin_amdgcn_mfma_f32_32x32x16_bf16(vtile_frag(vs, trbase, 1, 0), p1_, o0_, 0, 0, 0); o1_ = __builtin_amdgcn_mfma_f32_32x32x16_bf16(vtile_frag(vs, trbase, 1, 1), p1_, o1_, 0, 0, 0); \
        run_ -= cs_; } while (0)
#define SB_ELEM(S_, xm_, cs_, diag_, run_) do {   \
        _Pragma("unroll") for (int r = 0; r < 16; r += 2) { const f32x2 z = {S_[r], S_[r + 1]}; \
            f32x2 e; e.x = __builtin_amdgcn_exp2f(-fabsf(z.x)); e.y = __builtin_amdgcn_exp2f(-fabsf(z.y)); \
            const f32x2 d = e + 1.0f; \
            f32x2 lg; lg.x = __builtin_amdgcn_logf(d.x); lg.y = __builtin_amdgcn_logf(d.y); \
            f32x2 mx; mx.x = relu1(z.x); mx.y = relu1(z.y); \
            const f32x2 sp = mx + lg, t = z + ((f32x2){run_, run_} - sp); \
            xm_[r] = sp.x; xm_[r + 1] = sp.y; S_[r] = t.x; S_[r + 1] = t.y; } \
        if (diag_) { _Pragma("unroll") for (int r = 0; r < 16; ++r) { const bool valid = crow16(r, hi) < r32; xm_[r] = valid ? xm_[r] : 0.f; S_[r] = valid ? S_[r] : -INFINITY; } } \
        { f32x2 c2 = {0.f, 0.f}; _Pragma("unroll") for (int r = 0; r < 16; r += 2) c2 += (f32x2){xm_[r], xm_[r + 1]}; cs_ = half_sum(c2.x + c2.y); } } while (0)
#define SB_PAIR(dA_) do { \
        bf16x8 kf_[4]; _Pragma("unroll") for (int d0 = 0; d0 < 4; ++d0) kf_[d0] = ktile_frag(ks, r32, d0, hi); \
        f32x16 SA_ = {}, SB_ = {}; \
        _Pragma("unroll") for (int d0 = 0; d0 < 4; ++d0) { SA_ = __builtin_amdgcn_mfma_f32_32x32x16_bf16(kf_[d0], qa[d0], SA_, 0, 0, 0); SB_ = __builtin_amdgcn_mfma_f32_32x32x16_bf16(kf_[d0], qb[d0], SB_, 0, 0, 0); } \
        f32x16 xA_, xB_; float cA_, cB_; \
        SB_ELEM(SA_, xA_, cA_, dA_, runA); SB_ELEM(SB_, xB_, cB_, false, runB);            \
        SA_ = __builtin_amdgcn_mfma_f32_32x32x16_bf16(uf[0], pack8(xA_, 0), SA_, 0, 0, 0); SB_ = __builtin_amdgcn_mfma_f32_32x32x16_bf16(uf[0], pack8(xB_, 0), SB_, 0, 0, 0); \
        SA_ = __builtin_amdgcn_mfma_f32_32x32x16_bf16(uf[1], pack8(xA_, 1), SA_, 0, 0, 0); SB_ = __builtin_amdgcn_mfma_f32_32x32x16_bf16(uf[1], pack8(xB_, 1), SB_, 0, 0, 0); \
        _Pragma("unroll") for (int r = 0; r < 16; ++r) { SA_[r] = __builtin_amdgcn_exp2f(SA_[r]); SB_[r] = __builtin_amdgcn_exp2f(SB_[r]); } \
        { const bf16x8 pa_ = pack8(SA_, 0), pb_ = pack8(SB_, 0); const bf16x8 v0_ = vtile_frag(vs, trbase, 0, 0), v1_ = vtile_frag(vs, trbase, 0, 1); \
          a0 = __builtin_amdgcn_mfma_f32_32x32x16_bf16(v0_, pa_, a0, 0, 0, 0); b0 = __builtin_amdgcn_mfma_f32_32x32x16_bf16(v0_, pb_, b0, 0, 0, 0); \
          a1 = __builtin_amdgcn_mfma_f32_32x32x16_bf16(v1_, pa_, a1, 0, 0, 0); b1 = __builtin_amdgcn_mfma_f32_32x32x16_bf16(v1_, pb_, b1, 0, 0, 0); } \
        { const bf16x8 pa_ = pack8(SA_, 1), pb_ = pack8(SB_, 1); const bf16x8 v0_ = vtile_frag(vs, trbase, 1, 0), v1_ = vtile_frag(vs, trbase, 1, 1); \
          a0 = __builtin_amdgcn_mfma_f32_32x32x16_bf16(v0_, pa_, a0, 0, 0, 0); b0 = __builtin_amdgcn_mfma_f32_32x32x16_bf16(v0_, pb_, b0, 0, 0, 0); \
          a1 = __builtin_amdgcn_mfma_f32_32x32x16_bf16(v1_, pa_, a1, 0, 0, 0); b1 = __builtin_amdgcn_mfma_f32_32x32x16_bf16(v1_, pb_, b1, 0, 0, 0); } \
        runA -= cA_; runB -= cB_; } while (0)
__device__ __forceinline__ void sb_tile_dma(LAS unsigned char* slot, const bf16* base  , int key0, int lane) {
#pragma unroll
    for (int i = 0; i < 4; ++i) { const int key = 8 * i + (lane >> 3), src = (lane & 7) ^ ((key >> 1) & 7);
        __builtin_amdgcn_global_load_lds((const GAS unsigned*)(base + (size_t)(key0 + key) * NQKV + DM + src * 8), (LAS unsigned*)(slot + i * 1024), 16, 0, 0); }
#pragma unroll
    for (int i = 0; i < 4; ++i) { const int key = 8 * i + ((lane & 31) >> 2), d = 32 * (lane >> 5) + 8 * (lane & 3);
        __builtin_amdgcn_global_load_lds((const GAS unsigned*)(base + (size_t)(key0 + key) * NQKV + 2 * DM + d), (LAS unsigned*)(slot + 4096 + i * 1024), 16, 0, 0); }
}
__device__ __forceinline__ void phase_sb_pair(const Ctx& X, const bf16* QKV, bf16* O) {
    const int lane = X.lane, r32 = lane & 31, hi = lane >> 5;
    LAS unsigned char* ring = X.lds + X.wave * 16384;
    const int trbase = (4 * hi + ((lane & 15) >> 2)) * 64 + (16 * ((lane >> 4) & 1) + 4 * (lane & 3)) * 2;
    bf16x8 uf[2];
#pragma unroll
    for (int s = 0; s < 2; ++s)
#pragma unroll
        for (int j = 0; j < 8; ++j) uf[s][j] = ((16 * s + 8 * (j >> 2) + 4 * hi + (j & 3)) > r32) ? (short)0xBF80 : (short)0;
    for (int u = X.gw; u < NB * NH * 32; u += X.NGW) {
        const int b = u >> 9, h = (u >> 5) & 15, pb = ((u & 31) + 4 * (b >> 2) + (b & 3)) & 31, t0 = pb * 64;
        const bf16* base = QKV + (size_t)b * SEQ * NQKV + h * HD;
        asm volatile("s_waitcnt lgkmcnt(0)" ::: "memory");
        sb_tile_dma(ring, base, t0 + 32, lane);
        bf16x8 qa[4], qb[4];
#pragma unroll
        for (int d0 = 0; d0 < 4; ++d0) { qa[d0] = *(const GAS bf16x8*)(base + (size_t)(t0 + r32) * NQKV + 16 * d0 + 8 * hi); qb[d0] = *(const GAS bf16x8*)(base + (size_t)(t0 + 32 + r32) * NQKV + 16 * d0 + 8 * hi); }
        f32x16 a0 = {}, a1 = {}, b0 = {}, b1 = {}; float runA = 0.f, runB = 0.f;
        int slot = 0;
        for (int kt = 2 * pb + 1; kt >= 0; --kt) {
            asm volatile("s_waitcnt lgkmcnt(0)" ::: "memory");
            if (kt > 0) { sb_tile_dma(ring + (slot ^ 1) * 8192, base, (kt - 1) * 32, lane); WAITV(8); } else WAITV(0);
            const LAS unsigned char* ks = ring + slot * 8192; const LAS unsigned char* vs = ks + 4096;
            if (kt == 2 * pb + 1) { SB_TILE(SB, qb, true, runB, b0, b1); }
            else { const bool dA = (kt == 2 * pb); SB_PAIR(dA);
                if (__all(runA < -160.f && runB < -160.f)) break; }
            slot ^= 1;
        }
        store_ot(O + (size_t)(b * SEQ + t0 + r32) * DM + h * HD, a0, a1, 1.0f, hi);
        store_ot(O + (size_t)(b * SEQ + t0 + 32 + r32) * DM + h * HD, b0, b1, 1.0f, hi);
        WAITV(0);
    }
}

#ifndef MK_N_LAUNCHES
#define MK_N_LAUNCHES 1
#endif
constexpr int NPHASES = 19;
struct Args { const void* in[19]; float* out; unsigned char* ws; int ph_lo, ph_hi; };
static_assert(sizeof(Args) == 19 * 8 + 8 + 8 + 8, "Args has no padding");

__device__ __forceinline__ void moe_gemms_gu(const Ctx& X, const signed char* H8, const float* hs_e, const signed char* Wgu8_l, const float* wsc_l, const float* bgu_l, unsigned char* ACT, const unsigned* gcnt, const int* list) {
    LAS int* cntL = (LAS int*)(X.lds + EXTRA_OFF); LAS int* tsum = cntL + 32;
    moe_tables(X, gcnt, cntL, tsum);
    pg8::Gemm g{(const bf16*)H8, (const bf16*)Wgu8_l, DM, (size_t)2048 * DM};
    pg8::MoeOrder S{tsum, cntL, list, 8, X.G, (int)blockIdx.x, tsum[NE] * 8, 0};
    pg8::EpiSwiglu8 E{ACT, bgu_l, hs_e, wsc_l, &S};
    pg8::gemm_phase<pg8::EpiSwiglu8, pg8::MoeOrder, true, true, 1>(X.lds, g, S, E);
}
__device__ __forceinline__ void moe_gemms_down(const Ctx& X, const unsigned char* ACT8, const unsigned char* Wd8_l, const float* wsd_l, const float* bd_l, unsigned char* Y, const unsigned* gcnt, const int* list, const float* gate_e) {
    LAS int* cntL = (LAS int*)(X.lds + EXTRA_OFF); LAS int* tsum = cntL + 32;
    moe_tables(X, gcnt, cntL, tsum);
    pg8::Gemm g{(const bf16*)ACT8, (const bf16*)Wd8_l, DM, (size_t)DM * DM};
    pg8::MoeOrder S{tsum, cntL, list, 4, X.G, (int)blockIdx.x, tsum[NE] * 4, 0};
    pg8::EpiDownF8 E{Y, bd_l, gate_e, tsum, wsd_l};
    pg8::gemm_phase<pg8::EpiDownF8, pg8::MoeOrder, false, true, 2>(X.lds, g, S, E);
}

__global__ void __launch_bounds__(NTHREADS, 2) mk_fwd(Args a) {
    extern __shared__ __attribute__((aligned(16))) unsigned char lds_raw[];
    Ctx X; X.lds = (LAS unsigned char*)lds_raw; X.tid = threadIdx.x; X.lane = X.tid & 63; X.wave = __builtin_amdgcn_readfirstlane(X.tid >> 6);
    X.G = gridDim.x; { const int bx = blockIdx.x; X.vcu = (X.G % 8 == 0) ? (bx % 8) * (X.G / 8) + bx / 8 : bx; }
    X.gw = X.vcu * NWAVES + X.wave; X.NGW = X.G * NWAVES;
    volatile LAS unsigned* MISC = (volatile LAS unsigned*)(X.lds + LDSCTL_OFF);
    for (int u = X.tid; u < 256; u += NTHREADS) MISC[u] = 0u;
    __syncthreads();
    unsigned char* ws = a.ws;
    unsigned* ctl = (unsigned*)(ws + WS_CTL);
    XcdBarrier bar = xcd_barrier_post(ctl + CW_BAR, MISC + 8);
    const int lo = a.ph_lo, hi = a.ph_hi;
#ifndef ONLY_PHASE
#define ONLY_PHASE -1
#endif
#define IN(k) ((ONLY_PHASE < 0 || ONLY_PHASE == (k)) && lo <= (k) && (k) < hi)
#if defined(PROBE_LO)
    unsigned long long pr_t0 = 0, pr_t1 = 0;
#define PROBE_AT(k) do { if ((k) == PROBE_LO) pr_t0 = __builtin_amdgcn_s_memrealtime(); if ((k) == PROBE_HI) pr_t1 = __builtin_amdgcn_s_memrealtime(); } while (0)
#else
#define PROBE_AT(k) do {} while (0)
#endif
#define SEAM(k) do { if (IN(k) && IN((k) + 1)) xcd_barrier(bar); PROBE_AT((k) + 1); } while (0)
    const float* x_in = (const float*)a.in[0]; const float* c_in = (const float*)a.in[1]; const int* positions = (const int*)a.in[2];
    const float* ada_w = (const float*)a.in[3]; const float* ada_b = (const float*)a.in[4]; const float* norm1_g = (const float*)a.in[5]; const float* norm2_g = (const float*)a.in[6];
    const float* sb_w_qkv = (const float*)a.in[7]; const float* sb_w_o = (const float*)a.in[8]; const float* dsa_w_in = (const float*)a.in[9];
    const float* dsa_q_gain = (const float*)a.in[10]; const float* dsa_k_gain = (const float*)a.in[11]; const float* dsa_w_o = (const float*)a.in[12];
    const float* router_w = (const float*)a.in[13]; const float* router_b = (const float*)a.in[14];
    const float* exp_w_gu = (const float*)a.in[15]; const float* exp_b_gu = (const float*)a.in[16]; const float* exp_w_down = (const float*)a.in[17]; const float* exp_b_down = (const float*)a.in[18];
    float* out = a.out;
    float* mod = (float*)(ws + WS_MOD);
    signed char* Wqkv8 = (signed char*)(ws + WS_WQKV); bf16* Wo0_t = (bf16*)(ws + WS_WO0); signed char* Win8 = (signed char*)(ws + WS_WIN); bf16* Wo1_t = (bf16*)(ws + WS_WO1); signed char* Wgu8 = (signed char*)(ws + WS_WGU); bf16* Wd_t = (bf16*)(ws + WS_WD);
    float* wsc = (float*)(ws + WS_WSC); signed char* H8 = (signed char*)(ws + WS_H); float* HS = (float*)(ws + WS_HS);
    bf16* QKV = (bf16*)(ws + WS_QKV); unsigned char* ACT = ws + WS_A; unsigned char* Y = ws + WS_B; bf16* O = (bf16*)(ws + WS_O);
    bf16* PRAW = (bf16*)(ws + WS_PRAW); bf16* Q1 = (bf16*)(ws + WS_Q1); bf16* K1 = (bf16*)(ws + WS_K1); bf16* V1 = (bf16*)(ws + WS_V1); bf16* QI = (bf16*)(ws + WS_QI); bf16* KI = (bf16*)(ws + WS_KI); float* WI = (float*)(ws + WS_WI); float* QN = (float*)(ws + WS_QN);
    unsigned long long* MASK = (unsigned long long*)(ws + WS_MASK); float* SC = (float*)(ws + WS_SC);
    int* tok_e = (int*)(ws + WS_TOKE); int* tok_p = (int*)(ws + WS_TOKP); int* list = (int*)(ws + WS_LIST); float* gate_e = (float*)(ws + WS_GATE); float* hs_e = (float*)(ws + WS_HSE); bf16* XR = (bf16*)(ws + WS_XR);
    unsigned* gcnt0 = ctl + CW_CNT; unsigned* gcnt1 = ctl + CW_CNT + 32;
    const float* mod0 = mod; const float* mod1 = mod + (size_t)NB * 6144;

    PROBE_AT(0);
    if (IN(0)) { phase_prologue(X, c_in, ada_w, ada_b, mod, sb_w_qkv, sb_w_o, dsa_w_in, dsa_w_o, exp_w_gu, exp_w_down, Wqkv8, Wo0_t, Win8, Wo1_t, Wgu8, Wd_t, wsc, ctl + CW_ADA, ctl + CW_ITEM);
        if (IN(1)) { if (X.tid == 0) { XB_SPIN(xb_ld(ctl + CW_ADA) < 192u, bar.bar); __builtin_amdgcn_fence(__ATOMIC_ACQUIRE, "agent"); asm volatile("s_waitcnt vmcnt(0)" ::: "memory"); }
            __syncthreads(); }
        PROBE_AT(1); }
    if (IN(1)) { phase_norm1(X, x_in, norm1_g, mod0, H8, HS); SEAM(1); }
    if (IN(2)) { pg8::Gemm g{(const bf16*)H8, (const bf16*)Wqkv8, DM, 0}; pg8::StaticOrder S; S.init(NTOK, NQKV, X.G, (int)blockIdx.x); pg8::EpiBf16S8 E{QKV, NQKV, DM, QSCALE, HS, wsc};
        pg8::gemm_phase<pg8::EpiBf16S8, pg8::StaticOrder, false, true, 1>(X.lds, g, S, E); SEAM(2); }
#if defined(NAIVE_SB)
    if (IN(3)) { phase_sb_naive(X, QKV, O); SEAM(3); }
#else
    if (IN(3)) { phase_sb_pair(X, QKV, O); SEAM(3); }
#endif
    if (IN(4)) { pg8::Gemm g{O, Wo0_t, DM, 0}; pg8::StaticOrder S; S.init(NTOK, DM, X.G, (int)blockIdx.x); pg8::EpiResid<false> E{x_in, XR, mod0 + 2 * DM};
        pg8::gemm_phase<pg8::EpiResid<false>, pg8::StaticOrder, false, true>(X.lds, g, S, E); SEAM(4); }
    if (IN(5)) { phase_norm2_router(X, XR, norm2_g, mod0, router_w, router_b, H8, HS, tok_e, tok_p, gcnt0, list, gate_e, hs_e); SEAM(5); }
    if (IN(6)) { moe_gemms_gu(X, H8, hs_e, Wgu8, wsc + NQKV + NPROJ, exp_b_gu, ACT, gcnt0, list); SEAM(6); }
    if (IN(7)) { moe_gemms_down(X, ACT, (const unsigned char*)Wd_t, wsc + NQKV + NPROJ + 64 * 2048, exp_b_down, Y, gcnt0, list, gate_e); SEAM(7); }
    if (IN(8)) { phase_combine(X, XR, nullptr, Y, tok_e, tok_p, gcnt0, mod0, true, norm1_g + DM, mod1, H8, HS); SEAM(8); }
    if (IN(9)) { pg8::Gemm g{(const bf16*)H8, (const bf16*)Win8, DM, 0}; pg8::StaticOrder S; S.init(NTOK, NPROJ, X.G, (int)blockIdx.x); pg8::EpiBf16S8 E{PRAW, NPROJ, 0, 1.0f, HS, wsc + NQKV};
        pg8::gemm_phase<pg8::EpiBf16S8, pg8::StaticOrder, false, true, 1>(X.lds, g, S, E); SEAM(9); }
    float* ROPE = (float*)(ws + WS_ROPE);
    if (IN(10)) { phase_dsa_post2(X, PRAW, positions, dsa_k_gain, K1, V1, KI, WI, ROPE); SEAM(10); }
#if defined(NAIVE_IDX)
    if (IN(11)) { phase_idx_naive(X, QI, KI, WI, SC); SEAM(11); }
    if (IN(12)) { phase_topk_naive(X, SC, MASK); SEAM(12); }
#else
    if (IN(11)) { phase_idx_topk_coop(X, PRAW, ROPE, KI, WI, MASK); if (IN(13)) xcd_barrier(bar); PROBE_AT(12); PROBE_AT(13); }
#endif
#if defined(NAIVE_SPARSE)
    if (IN(13)) { phase_sparse_naive(X, Q1, K1, V1, MASK, O); SEAM(13); }
#else
    if (IN(13)) { const float mb = qk_bound(dsa_q_gain, dsa_k_gain, X.lane);
        if (mb <= 60.f) phase_sparse_coop2(X, PRAW, ROPE, dsa_q_gain, mb, K1, V1, (const unsigned char*)MASK, O);
        else phase_sparse_coop(X, PRAW, ROPE, dsa_q_gain, mb, K1, V1, (const unsigned char*)MASK, O);
        SEAM(13); }
#endif
    if (IN(14)) { pg8::Gemm g{O, Wo1_t, DM, 0}; pg8::StaticOrder S; S.init(NTOK, DM, X.G, (int)blockIdx.x); pg8::EpiResid<true> E{XR, XR, mod1 + 2 * DM};
        pg8::gemm_phase<pg8::EpiResid<true>, pg8::StaticOrder, false, true>(X.lds, g, S, E); SEAM(14); }
    if (IN(15)) { phase_norm2_router(X, XR, norm2_g + DM, mod1, router_w + (size_t)DM * NE, router_b + NE, H8, HS, tok_e, tok_p, gcnt1, list, gate_e, hs_e); SEAM(15); }
    if (IN(16)) { moe_gemms_gu(X, H8, hs_e, Wgu8 + (size_t)NE * 2048 * DM, wsc + NQKV + NPROJ + NE * 2048, exp_b_gu + (size_t)NE * 2048, ACT, gcnt1, list); SEAM(16); }
    if (IN(17)) { moe_gemms_down(X, ACT, (const unsigned char*)Wd_t + (size_t)NE * DM * DM, wsc + NQKV + NPROJ + 64 * 2048 + NE * DM, exp_b_down + (size_t)NE * DM, Y, gcnt1, list, gate_e); SEAM(17); }
    if (IN(18)) { phase_combine(X, XR, out, Y, tok_e, tok_p, gcnt1, mod1, false, nullptr, nullptr, nullptr, nullptr); }
#if defined(PROBE_SEC)
    if (blockIdx.x == 0 && X.tid == 0) { const unsigned long long span = *(volatile LAS unsigned long long*)(X.lds + LDSCTL_OFF + 64) * PROBE_MULT, t = __builtin_amdgcn_s_memrealtime(); while (__builtin_amdgcn_s_memrealtime() - t < span) __builtin_amdgcn_s_sleep(8); }
#endif
#if defined(PROBE_LO)
    PROBE_AT(19);
    if (blockIdx.x == 0 && X.tid == 0) { const unsigned long long span = (pr_t1 - pr_t0) * PROBE_MULT, t = __builtin_amdgcn_s_memrealtime(); while (__builtin_amdgcn_s_memrealtime() - t < span) __builtin_amdgcn_s_sleep(8); }
#endif
#undef IN
#undef SEAM
}

extern "C" void kernel_launch(void* const* d_in, const int* in_sizes, int n_in, void* d_out, int out_size, void* d_ws, size_t ws_size, hipStream_t stream) {
    static int grid = 0;
    if (grid == 0) {
        if (n_in != 19 || out_size != NTOK * DM || ws_size < WS_END) { fprintf(stderr, "kernel_launch: unexpected shapes (n_in %d, out %d, ws %zu < %zu)\n", n_in, out_size, ws_size, (size_t)WS_END); grid = -1; return; }
        int dev = 0, cus = 0, per_cu = 0;
        if (hipGetDevice(&dev) != hipSuccess || hipDeviceGetAttribute(&cus, hipDeviceAttributeMultiprocessorCount, dev) != hipSuccess) { grid = -1; return; }
        if (hipFuncSetAttribute((const void*)mk_fwd, hipFuncAttributeMaxDynamicSharedMemorySize, LDS_BYTES) != hipSuccess) { fprintf(stderr, "kernel_launch: hipFuncSetAttribute failed\n"); grid = -1; return; }
        if (hipOccupancyMaxActiveBlocksPerMultiprocessor(&per_cu, (const void*)mk_fwd, NTHREADS, LDS_BYTES) != hipSuccess || per_cu < 1)
            fprintf(stderr, "kernel_launch: occupancy query reports %d workgroups per CU\n", per_cu);
        (void)hipGetLastError();
        grid = cus;
    }
    if (grid < 0) return;
    if (hipMemsetAsync((char*)d_ws + WS_CTL, 0, CTL_ZERO_BYTES, stream) != hipSuccess) return;
    Args a{};
    for (int i = 0; i < 19; ++i) a.in[i] = d_in[i];
    a.out = (float*)d_out; a.ws = (unsigned char*)d_ws;
#if MK_N_LAUNCHES == 1
    a.ph_lo = 0; a.ph_hi = NPHASES;
    hipLaunchKernelGGL(mk_fwd, dim3(grid), dim3(NTHREADS), LDS_BYTES, stream, a);
#else
    for (int p = 0; p < NPHASES; ++p) { a.ph_lo = p; a.ph_hi = p + 1; hipLaunchKernelGGL(mk_fwd, dim3(grid), dim3(NTHREADS), LDS_BYTES, stream, a); }
#endif
}
```

```cpp
#include <hip/hip_runtime.h>
#include <cstdio>
#include <cstdint>

#define GAS __attribute__((address_space(1)))
#define LAS __attribute__((address_space(3)))
typedef unsigned short bf16;
typedef short bf16x8 __attribute__((ext_vector_type(8)));
typedef float f32x4 __attribute__((ext_vector_type(4)));
typedef float f32x2 __attribute__((ext_vector_type(2)));
__device__ __forceinline__ float relu1(float z) { const int b = __float_as_int(z); return __int_as_float(b > 0 ? b : 0); }
typedef unsigned u32x4 __attribute__((ext_vector_type(4)));
typedef unsigned u32x2 __attribute__((ext_vector_type(2)));
typedef GAS unsigned gu32;

constexpr int DM = 1024, NB = 32, SEQ = 2048, NTOK = NB * SEQ, NE = 32, TOPK = 4, HD = 64, NH = 16;
constexpr int NQKV = 3072, NPROJ = 2048, NPROJ_REAL = 1864;
constexpr int ECAP = 65536;
constexpr int MOE_ROWS = NTOK * TOPK + NE * 256;
constexpr float EPS = 1e-6f;
constexpr float LOG2E = 1.4426950408889634f;
constexpr float QSCALE = 0.125f * LOG2E;
constexpr int NWAVES = 8, NTHREADS = 512;

constexpr size_t MiB = (size_t)1 << 20;
constexpr size_t WS_CTL = 0, CTL_ZERO_BYTES = 1 * MiB;
constexpr size_t WS_MOD = 1 * MiB;
constexpr size_t WS_WQKV = 3 * MiB, WS_WO0 = 9 * MiB, WS_WIN = 11 * MiB, WS_WO1 = 15 * MiB, WS_WGU = 17 * MiB, WS_WD = 273 * MiB;
constexpr size_t WS_H = 402 * MiB;
constexpr size_t WS_HS = WS_H + 64 * MiB, WS_WSC = 6 * MiB;
constexpr size_t WS_A = 530 * MiB;
constexpr size_t WS_QKV = WS_A, WS_PRAW = WS_A, WS_Q1 = 786 * MiB, WS_K1 = 914 * MiB, WS_V1 = 930 * MiB, WS_QI = 946 * MiB, WS_KI = 1010 * MiB, WS_WI = 1018 * MiB, WS_QN = 1020 * MiB, WS_ROPE = 1022 * MiB;
constexpr size_t WS_B = 1058 * MiB;
constexpr size_t WS_O = WS_B, WS_MASK = 1186 * MiB, WS_SC = 1202 * MiB;
constexpr size_t WS_TOKE = 1720 * MiB, WS_TOKP = 1721 * MiB, WS_TOKG = 1722 * MiB, WS_LIST = 1724 * MiB, WS_GATE = 1732 * MiB, WS_HSE = 1740 * MiB, WS_XR = 1748 * MiB, WS_END = 1876 * MiB;
static_assert(WS_A + (size_t)MOE_ROWS * DM * 2 <= WS_B && WS_B + (size_t)MOE_ROWS * DM * 2 <= WS_TOKE && WS_SC + (size_t)NTOK * SEQ * 4 <= WS_TOKE, "ws map");
constexpr int CW_TMO = 0, CW_BAR = 4096, CW_CNT = 8192, CW_KMAX = 8320, CW_ADA = 8448, CW_ITEM = 8456;

constexpr int RING_BYTES = 131072;
constexpr int LDSCTL_OFF = RING_BYTES;
constexpr int EXTRA_OFF = RING_BYTES + 1024;
constexpr int LDS_BYTES = 163840;

#define WAITV(n) asm volatile("s_waitcnt vmcnt(" #n ")" ::: "memory")
#define SBAR() do { asm volatile("" ::: "memory"); __builtin_amdgcn_s_barrier(); asm volatile("" ::: "memory"); } while (0)
#define LDS_WAIT() asm volatile("s_waitcnt lgkmcnt(0)" ::: "memory")
#define VM_WAIT() asm volatile("s_waitcnt vmcnt(0)" ::: "memory")
__device__ __forceinline__ unsigned f2bf(float f) { unsigned u = __builtin_bit_cast(unsigned, f); return (u + 0x7fffu + ((u >> 16) & 1u)) >> 16; }
typedef __bf16 bf16x2n __attribute__((ext_vector_type(2)));
__device__ __forceinline__ unsigned cvt_pk_bf16(float lo, float hi) { return __builtin_bit_cast(unsigned, __builtin_convertvector((f32x2){lo, hi}, bf16x2n)); }
__device__ __forceinline__ unsigned pk2(float lo, float hi) { return cvt_pk_bf16(lo, hi); }
__device__ __forceinline__ float bflo(unsigned w) { return __uint_as_float(w << 16); }
__device__ __forceinline__ float bfhi(unsigned w) { return __uint_as_float(w & 0xffff0000u); }
__device__ __forceinline__ unsigned pack4i(float a, float b, float c, float d) { return ((unsigned)(int)a & 0xffu) | (((unsigned)(int)b & 0xffu) << 8) | (((unsigned)(int)c & 0xffu) << 16) | (((unsigned)(int)d & 0xffu) << 24); }
template <int CTRL> __device__ __forceinline__ float dpp_mov(float v) { return __uint_as_float((unsigned)__builtin_amdgcn_update_dpp(0, (int)__float_as_uint(v), CTRL, 0xF, 0xF, true)); }
__device__ __forceinline__ float row_sum16(float v) { v += dpp_mov<0xB1>(v); v += dpp_mov<0x4E>(v); v += dpp_mov<0x141>(v); v += dpp_mov<0x140>(v); return v; }
__device__ __forceinline__ float row_max16(float v) { v = fmaxf(v, dpp_mov<0xB1>(v)); v = fmaxf(v, dpp_mov<0x4E>(v)); v = fmaxf(v, dpp_mov<0x141>(v)); v = fmaxf(v, dpp_mov<0x140>(v)); return v; }
__device__ __forceinline__ float quad_sum(float v) { v += dpp_mov<0xB1>(v); v += dpp_mov<0x4E>(v); return v; }
__device__ __forceinline__ float wave_sum(float v) {
    v = row_sum16(v);
    { const auto r = __builtin_amdgcn_permlane16_swap(__float_as_uint(v), __float_as_uint(v), false, false); v = __uint_as_float(r[0]) + __uint_as_float(r[1]); }
    { const auto r = __builtin_amdgcn_permlane32_swap(__float_as_uint(v), __float_as_uint(v), false, false); v = __uint_as_float(r[0]) + __uint_as_float(r[1]); }
    return v;
}
__device__ __forceinline__ float half_max32(float v) {
    v = row_max16(v);
    { const auto r = __builtin_amdgcn_permlane16_swap(__float_as_uint(v), __float_as_uint(v), false, false); v = fmaxf(__uint_as_float(r[0]), __uint_as_float(r[1])); }
    return v;
}
__device__ __forceinline__ float wave_max(float v) {
    v = half_max32(v);
    { const auto r = __builtin_amdgcn_permlane32_swap(__float_as_uint(v), __float_as_uint(v), false, false); v = fmaxf(__uint_as_float(r[0]), __uint_as_float(r[1])); }
    return v;
}

#if defined(PROBE_SEC)
#define SEC_BEGIN2(tag) unsigned long long _s2_t0 = ((tag) == PROBE_SEC) ? __builtin_amdgcn_s_memrealtime() : 0ull
#define SEC_END2(tag) do { if ((tag) == PROBE_SEC && blockIdx.x == 0 && threadIdx.x == 0) { volatile LAS unsigned long long* _acc = (volatile LAS unsigned long long*)(lds + LDSCTL_OFF + 64); *_acc = *_acc + (__builtin_amdgcn_s_memrealtime() - _s2_t0); } } while (0)
#define SEC_BEGIN3(tag) unsigned long long _s3_t0 = ((tag) == PROBE_SEC) ? __builtin_amdgcn_s_memrealtime() : 0ull
#define SEC_END3(tag) do { asm volatile("s_waitcnt vmcnt(0)" ::: "memory"); if ((tag) == PROBE_SEC && blockIdx.x == 0 && threadIdx.x == 0) { volatile LAS unsigned long long* _acc = (volatile LAS unsigned long long*)(lds + LDSCTL_OFF + 64); *_acc = *_acc + (__builtin_amdgcn_s_memrealtime() - _s3_t0); } } while (0)
#else
#define SEC_BEGIN2(tag) do {} while (0)
#define SEC_END2(tag) do {} while (0)
#define SEC_BEGIN3(tag) do {} while (0)
#define SEC_END3(tag) do {} while (0)
#endif
namespace pg8 {
constexpr int BM = 256, BK = 64, HALF = 128, HTB = HALF * BK * 2, NXCD = 8, WGM = 8;
__host__ __device__ __forceinline__ int lds_byte(int r, int c) { const int st = (r >> 4) * 2 + (c >> 5), rr = r & 15, cc = c & 31, ob = rr * 64 + cc * 2; return st * 1024 + (ob ^ (((ob >> 9) & 1) << 5)); }
__host__ __device__ __forceinline__ void stage_rc(int b, int& R, int& C) { const int st = b / 1024, sb = b % 1024, swz = sb ^ (((sb >> 9) & 1) << 5); R = (st >> 1) * 16 + swz / 64; C = (st & 1) * 32 + (swz % 64) / 2; }
__host__ __device__ __forceinline__ int perm32(int rho) { const int n = rho >> 4, i = rho & 15; return 8 * (i >> 2) + 4 * n + (i & 3); }

constexpr float ACT_PRESCALE = 4.0f, Y_PRESCALE = 4.0f;
struct Unit { int pm, pn, e; };
struct Gemm { const bf16* A; const bf16* Bt; int K; size_t bstride; };

struct StaticOrder {
    int nM, nN, nwg, G, c;
    __device__ void init(int M, int N, int G_, int c_) { nM = M / BM; nN = N / BM; nwg = nM * nN; G = G_; c = c_; }
    __device__ bool next(int i, Unit& u) const {
        const long L = (long)i * G + c; if (L >= nwg) return false;
        int wgid = (int)L; { const int q = nwg / NXCD, r = nwg % NXCD, xcd = wgid % NXCD, off = wgid / NXCD; wgid = (xcd < r ? xcd * (q + 1) : r * (q + 1) + (xcd - r) * q) + off; }
        const int nig = WGM * nN, gid = wgid / nig, fm = gid * WGM, gsz = (nM - fm) < WGM ? (nM - fm) : WGM;
        u.pm = fm + ((wgid % nig) % gsz); u.pn = (wgid % nig) / gsz; u.e = 0; return true;
    }
    __device__ __forceinline__ int arow(const Unit&, int) const { return 0; }
};
struct MoeOrder {
    const LAS int* tsum; const LAS int* cnt; const int* list; int nN, G, c, total; mutable int ehint;
    __device__ bool next(int i, Unit& u) const {
        const int L = i * G + (c & 7) * (G >> 3) + (c >> 3); if (L >= total) return false;
        const int tile = L / nN; u.pn = L - tile * nN;
        int e = ehint; while (tile >= tsum[e + 1]) ++e;
        ehint = e; u.e = e; u.pm = tile; return true;
    }
    __device__ __forceinline__ int arow(const Unit& u, int r) const {
        int p = (u.pm - tsum[u.e]) * BM + r; const int c_ = cnt[u.e]; p = p < c_ ? p : c_ - 1; return list[(size_t)u.e * ECAP + p];
    }
};

using ::cvt_pk_bf16;

struct EpiBf16S {
    typedef f32x4 AccT; static constexpr int SEC = 50;
    static constexpr bool PERM = true;
    bf16* O; int ldc; int scale_cols; float scale0;
    __device__ __forceinline__ void operator()(const f32x4 (&acc)[2][2][4][2], const Unit& u, int wr, int wc, int fr, int fq) const {
        const int row0 = u.pm * BM + wr * 64 + fr, col0 = u.pn * BM + wc * 32 + 8 * fq; const float sc = (u.pn * BM < scale_cols) ? scale0 : 1.f;
#pragma unroll
        for (int ai = 0; ai < 2; ++ai)
#pragma unroll
            for (int m = 0; m < 4; ++m) { bf16* rowp = O + (size_t)(row0 + ai * HALF + m * 16) * ldc + col0;
#pragma unroll
                for (int bj = 0; bj < 2; ++bj) { const f32x4 v0 = acc[ai][bj][m][0] * sc, v1 = acc[ai][bj][m][1] * sc;
                    u32x4 w; w.x = cvt_pk_bf16(v0[0], v0[1]); w.y = cvt_pk_bf16(v0[2], v0[3]); w.z = cvt_pk_bf16(v1[0], v1[1]); w.w = cvt_pk_bf16(v1[2], v1[3]);
                    *(GAS u32x4*)(rowp + bj * HALF) = w; } }
    }
};
template <bool IN_BF16>
struct EpiResid {
    typedef f32x4 AccT; static constexpr int SEC = 40;
    static constexpr bool PERM = false;
    const void* xin; bf16* out; const float* gate;
    __device__ __forceinline__ void operator()(const f32x4 (&acc)[2][2][4][2], const Unit& u, int wr, int wc, int fr, int fq) const {
        const int row0 = u.pm * BM + wr * 64 + fr, b = u.pm >> 3, col0 = u.pn * BM + wc * 32 + 4 * fq;
#pragma unroll
        for (int bj = 0; bj < 2; ++bj)
#pragma unroll
            for (int n = 0; n < 2; ++n) { const int c = col0 + bj * HALF + 16 * n; const f32x4 g4 = *(const GAS f32x4*)(gate + (size_t)b * 6144 + c);
#pragma unroll
                for (int ai = 0; ai < 2; ++ai)
#pragma unroll
                    for (int m = 0; m < 4; ++m) { const size_t o = (size_t)(row0 + ai * HALF + m * 16) * DM + c; f32x4 x4;
                        if constexpr (IN_BF16) { const u32x2 w = *(const GAS u32x2*)((const bf16*)xin + o); x4 = (f32x4){bflo(w.x), bfhi(w.x), bflo(w.y), bfhi(w.y)}; }
                        else x4 = *(const GAS f32x4*)((const float*)xin + o);
                        const f32x4 r = x4 + g4 * acc[ai][bj][m][n];
                        *(GAS u32x2*)(out + o) = (u32x2){cvt_pk_bf16(r[0], r[1]), cvt_pk_bf16(r[2], r[3])}; } }
    }
};

__device__ __forceinline__ float swiglu1(float g, float u) {
    g = fminf(g, 7.0f); u = fminf(fmaxf(u, -7.0f), 7.0f);
    const float e = __builtin_amdgcn_exp2f(g * (-1.702f * LOG2E));
    return (u + 1.0f) * g * __builtin_amdgcn_rcpf(1.0f + e);
}
__device__ __forceinline__ f32x2 swiglu_pk(f32x2 g, f32x2 u) {
    g.x = fminf(g.x, 7.0f); g.y = fminf(g.y, 7.0f); u.x = __builtin_amdgcn_fmed3f(u.x, -6.0f, 8.0f); u.y = __builtin_amdgcn_fmed3f(u.y, -6.0f, 8.0f);
    const f32x2 t = g * (-1.702f * LOG2E);
    f32x2 e; e.x = __builtin_amdgcn_exp2f(t.x); e.y = __builtin_amdgcn_exp2f(t.y);
    const f32x2 d = e * (1.0f / ACT_PRESCALE) + (1.0f / ACT_PRESCALE);
    f32x2 r; r.x = __builtin_amdgcn_rcpf(d.x); r.y = __builtin_amdgcn_rcpf(d.y);
    return u * (g * r);
}
struct EpiSwiglu {
    typedef f32x4 AccT; static constexpr int SEC = 60;
    static constexpr bool PERM = true;
    bf16* ACT; const float* bgu;
    __device__ __forceinline__ void operator()(const f32x4 (&acc)[2][2][4][2], const Unit& u, int wr, int wc, int fr, int fq) const {
        const int row0 = u.pm * BM + wr * 64 + fr, jl0 = wc * 32 + 8 * fq, colA = u.pn * HALF + jl0;
        const GAS f32x4* bp = (const GAS f32x4*)(bgu + (size_t)u.e * 2048 + 2 * (u.pn * HALF + jl0));
        const f32x4 b0 = bp[0], b1 = bp[1], b2 = bp[2], b3 = bp[3];
        const f32x4 bg[2] = {(f32x4){b0[0], b0[2], b1[0], b1[2]}, (f32x4){b2[0], b2[2], b3[0], b3[2]}};
        const f32x4 bu[2] = {(f32x4){b0[1], b0[3], b1[1], b1[3]}, (f32x4){b2[1], b2[3], b3[1], b3[3]}};
#pragma unroll
        for (int ai = 0; ai < 2; ++ai)
#pragma unroll
            for (int m = 0; m < 4; ++m) { float o[8];
#pragma unroll
                for (int n = 0; n < 2; ++n) { const f32x4 g4 = acc[ai][0][m][n] + bg[n], u4 = acc[ai][1][m][n] + bu[n];
#pragma unroll
                    for (int i = 0; i < 4; ++i) o[4 * n + i] = swiglu1(g4[i], u4[i]); }
                u32x4 w; w.x = cvt_pk_bf16(o[0], o[1]); w.y = cvt_pk_bf16(o[2], o[3]); w.z = cvt_pk_bf16(o[4], o[5]); w.w = cvt_pk_bf16(o[6], o[7]);
                *(GAS u32x4*)(ACT + (size_t)(row0 + ai * HALF + m * 16) * DM + colA) = w; }
    }
};
struct EpiDown {
    typedef f32x4 AccT; static constexpr int SEC = 20;
    static constexpr bool PERM = true;
    bf16* Y; const float* bd; const float* gate_e; const LAS int* tsum;
    __device__ __forceinline__ void operator()(const f32x4 (&acc)[2][2][4][2], const Unit& u, int wr, int wc, int fr, int fq) const {
        const int row0 = u.pm * BM + wr * 64 + fr, col0 = u.pn * BM + wc * 32 + 8 * fq, lrow0 = (u.pm - tsum[u.e]) * BM + wr * 64 + fr;
        f32x4 bv[2][2];
#pragma unroll
        for (int bj = 0; bj < 2; ++bj)
#pragma unroll
            for (int n = 0; n < 2; ++n) bv[bj][n] = *(const GAS f32x4*)(bd + (size_t)u.e * DM + col0 + bj * HALF + 4 * n);
#pragma unroll
        for (int ai = 0; ai < 2; ++ai)
#pragma unroll
            for (int m = 0; m < 4; ++m) { const float gt = gate_e[(size_t)u.e * ECAP + lrow0 + ai * HALF + m * 16]; bf16* rowp = Y + (size_t)(row0 + ai * HALF + m * 16) * DM + col0;
#pragma unroll
                for (int bj = 0; bj < 2; ++bj) { const f32x4 v0 = (acc[ai][bj][m][0] + bv[bj][0]) * gt, v1 = (acc[ai][bj][m][1] + bv[bj][1]) * gt;
                    u32x4 w; w.x = cvt_pk_bf16(v0[0], v0[1]); w.y = cvt_pk_bf16(v0[2], v0[3]); w.z = cvt_pk_bf16(v1[0], v1[1]); w.w = cvt_pk_bf16(v1[2], v1[3]);
                    *(GAS u32x4*)(rowp + bj * HALF) = w; } }
    }
};
struct EpiDownF8 {
    typedef f32x4 AccT; static constexpr int SEC = 22;
    static constexpr bool PERM = true;
    unsigned char* Y; const float* bd; const float* gate_e; const LAS int* tsum; const float* wsd;
    __device__ __forceinline__ void operator()(const f32x4 (&acc)[2][2][4][2], const Unit& u, int wr, int wc, int fr, int fq) const {
        const int row0 = u.pm * BM + wr * 64 + fr, col0 = u.pn * BM + wc * 32 + 8 * fq, lrow0 = (u.pm - tsum[u.e]) * BM + wr * 64 + fr;
        float gt[2][4];
#pragma unroll
        for (int ai = 0; ai < 2; ++ai)
#pragma unroll
            for (int m = 0; m < 4; ++m) gt[ai][m] = gate_e[(size_t)u.e * ECAP + lrow0 + ai * HALF + m * 16] * Y_PRESCALE;
#pragma unroll
        for (int bj = 0; bj < 2; ++bj) {
            const GAS f32x4* bp = (const GAS f32x4*)(bd + (size_t)u.e * DM + col0 + bj * HALF); const GAS f32x4* sp = (const GAS f32x4*)(wsd + (size_t)u.e * DM + col0 + bj * HALF);
            const f32x4 b0 = bp[0], b1 = bp[1], s0 = sp[0] * (1.0f / ACT_PRESCALE), s1 = sp[1] * (1.0f / ACT_PRESCALE);
#pragma unroll
            for (int ai = 0; ai < 2; ++ai)
#pragma unroll
                for (int m = 0; m < 4; ++m) { const f32x4 a0 = acc[ai][bj][m][0], a1 = acc[ai][bj][m][1]; const float g4 = gt[ai][m];
                    const f32x2 p0 = ((f32x2){a0[0], a0[1]} * (f32x2){s0[0], s0[1]} + (f32x2){b0[0], b0[1]}) * g4, p1 = ((f32x2){a0[2], a0[3]} * (f32x2){s0[2], s0[3]} + (f32x2){b0[2], b0[3]}) * g4;
                    const f32x2 p2 = ((f32x2){a1[0], a1[1]} * (f32x2){s1[0], s1[1]} + (f32x2){b1[0], b1[1]}) * g4, p3 = ((f32x2){a1[2], a1[3]} * (f32x2){s1[2], s1[3]} + (f32x2){b1[2], b1[3]}) * g4;
#define MK_CL(x) __builtin_amdgcn_fmed3f((x), -448.f, 448.f)
                    unsigned w0 = 0u, w1 = 0u;
                    w0 = __builtin_amdgcn_cvt_pk_fp8_f32(MK_CL(p0.x), MK_CL(p0.y), w0, false); w0 = __builtin_amdgcn_cvt_pk_fp8_f32(MK_CL(p1.x), MK_CL(p1.y), w0, true);
                    w1 = __builtin_amdgcn_cvt_pk_fp8_f32(MK_CL(p2.x), MK_CL(p2.y), w1, false); w1 = __builtin_amdgcn_cvt_pk_fp8_f32(MK_CL(p3.x), MK_CL(p3.y), w1, true);
#undef MK_CL
                    *(GAS u32x2*)(Y + (size_t)(row0 + ai * HALF + m * 16) * DM + col0 + bj * HALF) = (u32x2){w0, w1}; }
        }
    }
};


typedef int i32x4e __attribute__((ext_vector_type(4)));
__device__ __forceinline__ f32x4 cvt4(const i32x4e v) { return (f32x4){(float)v[0], (float)v[1], (float)v[2], (float)v[3]}; }
struct EpiBf16S8 {   static constexpr int SEC = 30;
    typedef i32x4e AccT;
    static constexpr bool PERM = true;
    bf16* O; int ldc; int scale_cols; float scale0; const float* sa; const float* sb;
    __device__ __forceinline__ void operator()(const i32x4e (&acc)[2][2][4][2], const Unit& u, int wr, int wc, int fr, int fq) const {
        const int row0 = u.pm * BM + wr * 64 + fr, col0 = u.pn * BM + wc * 32 + 8 * fq; const float sc = (u.pn * BM < scale_cols) ? scale0 : 1.f;
        f32x4 bs[2][2];
#pragma unroll
        for (int bj = 0; bj < 2; ++bj)
#pragma unroll
            for (int n = 0; n < 2; ++n) bs[bj][n] = *(const GAS f32x4*)(sb + col0 + bj * HALF + 4 * n) * sc;
#pragma unroll
        for (int ai = 0; ai < 2; ++ai)
#pragma unroll
            for (int m = 0; m < 4; ++m) { const int r = row0 + ai * HALF + m * 16; const float ra = sa[r]; bf16* rowp = O + (size_t)r * ldc + col0;
#pragma unroll
                for (int bj = 0; bj < 2; ++bj) { const f32x4 v0 = cvt4(acc[ai][bj][m][0]) * bs[bj][0] * ra, v1 = cvt4(acc[ai][bj][m][1]) * bs[bj][1] * ra;
                    u32x4 w; w.x = cvt_pk_bf16(v0[0], v0[1]); w.y = cvt_pk_bf16(v0[2], v0[3]); w.z = cvt_pk_bf16(v1[0], v1[1]); w.w = cvt_pk_bf16(v1[2], v1[3]);
                    *(GAS u32x4*)(rowp + bj * HALF) = w; } }
    }
};
struct EpiSwiglu8 {   static constexpr int SEC = 10;
    typedef i32x4e AccT;
    static constexpr bool PERM = true;
    unsigned char* ACT; const float* bgu; const float* hs; const float* ws  ; const MoeOrder* S;
    __device__ __forceinline__ void operator()(const i32x4e (&acc)[2][2][4][2], const Unit& u, int wr, int wc, int fr, int fq) const {
        const int row0 = u.pm * BM + wr * 64 + fr, jl0 = wc * 32 + 8 * fq, colA = u.pn * HALF + jl0, lrow0 = (u.pm - S->tsum[u.e]) * BM + wr * 64 + fr;
        const GAS f32x4* bp = (const GAS f32x4*)(bgu + (size_t)u.e * 2048 + 2 * (u.pn * HALF + jl0));
        const f32x4 b0 = bp[0], b1 = bp[1], b2 = bp[2], b3 = bp[3];
        const f32x4 bg[2] = {(f32x4){b0[0], b0[2], b1[0], b1[2]}, (f32x4){b2[0], b2[2], b3[0], b3[2]}};
        const f32x4 bu[2] = {(f32x4){b0[1], b0[3], b1[1], b1[3]} + 1.0f, (f32x4){b2[1], b2[3], b3[1], b3[3]} + 1.0f};
        const GAS f32x4* wp = (const GAS f32x4*)(ws + (size_t)u.e * 2048 + u.pn * BM + jl0);
        const f32x4 wg[2] = {wp[0], wp[1]}, wu[2] = {wp[32], wp[33]};
#pragma unroll
        for (int ai = 0; ai < 2; ++ai)
#pragma unroll
            for (int m = 0; m < 4; ++m) { const float ra = hs[(size_t)u.e * ECAP + lrow0 + ai * HALF + m * 16]; f32x2 o[4];
#pragma unroll
                for (int n = 0; n < 2; ++n)
#pragma unroll
                    for (int h = 0; h < 2; ++h) { const i32x4e ag = acc[ai][0][m][n], au = acc[ai][1][m][n];
                        const f32x2 cg = {(float)ag[2 * h], (float)ag[2 * h + 1]}, cu = {(float)au[2 * h], (float)au[2 * h + 1]};
                        const f32x2 wgp = {wg[n][2 * h], wg[n][2 * h + 1]}, wup = {wu[n][2 * h], wu[n][2 * h + 1]}, bgp = {bg[n][2 * h], bg[n][2 * h + 1]}, bup = {bu[n][2 * h], bu[n][2 * h + 1]};
                        o[2 * n + h] = swiglu_pk((cg * wgp) * ra + bgp, (cu * wup) * ra + bup); }
                unsigned w0 = 0u, w1 = 0u;
                w0 = __builtin_amdgcn_cvt_pk_fp8_f32(o[0].x, o[0].y, w0, false); w0 = __builtin_amdgcn_cvt_pk_fp8_f32(o[1].x, o[1].y, w0, true);
                w1 = __builtin_amdgcn_cvt_pk_fp8_f32(o[2].x, o[2].y, w1, false); w1 = __builtin_amdgcn_cvt_pk_fp8_f32(o[3].x, o[3].y, w1, true);
                *(GAS u32x2*)(ACT + (size_t)(row0 + ai * HALF + m * 16) * DM + colA) = (u32x2){w0, w1}; }
    }
};
typedef int i32x4 __attribute__((ext_vector_type(4)));
typedef int i32x8 __attribute__((ext_vector_type(8)));
template <class Epi, class Sched, bool GATHER, bool ALIGN_EPI, int MODE = 0>
__device__ __forceinline__ void gemm_phase(LAS unsigned char* lds, const Gemm g, const Sched& S, const Epi& E) {
    const int tid = threadIdx.x, wid = __builtin_amdgcn_readfirstlane(tid >> 6), lane = tid & 63, wr = wid >> 2, wc = wid & 3, fr = lane & 15, fq = lane >> 4;
    constexpr int ESZ = MODE ? 1 : 2; constexpr bool INT8 = (MODE == 1);
    const int K = g.K, KB = K * ESZ  , nt = KB / (BK * 2);
    int Rr[2], Cc[2]; unsigned voffB[2];
#pragma unroll
    for (int i = 0; i < 2; ++i) { stage_rc(tid * 16 + i * 8192, Rr[i], Cc[i]); const int Rb = Epi::PERM ? ((Rr[i] & ~31) + perm32(Rr[i] & 31)) : Rr[i]; voffB[i] = (unsigned)(Rb * KB + Cc[i] * 2); }
    const size_t kstep = (size_t)(BK * 2), hstep = (size_t)HALF * KB, tstep = 2 * hstep;
    const unsigned ldsw = (unsigned)wid * 1024u;
    const int aoff = lds_byte(wr * 64 + fr, fq * 8), boff = lds_byte(wc * 32 + fr, fq * 8);
#define PG8_SA(b, h) (((b) * 2 + (h)) * HTB)
#define PG8_SB(b, h) ((4 + (b) * 2 + (h)) * HTB)
#define PG8_STAGE(bufoff, gbase, voff) do { _Pragma("unroll") for (int _i = 0; _i < 2; ++_i) \
        __builtin_amdgcn_global_load_lds((const GAS unsigned*)((const char*)(gbase) + (voff)[_i]), (LAS unsigned*)(lds + (bufoff) + ldsw + _i * 8192), 16, 0, 0); } while (0)
#define PG8_RD(off) (*(const LAS i32x4*)(lds + (off)))
#define PG8_LDA(dst, b, h) do { _Pragma("unroll") for (int m = 0; m < 4; ++m) { const i32x4 r0_ = PG8_RD(PG8_SA(b, h) + aoff + m * 2048), r1_ = PG8_RD(PG8_SA(b, h) + aoff + m * 2048 + 1024); \
        if constexpr (MODE == 2) dst##8[m] = __builtin_shufflevector(r0_, r1_, 0, 1, 2, 3, 4, 5, 6, 7); else { dst[m][0] = __builtin_bit_cast(bf16x8, r0_); dst[m][1] = __builtin_bit_cast(bf16x8, r1_); } } } while (0)
#define PG8_LDB(dst, b, h) do { _Pragma("unroll") for (int n = 0; n < 2; ++n) { const i32x4 r0_ = PG8_RD(PG8_SB(b, h) + boff + n * 2048), r1_ = PG8_RD(PG8_SB(b, h) + boff + n * 2048 + 1024); \
        if constexpr (MODE == 2) dst##8[n] = __builtin_shufflevector(r0_, r1_, 0, 1, 2, 3, 4, 5, 6, 7); else { dst[n][0] = __builtin_bit_cast(bf16x8, r0_); dst[n][1] = __builtin_bit_cast(bf16x8, r1_); } } } while (0)
#define PG8_CAT(lo, hi) __builtin_shufflevector(__builtin_bit_cast(i32x4, lo), __builtin_bit_cast(i32x4, hi), 0, 1, 2, 3, 4, 5, 6, 7)
#define PG8_MMA(ai, bj, At, Bt) do { __builtin_amdgcn_s_setprio(1); _Pragma("unroll") for (int m = 0; m < 4; ++m) _Pragma("unroll") for (int n = 0; n < 2; ++n) _Pragma("unroll") for (int k = 0; k < 2; ++k) { \
        if constexpr (MODE == 2) { if (k == 0) asm volatile("v_mfma_scale_f32_16x16x128_f8f6f4 %0, %1, %2, %0, %3, %3 op_sel_hi:[0,0,0]" : "+v"(acc[ai][bj][m][n]) : "v"(Bt##8[n]), "v"(At##8[m]), "v"(f8scale)); } \
        else if constexpr (INT8) acc[ai][bj][m][n] = __builtin_bit_cast(AccT, __builtin_amdgcn_mfma_i32_16x16x64_i8(__builtin_bit_cast(i32x4, Bt[n][k]), __builtin_bit_cast(i32x4, At[m][k]), __builtin_bit_cast(i32x4, acc[ai][bj][m][n]), 0, 0, 0)); \
        else acc[ai][bj][m][n] = __builtin_bit_cast(AccT, __builtin_amdgcn_mfma_f32_16x16x32_bf16(Bt[n][k], At[m][k], __builtin_bit_cast(f32x4, acc[ai][bj][m][n]), 0, 0, 0)); } __builtin_amdgcn_s_setprio(0); } while (0)
#define PG8_WAIT_V(n) asm volatile("s_waitcnt vmcnt(" #n ")" ::: "memory")
#define PG8_WAIT_L(n) asm volatile("s_waitcnt lgkmcnt(" #n ")" ::: "memory")
#define PG8_BAR __builtin_amdgcn_s_barrier()
#define PG8_SCHED __builtin_amdgcn_sched_barrier(0)
    Unit cur, nxt; int ui = 0;
    if (!S.next(0, cur)) return;
    typedef typename Epi::AccT AccT;
    AccT acc[2][2][4][2];
#pragma unroll
    for (int a = 0; a < 2; ++a)
#pragma unroll
        for (int b = 0; b < 2; ++b)
#pragma unroll
            for (int m = 0; m < 4; ++m)
#pragma unroll
                for (int n = 0; n < 2; ++n) acc[a][b][m][n] = AccT{};
    const int f8scale = 0x7F7F7F7F;
    bf16x8 At[4][2], B0[2][2], B1[2][2]; i32x8 At8[4], B08[2], B18[2];
    unsigned vA0[2], vA1[2];
#pragma unroll
    for (int i = 0; i < 2; ++i) {
        if constexpr (GATHER) { vA0[i] = (unsigned)(S.arow(cur, Rr[i]) * KB + Cc[i] * 2); vA1[i] = (unsigned)(S.arow(cur, HALF + Rr[i]) * KB + Cc[i] * 2); }
        else { vA0[i] = (unsigned)(Rr[i] * KB + Cc[i] * 2); vA1[i] = vA0[i] + (unsigned)hstep; }
    }
    const char* cA = GATHER ? (const char*)g.A : (const char*)g.A + (size_t)cur.pm * tstep;
    const char* cB = (const char*)g.Bt + (size_t)cur.e * g.bstride + (size_t)cur.pn * tstep;
    PG8_STAGE(PG8_SB(0, 0), cB, voffB); PG8_STAGE(PG8_SB(0, 1), cB + hstep, voffB); PG8_STAGE(PG8_SA(0, 0), cA, vA0); PG8_STAGE(PG8_SA(0, 1), cA, vA1);
    if (wr == 1) PG8_BAR;
    PG8_WAIT_V(2); PG8_BAR;
    PG8_STAGE(PG8_SB(1, 0), cB + kstep, voffB); PG8_STAGE(PG8_SA(1, 0), cA + kstep, vA0); PG8_STAGE(PG8_SB(1, 1), cB + hstep + kstep, voffB);
    PG8_WAIT_V(6); PG8_BAR;
    for (;;) {
        const bool has_next = S.next(ui + 1, nxt);
        const char* nA = has_next ? (GATHER ? (const char*)g.A : (const char*)g.A + (size_t)nxt.pm * tstep) : cA;
        const char* nB = has_next ? (const char*)g.Bt + (size_t)nxt.e * g.bstride + (size_t)nxt.pn * tstep : cB;
        int nr0[2] = {0, 0}, nr1[2] = {0, 0};
        if constexpr (GATHER) { if (has_next) {
#pragma unroll
            for (int i = 0; i < 2; ++i) { nr0[i] = S.arow(nxt, Rr[i]); nr1[i] = S.arow(nxt, HALF + Rr[i]); } } }
        SEC_BEGIN2(Epi::SEC);
        for (int t = 0; t < nt; t += 2) {
            const bool last = (t == nt - 2);
            const char* a1 = cA + (size_t)(t + 1) * kstep;
            const char* a2 = last ? nA : cA + (size_t)(t + 2) * kstep; const char* b2 = last ? nB : cB + (size_t)(t + 2) * kstep;
            const char* a3 = a2 + kstep; const char* b3 = b2 + kstep;
            if constexpr (GATHER) { if (last && has_next) {
                asm volatile("" : "+v"(nr0[0]), "+v"(nr0[1]), "+v"(nr1[0]), "+v"(nr1[1]));
#pragma unroll
                for (int i = 0; i < 2; ++i) { vA0[i] = (unsigned)(nr0[i] * KB + Cc[i] * 2); nr1[i] = (int)(unsigned)(nr1[i] * KB + Cc[i] * 2); } } }
            unsigned w0[2], w1[2];
#pragma unroll
            for (int i = 0; i < 2; ++i) { w0[i] = vA0[i]; w1[i] = (GATHER && last && has_next) ? (unsigned)nr1[i] : vA1[i]; }
            PG8_LDB(B0, 0, 0); PG8_LDB(B1, 0, 1); PG8_SCHED; PG8_LDA(At, 0, 0); PG8_STAGE(PG8_SA(1, 1), a1, vA1);
            PG8_WAIT_V(8); PG8_WAIT_L(0); PG8_BAR; PG8_MMA(0, 0, At, B0); PG8_MMA(0, 1, At, B1); PG8_BAR; PG8_SCHED;
            PG8_LDA(At, 0, 1); PG8_STAGE(PG8_SB(0, 0), b2, voffB); PG8_STAGE(PG8_SB(0, 1), b2 + hstep, voffB); PG8_STAGE(PG8_SA(0, 0), a2, w0);
            PG8_WAIT_V(8); PG8_WAIT_L(0); PG8_BAR; PG8_MMA(1, 0, At, B0); PG8_MMA(1, 1, At, B1); PG8_BAR; PG8_SCHED;
            PG8_LDB(B0, 1, 0); PG8_LDB(B1, 1, 1); PG8_SCHED; PG8_LDA(At, 1, 0); PG8_STAGE(PG8_SA(0, 1), a2, w1);
            PG8_WAIT_V(8); PG8_WAIT_L(0); PG8_BAR; PG8_MMA(0, 0, At, B0); PG8_MMA(0, 1, At, B1); PG8_BAR; PG8_SCHED;
            PG8_LDA(At, 1, 1); PG8_STAGE(PG8_SB(1, 0), b3, voffB); PG8_STAGE(PG8_SB(1, 1), b3 + hstep, voffB); PG8_STAGE(PG8_SA(1, 0), a3, w0);
            PG8_WAIT_V(8); PG8_WAIT_L(0); PG8_BAR; PG8_MMA(1, 0, At, B0); PG8_MMA(1, 1, At, B1); PG8_BAR; PG8_SCHED;
        }
        if constexpr (ALIGN_EPI) { if (wr == 0) PG8_BAR; }
        SEC_END2(Epi::SEC);
        SEC_BEGIN3(Epi::SEC + 1);
        if constexpr (MODE == 2) {
            asm volatile("s_nop 15\n\ts_nop 15" : "+v"(acc[0][0][0][0]), "+v"(acc[0][0][0][1]), "+v"(acc[0][0][1][0]), "+v"(acc[0][0][1][1]), "+v"(acc[0][0][2][0]), "+v"(acc[0][0][2][1]), "+v"(acc[0][0][3][0]), "+v"(acc[0][0][3][1]),
                         "+v"(acc[0][1][0][0]), "+v"(acc[0][1][0][1]), "+v"(acc[0][1][1][0]), "+v"(acc[0][1][1][1]), "+v"(acc[0][1][2][0]), "+v"(acc[0][1][2][1]), "+v"(acc[0][1][3][0]), "+v"(acc[0][1][3][1]) :: "memory");
            asm volatile("" : "+v"(acc[1][0][0][0]), "+v"(acc[1][0][0][1]), "+v"(acc[1][0][1][0]), "+v"(acc[1][0][1][1]), "+v"(acc[1][0][2][0]), "+v"(acc[1][0][2][1]), "+v"(acc[1][0][3][0]), "+v"(acc[1][0][3][1]),
                         "+v"(acc[1][1][0][0]), "+v"(acc[1][1][0][1]), "+v"(acc[1][1][1][0]), "+v"(acc[1][1][1][1]), "+v"(acc[1][1][2][0]), "+v"(acc[1][1][2][1]), "+v"(acc[1][1][3][0]), "+v"(acc[1][1][3][1]) :: "memory");
        }
        E(acc, cur, wr, wc, fr, fq);
        SEC_END3(Epi::SEC + 1);
        if (!has_next) break;
#pragma unroll
        for (int a = 0; a < 2; ++a)
#pragma unroll
            for (int b = 0; b < 2; ++b)
#pragma unroll
                for (int m = 0; m < 4; ++m)
#pragma unroll
                    for (int n = 0; n < 2; ++n) acc[a][b][m][n] = AccT{};
        cur = nxt; cA = nA; cB = nB; ++ui;
        if constexpr (GATHER) {
#pragma unroll
            for (int i = 0; i < 2; ++i) vA1[i] = (unsigned)nr1[i]; }
        if constexpr (ALIGN_EPI) { if (wr == 1) PG8_BAR; }
    }
    PG8_WAIT_V(0);
    if constexpr (!ALIGN_EPI) { if (wr == 0) PG8_BAR; }
    PG8_BAR;
#undef PG8_SA
#undef PG8_SB
#undef PG8_STAGE
#undef PG8_LDA
#undef PG8_RD
#undef PG8_LDB
#undef PG8_MMA
#undef PG8_CAT
#undef PG8_WAIT_V
#undef PG8_WAIT_L
#undef PG8_BAR
#undef PG8_SCHED
}
}

#define XB_TMO      128
#define XB_XCNT(j)  (256  + 64 * (j))
#define XB_XSUB(j)  (1280 + 64 * (j))
#define XB_XGEN(j)  (2304 + 64 * (j))
#define XB_TOP      3328
#define XB_TOPGEN   3392
#define XCD_BAR_WORDS 3456
#define XB_SPIN_CAP (1u << 22)
__device__ __forceinline__ unsigned xb_ld(unsigned* p)              { return __hip_atomic_load(p, __ATOMIC_RELAXED, __HIP_MEMORY_SCOPE_AGENT); }
__device__ __forceinline__ unsigned xb_add(unsigned* p, unsigned v) { return __hip_atomic_fetch_add(p, v, __ATOMIC_RELAXED, __HIP_MEMORY_SCOPE_AGENT); }
__device__ __forceinline__ unsigned xb_xcc_id() { return (unsigned)__builtin_amdgcn_s_getreg((3 << 11) | 20) & 0xFu; }
#define XB_SPIN(cond, bar) do { unsigned _sp = 0; while (cond) { __builtin_amdgcn_s_sleep(1); \
    if ((++_sp & 255u) == 0u) { if (xb_ld(&(bar)[XB_TMO])) break; if (_sp > XB_SPIN_CAP) { atomicAdd(&(bar)[XB_TMO], 1u); break; } } } } while (0)
struct XcdBarrier { unsigned* bar; unsigned x; volatile LAS unsigned* st; };
__device__ __forceinline__ XcdBarrier xcd_barrier_post(unsigned* bar, volatile LAS unsigned* st) {
    XcdBarrier b; b.bar = bar; b.x = xb_xcc_id(); b.st = st;
    if (threadIdx.x == 0) (void)xb_add(&bar[XB_XCNT(b.x)], 1u);
    return b;
}
__device__ __forceinline__ void xcd_barrier_complete(unsigned* bar, unsigned x, unsigned& nloc, unsigned& nx) {
    const unsigned G = gridDim.x * gridDim.y * gridDim.z;
    unsigned sum, cnt, mine, sp = 0u;
    for (;;) {
        sum = 0u; cnt = 0u; mine = 0u;
#pragma unroll
        for (unsigned j = 0; j < 16; ++j) { const unsigned c = xb_ld(&bar[XB_XCNT(j)]); sum += c; cnt += (c > 0u) ? 1u : 0u; mine = (j == x) ? c : mine; }
        if (sum == G) break;
        __builtin_amdgcn_s_sleep(1);
        if ((++sp & 255u) == 0u) { if (xb_ld(&bar[XB_TMO])) break; if (sp > XB_SPIN_CAP) { atomicAdd(&bar[XB_TMO], 1u); break; } }
    }
    nloc = mine > 0u ? mine : 1u; nx = cnt > 0u ? cnt : 1u;
}
__device__ __forceinline__ void xcd_barrier(const XcdBarrier& b) {
    asm volatile("s_waitcnt vmcnt(0)" ::: "memory");
    __syncthreads();
    if (threadIdx.x == 0) {
        unsigned* bar = b.bar;
        __builtin_amdgcn_s_waitcnt(0);
        unsigned nloc = b.st[0], nx = b.st[1];
        if (nloc == 0u) { xcd_barrier_complete(bar, b.x, nloc, nx); b.st[0] = nloc; b.st[1] = nx; }
        const unsigned old = xb_add(&bar[XB_XSUB(b.x)], 1u);
        const unsigned gen = old / nloc;
        if (old + 1u == (gen + 1u) * nloc) {
            __builtin_amdgcn_fence(__ATOMIC_RELEASE, "agent");
            asm volatile("s_waitcnt vmcnt(0)" ::: "memory");
            const unsigned og = xb_add(&bar[XB_TOP], 1u);
            const unsigned tg = og / nx;
            if (og + 1u == (tg + 1u) * nx) xb_add(&bar[XB_TOPGEN], 1u);
            else XB_SPIN(xb_ld(&bar[XB_TOPGEN]) == tg, bar);
            __builtin_amdgcn_fence(__ATOMIC_ACQUIRE, "agent");
            xb_add(&bar[XB_XGEN(b.x)], 1u);
            asm volatile("s_waitcnt vmcnt(0)" ::: "memory");
        } else {
            XB_SPIN(xb_ld(&bar[XB_XGEN(b.x)]) == gen, bar);
            __builtin_amdgcn_fence(__ATOMIC_ACQUIRE, "agent");
            asm volatile("s_waitcnt vmcnt(0)" ::: "memory");
        }
    }
    __syncthreads();
}


#if defined(PROBE_SEC)
#define SEC_BEGIN(tag) unsigned long long _sec_t0_##tag = ((tag) == PROBE_SEC) ? __builtin_amdgcn_s_memrealtime() : 0ull
#define SEC_END(tag) do { if ((tag) == PROBE_SEC && blockIdx.x == 0 && threadIdx.x == 0) { volatile LAS unsigned long long* _acc = (volatile LAS unsigned long long*)(X.lds + LDSCTL_OFF + 64); *_acc = *_acc + (__builtin_amdgcn_s_memrealtime() - _sec_t0_##tag); } } while (0)
#else
#define SEC_BEGIN(tag) do {} while (0)
#define SEC_END(tag) do {} while (0)
#endif
struct Ctx { LAS unsigned char* lds; int tid, lane, wave, G, vcu, gw, NGW; };

__device__ __forceinline__ void p0_transpose_item(const float* W, int Nsrc, int Ndst, int mode, bf16* WT, LAS float* scr, int item, int lane) {
    const int nblk = Ndst / 32, kb = item / nblk, nb = item - kb * nblk, k0 = 64 * kb, n0 = 32 * nb;
    const int nd = n0 + (lane & 31);
    const int sc = mode ? (2 * (128 * (nd >> 8) + (nd & 127)) + ((nd >> 7) & 1)) : nd;
    const bool ok = sc < Nsrc;
    const GAS float* Wg = (const GAS float*)W;
#pragma unroll 8
    for (int i = 0; i < 32; ++i) { const int kk = 2 * i + (lane >> 5); scr[kk * 33 + (lane & 31)] = ok ? Wg[(size_t)(k0 + kk) * Nsrc + sc] : 0.f; }
    LDS_WAIT(); asm volatile("" ::: "memory");
    const int c = lane & 7;
#pragma unroll
    for (int j = 0; j < 4; ++j) { const int n = (lane >> 3) + 8 * j; const LAS float* s = scr + (8 * c) * 33 + n;
        u32x4 o; o.x = pk2(s[0 * 33], s[1 * 33]); o.y = pk2(s[2 * 33], s[3 * 33]); o.z = pk2(s[4 * 33], s[5 * 33]); o.w = pk2(s[6 * 33], s[7 * 33]);
        *(GAS u32x4*)(WT + (size_t)(n0 + n) * DM + k0 + 8 * c) = o; }
    LDS_WAIT(); asm volatile("" ::: "memory");
}
struct P0Item { const float* W; int Nsrc, c0, mode, q; signed char* W8; float* wsc; };
__device__ __forceinline__ void p0_item_dma(const Ctx& X, const P0Item& d) {
    const int tid = X.tid, chunk = tid & 7; int sc = d.c0 + 4 * chunk; if (sc > d.Nsrc - 4) sc = d.Nsrc - 4;
    const GAS float* src = (const GAS float*)d.W + (size_t)(tid >> 3) * d.Nsrc + sc;
#pragma unroll
    for (int r = 0; r < 16; ++r) __builtin_amdgcn_global_load_lds((const GAS unsigned*)(src + (size_t)(64 * r) * d.Nsrc), (LAS unsigned*)(X.lds + r * 8192 + X.wave * 1024), 16, 0, 0);
}
template <int Q>
__device__ __forceinline__ void p0_item_process(const Ctx& X, const P0Item& d, const P0Item* next) {
    LAS float* T = (LAS float*)X.lds;
    LAS float* part = (LAS float*)(X.lds + EXTRA_OFF);
    const int tid = X.tid, col = tid & 31, kg = tid >> 5;
    WAITV(0); __syncthreads();
    const bool ok = (d.c0 + col) < d.Nsrc;
    float v[64]; float am = 0.f;
#pragma unroll
    for (int i = 0; i < 64; ++i) { v[i] = T[(kg * 64 + i) * 32 + col]; am = fmaxf(am, fabsf(v[i])); }
    part[kg * 32 + col] = ok ? am : 0.f;
    asm volatile("s_waitcnt lgkmcnt(0)" ::: "memory");
    __syncthreads();
    if (next) p0_item_dma(X, *next);
    const int cs = d.c0 + col, j = cs >> 1, nd = d.mode ? (256 * (j >> 7) + 128 * (cs & 1) + (j & 127)) : cs;
    if (tid < 32) { float a = 0.f;
#pragma unroll
        for (int g = 0; g < 16; ++g) a = fmaxf(a, part[g * 32 + tid]);
        constexpr float QMAX = (Q == 2) ? 384.0f : 127.0f; part[512 + tid] = a > 0.f ? QMAX / a : 0.f; d.wsc[nd] = a * (1.0f / QMAX); }
    __syncthreads();
    const float inv = part[512 + col];
    GAS u32x4* dst = (GAS u32x4*)(d.W8 + (size_t)nd * DM + kg * 64);
    if constexpr (Q == 2) {
#pragma unroll
        for (int q = 0; q < 4; ++q) { unsigned w[4];
#pragma unroll
            for (int e = 0; e < 4; ++e) { unsigned x = 0u; x = __builtin_amdgcn_cvt_pk_fp8_f32(v[16 * q + 4 * e] * inv, v[16 * q + 4 * e + 1] * inv, x, false); x = __builtin_amdgcn_cvt_pk_fp8_f32(v[16 * q + 4 * e + 2] * inv, v[16 * q + 4 * e + 3] * inv, x, true); w[e] = x; }
            dst[q] = (u32x4){w[0], w[1], w[2], w[3]}; }
    } else {
#pragma unroll
        for (int q = 0; q < 4; ++q) { u32x4 w;
            w.x = pack4i(rintf(v[16 * q + 0] * inv), rintf(v[16 * q + 1] * inv), rintf(v[16 * q + 2] * inv), rintf(v[16 * q + 3] * inv));
            w.y = pack4i(rintf(v[16 * q + 4] * inv), rintf(v[16 * q + 5] * inv), rintf(v[16 * q + 6] * inv), rintf(v[16 * q + 7] * inv));
            w.z = pack4i(rintf(v[16 * q + 8] * inv), rintf(v[16 * q + 9] * inv), rintf(v[16 * q + 10] * inv), rintf(v[16 * q + 11] * inv));
            w.w = pack4i(rintf(v[16 * q + 12] * inv), rintf(v[16 * q + 13] * inv), rintf(v[16 * q + 14] * inv), rintf(v[16 * q + 15] * inv));
            dst[q] = w; }
    }
    __syncthreads();
}
__device__ __forceinline__ void phase_prologue(const Ctx& X, const float* c_in, const float* ada_w, const float* ada_b, float* mod,
                                               const float* w_qkv, const float* w_o0, const float* w_in, const float* w_o1, const float* w_gu, const float* w_down,
                                               signed char* Wqkv8, bf16* Wo0_t, signed char* Win8, bf16* Wo1_t, signed char* Wgu8, bf16* Wd_t, float* wsc, unsigned* ada_flag, unsigned* item_ctr) {
    if (blockIdx.x < 192) {
        const int l = blockIdx.x / 96, j0 = (blockIdx.x % 96) * 64;
        LAS float* cs = (LAS float*)X.lds;
        for (int i = 0; i < 64; ++i) { const int idx = i * NTHREADS + X.tid, b = idx >> 10, k = idx & 1023; const float v = c_in[idx]; cs[k * 32 + b] = v / (1.0f + __expf(-v)); }
        __syncthreads();
        float acc[32];
#pragma unroll
        for (int b = 0; b < 32; ++b) acc[b] = 0.f;
        const GAS float* wp = (const GAS float*)ada_w + ((size_t)l * DM + X.wave * 128) * 6144 + j0 + X.lane;
#pragma unroll 4
        for (int k = 0; k < 128; ++k) { const float w = wp[(size_t)k * 6144]; const LAS f32x4* c4 = (const LAS f32x4*)(cs + (X.wave * 128 + k) * 32);
#pragma unroll
            for (int b4 = 0; b4 < 8; ++b4) { const f32x4 cv = c4[b4]; acc[4 * b4 + 0] += w * cv[0]; acc[4 * b4 + 1] += w * cv[1]; acc[4 * b4 + 2] += w * cv[2]; acc[4 * b4 + 3] += w * cv[3]; } }
        __syncthreads();
        LAS float* red = (LAS float*)X.lds;
#pragma unroll
        for (int b = 0; b < 32; ++b) red[(X.wave * 32 + b) * 64 + X.lane] = acc[b];
        __syncthreads();
        for (int i = 0; i < 4; ++i) { const int o = i * NTHREADS + X.tid, b = o >> 6, ln = o & 63; float s = 0.f;
#pragma unroll
            for (int w = 0; w < 8; ++w) s += red[(w * 32 + b) * 64 + ln];
            mod[((size_t)l * NB + b) * 6144 + j0 + ln] = s + ada_b[l * 6144 + j0 + ln]; }
        asm volatile("s_waitcnt vmcnt(0)" ::: "memory");
        __syncthreads();
        if (X.tid == 0) { __builtin_amdgcn_fence(__ATOMIC_RELEASE, "agent"); asm volatile("s_waitcnt vmcnt(0)" ::: "memory"); (void)xb_add(ada_flag, 1u); }
    }
    LAS float* scr = (LAS float*)(X.lds + X.wave * 16384);
    constexpr int Q_GU = 64 * 64, Q_QKV = NQKV / 32, Q_IN = NPROJ / 32, N_ITEMS = Q_GU + Q_QKV + Q_IN + 64 * 32;
    auto describe = [&](int it) -> P0Item {
        int r = it;
        if (r < Q_GU) { const int mat = r >> 6; return P0Item{w_gu + (size_t)mat * DM * 2048, 2048, 32 * (r & 63), 1, 1, Wgu8 + (size_t)mat * 2048 * DM, wsc + NQKV + NPROJ + mat * 2048}; } r -= Q_GU;
        if (r < Q_QKV) return P0Item{w_qkv, NQKV, 32 * r, 0, 1, Wqkv8, wsc}; r -= Q_QKV;
        if (r < Q_IN) return P0Item{w_in, NPROJ_REAL, 32 * r, 0, 1, Win8, wsc + NQKV}; r -= Q_IN;
        const int mat = r >> 5; return P0Item{w_down + (size_t)mat * DM * DM, DM, 32 * (r & 31), 0, 2, (signed char*)Wd_t + (size_t)mat * DM * DM, wsc + NQKV + NPROJ + 64 * 2048 + mat * DM};
    };
    SEC_BEGIN(6);
    { volatile LAS int* slot = (volatile LAS int*)(X.lds + LDSCTL_OFF + 128);
      auto fetch = [&](int par) -> int { if (X.tid == 0) slot[par] = (int)xb_add(item_ctr, 1u); __syncthreads(); return __builtin_amdgcn_readfirstlane(slot[par]); };
      int par = 0;
      int it = fetch(par); par ^= 1;
      P0Item cur = describe(it < N_ITEMS ? it : 0);
      if (it < N_ITEMS) p0_item_dma(X, cur);
      while (it < N_ITEMS) {
          const int nxt = fetch(par); par ^= 1;
          const bool hn = nxt < N_ITEMS; const P0Item nx = describe(hn ? nxt : it);
          if (cur.q == 2) p0_item_process<2>(X, cur, hn ? &nx : nullptr); else p0_item_process<1>(X, cur, hn ? &nx : nullptr);
          cur = nx; it = nxt; } }
    { LAS float* scr = (LAS float*)(X.lds + X.wave * 16384);
      for (int r = X.gw; r < 2 * 16 * 32; r += X.NGW) { if (r < 512) p0_transpose_item(w_o0, DM, DM, 0, Wo0_t, scr, r, X.lane); else p0_transpose_item(w_o1, DM, DM, 0, Wo1_t, scr, r - 512, X.lane); } }
    SEC_END(6);

}

__device__ __forceinline__ void norm_mod_store(const f32x4 (&v)[4], const float* gnorm, const float* modb, int shi, int sci, bf16* hrow, int lane, f32x4 (&h)[4]) {
    float ss = 0.f;
#pragma unroll
    for (int j = 0; j < 4; ++j) ss += (v[j][0] * v[j][0] + v[j][1] * v[j][1]) + (v[j][2] * v[j][2] + v[j][3] * v[j][3]);
    const float rstd = 1.0f / sqrtf(wave_sum(ss) * (1.0f / DM) + EPS);
#pragma unroll
    for (int j = 0; j < 4; ++j) {
        const f32x4 g4 = ((const GAS f32x4*)gnorm)[64 * j + lane], sc4 = ((const GAS f32x4*)(modb + sci * DM))[64 * j + lane], sh4 = ((const GAS f32x4*)(modb + shi * DM))[64 * j + lane];
        h[j] = (v[j] * rstd) * g4 * (1.0f + sc4) + sh4;
    }
    (void)hrow;
}
__device__ __forceinline__ void norm_mod_coef(const float* gnorm, const float* modb, int shi, int sci, int lane, f32x4 (&A)[4], f32x4 (&B)[4]) {
#pragma unroll
    for (int j = 0; j < 4; ++j) { const f32x4 g4 = ((const GAS f32x4*)gnorm)[64 * j + lane], sc4 = ((const GAS f32x4*)(modb + sci * DM))[64 * j + lane]; A[j] = g4 * (1.0f + sc4); B[j] = ((const GAS f32x4*)(modb + shi * DM))[64 * j + lane]; }
}
__device__ __forceinline__ void norm_mod_apply(const f32x4 (&v)[4], const f32x4 (&A)[4], const f32x4 (&B)[4], f32x4 (&h)[4]) {
    float ss = 0.f;
#pragma unroll
    for (int j = 0; j < 4; ++j) ss += (v[j][0] * v[j][0] + v[j][1] * v[j][1]) + (v[j][2] * v[j][2] + v[j][3] * v[j][3]);
    const float rstd = 1.0f / sqrtf(wave_sum(ss) * (1.0f / DM) + EPS);
#pragma unroll
    for (int j = 0; j < 4; ++j) h[j] = (v[j] * rstd) * A[j] + B[j];
}
__device__ __forceinline__ float quant_row_store(const f32x4 (&h)[4], signed char* qrow, float* hs, int lane) {
    float am = 0.f;
#pragma unroll
    for (int j = 0; j < 4; ++j) am = fmaxf(am, fmaxf(fmaxf(fabsf(h[j][0]), fabsf(h[j][1])), fmaxf(fabsf(h[j][2]), fabsf(h[j][3]))));
    am = wave_max(am);
    const float inv = am > 0.f ? 127.0f / am : 0.f;
    GAS unsigned* q4 = (GAS unsigned*)qrow + lane;
#pragma unroll
    for (int j = 0; j < 4; ++j) q4[64 * j] = pack4i(rintf(h[j][0] * inv), rintf(h[j][1] * inv), rintf(h[j][2] * inv), rintf(h[j][3] * inv));
    if (lane == 0) *hs = am * (1.0f / 127.0f);
    return am * (1.0f / 127.0f);
}

__device__ __forceinline__ void load_row_f32(const float* p, int lane, f32x4 (&v)[4]) { const GAS f32x4* xr = (const GAS f32x4*)p + lane;
#pragma unroll
    for (int j = 0; j < 4; ++j) v[j] = xr[64 * j]; }
__device__ __forceinline__ void load_row_bf16(const bf16* p, int lane, f32x4 (&v)[4]) { const GAS u32x2* xr = (const GAS u32x2*)p + lane;
#pragma unroll
    for (int j = 0; j < 4; ++j) { const u32x2 w = xr[64 * j]; v[j] = (f32x4){bflo(w.x), bfhi(w.x), bflo(w.y), bfhi(w.y)}; } }
__device__ __forceinline__ void store_row_bf16(bf16* p, int lane, const f32x4 (&v)[4]) { GAS u32x2* xr = (GAS u32x2*)p + lane;
#pragma unroll
    for (int j = 0; j < 4; ++j) xr[64 * j] = (u32x2){pk2(v[j][0], v[j][1]), pk2(v[j][2], v[j][3])}; }
__device__ __forceinline__ void phase_norm1(const Ctx& X, const float* xin, const float* gnorm, const float* mod_l, signed char* H8, float* HS) {
    const int per = NTOK / X.NGW, m0 = X.gw * per;
    f32x4 A[4], B[4]; norm_mod_coef(gnorm, mod_l + (size_t)(m0 >> 11) * 6144, 0, 1, X.lane, A, B);
    f32x4 v[4], vn[4], h[4];
    load_row_f32(xin + (size_t)m0 * DM, X.lane, v);
    for (int m = m0; m < m0 + per; ++m) {
        load_row_f32(xin + (size_t)((m + 1 < m0 + per) ? m + 1 : m) * DM, X.lane, vn);
        norm_mod_apply(v, A, B, h);
        quant_row_store(h, H8 + (size_t)m * DM, HS + m, X.lane);
#pragma unroll
        for (int j = 0; j < 4; ++j) v[j] = vn[j];
    }
}
__device__ __forceinline__ void moe_tables(const Ctx& X, const unsigned* gcnt, LAS int* cntL, LAS int* tsum) {
    __syncthreads();
    if (X.tid < NE) cntL[X.tid] = (int)__hip_atomic_load(gcnt + X.tid, __ATOMIC_RELAXED, __HIP_MEMORY_SCOPE_AGENT);
    __syncthreads();
    if (X.tid == 0) { int s = 0; for (int e = 0; e < NE; ++e) { tsum[e] = s; s += (cntL[e] + 255) >> 8; } tsum[NE] = s; }
    __syncthreads();
}
__device__ __forceinline__ void phase_combine(const Ctx& X, bf16* xr_io, float* out_f32  , const unsigned char* Y, const int* tok_e, const int* tok_p, const unsigned* gcnt, const float* mod_l  ,
                                              bool do_norm, const float* gnorm_next, const float* mod_next, signed char* H8, float* HS) {
    LAS int* cntL = (LAS int*)(X.lds + EXTRA_OFF); LAS int* tsum = cntL + 32;
    moe_tables(X, gcnt, cntL, tsum);
    const int per = NTOK / X.NGW, m0 = X.gw * per, b = m0 >> 11;
    f32x4 G2[4], A[4], B[4];
#pragma unroll
    for (int j = 0; j < 4; ++j) { G2[j] = ((const GAS f32x4*)(mod_l + (size_t)b * 6144 + 5 * DM))[64 * j + X.lane] * (1.0f / pg8::Y_PRESCALE); A[j] = G2[j]; B[j] = G2[j]; }
    if (do_norm) norm_mod_coef(gnorm_next, mod_next + (size_t)b * 6144, 0, 1, X.lane, A, B);
    for (int m = m0; m < m0 + per; ++m) {
        f32x4 v[4], a[4], h[4];
        load_row_bf16(xr_io + (size_t)m * DM, X.lane, v);
#pragma unroll
        for (int j = 0; j < 4; ++j) a[j] = (f32x4){0.f, 0.f, 0.f, 0.f};
#pragma unroll
        for (int k = 0; k < TOPK; ++k) { const int e = tok_e[m * 4 + k], p = tok_p[m * 4 + k]; const GAS unsigned* yr = (const GAS unsigned*)(Y + ((size_t)tsum[e] * 256 + p) * DM) + X.lane;
#pragma unroll
            for (int j = 0; j < 4; ++j) { const unsigned w = yr[64 * j]; const f32x2 lo = __builtin_amdgcn_cvt_pk_f32_fp8(w, false), hi = __builtin_amdgcn_cvt_pk_f32_fp8(w, true);
                a[j][0] += lo[0]; a[j][1] += lo[1]; a[j][2] += hi[0]; a[j][3] += hi[1]; } }
#pragma unroll
        for (int j = 0; j < 4; ++j) v[j] = v[j] + G2[j] * a[j];
        if (out_f32) { GAS f32x4* orow = (GAS f32x4*)(out_f32 + (size_t)m * DM) + X.lane;
#pragma unroll
            for (int j = 0; j < 4; ++j) orow[64 * j] = v[j]; }
        else store_row_bf16(xr_io + (size_t)m * DM, X.lane, v);
        if (do_norm) { norm_mod_apply(v, A, B, h); quant_row_store(h, H8 + (size_t)m * DM, HS + m, X.lane); }
    }
}
__device__ __forceinline__ void phase_norm2_router(const Ctx& X, const bf16* xin, const float* gnorm, const float* mod_l, const float* rw, const float* rb, signed char* H8, float* HS,
                                                   int* tok_e, int* tok_p, unsigned* gcnt, int* list, float* gate_e, float* hs_e) {
    constexpr int HROW = 2064;
    LAS unsigned char* hhi = X.lds; LAS unsigned char* hlo = X.lds + 16 * HROW; LAS float* part = (LAS float*)(X.lds + 2 * 16 * HROW);
    LAS int* cntL = (LAS int*)(X.lds + EXTRA_OFF); LAS int* baseL = cntL + 32; LAS int* selE = baseL + 32; LAS int* selR = selE + 1024; LAS float* selG = (LAS float*)(selR + 1024); LAS float* selH = selG + 1024;
    const int lane = X.lane, fr = lane & 15, fq = lane >> 4, half = lane >> 5, l32 = lane & 31, wave = X.wave;
    bf16x8 bhi[4][2], blo[4][2];
#pragma unroll
    for (int s4 = 0; s4 < 4; ++s4)
#pragma unroll
        for (int nt = 0; nt < 2; ++nt)
#pragma unroll
            for (int j = 0; j < 8; ++j) { const float w = rw[(size_t)(128 * wave + 32 * s4 + 8 * fq + j) * NE + 16 * nt + fr]; const unsigned hb = f2bf(w); const float lo = w - __uint_as_float(hb << 16);
                bhi[s4][nt][j] = (short)hb; blo[s4][nt][j] = (short)f2bf(lo); }
    if (X.tid < NE) cntL[X.tid] = 0;
    const float rbias = rb[l32];
    __syncthreads();
    const int t0 = blockIdx.x * 256;
    f32x4 nA[4], nB[4]; norm_mod_coef(gnorm, mod_l + (size_t)(t0 >> 11) * 6144, 3, 4, lane, nA, nB);
    f32x4 xv[2][4], xn[2][4];
#pragma unroll
    for (int q = 0; q < 2; ++q) load_row_bf16(xin + (size_t)(t0 + 2 * wave + q) * DM, lane, xv[q]);
    for (int it = 0; it < 16; ++it) {
        { const int itn = it < 15 ? it + 1 : it;
#pragma unroll
          for (int q = 0; q < 2; ++q) load_row_bf16(xin + (size_t)(t0 + itn * 16 + 2 * wave + q) * DM, lane, xn[q]); }
#pragma unroll
        for (int q = 0; q < 2; ++q) {
            const int lt = it * 16 + 2 * wave + q, m = t0 + lt; f32x4 v[4], h[4];
#pragma unroll
            for (int j = 0; j < 4; ++j) v[j] = xv[q][j];
            norm_mod_apply(v, nA, nB, h);
            const float hsv = quant_row_store(h, H8 + (size_t)m * DM, HS + m, lane); if (lane == 0) selH[lt] = hsv;
#pragma unroll
            for (int j = 0; j < 4; ++j) { const unsigned w01 = pk2(h[j][0], h[j][1]), w23 = pk2(h[j][2], h[j][3]);
                const int off = (2 * wave + q) * HROW + (256 * j + 4 * lane) * 2;
                *(LAS u32x2*)(hhi + off) = (u32x2){w01, w23};
                *(LAS u32x2*)(hlo + off) = (u32x2){pk2(h[j][0] - bflo(w01), h[j][1] - bfhi(w01)), pk2(h[j][2] - bflo(w23), h[j][3] - bfhi(w23))}; }
        }
        __syncthreads();
        f32x4 acc0 = {0.f, 0.f, 0.f, 0.f}, acc1 = {0.f, 0.f, 0.f, 0.f};
#pragma unroll
        for (int s4 = 0; s4 < 4; ++s4) { const int off = fr * HROW + (128 * wave + 32 * s4 + 8 * fq) * 2;
            const bf16x8 ah = *(const LAS bf16x8*)(hhi + off), al = *(const LAS bf16x8*)(hlo + off);
            acc0 = __builtin_amdgcn_mfma_f32_16x16x32_bf16(ah, bhi[s4][0], acc0, 0, 0, 0); acc1 = __builtin_amdgcn_mfma_f32_16x16x32_bf16(ah, bhi[s4][1], acc1, 0, 0, 0);
            acc0 = __builtin_amdgcn_mfma_f32_16x16x32_bf16(al, bhi[s4][0], acc0, 0, 0, 0); acc1 = __builtin_amdgcn_mfma_f32_16x16x32_bf16(al, bhi[s4][1], acc1, 0, 0, 0);
            acc0 = __builtin_amdgcn_mfma_f32_16x16x32_bf16(ah, blo[s4][0], acc0, 0, 0, 0); acc1 = __builtin_amdgcn_mfma_f32_16x16x32_bf16(ah, blo[s4][1], acc1, 0, 0, 0); }
#pragma unroll
        for (int i = 0; i < 4; ++i) { part[(wave * 16 + 4 * fq + i) * 32 + fr] = acc0[i]; part[(wave * 16 + 4 * fq + i) * 32 + 16 + fr] = acc1[i]; }
        __syncthreads();
        const int lt = it * 16 + 2 * wave + half;
        float logit = rbias;
#pragma unroll
        for (int w8 = 0; w8 < 8; ++w8) logit += part[(w8 * 16 + 2 * wave + half) * 32 + l32];
        float tv[4]; int te[4]; float cur = logit;
#pragma unroll
        for (int k = 0; k < 4; ++k) { const float mx = half_max32(cur);
            const unsigned long long bal = __ballot(cur == mx); const unsigned mine = half ? (unsigned)(bal >> 32) : (unsigned)bal;
            const int e = __ffs(mine) - 1; tv[k] = mx; te[k] = e; if (l32 == e) cur = -INFINITY; }
        const float p1 = __expf(tv[1] - tv[0]), p2 = __expf(tv[2] - tv[0]), p3 = __expf(tv[3] - tv[0]); const float inv = 1.0f / (1.0f + p1 + p2 + p3);
        if (l32 < 4) { const int k = l32; const int e = k == 0 ? te[0] : k == 1 ? te[1] : k == 2 ? te[2] : te[3]; const float gk = (k == 0 ? 1.0f : k == 1 ? p1 : k == 2 ? p2 : p3) * inv;
            const int rank = __hip_atomic_fetch_add(cntL + e, 1, __ATOMIC_RELAXED, __HIP_MEMORY_SCOPE_WORKGROUP);
            const int si = lt * 4 + k; selE[si] = e; selR[si] = rank; selG[si] = gk; }
#pragma unroll
        for (int q = 0; q < 2; ++q)
#pragma unroll
            for (int j = 0; j < 4; ++j) xv[q][j] = xn[q][j];
    }
    __syncthreads();
    if (X.tid < NE) baseL[X.tid] = (int)__hip_atomic_fetch_add(gcnt + X.tid, (unsigned)cntL[X.tid], __ATOMIC_RELAXED, __HIP_MEMORY_SCOPE_AGENT);
    __syncthreads();
    for (int si = X.tid; si < 256 * 4; si += NTHREADS) { const int e = selE[si], p = baseL[e] + selR[si], m = t0 + (si >> 2);
        tok_e[(size_t)m * 4 + (si & 3)] = e; tok_p[(size_t)m * 4 + (si & 3)] = p; list[(size_t)e * ECAP + p] = m; gate_e[(size_t)e * ECAP + p] = selG[si]; hs_e[(size_t)e * ECAP + p] = selH[si >> 2]; }
    __syncthreads();
}

__device__ __forceinline__ void phase_sb_naive(const Ctx& X, const bf16* QKV, bf16* O) {
    for (int item = blockIdx.x; item < NB * NH * 4; item += X.G) {
        const int b = item >> 6, h = (item >> 2) & 15, t = (item & 3) * 512 + X.tid;
        const GAS u32x4* qp = (const GAS u32x4*)(QKV + ((size_t)(b * SEQ + t)) * NQKV + h * HD);
        float q[64], o[64];
#pragma unroll
        for (int i = 0; i < 8; ++i) { const u32x4 w = qp[i]; q[8 * i] = bflo(w.x); q[8 * i + 1] = bfhi(w.x); q[8 * i + 2] = bflo(w.y); q[8 * i + 3] = bfhi(w.y); q[8 * i + 4] = bflo(w.z); q[8 * i + 5] = bfhi(w.z); q[8 * i + 6] = bflo(w.w); q[8 * i + 7] = bfhi(w.w); }
#pragma unroll
        for (int d = 0; d < 64; ++d) o[d] = 0.f;
        float L = 0.f;
        for (int s = t - 1; s >= 0; --s) {
            const GAS u32x4* kp = (const GAS u32x4*)(QKV + ((size_t)(b * SEQ + s)) * NQKV + DM + h * HD);
            float z = 0.f;
#pragma unroll
            for (int i = 0; i < 8; ++i) { const u32x4 w = kp[i]; z += q[8 * i] * bflo(w.x) + q[8 * i + 1] * bfhi(w.x) + q[8 * i + 2] * bflo(w.y) + q[8 * i + 3] * bfhi(w.y) + q[8 * i + 4] * bflo(w.z) + q[8 * i + 5] * bfhi(w.z) + q[8 * i + 6] * bflo(w.w) + q[8 * i + 7] * bfhi(w.w); }
            const float sp = fmaxf(z, 0.f) + __builtin_amdgcn_logf(1.0f + __builtin_amdgcn_exp2f(-fabsf(z)));
            const float a = __builtin_amdgcn_exp2f(z - sp + L);
            const GAS u32x4* vp = kp + (DM * 2 / 16);
#pragma unroll
            for (int i = 0; i < 8; ++i) { const u32x4 w = vp[i]; o[8 * i] += a * bflo(w.x); o[8 * i + 1] += a * bfhi(w.x); o[8 * i + 2] += a * bflo(w.y); o[8 * i + 3] += a * bfhi(w.y); o[8 * i + 4] += a * bflo(w.z); o[8 * i + 5] += a * bfhi(w.z); o[8 * i + 6] += a * bflo(w.w); o[8 * i + 7] += a * bfhi(w.w); }
            L -= sp;
            if (L < -160.f) break;
        }
        GAS u32x4* op = (GAS u32x4*)(O + ((size_t)(b * SEQ + t)) * DM + h * HD);
#pragma unroll
        for (int i = 0; i < 8; ++i) op[i] = (u32x4){pk2(o[8 * i], o[8 * i + 1]), pk2(o[8 * i + 2], o[8 * i + 3]), pk2(o[8 * i + 4], o[8 * i + 5]), pk2(o[8 * i + 6], o[8 * i + 7])};
    }
}

__device__ __forceinline__ void ld16(const bf16* p, float (&x)[16]) {
    const GAS u32x4* q = (const GAS u32x4*)p; const u32x4 a = q[0], b = q[1];
    x[0] = bflo(a.x); x[1] = bfhi(a.x); x[2] = bflo(a.y); x[3] = bfhi(a.y); x[4] = bflo(a.z); x[5] = bfhi(a.z); x[6] = bflo(a.w); x[7] = bfhi(a.w);
    x[8] = bflo(b.x); x[9] = bfhi(b.x); x[10] = bflo(b.y); x[11] = bfhi(b.y); x[12] = bflo(b.z); x[13] = bfhi(b.z); x[14] = bflo(b.w); x[15] = bfhi(b.w);
}
__device__ __forceinline__ void st16(bf16* p, const float (&x)[16]) {
    GAS u32x4* q = (GAS u32x4*)p;
    q[0] = (u32x4){pk2(x[0], x[1]), pk2(x[2], x[3]), pk2(x[4], x[5]), pk2(x[6], x[7])}; q[1] = (u32x4){pk2(x[8], x[9]), pk2(x[10], x[11]), pk2(x[12], x[13]), pk2(x[14], x[15])};
}
__device__ __forceinline__ void up16(const u32x4 a, const u32x4 b, float (&x)[16]) {
    x[0] = bflo(a.x); x[1] = bfhi(a.x); x[2] = bflo(a.y); x[3] = bfhi(a.y); x[4] = bflo(a.z); x[5] = bfhi(a.z); x[6] = bflo(a.w); x[7] = bfhi(a.w);
    x[8] = bflo(b.x); x[9] = bfhi(b.x); x[10] = bflo(b.y); x[11] = bfhi(b.y); x[12] = bflo(b.z); x[13] = bfhi(b.z); x[14] = bflo(b.w); x[15] = bfhi(b.w);
}
struct PostRaw { u32x4 q0, q1, k0, k1, i0, i1; unsigned wi; int pos; };
__device__ __forceinline__ PostRaw post_load(const bf16* P, const int* positions, int m, int lane) {
    PostRaw r; const GAS u32x4* pr = (const GAS u32x4*)(P + (size_t)m * NPROJ);
    r.q0 = pr[2 * lane]; r.q1 = pr[2 * lane + 1];
    const int lk = lane & 15; r.k0 = pr[128 + 2 * lk]; r.k1 = pr[128 + 2 * lk + 1];
    const int li = lane < 36 ? lane : 35; r.i0 = pr[160 + 2 * li]; r.i1 = pr[160 + 2 * li + 1];
    r.wi = (unsigned)P[(size_t)m * NPROJ + 1856 + (lane & 7)]; r.pos = positions[m];
    return r;
}
__device__ __forceinline__ void phase_dsa_post(const Ctx& X, const bf16* P, const int* positions, const float* qgain, const float* kgain, bf16* Q1, bf16* K1, bf16* V1, bf16* QI, bf16* KI, float* WI, float* QN, unsigned* kmax_bits) {
    const int l4 = X.lane & 3;
    float gq[16], gk[16];
#pragma unroll
    for (int i = 0; i < 16; ++i) { gq[i] = qgain[l4 * 16 + i]; gk[i] = kgain[l4 * 16 + i]; }
    const float inv_i = expf(-logf(500000.0f) * (2.0f * (float)(X.lane & 7) / 16.0f));
    const int per = NTOK / X.NGW, m0 = X.gw * per;
    float kmx = 0.f, qmx = 0.f;
    PostRaw cur = post_load(P, positions, m0, X.lane);
    for (int m = m0; m < m0 + per; ++m) {
        const int mn = (m + 1 < m0 + per) ? m + 1 : m;
        const PostRaw nxt = post_load(P, positions, mn, X.lane);
        float cs = 1.f, sn = 0.f;
        sincosf((float)cur.pos * inv_i, &sn, &cs);
        float cz[8], sz[8];
#pragma unroll
        for (int i = 0; i < 8; ++i) { cz[i] = __shfl(cs, i); sz[i] = __shfl(sn, i); }
        float x[16];
        up16(cur.q0, cur.q1, x);
        { float ss = 0.f;
#pragma unroll
          for (int i = 0; i < 16; ++i) ss += x[i] * x[i];
          ss += __shfl_xor(ss, 1); ss += __shfl_xor(ss, 2);
          const float r = 1.0f / sqrtf(ss * (1.0f / 64.0f) + EPS);
#pragma unroll
          for (int i = 0; i < 16; ++i) x[i] = x[i] * r * gq[i];
          if (l4 == 0) {
#pragma unroll
              for (int i = 0; i < 8; ++i) { const float a = x[i], b2 = x[i + 8]; x[i] = a * cz[i] - b2 * sz[i]; x[i + 8] = b2 * cz[i] + a * sz[i]; } }
          float n2 = 0.f;
#pragma unroll
          for (int i = 0; i < 16; ++i) { x[i] *= QSCALE; n2 += x[i] * x[i]; }
#pragma unroll
          for (int o = 1; o < 4; o <<= 1) n2 += __shfl_xor(n2, o);
#pragma unroll
          for (int o = 4; o < 64; o <<= 1) n2 = fmaxf(n2, __shfl_xor(n2, o));
          qmx = fmaxf(qmx, n2);
          if (X.lane == 0) QN[m] = sqrtf(n2) * 1.01f;
          st16(Q1 + (size_t)m * DM + X.lane * 16, x); }
        { up16(cur.k0, cur.k1, x);
          float ss = 0.f;
#pragma unroll
          for (int i = 0; i < 16; ++i) ss += x[i] * x[i];
          ss += __shfl_xor(ss, 1); ss += __shfl_xor(ss, 2);
          if (X.lane < 8) { const float r = 1.0f / sqrtf(ss * (1.0f / 64.0f) + EPS);
#pragma unroll
              for (int i = 0; i < 16; ++i) x[i] = x[i] * r * gk[i];
              if (l4 == 0) {
#pragma unroll
                  for (int i = 0; i < 8; ++i) { const float a = x[i], b2 = x[i + 8]; x[i] = a * cz[i] - b2 * sz[i]; x[i + 8] = b2 * cz[i] + a * sz[i]; } }
              st16(K1 + (size_t)m * 128 + X.lane * 16, x);
          } else if (X.lane < 16) st16(V1 + (size_t)m * 128 + (X.lane - 8) * 16, x);
          float k2 = 0.f;
#pragma unroll
          for (int i = 0; i < 16; ++i) k2 += x[i] * x[i];
          k2 += __shfl_xor(k2, 1); k2 += __shfl_xor(k2, 2); k2 = fmaxf(k2, __shfl_xor(k2, 4));
          kmx = fmaxf(kmx, k2); }
        if (X.lane < 36) { up16(cur.i0, cur.i1, x);
            if (l4 == 0) {
#pragma unroll
                for (int i = 0; i < 8; ++i) { const float a = x[i], b2 = x[i + 8]; x[i] = a * cz[i] - b2 * sz[i]; x[i + 8] = b2 * cz[i] + a * sz[i]; } }
            if (X.lane < 32) st16(QI + (size_t)m * 512 + X.lane * 16, x); else st16(KI + (size_t)m * 64 + (X.lane - 32) * 16, x); }
        if (X.lane < 8) WI[(size_t)m * 8 + X.lane] = bflo(cur.wi) * (0.35355339059327373f * 0.125f);
        cur = nxt;
    }
    if (X.lane == 0) { atomicMax(kmax_bits + (m0 >> 11), __float_as_uint(sqrtf(kmx) * 1.01f)); atomicMax(kmax_bits + 32 + (m0 >> 11), __float_as_uint(sqrtf(qmx) * 1.01f)); }
}
__device__ __forceinline__ void phase_dsa_post2(const Ctx& X, const bf16* P, const int* positions, const float* kgain, bf16* K1, bf16* V1, bf16* KI, float* WI, float* ROPE) {
    const int l16 = X.lane & 15, grp = X.lane >> 4, l4 = X.lane & 3, gbase = X.lane & 48;
    float gk[16];
#pragma unroll
    for (int i = 0; i < 16; ++i) gk[i] = kgain[l4 * 16 + i];
    const float inv_i = expf(-logf(500000.0f) * (2.0f * (float)(l16 & 7) / 16.0f));
    const int per = NTOK / X.NGW, m0 = X.gw * per;
    for (int mm = m0; mm < m0 + per; mm += 4) {
        const int m = mm + grp;
        const GAS u32x4* pr = (const GAS u32x4*)(P + (size_t)m * NPROJ);
        const u32x4 k0 = pr[128 + 2 * l16], k1 = pr[128 + 2 * l16 + 1];
        const int li = l16 & 3; const u32x4 i0 = pr[224 + 2 * li], i1 = pr[224 + 2 * li + 1];
        const unsigned wiw = (unsigned)P[(size_t)m * NPROJ + 1856 + (l16 & 7)];
        float sn, cs; sincosf((float)positions[m] * inv_i, &sn, &cs);
        ROPE[(size_t)m * 16 + l16] = (l16 & 8) ? sn : cs;
        float cz[8], sz[8];
#pragma unroll
        for (int i = 0; i < 8; ++i) { cz[i] = __shfl(cs, gbase + i); sz[i] = __shfl(sn, gbase + i); }
        float x[16];
        up16(k0, k1, x);
        float ss = 0.f;
#pragma unroll
        for (int i = 0; i < 16; ++i) ss += x[i] * x[i];
        ss = quad_sum(ss);
        if (l16 < 8) { const float r = 1.0f / sqrtf(ss * (1.0f / 64.0f) + EPS);
#pragma unroll
            for (int i = 0; i < 16; ++i) x[i] = x[i] * r * gk[i];
            if (l4 == 0) {
#pragma unroll
                for (int i = 0; i < 8; ++i) { const float a = x[i], b2 = x[i + 8]; x[i] = a * cz[i] - b2 * sz[i]; x[i + 8] = b2 * cz[i] + a * sz[i]; } }
            st16(K1 + (size_t)m * 128 + l16 * 16, x);
        } else st16(V1 + (size_t)m * 128 + (l16 - 8) * 16, x);
        if (l16 < 4) { up16(i0, i1, x);
            if (l16 == 0) {
#pragma unroll
                for (int i = 0; i < 8; ++i) { const float a = x[i], b2 = x[i + 8]; x[i] = a * cz[i] - b2 * sz[i]; x[i + 8] = b2 * cz[i] + a * sz[i]; } }
            st16(KI + (size_t)m * 64 + l16 * 16, x); }
        if (l16 < 8) WI[(size_t)m * 8 + l16] = bflo(wiw) * (0.35355339059327373f * 0.125f);
    }
}
__device__ __forceinline__ void phase_idx_naive(const Ctx& X, const bf16* QI, const bf16* KI, const float* WI, float* SC) {
    LAS float* qs = (LAS float*)X.lds;
    const int ntb = NTOK / X.G;
    for (int i = 0; i < ntb; ++i) {
        const int m = blockIdx.x * ntb + i, b = m >> 11, t = m & 2047, nadm = 64 * ((t >> 6) + 1);
        __syncthreads();
        qs[X.tid] = bflo((unsigned)QI[(size_t)m * 512 + X.tid]); if (X.tid < 8) qs[512 + X.tid] = WI[(size_t)m * 8 + X.tid];
        __syncthreads();
        for (int s = X.tid; s < nadm; s += NTHREADS) {
            const GAS u32x4* kp = (const GAS u32x4*)(KI + ((size_t)(b * SEQ + s)) * 64); float k[64];
#pragma unroll
            for (int j = 0; j < 8; ++j) { const u32x4 w = kp[j]; k[8 * j] = bflo(w.x); k[8 * j + 1] = bfhi(w.x); k[8 * j + 2] = bflo(w.y); k[8 * j + 3] = bfhi(w.y); k[8 * j + 4] = bflo(w.z); k[8 * j + 5] = bfhi(w.z); k[8 * j + 6] = bflo(w.w); k[8 * j + 7] = bfhi(w.w); }
            float sc = 0.f;
#pragma unroll 1
            for (int hh = 0; hh < 8; ++hh) { float d = 0.f; asm volatile("" ::: "memory");
#pragma unroll
                for (int j = 0; j < 16; ++j) { const f32x4 q4 = ((const LAS f32x4*)(qs + hh * 64))[j]; d += (q4[0] * k[4 * j] + q4[1] * k[4 * j + 1]) + (q4[2] * k[4 * j + 2] + q4[3] * k[4 * j + 3]); }
                sc += qs[512 + hh] * fmaxf(d, 0.f); }
            SC[(size_t)m * SEQ + s] = sc;
        }
    }
}
__device__ __forceinline__ unsigned ord_key(float x) { const unsigned u = __float_as_uint(x); return (u & 0x80000000u) ? ~u : (u | 0x80000000u); }
__device__ __forceinline__ int wave_count_sum(unsigned v) {
    int t = 0;
#pragma unroll
    for (int b = 0; b < 6; ++b) t += __popcll(__ballot((v >> b) & 1u)) << b;
    return t;
}
template <int NR>
__device__ __forceinline__ void topk_select_nr(const unsigned (&key)[32], int c, unsigned long long* maskrow, int lane) {
    unsigned long long mine = ~0ull;
    if (c >= 4) {
        unsigned T = 0u;
        for (int bit = 31; bit >= 0; --bit) { const unsigned cand = T | (1u << bit); unsigned cl = 0u;
#pragma unroll
            for (int m = 0; m < NR; ++m) cl += (key[m] >= cand) ? 1u : 0u;
            const int cnt = wave_count_sum(cl);
            if (cnt >= 256) { T = cand; if (cnt == 256) break; } }
        unsigned gl = 0u;
#pragma unroll
        for (int m = 0; m < NR; ++m) gl += (key[m] > T) ? 1u : 0u;
        const int gt = wave_count_sum(gl);
        int need = 256 - gt;
        {
#pragma unroll
        for (int m = 0; m < NR; ++m) {
            unsigned long long eq = __ballot(key[m] == T); const unsigned long long g = __ballot(key[m] > T);
            int pe = __popcll(eq);
            while (pe > need) { eq &= ~(1ull << (63 - __clzll(eq))); --pe; }
            need -= pe;
            if (lane == m) mine = g | eq; }
        }
    }
    if (lane <= c) maskrow[lane] = mine;
}
__device__ __forceinline__ void topk_select_store(const unsigned (&key)[32], int c, unsigned long long* maskrow, int lane) {
    if (c < 8) topk_select_nr<8>(key, c, maskrow, lane); else if (c < 16) topk_select_nr<16>(key, c, maskrow, lane); else if (c < 24) topk_select_nr<24>(key, c, maskrow, lane); else topk_select_nr<32>(key, c, maskrow, lane);
}
__device__ __forceinline__ void phase_topk_naive(const Ctx& X, const float* SC, unsigned long long* MASK) {
    for (int m = X.gw; m < NTOK; m += X.NGW) {
        const int c = (m & 2047) >> 6; unsigned key[32];
#pragma unroll
        for (int j = 0; j < 32; ++j) key[j] = (j <= c) ? ord_key(SC[(size_t)m * SEQ + j * 64 + X.lane]) : 0u;
        topk_select_store(key, c, MASK + (size_t)m * 32, X.lane);
    }
}
__device__ __forceinline__ void phase_sparse_naive(const Ctx& X, const bf16* Q1, const bf16* K1, const bf16* V1, const unsigned long long* MASK, bf16* O) {
    for (int item = blockIdx.x; item < NTOK / 32; item += X.G) {
        const int m = item * 32 + (X.tid >> 4), h = X.tid & 15, g = h >> 3, b = m >> 11, c = (m & 2047) >> 6;
        const GAS u32x4* qp = (const GAS u32x4*)(Q1 + (size_t)m * DM + h * HD);
        float q[64], o[64];
#pragma unroll
        for (int i = 0; i < 8; ++i) { const u32x4 w = qp[i]; q[8 * i] = bflo(w.x); q[8 * i + 1] = bfhi(w.x); q[8 * i + 2] = bflo(w.y); q[8 * i + 3] = bfhi(w.y); q[8 * i + 4] = bflo(w.z); q[8 * i + 5] = bfhi(w.z); q[8 * i + 6] = bflo(w.w); q[8 * i + 7] = bfhi(w.w); }
#pragma unroll
        for (int d = 0; d < 64; ++d) o[d] = 0.f;
        float mx = -1e30f, l = 0.f;
        for (int j = 0; j <= c; ++j) {
            unsigned long long bits = MASK[(size_t)m * 32 + j];
            while (bits) { const int s = j * 64 + __ffsll((long long)bits) - 1; bits &= bits - 1;
                const GAS u32x4* kp = (const GAS u32x4*)(K1 + ((size_t)(b * SEQ + s)) * 128 + g * HD); float z = 0.f;
#pragma unroll
                for (int i = 0; i < 8; ++i) { const u32x4 w = kp[i]; z += q[8 * i] * bflo(w.x) + q[8 * i + 1] * bfhi(w.x) + q[8 * i + 2] * bflo(w.y) + q[8 * i + 3] * bfhi(w.y) + q[8 * i + 4] * bflo(w.z) + q[8 * i + 5] * bfhi(w.z) + q[8 * i + 6] * bflo(w.w) + q[8 * i + 7] * bfhi(w.w); }
                const float mn = fmaxf(mx, z), f = __builtin_amdgcn_exp2f(mx - mn), p = __builtin_amdgcn_exp2f(z - mn); mx = mn; l = l * f + p;
                const GAS u32x4* vp = (const GAS u32x4*)(V1 + ((size_t)(b * SEQ + s)) * 128 + g * HD);
#pragma unroll
                for (int i = 0; i < 8; ++i) { const u32x4 w = vp[i]; o[8 * i] = o[8 * i] * f + p * bflo(w.x); o[8 * i + 1] = o[8 * i + 1] * f + p * bfhi(w.x); o[8 * i + 2] = o[8 * i + 2] * f + p * bflo(w.y); o[8 * i + 3] = o[8 * i + 3] * f + p * bfhi(w.y);
                    o[8 * i + 4] = o[8 * i + 4] * f + p * bflo(w.z); o[8 * i + 5] = o[8 * i + 5] * f + p * bfhi(w.z); o[8 * i + 6] = o[8 * i + 6] * f + p * bflo(w.w); o[8 * i + 7] = o[8 * i + 7] * f + p * bfhi(w.w); }
            }
        }
        const float il = 1.0f / l;
        GAS u32x4* op = (GAS u32x4*)(O + (size_t)m * DM + h * HD);
#pragma unroll
        for (int i = 0; i < 8; ++i) op[i] = (u32x4){pk2(o[8 * i] * il, o[8 * i + 1] * il), pk2(o[8 * i + 2] * il, o[8 * i + 3] * il), pk2(o[8 * i + 4] * il, o[8 * i + 5] * il), pk2(o[8 * i + 6] * il, o[8 * i + 7] * il)};
    }
}


typedef float f32x16 __attribute__((ext_vector_type(16)));
typedef short v4i16_t __attribute__((ext_vector_type(4)));
__device__ __forceinline__ int crow16(int r, int hi) { return (r & 3) + 8 * (r >> 2) + 4 * hi; }
__device__ __forceinline__ float half_sum(float v) { const auto rr = __builtin_amdgcn_permlane32_swap(__float_as_uint(v), __float_as_uint(v), false, false); return __uint_as_float(rr[0]) + __uint_as_float(rr[1]); }
__device__ __forceinline__ float half_max(float v) { const auto rr = __builtin_amdgcn_permlane32_swap(__float_as_uint(v), __float_as_uint(v), false, false); return fmaxf(__uint_as_float(rr[0]), __uint_as_float(rr[1])); }
__device__ __forceinline__ float qk_bound(const float* qgain, const float* kgain, int lane) {
    float a = fabsf(qgain[lane]), b = fabsf(kgain[lane]);
    a = wave_max(a); b = wave_max(b);
    return 64.0f * a * b * QSCALE * 1.02f;
}
__device__ __forceinline__ void rope_frag0(float (&x)[8], const f32x4 (&cs)[2], const f32x4 (&sn)[2], int hi) {
#pragma unroll
    for (int j = 0; j < 8; ++j) { const auto rr = __builtin_amdgcn_permlane32_swap(__float_as_uint(x[j]), __float_as_uint(x[j]), false, false);
        const float p = __uint_as_float(hi ? rr[0] : rr[1]); const float c = cs[j >> 2][j & 3], s_ = sn[j >> 2][j & 3];
        x[j] = hi ? (x[j] * c + p * s_) : (x[j] * c - p * s_); }
}
__device__ __forceinline__ void unpack8(const u32x4 w, float (&x)[8]) { x[0] = bflo(w.x); x[1] = bfhi(w.x); x[2] = bflo(w.y); x[3] = bfhi(w.y); x[4] = bflo(w.z); x[5] = bfhi(w.z); x[6] = bflo(w.w); x[7] = bfhi(w.w); }
__device__ __forceinline__ bf16x8 packf8(const float (&x)[8]) { u32x4 w; w.x = pg8::cvt_pk_bf16(x[0], x[1]); w.y = pg8::cvt_pk_bf16(x[2], x[3]); w.z = pg8::cvt_pk_bf16(x[4], x[5]); w.w = pg8::cvt_pk_bf16(x[6], x[7]); return __builtin_bit_cast(bf16x8, w); }
struct RawFr { u32x4 w[4]; };
__device__ __forceinline__ RawFr raw_frags(const bf16* prow, int hi) { RawFr r;
#pragma unroll
    for (int d0 = 0; d0 < 4; ++d0) r.w[d0] = *(const GAS u32x4*)(prow + 16 * d0 + 8 * hi);
    return r; }
__device__ __forceinline__ void q_frags_from_raw(const RawFr& raw, const float* gq, const f32x4 (&cs)[2], const f32x4 (&sn)[2], int hi, bf16x8 (&qf)[4]) {
    float x[4][8]; float ss = 0.f;
#pragma unroll
    for (int d0 = 0; d0 < 4; ++d0) { unpack8(raw.w[d0], x[d0]);
#pragma unroll
        for (int j = 0; j < 8; ++j) ss += x[d0][j] * x[d0][j]; }
    ss = half_sum(ss);
    const float r = QSCALE / sqrtf(ss * (1.0f / 64.0f) + EPS);
#pragma unroll
    for (int d0 = 0; d0 < 4; ++d0) { const f32x4 g0 = *(const GAS f32x4*)(gq + 16 * d0 + 8 * hi), g1 = *(const GAS f32x4*)(gq + 16 * d0 + 8 * hi + 4);
#pragma unroll
        for (int j = 0; j < 4; ++j) { x[d0][j] *= r * g0[j]; x[d0][4 + j] *= r * g1[j]; } }
    rope_frag0(x[0], cs, sn, hi);
#pragma unroll
    for (int d0 = 0; d0 < 4; ++d0) qf[d0] = packf8(x[d0]);
}
__device__ __forceinline__ void load_q_frags(const bf16* prow, const float* gq, const f32x4 (&cs)[2], const f32x4 (&sn)[2], int hi, bf16x8 (&qf)[4]) { const RawFr raw = raw_frags(prow, hi); q_frags_from_raw(raw, gq, cs, sn, hi, qf); }
__device__ __forceinline__ void qi_frags_from_raw(const RawFr& raw, const f32x4 (&cs)[2], const f32x4 (&sn)[2], int hi, bf16x8 (&qf)[4]) {
    float x0[8]; unpack8(raw.w[0], x0);
    rope_frag0(x0, cs, sn, hi);
    qf[0] = packf8(x0);
#pragma unroll
    for (int d0 = 1; d0 < 4; ++d0) qf[d0] = __builtin_bit_cast(bf16x8, raw.w[d0]);
}
__device__ __forceinline__ bf16x8 pack8(const f32x16& v, int s) {
    u32x4 w; w.x = pg8::cvt_pk_bf16(v[8 * s + 0], v[8 * s + 1]); w.y = pg8::cvt_pk_bf16(v[8 * s + 2], v[8 * s + 3]); w.z = pg8::cvt_pk_bf16(v[8 * s + 4], v[8 * s + 5]); w.w = pg8::cvt_pk_bf16(v[8 * s + 6], v[8 * s + 7]);
    return __builtin_bit_cast(bf16x8, w);
}
__device__ __forceinline__ void vtile_write(LAS unsigned char* vl, const u32x4 (&vr)[4], int lane) {
#pragma unroll
    for (int i = 0; i < 4; ++i) *(LAS u32x4*)(vl + (i * 2 + ((lane & 7) >> 2)) * 512 + (lane >> 3) * 64 + (lane & 3) * 16) = vr[i];
}
__device__ __forceinline__ bf16x8 vtile_frag(const LAS unsigned char* vl, int trbase, int s, int d0) {
    const v4i16_t lo = __builtin_amdgcn_ds_read_tr16_b64_v4i16((LAS v4i16_t*)(vl + trbase + ((2 * s + 0) * 2 + d0) * 512));
    const v4i16_t hi = __builtin_amdgcn_ds_read_tr16_b64_v4i16((LAS v4i16_t*)(vl + trbase + ((2 * s + 1) * 2 + d0) * 512));
    return (bf16x8){lo[0], lo[1], lo[2], lo[3], hi[0], hi[1], hi[2], hi[3]};
}
__device__ __forceinline__ void store_ot(bf16* orow, const f32x16& o0, const f32x16& o1, float sc, int hi) {
#pragma unroll
    for (int rg = 0; rg < 4; ++rg) {
        *(GAS u32x2*)(orow + 8 * rg + 4 * hi) = (u32x2){pg8::cvt_pk_bf16(o0[4 * rg] * sc, o0[4 * rg + 1] * sc), pg8::cvt_pk_bf16(o0[4 * rg + 2] * sc, o0[4 * rg + 3] * sc)};
        *(GAS u32x2*)(orow + 32 + 8 * rg + 4 * hi) = (u32x2){pg8::cvt_pk_bf16(o1[4 * rg] * sc, o1[4 * rg + 1] * sc), pg8::cvt_pk_bf16(o1[4 * rg + 2] * sc, o1[4 * rg + 3] * sc)};
    }
}

__device__ __forceinline__ void phase_sb_fast(const Ctx& X, const bf16* QKV, bf16* O) {
    const int lane = X.lane, r32 = lane & 31, hi = lane >> 5;
    LAS unsigned char* vl = X.lds + X.wave * 4096;
    const int trbase = (4 * hi + ((lane & 15) >> 2)) * 64 + (16 * ((lane >> 4) & 1) + 4 * (lane & 3)) * 2;
    bf16x8 uf[2];
#pragma unroll
    for (int s = 0; s < 2; ++s)
#pragma unroll
        for (int j = 0; j < 8; ++j) uf[s][j] = ((16 * s + 8 * (j >> 2) + 4 * hi + (j & 3)) > r32) ? (short)0x3F80 : (short)0;
    for (int u = X.gw; u < NB * NH * 64; u += X.NGW) {
        const int b = u >> 10, h = (u >> 6) & 15, qb = u & 63, t0 = qb * 32;
        const bf16* base = QKV + (size_t)b * SEQ * NQKV + h * HD;
        bf16x8 qf[4];
#pragma unroll
        for (int d0 = 0; d0 < 4; ++d0) qf[d0] = *(const GAS bf16x8*)(base + (size_t)(t0 + r32) * NQKV + 16 * d0 + 8 * hi);
        f32x16 o0 = {}, o1 = {}; float run = 0.f;
        bf16x8 kf[4], kn[4]; u32x4 vr[4], vn[4];
#pragma unroll
        for (int d0 = 0; d0 < 4; ++d0) kf[d0] = *(const GAS bf16x8*)(base + (size_t)(t0 + r32) * NQKV + DM + 16 * d0 + 8 * hi);
#pragma unroll
        for (int i = 0; i < 4; ++i) vr[i] = *(const GAS u32x4*)(base + (size_t)(t0 + i * 8 + (lane >> 3)) * NQKV + 2 * DM + 8 * (lane & 7));
        for (int kt = qb; kt >= 0; --kt) {
            { const int keyn = (kt > 0 ? kt - 1 : 0) * 32;
#pragma unroll
              for (int d0 = 0; d0 < 4; ++d0) kn[d0] = *(const GAS bf16x8*)(base + (size_t)(keyn + r32) * NQKV + DM + 16 * d0 + 8 * hi);
#pragma unroll
              for (int i = 0; i < 4; ++i) vn[i] = *(const GAS u32x4*)(base + (size_t)(keyn + i * 8 + (lane >> 3)) * NQKV + 2 * DM + 8 * (lane & 7)); }
            asm volatile("" ::: "memory");
            vtile_write(vl, vr, lane);
            f32x16 S = {};
#pragma unroll
            for (int d0 = 0; d0 < 4; ++d0) S = __builtin_amdgcn_mfma_f32_32x32x16_bf16(kf[d0], qf[d0], S, 0, 0, 0);
            const bool diag = (kt == qb);
            f32x16 xm, ls; float cs = 0.f;
#pragma unroll
            for (int r = 0; r < 16; ++r) { const float z = S[r]; const float sp = fmaxf(z, 0.f) + __builtin_amdgcn_logf(1.0f + __builtin_amdgcn_exp2f(-fabsf(z)));
                const bool valid = !diag || (crow16(r, hi) < r32);
                xm[r] = valid ? -sp : 0.f; ls[r] = valid ? z - sp : -INFINITY; cs += xm[r]; }
            cs = half_sum(cs);
            f32x16 T;
#pragma unroll
            for (int r = 0; r < 16; ++r) T[r] = run;
            T = __builtin_amdgcn_mfma_f32_32x32x16_bf16(uf[0], pack8(xm, 0), T, 0, 0, 0);
            T = __builtin_amdgcn_mfma_f32_32x32x16_bf16(uf[1], pack8(xm, 1), T, 0, 0, 0);
            f32x16 a;
#pragma unroll
            for (int r = 0; r < 16; ++r) a[r] = __builtin_amdgcn_exp2f(ls[r] + T[r]);
            const bf16x8 p0 = pack8(a, 0), p1 = pack8(a, 1);
            asm volatile("" ::: "memory");
            o0 = __builtin_amdgcn_mfma_f32_32x32x16_bf16(vtile_frag(vl, trbase, 0, 0), p0, o0, 0, 0, 0);
            o1 = __builtin_amdgcn_mfma_f32_32x32x16_bf16(vtile_frag(vl, trbase, 0, 1), p0, o1, 0, 0, 0);
            o0 = __builtin_amdgcn_mfma_f32_32x32x16_bf16(vtile_frag(vl, trbase, 1, 0), p1, o0, 0, 0, 0);
            o1 = __builtin_amdgcn_mfma_f32_32x32x16_bf16(vtile_frag(vl, trbase, 1, 1), p1, o1, 0, 0, 0);
            asm volatile("" ::: "memory");
            run += cs;
            if (__all(run < -160.f)) break;
#pragma unroll
            for (int d0 = 0; d0 < 4; ++d0) { kf[d0] = kn[d0]; vr[d0] = vn[d0]; }
        }
        store_ot(O + (size_t)(b * SEQ + t0 + r32) * DM + h * HD, o0, o1, 1.0f, hi);
    }
}

__device__ __forceinline__ void phase_sparse_fast(const Ctx& X, const bf16* Q1, const bf16* K1, const bf16* V1, const unsigned* MASK32, bf16* O) {
    const int lane = X.lane, r32 = lane & 31, hi = lane >> 5;
    LAS unsigned char* vl = X.lds + X.wave * 4096;
    const int trbase = (4 * hi + ((lane & 15) >> 2)) * 64 + (16 * ((lane >> 4) & 1) + 4 * (lane & 3)) * 2;
    for (int u = X.gw; u < NB * 64 * NH; u += X.NGW) {
        const int h = u & 15, tb = (u >> 4) & 63, b = u >> 10, g = h >> 3, t0 = tb * 32, ntile = 2 * ((t0 >> 6) + 1);
        const size_t tok = (size_t)b * SEQ + t0 + r32;
        bf16x8 qf[4];
#pragma unroll
        for (int d0 = 0; d0 < 4; ++d0) qf[d0] = *(const GAS bf16x8*)(Q1 + tok * DM + h * HD + 16 * d0 + 8 * hi);
        const bf16* kb = K1 + (size_t)b * SEQ * 128 + g * HD; const bf16* vb = V1 + (size_t)b * SEQ * 128 + g * HD;
        f32x16 o0 = {}, o1 = {}; float mrun = -1e30f, l = 0.f;
        for (int kt = 0; kt < ntile; ++kt) {
            const int key0 = kt * 32;
            bf16x8 kf[4]; u32x4 vr[4];
#pragma unroll
            for (int d0 = 0; d0 < 4; ++d0) kf[d0] = *(const GAS bf16x8*)(kb + (size_t)(key0 + r32) * 128 + 16 * d0 + 8 * hi);
#pragma unroll
            for (int i = 0; i < 4; ++i) vr[i] = *(const GAS u32x4*)(vb + (size_t)(key0 + i * 8 + (lane >> 3)) * 128 + 8 * (lane & 7));
            const unsigned mw = MASK32[tok * 64 + kt] >> (4 * hi);
            asm volatile("" ::: "memory");
            vtile_write(vl, vr, lane);
            f32x16 S = {};
#pragma unroll
            for (int d0 = 0; d0 < 4; ++d0) S = __builtin_amdgcn_mfma_f32_32x32x16_bf16(kf[d0], qf[d0], S, 0, 0, 0);
            float mx = -INFINITY;
#pragma unroll
            for (int r = 0; r < 16; ++r) { const unsigned msk = (unsigned)__builtin_amdgcn_sbfe((int)mw, (r & 3) + 8 * (r >> 2), 1);
                S[r] = __uint_as_float((__float_as_uint(S[r]) & msk) | (0xFF800000u & ~msk)); mx = fmaxf(mx, S[r]); }
            mx = half_max(mx);
            const float mnew = fmaxf(mrun, mx), f = __builtin_amdgcn_exp2f(mrun - mnew); mrun = mnew;
            f32x16 p; float ps = 0.f;
#pragma unroll
            for (int r = 0; r < 16; ++r) { p[r] = __builtin_amdgcn_exp2f(S[r] - mnew); ps += p[r]; }
            l = l * f + ps;
            if (__any(f != 1.0f)) {
#pragma unroll
                for (int r = 0; r < 16; ++r) { o0[r] *= f; o1[r] *= f; } }
            const bf16x8 p0 = pack8(p, 0), p1 = pack8(p, 1);
            asm volatile("" ::: "memory");
            o0 = __builtin_amdgcn_mfma_f32_32x32x16_bf16(vtile_frag(vl, trbase, 0, 0), p0, o0, 0, 0, 0);
            o1 = __builtin_amdgcn_mfma_f32_32x32x16_bf16(vtile_frag(vl, trbase, 0, 1), p0, o1, 0, 0, 0);
            o0 = __builtin_amdgcn_mfma_f32_32x32x16_bf16(vtile_frag(vl, trbase, 1, 0), p1, o0, 0, 0, 0);
            o1 = __builtin_amdgcn_mfma_f32_32x32x16_bf16(vtile_frag(vl, trbase, 1, 1), p1, o1, 0, 0, 0);
            asm volatile("" ::: "memory");
        }
        l = half_sum(l);
        store_ot(O + tok * DM + h * HD, o0, o1, 1.0f / l, hi);
    }
}

__device__ __forceinline__ void phase_idx_topk_fast(const Ctx& X, const bf16* QI, const bf16* KI, const float* WI, unsigned long long* MASK) {
    const int lane = X.lane, r32 = lane & 31, hi = lane >> 5;
    const int tkr = 2 * ((r32 >> 2) & 1) + (r32 >> 4), hdr = (r32 & 3) + 4 * ((r32 >> 3) & 1);
    int round = 0;
    for (int u0 = X.gw; u0 < NTOK / 4; u0 += X.NGW, ++round) {
        const int b = u0 >> 9; int tg = u0 & 511; if (round & 1) tg = 511 - tg;
        const int t0 = tg * 4, c = t0 >> 6; const size_t tok0 = (size_t)b * SEQ + t0;
        bf16x8 qf[4];
#pragma unroll
        for (int d0 = 0; d0 < 4; ++d0) qf[d0] = *(const GAS bf16x8*)(QI + (tok0 + tkr) * 512 + hdr * 64 + 16 * d0 + 8 * hi);
        float w0[8], w1[8];
#pragma unroll
        for (int hh = 0; hh < 8; ++hh) { w0[hh] = WI[(tok0 + 2 * hi) * 8 + hh]; w1[hh] = WI[(tok0 + 2 * hi + 1) * 8 + hh]; }
        unsigned k0[32], k1[32], k2[32], k3[32];
        const bf16* kib = KI + (size_t)b * SEQ * 64;
#pragma unroll
        for (int m = 0; m < 32; ++m) {
            if (m <= c) {
                float sa[2], sb[2];
#pragma unroll
                for (int half = 0; half < 2; ++half) {
                    const int key0 = 64 * m + 32 * half; f32x16 R = {};
#pragma unroll
                    for (int d0 = 0; d0 < 4; ++d0) { const bf16x8 kf = *(const GAS bf16x8*)(kib + (size_t)(key0 + r32) * 64 + 16 * d0 + 8 * hi); R = __builtin_amdgcn_mfma_f32_32x32x16_bf16(qf[d0], kf, R, 0, 0, 0); }
                    float s0 = 0.f, s1 = 0.f;
#pragma unroll
                    for (int hh = 0; hh < 8; ++hh) { s0 += w0[hh] * fmaxf(R[hh], 0.f); s1 += w1[hh] * fmaxf(R[8 + hh], 0.f); }
                    sa[half] = s0; sb[half] = s1;
                }
                const auto ra = __builtin_amdgcn_permlane32_swap(ord_key(sa[0]), ord_key(sa[1]), false, false);
                const auto rb = __builtin_amdgcn_permlane32_swap(ord_key(sb[0]), ord_key(sb[1]), false, false);
                k0[m] = ra[0]; k2[m] = ra[1]; k1[m] = rb[0]; k3[m] = rb[1];
            } else { k0[m] = 0u; k1[m] = 0u; k2[m] = 0u; k3[m] = 0u; }
        }
        topk_select_store(k0, c, MASK + (tok0 + 0) * 32, lane);
        topk_select_store(k1, c, MASK + (tok0 + 1) * 32, lane);
        topk_select_store(k2, c, MASK + (tok0 + 2) * 32, lane);
        topk_select_store(k3, c, MASK + (tok0 + 3) * 32, lane);
    }
}


__device__ __forceinline__ void wait_vm_le(int n) {
    switch (n) { case 0: WAITV(0); break; case 1: WAITV(1); break; case 2: WAITV(2); break; case 3: WAITV(3); break; case 4: WAITV(4); break; case 5: WAITV(5); break; case 6: WAITV(6); break;
                 case 7: WAITV(7); break; case 8: WAITV(8); break; case 9: WAITV(9); break; case 10: WAITV(10); break; case 11: WAITV(11); break; case 12: WAITV(12); break; default: WAITV(12); break; }
}
__device__ __forceinline__ void ktile_dma(LAS unsigned char* slot, const bf16* rows  , int pitch, int tid, int wave) {
    const int key = tid >> 3, cpos = tid & 7, src = cpos ^ ((key >> 1) & 7);
    __builtin_amdgcn_global_load_lds((const GAS unsigned*)(rows + (size_t)key * pitch + src * 8), (LAS unsigned*)(slot + wave * 1024), 16, 0, 0);
}
__device__ __forceinline__ bf16x8 ktile_frag(const LAS unsigned char* slot, int key, int d0, int hi) {
    return *(const LAS bf16x8*)(slot + key * 128 + (((2 * d0 + hi) ^ ((key >> 1) & 7)) << 4));
}
__device__ __forceinline__ void vtile_dma(LAS unsigned char* slot, const bf16* rows, int pitch, int tid, int wave) {
    const int st = tid >> 5, row = (tid & 31) >> 2, ch = tid & 3, key = (st >> 1) * 8 + row, d = (st & 1) * 32 + ch * 8;
    __builtin_amdgcn_global_load_lds((const GAS unsigned*)(rows + (size_t)key * pitch + d), (LAS unsigned*)(slot + wave * 1024), 16, 0, 0);
}

__device__ __forceinline__ void phase_sparse_coop(const Ctx& X, const bf16* PRAW, const float* ROPE, const float* qgain, float Mb, const bf16* K1, const bf16* V1, const unsigned char* MASKB, bf16* O) {
    const int lane = X.lane, r32 = lane & 31, hi = lane >> 5, tid = X.tid, wave = X.wave;
    constexpr int SP_NS = 6, SP_D = 5;
    LAS unsigned char* kring = X.lds; LAS unsigned char* vring = X.lds + SP_NS * 8192; LAS unsigned char* mlds = X.lds + 2 * SP_NS * 8192;
    const int trbase = (4 * hi + ((lane & 15) >> 2)) * 64 + (16 * ((lane >> 4) & 1) + 4 * (lane & 3)) * 2;
    for (int i = 0; i < 16; ++i) {
        const int P = blockIdx.x + 256 * i; if (P >= NB * 2 * 64) break;
        int tb = P & 63; const int g = (P >> 6) & 1, b = P >> 7; if (i & 1) tb = 63 - tb;
        const int t0 = tb * 32, c = t0 >> 6, h = 8 * g + wave;
        const size_t tokb = (size_t)b * SEQ, tok = tokb + t0 + r32;
        const bf16* kb = K1 + tokb * 128 + g * HD; const bf16* vb = V1 + tokb * 128 + g * HD;
        __builtin_amdgcn_global_load_lds((const GAS unsigned*)(MASKB + (tokb + t0 + (tid >> 4)) * 256 + (tid & 15) * 16), (LAS unsigned*)(mlds + wave * 1024), 16, 0, 0);
        bf16x8 qf[4];
        { const GAS f32x4* rp = (const GAS f32x4*)(ROPE + tok * 16); const f32x4 cs[2] = {rp[0], rp[1]}, sn[2] = {rp[2], rp[3]};
          load_q_frags(PRAW + tok * NPROJ + h * HD, qgain, cs, sn, hi, qf); }
#pragma unroll
        for (int p = 0; p < SP_D; ++p) if (p <= c) { ktile_dma(kring + p * 8192, kb + (size_t)p * 64 * 128, 128, tid, wave); vtile_dma(vring + p * 8192, vb + (size_t)p * 64 * 128, 128, tid, wave); }
        f32x16 o0 = {}, o1 = {}; float mrun = -1e30f, l = 0.f;
        const float Mrow = Mb;
        const bool fast = !__any(!(Mrow <= 60.f));
        const float cinit = fast ? -Mrow : 0.f;
#define SP_QK(SA_, SB_, slot_) do { const LAS unsigned char* ks_ = kring + (slot_) * 8192; \
            _Pragma("unroll") for (int r = 0; r < 16; ++r) { SA_[r] = cinit; SB_[r] = cinit; } \
            _Pragma("unroll") for (int d0 = 0; d0 < 4; ++d0) { SA_ = __builtin_amdgcn_mfma_f32_32x32x16_bf16(ktile_frag(ks_, r32, d0, hi), qf[d0], SA_, 0, 0, 0); SB_ = __builtin_amdgcn_mfma_f32_32x32x16_bf16(ktile_frag(ks_, 32 + r32, d0, hi), qf[d0], SB_, 0, 0, 0); } } while (0)
#define SP_PV(C0_, C1_) do { \
            { const bf16x8 pa = pack8(C0_, 0), pb = pack8(C0_, 1); \
              o0 = __builtin_amdgcn_mfma_f32_32x32x16_bf16(vtile_frag(vs, trbase, 0, 0), pa, o0, 0, 0, 0); o1 = __builtin_amdgcn_mfma_f32_32x32x16_bf16(vtile_frag(vs, trbase, 0, 1), pa, o1, 0, 0, 0); \
              o0 = __builtin_amdgcn_mfma_f32_32x32x16_bf16(vtile_frag(vs, trbase, 1, 0), pb, o0, 0, 0, 0); o1 = __builtin_amdgcn_mfma_f32_32x32x16_bf16(vtile_frag(vs, trbase, 1, 1), pb, o1, 0, 0, 0); } \
            { const bf16x8 pc = pack8(C1_, 0), pd = pack8(C1_, 1); \
              o0 = __builtin_amdgcn_mfma_f32_32x32x16_bf16(vtile_frag(vs, trbase, 2, 0), pc, o0, 0, 0, 0); o1 = __builtin_amdgcn_mfma_f32_32x32x16_bf16(vtile_frag(vs, trbase, 2, 1), pc, o1, 0, 0, 0); \
              o0 = __builtin_amdgcn_mfma_f32_32x32x16_bf16(vtile_frag(vs, trbase, 3, 0), pd, o0, 0, 0, 0); o1 = __builtin_amdgcn_mfma_f32_32x32x16_bf16(vtile_frag(vs, trbase, 3, 1), pd, o1, 0, 0, 0); } } while (0)
        if (fast) {
            f32x16 S0, S1, N0, N1;
            { const int ahead = c < (SP_D - 1) ? c : (SP_D - 1); wait_vm_le(2 * ahead); }
            SBAR();
            SP_QK(S0, S1, 0);
            int slot = 0;
#define SP_STEP(C0_, C1_, X0_, X1_, m_) do { const int m = (m_); \
                const int slotn = (slot == SP_NS - 1) ? 0 : slot + 1; \
                { int ahead = (c - m - 1) < (SP_D - 2) ? (c - m - 1) : (SP_D - 2); if (ahead < 0) ahead = 0; wait_vm_le(2 * ahead); } \
                SBAR(); \
                if (m + SP_D <= c) { const int s2 = (slot == 0) ? SP_NS - 1 : slot - 1; ktile_dma(kring + s2 * 8192, kb + (size_t)(m + SP_D) * 64 * 128, 128, tid, wave); vtile_dma(vring + s2 * 8192, vb + (size_t)(m + SP_D) * 64 * 128, 128, tid, wave); } \
                if (m + 1 <= c) SP_QK(X0_, X1_, slotn); \
                const LAS unsigned char* vs = vring + slot * 8192; \
                const u32x2 mw2 = *(const LAS u32x2*)(mlds + r32 * 256 + m * 8); \
                const unsigned mwa = mw2.x >> (4 * hi), mwb = mw2.y >> (4 * hi); \
                float ps = 0.f; \
                _Pragma("unroll") for (int r = 0; r < 16; ++r) { const int pos = (r & 3) + 8 * (r >> 2); \
                    const unsigned ma = (unsigned)__builtin_amdgcn_sbfe((int)mwa, pos, 1), mb = (unsigned)__builtin_amdgcn_sbfe((int)mwb, pos, 1); \
                    C0_[r] = __uint_as_float(__float_as_uint(__builtin_amdgcn_exp2f(C0_[r])) & ma); C1_[r] = __uint_as_float(__float_as_uint(__builtin_amdgcn_exp2f(C1_[r])) & mb); ps += C0_[r] + C1_[r]; } \
                l += ps; \
                SP_PV(C0_, C1_); \
                slot = slotn; } while (0)
            for (int mm = 0; mm <= c; mm += 2) {
                SP_STEP(S0, S1, N0, N1, mm);
                if (mm + 1 <= c) SP_STEP(N0, N1, S0, S1, mm + 1);
            }
#undef SP_STEP
        } else {
            int slot = 0;
            for (int m = 0; m <= c; ++m) {
                { const int ahead = (c - m) < (SP_D - 1) ? (c - m) : (SP_D - 1); wait_vm_le(2 * ahead); }
                SBAR();
                if (m + SP_D <= c) { const int s2 = (slot == 0) ? SP_NS - 1 : slot - 1; ktile_dma(kring + s2 * 8192, kb + (size_t)(m + SP_D) * 64 * 128, 128, tid, wave); vtile_dma(vring + s2 * 8192, vb + (size_t)(m + SP_D) * 64 * 128, 128, tid, wave); }
                const LAS unsigned char* vs = vring + slot * 8192;
                f32x16 S0, S1;
                SP_QK(S0, S1, slot);
                const u32x2 mw2 = *(const LAS u32x2*)(mlds + r32 * 256 + m * 8);
                const unsigned mwa = mw2.x >> (4 * hi), mwb = mw2.y >> (4 * hi);
                float mx = -INFINITY;
#pragma unroll
                for (int r = 0; r < 16; ++r) { const int pos = (r & 3) + 8 * (r >> 2);
                    const unsigned ma = (unsigned)__builtin_amdgcn_sbfe((int)mwa, pos, 1), mb = (unsigned)__builtin_amdgcn_sbfe((int)mwb, pos, 1);
                    S0[r] = __uint_as_float((__float_as_uint(S0[r]) & ma) | (0xFF800000u & ~ma)); S1[r] = __uint_as_float((__float_as_uint(S1[r]) & mb) | (0xFF800000u & ~mb));
                    mx = fmaxf(mx, fmaxf(S0[r], S1[r])); }
                mx = half_max(mx);
                const float mnew = fmaxf(mrun, mx), f = __builtin_amdgcn_exp2f(mrun - mnew); mrun = mnew;
                float ps = 0.f;
#pragma unroll
                for (int r = 0; r < 16; ++r) { S0[r] = __builtin_amdgcn_exp2f(S0[r] - mnew); S1[r] = __builtin_amdgcn_exp2f(S1[r] - mnew); ps += S0[r] + S1[r]; }
                l = l * f + ps;
                if (__any(f != 1.0f)) {
#pragma unroll
                    for (int r = 0; r < 16; ++r) { o0[r] *= f; o1[r] *= f; } }
                SP_PV(S0, S1);
                slot = (slot == SP_NS - 1) ? 0 : slot + 1;
            }
        }
#undef SP_QK
#undef SP_PV
        l = half_sum(l);
        store_ot(O + tok * DM + h * HD, o0, o1, 1.0f / l, hi);
        asm volatile("s_waitcnt lgkmcnt(0)" ::: "memory");
        SBAR();
    }
}


__device__ __forceinline__ void phase_sparse_coop2(const Ctx& X, const bf16* PRAW, const float* ROPE, const float* qgain, float Mb, const bf16* K1, const bf16* V1, const unsigned char* MASKB, bf16* O) {
    const int lane = X.lane, r32 = lane & 31, hi = lane >> 5, tid = X.tid, wave = X.wave, g = wave >> 2, hA = 8 * g + 2 * (wave & 3);
    constexpr int NS = 3, D = 2;
    LAS unsigned char* kring = X.lds; LAS unsigned char* vring = X.lds + NS * 16384; LAS unsigned char* mlds = X.lds + 2 * NS * 16384;
    const int trbase = (4 * hi + ((lane & 15) >> 2)) * 64 + (16 * ((lane >> 4) & 1) + 4 * (lane & 3)) * 2;
    for (int i = 0; i < 8; ++i) {
        const int P = blockIdx.x + 256 * i; if (P >= NB * 64) break;
        int tb = P & 63; const int b = P >> 6; if (i & 1) tb = 63 - tb;
        const int t0 = tb * 32, c = t0 >> 6;
        const size_t tokb = (size_t)b * SEQ, tok = tokb + t0 + r32;
        const bf16* kb0 = K1 + tokb * 128; const bf16* vb0 = V1 + tokb * 128;
#define SP2_DMA(slot_, tile_) do { LAS unsigned char* ks_ = kring + (slot_) * 16384; LAS unsigned char* vs_ = vring + (slot_) * 16384; const size_t ro_ = (size_t)(tile_) * 64 * 128; \
            ktile_dma(ks_, kb0 + ro_, 128, tid, wave); ktile_dma(ks_ + 8192, kb0 + ro_ + HD, 128, tid, wave); vtile_dma(vs_, vb0 + ro_, 128, tid, wave); vtile_dma(vs_ + 8192, vb0 + ro_ + HD, 128, tid, wave); } while (0)
        __builtin_amdgcn_global_load_lds((const GAS unsigned*)(MASKB + (tokb + t0 + (tid >> 4)) * 256 + (tid & 15) * 16), (LAS unsigned*)(mlds + wave * 1024), 16, 0, 0);
        const RawFr rwA = raw_frags(PRAW + tok * NPROJ + hA * HD, hi), rwB = raw_frags(PRAW + tok * NPROJ + (hA + 1) * HD, hi);
        const GAS f32x4* rp = (const GAS f32x4*)(ROPE + tok * 16); const f32x4 cs[2] = {rp[0], rp[1]}, sn[2] = {rp[2], rp[3]};
        asm volatile("" ::: "memory");
#pragma unroll
        for (int p = 0; p < D; ++p) if (p <= c) SP2_DMA(p, p);
        asm volatile("" ::: "memory");
        bf16x8 qa[4], qb[4];
        q_frags_from_raw(rwA, qgain, cs, sn, hi, qa); q_frags_from_raw(rwB, qgain, cs, sn, hi, qb);
        f32x16 a0 = {}, a1 = {}, b0 = {}, b1 = {}; float lA = 0.f, lB = 0.f;
        const float cinit = -Mb;
        int slot = 0;
        for (int m = 0; m <= c; ++m) {
            { const int ahead = (c - m) < (D - 1) ? (c - m) : (D - 1); wait_vm_le(4 * ahead); }
            SBAR();
            if (m + D <= c) { const int s2 = (slot == 0) ? NS - 1 : slot - 1; SP2_DMA(s2, m + D); }
            const LAS unsigned char* ks = kring + slot * 16384 + g * 8192; const LAS unsigned char* vs = vring + slot * 16384 + g * 8192;
            f32x16 A0, A1, B0, B1;
            { const u32x2 mw2 = *(const LAS u32x2*)(mlds + r32 * 256 + m * 8);
              const unsigned mwa = mw2.x >> (4 * hi), mwb = mw2.y >> (4 * hi), cb = __float_as_uint(cinit);
#pragma unroll
              for (int r = 0; r < 16; ++r) { const int pos = (r & 3) + 8 * (r >> 2);
                  const unsigned ma = (unsigned)__builtin_amdgcn_sbfe((int)mwa, pos, 1), mb = (unsigned)__builtin_amdgcn_sbfe((int)mwb, pos, 1);
                  const float ia = __uint_as_float((ma & cb) | (~ma & 0xFF800000u)), ib = __uint_as_float((mb & cb) | (~mb & 0xFF800000u));
                  A0[r] = ia; B0[r] = ia; A1[r] = ib; B1[r] = ib; } }
#pragma unroll
            for (int d0 = 0; d0 < 4; ++d0) { const bf16x8 k0 = ktile_frag(ks, r32, d0, hi), k1 = ktile_frag(ks, 32 + r32, d0, hi);
                A0 = __builtin_amdgcn_mfma_f32_32x32x16_bf16(k0, qa[d0], A0, 0, 0, 0); B0 = __builtin_amdgcn_mfma_f32_32x32x16_bf16(k0, qb[d0], B0, 0, 0, 0);
                A1 = __builtin_amdgcn_mfma_f32_32x32x16_bf16(k1, qa[d0], A1, 0, 0, 0); B1 = __builtin_amdgcn_mfma_f32_32x32x16_bf16(k1, qb[d0], B1, 0, 0, 0); }
            f32x2 pA0 = {0.f, 0.f}, pA1 = {0.f, 0.f}, pB0 = {0.f, 0.f}, pB1 = {0.f, 0.f};
#pragma unroll
            for (int r = 0; r < 16; ++r) { A0[r] = __builtin_amdgcn_exp2f(A0[r]); A1[r] = __builtin_amdgcn_exp2f(A1[r]); B0[r] = __builtin_amdgcn_exp2f(B0[r]); B1[r] = __builtin_amdgcn_exp2f(B1[r]); }
#pragma unroll
            for (int r = 0; r < 16; r += 2) { pA0 += (f32x2){A0[r], A0[r + 1]}; pA1 += (f32x2){A1[r], A1[r + 1]}; pB0 += (f32x2){B0[r], B0[r + 1]}; pB1 += (f32x2){B1[r], B1[r + 1]}; }
            { const f32x2 sa2 = pA0 + pA1, sb2 = pB0 + pB1; lA += sa2.x + sa2.y; lB += sb2.x + sb2.y; }
#define SP2_PV(s4_, PA_, PB_) do { const bf16x8 v0_ = vtile_frag(vs, trbase, s4_, 0), v1_ = vtile_frag(vs, trbase, s4_, 1); \
                a0 = __builtin_amdgcn_mfma_f32_32x32x16_bf16(v0_, PA_, a0, 0, 0, 0); a1 = __builtin_amdgcn_mfma_f32_32x32x16_bf16(v1_, PA_, a1, 0, 0, 0); \
                b0 = __builtin_amdgcn_mfma_f32_32x32x16_bf16(v0_, PB_, b0, 0, 0, 0); b1 = __builtin_amdgcn_mfma_f32_32x32x16_bf16(v1_, PB_, b1, 0, 0, 0); } while (0)
            { const bf16x8 pa = pack8(A0, 0), pb = pack8(B0, 0); SP2_PV(0, pa, pb); }
            { const bf16x8 pa = pack8(A0, 1), pb = pack8(B0, 1); SP2_PV(1, pa, pb); }
            { const bf16x8 pa = pack8(A1, 0), pb = pack8(B1, 0); SP2_PV(2, pa, pb); }
            { const bf16x8 pa = pack8(A1, 1), pb = pack8(B1, 1); SP2_PV(3, pa, pb); }
#undef SP2_PV
            slot = (slot == NS - 1) ? 0 : slot + 1;
        }
#undef SP2_DMA
        lA = half_sum(lA); lB = half_sum(lB);
        store_ot(O + tok * DM + hA * HD, a0, a1, 1.0f / lA, hi);
        store_ot(O + tok * DM + (hA + 1) * HD, b0, b1, 1.0f / lB, hi);
        asm volatile("s_waitcnt lgkmcnt(0)" ::: "memory");
        SBAR();
    }
}

__device__ __forceinline__ void phase_idx_topk_coop(const Ctx& X, const bf16* PRAW, const float* ROPE, const bf16* KI, const float* WI, unsigned long long* MASK) {
    const int lane = X.lane, r32 = lane & 31, hi = lane >> 5, tid = X.tid, wave = X.wave;
    const int tkr = 2 * ((r32 >> 2) & 1) + (r32 >> 4), hdr = (r32 & 3) + 4 * ((r32 >> 3) & 1);
    LAS unsigned char* kring = X.lds;
    for (int i = 0; i < 8; ++i) {
        const int P = blockIdx.x + 256 * i; if (P >= NB * 64) break;
        int tb = P & 63; const int b = P >> 6; if (i & 1) tb = 63 - tb;
        const int t0 = tb * 32 + 4 * wave, c = tb >> 1; const size_t tokb = (size_t)b * SEQ, tok0 = tokb + t0;
        const bf16* kib = KI + tokb * 64;
        const RawFr rwq = raw_frags(PRAW + (tok0 + tkr) * NPROJ + 1280 + hdr * 64, hi);
        const GAS f32x4* rp = (const GAS f32x4*)(ROPE + (tok0 + tkr) * 16); const f32x4 cs[2] = {rp[0], rp[1]}, sn[2] = {rp[2], rp[3]};
        float w0[8], w1[8];
        { const GAS f32x4* wp = (const GAS f32x4*)(WI + (tok0 + 2 * hi) * 8); const f32x4 a = wp[0], b4 = wp[1], c4 = wp[2], d4 = wp[3];
#pragma unroll
          for (int hh = 0; hh < 4; ++hh) { w0[hh] = a[hh]; w0[4 + hh] = b4[hh]; w1[hh] = c4[hh]; w1[4 + hh] = d4[hh]; } }
        asm volatile("" ::: "memory");
#pragma unroll
        for (int p = 0; p < 7; ++p) if (p <= c) ktile_dma(kring + p * 8192, kib + (size_t)p * 64 * 64, 64, tid, wave);
        asm volatile("" ::: "memory");
        bf16x8 qf[4];
        qi_frags_from_raw(rwq, cs, sn, hi, qf);
        unsigned k0[32], k1[32], k2[32], k3[32];
        SEC_BEGIN(1);
#pragma unroll
        for (int m = 0; m < 32; ++m) {
            if (m <= c) {
                { SEC_BEGIN(3);
                { const int ahead = (c - m) < 6 ? (c - m) : 6; wait_vm_le(ahead); }
                SEC_END(3); }
                { SEC_BEGIN(4);
                SBAR();
                SEC_END(4); }
                if (m + 7 <= c) ktile_dma(kring + ((m + 7) % 8) * 8192, kib + (size_t)(m + 7) * 64 * 64, 64, tid, wave);
                const LAS unsigned char* ks = kring + (m % 8) * 8192;
                float sa[2], sb[2];
                { bf16x8 kfa[4], kfb[4];
#pragma unroll
                  for (int d0 = 0; d0 < 4; ++d0) { kfa[d0] = ktile_frag(ks, r32, d0, hi); kfb[d0] = ktile_frag(ks, 32 + r32, d0, hi); }
                  f32x16 Ra = {}, Rb = {};
#pragma unroll
                  for (int d0 = 0; d0 < 4; ++d0) { Ra = __builtin_amdgcn_mfma_f32_32x32x16_bf16(qf[d0], kfa[d0], Ra, 0, 0, 0); Rb = __builtin_amdgcn_mfma_f32_32x32x16_bf16(qf[d0], kfb[d0], Rb, 0, 0, 0); }
                  f32x2 sA = {0.f, 0.f}, sB = {0.f, 0.f};
#pragma unroll
                  for (int hh = 0; hh < 8; ++hh) { sA = (f32x2){relu1(Ra[hh]), relu1(Rb[hh])} * w0[hh] + sA; sB = (f32x2){relu1(Ra[8 + hh]), relu1(Rb[8 + hh])} * w1[hh] + sB; }
                  sa[0] = sA.x; sb[0] = sB.x; sa[1] = sA.y; sb[1] = sB.y; }
                const auto ra = __builtin_amdgcn_permlane32_swap(ord_key(sa[0]), ord_key(sa[1]), false, false);
                const auto rb = __builtin_amdgcn_permlane32_swap(ord_key(sb[0]), ord_key(sb[1]), false, false);
                k0[m] = ra[0]; k2[m] = ra[1]; k1[m] = rb[0]; k3[m] = rb[1];
            } else { k0[m] = 0u; k1[m] = 0u; k2[m] = 0u; k3[m] = 0u; }
        }
        asm volatile("s_waitcnt lgkmcnt(0)" ::: "memory");
        SBAR();
        SEC_END(1);
        SEC_BEGIN(2);
        topk_select_store(k0, c, MASK + (tok0 + 0) * 32, lane);
        topk_select_store(k1, c, MASK + (tok0 + 1) * 32, lane);
        topk_select_store(k2, c, MASK + (tok0 + 2) * 32, lane);
        topk_select_store(k3, c, MASK + (tok0 + 3) * 32, lane);
        SEC_END(2);
    }
}


#define SB_TILE(S_, qf_, diag_, run_, o0_, o1_) do { \
        f32x16 S_ = {}; \
        _Pragma("unroll") for (int d0 = 0; d0 < 4; ++d0) S_ = __builtin_amdgcn_mfma_f32_32x32x16_bf16(ktile_frag(ks, r32, d0, hi), qf_[d0], S_, 0, 0, 0); \
        f32x16 xm_, ls_; float cs_ = 0.f; \
        _Pragma("unroll") for (int r = 0; r < 16; ++r) { const float z = S_[r]; const float sp = relu1(z) + __builtin_amdgcn_logf(1.0f + __builtin_amdgcn_exp2f(-fabsf(z))); \
            const bool valid = !(diag_) || (crow16(r, hi) < r32); xm_[r] = valid ? sp : 0.f; ls_[r] = valid ? z - sp : -INFINITY; cs_ += xm_[r]; } \
        cs_ = half_sum(cs_); \
        f32x16 T_; _Pragma("unroll") for (int r = 0; r < 16; ++r) T_[r] = run_; \
        T_ = __builtin_amdgcn_mfma_f32_32x32x16_bf16(uf[0], pack8(xm_, 0), T_, 0, 0, 0); \
        T_ = __builtin_amdgcn_mfma_f32_32x32x16_bf16(uf[1], pack8(xm_, 1), T_, 0, 0, 0); \
        _Pragma("unroll") for (int r = 0; r < 16; ++r) T_[r] = __builtin_amdgcn_exp2f(ls_[r] + T_[r]); \
        const bf16x8 p0_ = pack8(T_, 0), p1_ = pack8(T_, 1); \
        o0_ = __builtin_amdgcn_mfma_f32_32x32x16_bf16(vtile_frag(vs, trbase, 0, 0), p0_, o0_, 0, 0, 0); o1_ = __builtin_amdgcn_mfma_f32_32x32x16_bf16(vtile_frag(vs, trbase, 0, 1), p0_, o1_, 0, 0, 0); \
        o0_ = __builtin_amdgcn_mfma_f32_32x32x16_bf16(vtile_frag(vs, trbase, 1, 0), p1_, o0_, 0, 0, 0); o1_ = __builtin_amdgcn_mfma_f32_32x32x16_bf16(vtile_frag(vs, trbase, 1, 1), p1_, o1_, 0, 0, 0); \
        run_ -= cs_; } while (0)
#define SB_ELEM(S_, xm_, cs_, diag_, run_) do {   \
        _Pragma("unroll") for (int r = 0; r < 16; r += 2) { const f32x2 z = {S_[r], S_[r + 1]}; \
            f32x2 e; e.x = __builtin_amdgcn_exp2f(-fabsf(z.x)); e.y = __builtin_amdgcn_exp2f(-fabsf(z.y)); \
            const f32x2 d = e + 1.0f; \
            f32x2 lg; lg.x = __builtin_amdgcn_logf(d.x); lg.y = __builtin_amdgcn_logf(d.y); \
            f32x2 mx; mx.x = relu1(z.x); mx.y = relu1(z.y); \
            const f32x2 sp = mx + lg, t = z + ((f32x2){run_, run_} - sp); \
            xm_[r] = sp.x; xm_[r + 1] = sp.y; S_[r] = t.x; S_[r + 1] = t.y; } \
        if (diag_) { _Pragma("unroll") for (int r = 0; r < 16; ++r) { const bool valid = crow16(r, hi) < r32; xm_[r] = valid ? xm_[r] : 0.f; S_[r] = valid ? S_[r] : -INFINITY; } } \
        { f32x2 c2 = {0.f, 0.f}; _Pragma("unroll") for (int r = 0; r < 16; r += 2) c2 += (f32x2){xm_[r], xm_[r + 1]}; cs_ = half_sum(c2.x + c2.y); } } while (0)
#define SB_PAIR(dA_) do { \
        bf16x8 kf_[4]; _Pragma("unroll") for (int d0 = 0; d0 < 4; ++d0) kf_[d0] = ktile_frag(ks, r32, d0, hi); \
        f32x16 SA_ = {}, SB_ = {}; \
        _Pragma("unroll") for (int d0 = 0; d0 < 4; ++d0) { SA_ = __builtin_amdgcn_mfma_f32_32x32x16_bf16(kf_[d0], qa[d0], SA_, 0, 0, 0); SB_ = __builtin_amdgcn_mfma_f32_32x32x16_bf16(kf_[d0], qb[d0], SB_, 0, 0, 0); } \
        f32x16 xA_, xB_; float cA_, cB_; \
        SB_ELEM(SA_, xA_, cA_, dA_, runA); SB_ELEM(SB_, xB_, cB_, false, runB);            \
        SA_ = __builtin_amdgcn_mfma_f32_32x32x16_bf16(uf[0], pack8(xA_, 0), SA_, 0, 0, 0); SB_ = __builtin_amdgcn_mfma_f32_32x32x16_bf16(uf[0], pack8(xB_, 0), SB_, 0, 0, 0); \
        SA_ = __builtin_amdgcn_mfma_f32_32x32x16_bf16(uf[1], pack8(xA_, 1), SA_, 0, 0, 0); SB_ = __builtin_amdgcn_mfma_f32_32x32x16_bf16(uf[1], pack8(xB_, 1), SB_, 0, 0, 0); \
        _Pragma("unroll") for (int r = 0; r < 16; ++r) { SA_[r] = __builtin_amdgcn_exp2f(SA_[r]); SB_[r] = __builtin_amdgcn_exp2f(SB_[r]); } \
        { const bf16x8 pa_ = pack8(SA_, 0), pb_ = pack8(SB_, 0); const bf16x8 v0_ = vtile_frag(vs, trbase, 0, 0), v1_ = vtile_frag(vs, trbase, 0, 1); \
          a0 = __builtin_amdgcn_mfma_f32_32x32x16_bf16(v0_, pa_, a0, 0, 0, 0); b0 = __builtin_amdgcn_mfma_f32_32x32x16_bf16(v0_, pb_, b0, 0, 0, 0); \
          a1 = __builtin_amdgcn_mfma_f32_32x32x16_bf16(v1_, pa_, a1, 0, 0, 0); b1 = __builtin_amdgcn_mfma_f32_32x32x16_bf16(v1_, pb_, b1, 0, 0, 0); } \
        { const bf16x8 pa_ = pack8(SA_, 1), pb_ = pack8(SB_, 1); const bf16x8 v0_ = vtile_frag(vs, trbase, 1, 0), v1_ = vtile_frag(vs, trbase, 1, 1); \
          a0 = __builtin_amdgcn_mfma_f32_32x32x16_bf16(v0_, pa_, a0, 0, 0, 0); b0 = __builtin_amdgcn_mfma_f32_32x32x16_bf16(v0_, pb_, b0, 0, 0, 0); \
          a1 = __builtin_amdgcn_mfma_f32_32x32x16_bf16(v1_, pa_, a1, 0, 0, 0); b1 = __builtin_amdgcn_mfma_f32_32x32x16_bf16(v1_, pb_, b1, 0, 0, 0); } \
        runA -= cA_; runB -= cB_; } while (0)
__device__ __forceinline__ void sb_tile_dma(LAS unsigned char* slot, const bf16* base  , int key0, int lane) {
#pragma unroll
    for (int i = 0; i < 4; ++i) { const int key = 8 * i + (lane >> 3), src = (lane & 7) ^ ((key >> 1) & 7);
        __builtin_amdgcn_global_load_lds((const GAS unsigned*)(base + (size_t)(key0 + key) * NQKV + DM + src * 8), (LAS unsigned*)(slot + i * 1024), 16, 0, 0); }
#pragma unroll
    for (int i = 0; i < 4; ++i) { const int key = 8 * i + ((lane & 31) >> 2), d = 32 * (lane >> 5) + 8 * (lane & 3);
        __builtin_amdgcn_global_load_lds((const GAS unsigned*)(base + (size_t)(key0 + key) * NQKV + 2 * DM + d), (LAS unsigned*)(slot + 4096 + i * 1024), 16, 0, 0); }
}
__device__ __forceinline__ void phase_sb_pair(const Ctx& X, const bf16* QKV, bf16* O) {
    const int lane = X.lane, r32 = lane & 31, hi = lane >> 5;
    LAS unsigned char* ring = X.lds + X.wave * 16384;
    const int trbase = (4 * hi + ((lane & 15) >> 2)) * 64 + (16 * ((lane >> 4) & 1) + 4 * (lane & 3)) * 2;
    bf16x8 uf[2];
#pragma unroll
    for (int s = 0; s < 2; ++s)
#pragma unroll
        for (int j = 0; j < 8; ++j) uf[s][j] = ((16 * s + 8 * (j >> 2) + 4 * hi + (j & 3)) > r32) ? (short)0xBF80 : (short)0;
    for (int u = X.gw; u < NB * NH * 32; u += X.NGW) {
        const int b = u >> 9, h = (u >> 5) & 15, pb = u & 31, t0 = pb * 64;
        const bf16* base = QKV + (size_t)b * SEQ * NQKV + h * HD;
        asm volatile("s_waitcnt lgkmcnt(0)" ::: "memory");
        sb_tile_dma(ring, base, t0 + 32, lane);
        bf16x8 qa[4], qb[4];
#pragma unroll
        for (int d0 = 0; d0 < 4; ++d0) { qa[d0] = *(const GAS bf16x8*)(base + (size_t)(t0 + r32) * NQKV + 16 * d0 + 8 * hi); qb[d0] = *(const GAS bf16x8*)(base + (size_t)(t0 + 32 + r32) * NQKV + 16 * d0 + 8 * hi); }
        f32x16 a0 = {}, a1 = {}, b0 = {}, b1 = {}; float runA = 0.f, runB = 0.f;
        int slot = 0;
        for (int kt = 2 * pb + 1; kt >= 0; --kt) {
            asm volatile("s_waitcnt lgkmcnt(0)" ::: "memory");
            if (kt > 0) { sb_tile_dma(ring + (slot ^ 1) * 8192, base, (kt - 1) * 32, lane); WAITV(8); } else WAITV(0);
            const LAS unsigned char* ks = ring + slot * 8192; const LAS unsigned char* vs = ks + 4096;
            if (kt == 2 * pb + 1) { SB_TILE(SB, qb, true, runB, b0, b1); }
            else { const bool dA = (kt == 2 * pb); SB_PAIR(dA);
                if (__all(runA < -160.f && runB < -160.f)) break; }
            slot ^= 1;
        }
        store_ot(O + (size_t)(b * SEQ + t0 + r32) * DM + h * HD, a0, a1, 1.0f, hi);
        store_ot(O + (size_t)(b * SEQ + t0 + 32 + r32) * DM + h * HD, b0, b1, 1.0f, hi);
        WAITV(0);
    }
}

#ifndef MK_N_LAUNCHES
#define MK_N_LAUNCHES 1
#endif
constexpr int NPHASES = 19;
struct Args { const void* in[19]; float* out; unsigned char* ws; int ph_lo, ph_hi; };
static_assert(sizeof(Args) == 19 * 8 + 8 + 8 + 8, "Args has no padding");

__device__ __forceinline__ void moe_gemms_gu(const Ctx& X, const signed char* H8, const float* hs_e, const signed char* Wgu8_l, const float* wsc_l, const float* bgu_l, unsigned char* ACT, const unsigned* gcnt, const int* list) {
    LAS int* cntL = (LAS int*)(X.lds + EXTRA_OFF); LAS int* tsum = cntL + 32;
    moe_tables(X, gcnt, cntL, tsum);
    pg8::Gemm g{(const bf16*)H8, (const bf16*)Wgu8_l, DM, (size_t)2048 * DM};
    pg8::MoeOrder S{tsum, cntL, list, 8, X.G, (int)blockIdx.x, tsum[NE] * 8, 0};
    pg8::EpiSwiglu8 E{ACT, bgu_l, hs_e, wsc_l, &S};
    pg8::gemm_phase<pg8::EpiSwiglu8, pg8::MoeOrder, true, true, 1>(X.lds, g, S, E);
}
__device__ __forceinline__ void moe_gemms_down(const Ctx& X, const unsigned char* ACT8, const unsigned char* Wd8_l, const float* wsd_l, const float* bd_l, unsigned char* Y, const unsigned* gcnt, const int* list, const float* gate_e) {
    LAS int* cntL = (LAS int*)(X.lds + EXTRA_OFF); LAS int* tsum = cntL + 32;
    moe_tables(X, gcnt, cntL, tsum);
    pg8::Gemm g{(const bf16*)ACT8, (const bf16*)Wd8_l, DM, (size_t)DM * DM};
    pg8::MoeOrder S{tsum, cntL, list, 4, X.G, (int)blockIdx.x, tsum[NE] * 4, 0};
    pg8::EpiDownF8 E{Y, bd_l, gate_e, tsum, wsd_l};
    pg8::gemm_phase<pg8::EpiDownF8, pg8::MoeOrder, false, true, 2>(X.lds, g, S, E);
}

__global__ void __launch_bounds__(NTHREADS, 2) mk_fwd(Args a) {
    extern __shared__ __attribute__((aligned(16))) unsigned char lds_raw[];
    Ctx X; X.lds = (LAS unsigned char*)lds_raw; X.tid = threadIdx.x; X.lane = X.tid & 63; X.wave = __builtin_amdgcn_readfirstlane(X.tid >> 6);
    X.G = gridDim.x; { const int bx = blockIdx.x; X.vcu = (X.G % 8 == 0) ? (bx % 8) * (X.G / 8) + bx / 8 : bx; }
    X.gw = X.vcu * NWAVES + X.wave; X.NGW = X.G * NWAVES;
    volatile LAS unsigned* MISC = (volatile LAS unsigned*)(X.lds + LDSCTL_OFF);
    for (int u = X.tid; u < 256; u += NTHREADS) MISC[u] = 0u;
    __syncthreads();
    unsigned char* ws = a.ws;
    unsigned* ctl = (unsigned*)(ws + WS_CTL);
    XcdBarrier bar = xcd_barrier_post(ctl + CW_BAR, MISC + 8);
    const int lo = a.ph_lo, hi = a.ph_hi;
#ifndef ONLY_PHASE
#define ONLY_PHASE -1
#endif
#define IN(k) ((ONLY_PHASE < 0 || ONLY_PHASE == (k)) && lo <= (k) && (k) < hi)
#if defined(PROBE_LO)
    unsigned long long pr_t0 = 0, pr_t1 = 0;
#define PROBE_AT(k) do { if ((k) == PROBE_LO) pr_t0 = __builtin_amdgcn_s_memrealtime(); if ((k) == PROBE_HI) pr_t1 = __builtin_amdgcn_s_memrealtime(); } while (0)
#else
#define PROBE_AT(k) do {} while (0)
#endif
#define SEAM(k) do { if (IN(k) && IN((k) + 1)) xcd_barrier(bar); PROBE_AT((k) + 1); } while (0)
    const float* x_in = (const float*)a.in[0]; const float* c_in = (const float*)a.in[1]; const int* positions = (const int*)a.in[2];
    const float* ada_w = (const float*)a.in[3]; const float* ada_b = (const float*)a.in[4]; const float* norm1_g = (const float*)a.in[5]; const float* norm2_g = (const float*)a.in[6];
    const float* sb_w_qkv = (const float*)a.in[7]; const float* sb_w_o = (const float*)a.in[8]; const float* dsa_w_in = (const float*)a.in[9];
    const float* dsa_q_gain = (const float*)a.in[10]; const float* dsa_k_gain = (const float*)a.in[11]; const float* dsa_w_o = (const float*)a.in[12];
    const float* router_w = (const float*)a.in[13]; const float* router_b = (const float*)a.in[14];
    const float* exp_w_gu = (const float*)a.in[15]; const float* exp_b_gu = (const float*)a.in[16]; const float* exp_w_down = (const float*)a.in[17]; const float* exp_b_down = (const float*)a.in[18];
    float* out = a.out;
    float* mod = (float*)(ws + WS_MOD);
    signed char* Wqkv8 = (signed char*)(ws + WS_WQKV); bf16* Wo0_t = (bf16*)(ws + WS_WO0); signed char* Win8 = (signed char*)(ws + WS_WIN); bf16* Wo1_t = (bf16*)(ws + WS_WO1); signed char* Wgu8 = (signed char*)(ws + WS_WGU); bf16* Wd_t = (bf16*)(ws + WS_WD);
    float* wsc = (float*)(ws + WS_WSC); signed char* H8 = (signed char*)(ws + WS_H); float* HS = (float*)(ws + WS_HS);
    bf16* QKV = (bf16*)(ws + WS_QKV); unsigned char* ACT = ws + WS_A; unsigned char* Y = ws + WS_B; bf16* O = (bf16*)(ws + WS_O);
    bf16* PRAW = (bf16*)(ws + WS_PRAW); bf16* Q1 = (bf16*)(ws + WS_Q1); bf16* K1 = (bf16*)(ws + WS_K1); bf16* V1 = (bf16*)(ws + WS_V1); bf16* QI = (bf16*)(ws + WS_QI); bf16* KI = (bf16*)(ws + WS_KI); float* WI = (float*)(ws + WS_WI); float* QN = (float*)(ws + WS_QN);
    unsigned long long* MASK = (unsigned long long*)(ws + WS_MASK); float* SC = (float*)(ws + WS_SC);
    int* tok_e = (int*)(ws + WS_TOKE); int* tok_p = (int*)(ws + WS_TOKP); int* list = (int*)(ws + WS_LIST); float* gate_e = (float*)(ws + WS_GATE); float* hs_e = (float*)(ws + WS_HSE); bf16* XR = (bf16*)(ws + WS_XR);
    unsigned* gcnt0 = ctl + CW_CNT; unsigned* gcnt1 = ctl + CW_CNT + 32;
    const float* mod0 = mod; const float* mod1 = mod + (size_t)NB * 6144;

    PROBE_AT(0);
    if (IN(0)) { phase_prologue(X, c_in, ada_w, ada_b, mod, sb_w_qkv, sb_w_o, dsa_w_in, dsa_w_o, exp_w_gu, exp_w_down, Wqkv8, Wo0_t, Win8, Wo1_t, Wgu8, Wd_t, wsc, ctl + CW_ADA, ctl + CW_ITEM);
        if (IN(1)) { if (X.tid == 0) { XB_SPIN(xb_ld(ctl + CW_ADA) < 192u, bar.bar); __builtin_amdgcn_fence(__ATOMIC_ACQUIRE, "agent"); asm volatile("s_waitcnt vmcnt(0)" ::: "memory"); }
            __syncthreads(); }
        PROBE_AT(1); }
    if (IN(1)) { phase_norm1(X, x_in, norm1_g, mod0, H8, HS); SEAM(1); }
    if (IN(2)) { pg8::Gemm g{(const bf16*)H8, (const bf16*)Wqkv8, DM, 0}; pg8::StaticOrder S; S.init(NTOK, NQKV, X.G, (int)blockIdx.x); pg8::EpiBf16S8 E{QKV, NQKV, DM, QSCALE, HS, wsc};
        pg8::gemm_phase<pg8::EpiBf16S8, pg8::StaticOrder, false, true, 1>(X.lds, g, S, E); SEAM(2); }
#if defined(NAIVE_SB)
    if (IN(3)) { phase_sb_naive(X, QKV, O); SEAM(3); }
#else
    if (IN(3)) { phase_sb_pair(X, QKV, O); SEAM(3); }
#endif
    if (IN(4)) { pg8::Gemm g{O, Wo0_t, DM, 0}; pg8::StaticOrder S; S.init(NTOK, DM, X.G, (int)blockIdx.x); pg8::EpiResid<false> E{x_in, XR, mod0 + 2 * DM};
        pg8::gemm_phase<pg8::EpiResid<false>, pg8::StaticOrder, false, true>(X.lds, g, S, E); SEAM(4); }
    if (IN(5)) { phase_norm2_router(X, XR, norm2_g, mod0, router_w, router_b, H8, HS, tok_e, tok_p, gcnt0, list, gate_e, hs_e); SEAM(5); }
    if (IN(6)) { moe_gemms_gu(X, H8, hs_e, Wgu8, wsc + NQKV + NPROJ, exp_b_gu, ACT, gcnt0, list); SEAM(6); }
    if (IN(7)) { moe_gemms_down(X, ACT, (const unsigned char*)Wd_t, wsc + NQKV + NPROJ + 64 * 2048, exp_b_down, Y, gcnt0, list, gate_e); SEAM(7); }
    if (IN(8)) { phase_combine(X, XR, nullptr, Y, tok_e, tok_p, gcnt0, mod0, true, norm1_g + DM, mod1, H8, HS); SEAM(8); }
    if (IN(9)) { pg8::Gemm g{(const bf16*)H8, (const bf16*)Win8, DM, 0}; pg8::StaticOrder S; S.init(NTOK, NPROJ, X.G, (int)blockIdx.x); pg8::EpiBf16S8 E{PRAW, NPROJ, 0, 1.0f, HS, wsc + NQKV};
        pg8::gemm_phase<pg8::EpiBf16S8, pg8::StaticOrder, false, true, 1>(X.lds, g, S, E); SEAM(9); }
    float* ROPE = (float*)(ws + WS_ROPE);
    if (IN(10)) { phase_dsa_post2(X, PRAW, positions, dsa_k_gain, K1, V1, KI, WI, ROPE); SEAM(10); }
#if defined(NAIVE_IDX)
    if (IN(11)) { phase_idx_naive(X, QI, KI, WI, SC); SEAM(11); }
    if (IN(12)) { phase_topk_naive(X, SC, MASK); SEAM(12); }
#else
    if (IN(11)) { phase_idx_topk_coop(X, PRAW, ROPE, KI, WI, MASK);
        if (IN(13)) { const float mb0 = qk_bound(dsa_q_gain, dsa_k_gain, X.lane);
            if (mb0 <= 60.f) { asm volatile("s_waitcnt vmcnt(0)" ::: "memory"); __syncthreads(); } else xcd_barrier(bar); }
        PROBE_AT(12); PROBE_AT(13); }
#endif
#if defined(NAIVE_SPARSE)
    if (IN(13)) { phase_sparse_naive(X, Q1, K1, V1, MASK, O); SEAM(13); }
#else
    if (IN(13)) { const float mb = qk_bound(dsa_q_gain, dsa_k_gain, X.lane);
        if (mb <= 60.f) phase_sparse_coop2(X, PRAW, ROPE, dsa_q_gain, mb, K1, V1, (const unsigned char*)MASK, O);
        else phase_sparse_coop(X, PRAW, ROPE, dsa_q_gain, mb, K1, V1, (const unsigned char*)MASK, O);
        SEAM(13); }
#endif
    if (IN(14)) { pg8::Gemm g{O, Wo1_t, DM, 0}; pg8::StaticOrder S; S.init(NTOK, DM, X.G, (int)blockIdx.x); pg8::EpiResid<true> E{XR, XR, mod1 + 2 * DM};
        pg8::gemm_phase<pg8::EpiResid<true>, pg8::StaticOrder, false, true>(X.lds, g, S, E); SEAM(14); }
    if (IN(15)) { phase_norm2_router(X, XR, norm2_g + DM, mod1, router_w + (size_t)DM * NE, router_b + NE, H8, HS, tok_e, tok_p, gcnt1, list, gate_e, hs_e); SEAM(15); }
    if (IN(16)) { moe_gemms_gu(X, H8, hs_e, Wgu8 + (size_t)NE * 2048 * DM, wsc + NQKV + NPROJ + NE * 2048, exp_b_gu + (size_t)NE * 2048, ACT, gcnt1, list); SEAM(16); }
    if (IN(17)) { moe_gemms_down(X, ACT, (const unsigned char*)Wd_t + (size_t)NE * DM * DM, wsc + NQKV + NPROJ + 64 * 2048 + NE * DM, exp_b_down + (size_t)NE * DM, Y, gcnt1, list, gate_e); SEAM(17); }
    if (IN(18)) { phase_combine(X, XR, out, Y, tok_e, tok_p, gcnt1, mod1, false, nullptr, nullptr, nullptr, nullptr); }
#if defined(PROBE_SEC)
    if (blockIdx.x == 0 && X.tid == 0) { const unsigned long long span = *(volatile LAS unsigned long long*)(X.lds + LDSCTL_OFF + 64) * PROBE_MULT, t = __builtin_amdgcn_s_memrealtime(); while (__builtin_amdgcn_s_memrealtime() - t < span) __builtin_amdgcn_s_sleep(8); }
#endif
#if defined(PROBE_LO)
    PROBE_AT(19);
    if (blockIdx.x == 0 && X.tid == 0) { const unsigned long long span = (pr_t1 - pr_t0) * PROBE_MULT, t = __builtin_amdgcn_s_memrealtime(); while (__builtin_amdgcn_s_memrealtime() - t < span) __builtin_amdgcn_s_sleep(8); }
#endif
#undef IN
#undef SEAM
}

extern "C" void kernel_launch(void* const* d_in, const int* in_sizes, int n_in, void* d_out, int out_size, void* d_ws, size_t ws_size, hipStream_t stream) {
    static int grid = 0;
    if (grid == 0) {
        if (n_in != 19 || out_size != NTOK * DM || ws_size < WS_END) { fprintf(stderr, "kernel_launch: unexpected shapes (n_in %d, out %d, ws %zu < %zu)\n", n_in, out_size, ws_size, (size_t)WS_END); grid = -1; return; }
        int dev = 0, cus = 0, per_cu = 0;
        if (hipGetDevice(&dev) != hipSuccess || hipDeviceGetAttribute(&cus, hipDeviceAttributeMultiprocessorCount, dev) != hipSuccess) { grid = -1; return; }
        if (hipFuncSetAttribute((const void*)mk_fwd, hipFuncAttributeMaxDynamicSharedMemorySize, LDS_BYTES) != hipSuccess) { fprintf(stderr, "kernel_launch: hipFuncSetAttribute failed\n"); grid = -1; return; }
        if (hipOccupancyMaxActiveBlocksPerMultiprocessor(&per_cu, (const void*)mk_fwd, NTHREADS, LDS_BYTES) != hipSuccess || per_cu < 1)
            fprintf(stderr, "kernel_launch: occupancy query reports %d workgroups per CU\n", per_cu);
        (void)hipGetLastError();
        grid = cus;
    }
    if (grid < 0) return;
    if (hipMemsetAsync((char*)d_ws + WS_CTL, 0, CTL_ZERO_BYTES, stream) != hipSuccess) return;
    Args a{};
    for (int i = 0; i < 19; ++i) a.in[i] = d_in[i];
    a.out = (float*)d_out; a.ws = (unsigned char*)d_ws;
#if MK_N_LAUNCHES == 1
    a.ph_lo = 0; a.ph_hi = NPHASES;
    hipLaunchKernelGGL(mk_fwd, dim3(grid), dim3(NTHREADS), LDS_BYTES, stream, a);
#else
    for (int p = 0; p < NPHASES; ++p) { a.ph_lo = p; a.ph_hi = p + 1; hipLaunchKernelGGL(mk_fwd, dim3(grid), dim3(NTHREADS), LDS_BYTES, stream, a); }
#endif
}
```

```cpp
#include <hip/hip_runtime.h>
#include <cstdio>
#include <cstdint>

#define GAS __attribute__((address_space(1)))
#define LAS __attribute__((address_space(3)))
typedef unsigned short bf16;
typedef short bf16x8 __attribute__((ext_vector_type(8)));
typedef float f32x4 __attribute__((ext_vector_type(4)));
typedef float f32x2 __attribute__((ext_vector_type(2)));
__device__ __forceinline__ float relu1(float z) { const int b = __float_as_int(z); return __int_as_float(b > 0 ? b : 0); }
typedef unsigned u32x4 __attribute__((ext_vector_type(4)));
typedef unsigned u32x2 __attribute__((ext_vector_type(2)));
typedef GAS unsigned gu32;

constexpr int DM = 1024, NB = 32, SEQ = 2048, NTOK = NB * SEQ, NE = 32, TOPK = 4, HD = 64, NH = 16;
constexpr int NQKV = 3072, NPROJ = 2048, NPROJ_REAL = 1864;
constexpr int ECAP = 65536;
constexpr int MOE_ROWS = NTOK * TOPK + NE * 256;
constexpr float EPS = 1e-6f;
constexpr float LOG2E = 1.4426950408889634f;
constexpr float QSCALE = 0.125f * LOG2E;
constexpr int NWAVES = 8, NTHREADS = 512;

constexpr size_t MiB = (size_t)1 << 20;
constexpr size_t WS_CTL = 0, CTL_ZERO_BYTES = 1 * MiB;
constexpr size_t WS_MOD = 1 * MiB;
constexpr size_t WS_WQKV = 3 * MiB, WS_WO0 = 9 * MiB, WS_WIN = 11 * MiB, WS_WO1 = 15 * MiB, WS_WGU = 17 * MiB, WS_WD = 273 * MiB;
constexpr size_t WS_H = 402 * MiB;
constexpr size_t WS_HS = WS_H + 64 * MiB, WS_WSC = 6 * MiB;
constexpr size_t WS_A = 530 * MiB;
constexpr size_t WS_QKV = WS_A, WS_PRAW = WS_A, WS_Q1 = 786 * MiB, WS_K1 = 914 * MiB, WS_V1 = 930 * MiB, WS_QI = 946 * MiB, WS_KI = 1010 * MiB, WS_WI = 1018 * MiB, WS_QN = 1020 * MiB, WS_ROPE = 1022 * MiB;
constexpr size_t WS_B = 1058 * MiB;
constexpr size_t WS_O = WS_B, WS_MASK = 1186 * MiB, WS_SC = 1202 * MiB;
constexpr size_t WS_TOKE = 1720 * MiB, WS_TOKP = 1721 * MiB, WS_TOKG = 1722 * MiB, WS_LIST = 1724 * MiB, WS_GATE = 1732 * MiB, WS_HSE = 1740 * MiB, WS_XR = 1748 * MiB, WS_END = 1876 * MiB;
static_assert(WS_A + (size_t)MOE_ROWS * DM * 2 <= WS_B && WS_B + (size_t)MOE_ROWS * DM * 2 <= WS_TOKE && WS_SC + (size_t)NTOK * SEQ * 4 <= WS_TOKE, "ws map");
constexpr int CW_TMO = 0, CW_BAR = 4096, CW_CNT = 8192, CW_KMAX = 8320, CW_ADA = 8448, CW_ITEM = 8456;

constexpr int RING_BYTES = 131072;
constexpr int LDSCTL_OFF = RING_BYTES;
constexpr int EXTRA_OFF = RING_BYTES + 1024;
constexpr int LDS_BYTES = 163840;

#define WAITV(n) asm volatile("s_waitcnt vmcnt(" #n ")" ::: "memory")
#define SBAR() do { asm volatile("" ::: "memory"); __builtin_amdgcn_s_barrier(); asm volatile("" ::: "memory"); } while (0)
#define LDS_WAIT() asm volatile("s_waitcnt lgkmcnt(0)" ::: "memory")
#define VM_WAIT() asm volatile("s_waitcnt vmcnt(0)" ::: "memory")
__device__ __forceinline__ unsigned f2bf(float f) { unsigned u = __builtin_bit_cast(unsigned, f); return (u + 0x7fffu + ((u >> 16) & 1u)) >> 16; }
typedef __bf16 bf16x2n __attribute__((ext_vector_type(2)));
__device__ __forceinline__ unsigned cvt_pk_bf16(float lo, float hi) { return __builtin_bit_cast(unsigned, __builtin_convertvector((f32x2){lo, hi}, bf16x2n)); }
__device__ __forceinline__ unsigned pk2(float lo, float hi) { return cvt_pk_bf16(lo, hi); }
__device__ __forceinline__ float bflo(unsigned w) { return __uint_as_float(w << 16); }
__device__ __forceinline__ float bfhi(unsigned w) { return __uint_as_float(w & 0xffff0000u); }
__device__ __forceinline__ unsigned pack4i(float a, float b, float c, float d) { return ((unsigned)(int)a & 0xffu) | (((unsigned)(int)b & 0xffu) << 8) | (((unsigned)(int)c & 0xffu) << 16) | (((unsigned)(int)d & 0xffu) << 24); }
template <int CTRL> __device__ __forceinline__ float dpp_mov(float v) { return __uint_as_float((unsigned)__builtin_amdgcn_update_dpp(0, (int)__float_as_uint(v), CTRL, 0xF, 0xF, true)); }
__device__ __forceinline__ float row_sum16(float v) { v += dpp_mov<0xB1>(v); v += dpp_mov<0x4E>(v); v += dpp_mov<0x141>(v); v += dpp_mov<0x140>(v); return v; }
__device__ __forceinline__ float row_max16(float v) { v = fmaxf(v, dpp_mov<0xB1>(v)); v = fmaxf(v, dpp_mov<0x4E>(v)); v = fmaxf(v, dpp_mov<0x141>(v)); v = fmaxf(v, dpp_mov<0x140>(v)); return v; }
__device__ __forceinline__ float quad_sum(float v) { v += dpp_mov<0xB1>(v); v += dpp_mov<0x4E>(v); return v; }
__device__ __forceinline__ float wave_sum(float v) {
    v = row_sum16(v);
    { const auto r = __builtin_amdgcn_permlane16_swap(__float_as_uint(v), __float_as_uint(v), false, false); v = __uint_as_float(r[0]) + __uint_as_float(r[1]); }
    { const auto r = __builtin_amdgcn_permlane32_swap(__float_as_uint(v), __float_as_uint(v), false, false); v = __uint_as_float(r[0]) + __uint_as_float(r[1]); }
    return v;
}
__device__ __forceinline__ float half_max32(float v) {
    v = row_max16(v);
    { const auto r = __builtin_amdgcn_permlane16_swap(__float_as_uint(v), __float_as_uint(v), false, false); v = fmaxf(__uint_as_float(r[0]), __uint_as_float(r[1])); }
    return v;
}
__device__ __forceinline__ float wave_max(float v) {
    v = half_max32(v);
    { const auto r = __builtin_amdgcn_permlane32_swap(__float_as_uint(v), __float_as_uint(v), false, false); v = fmaxf(__uint_as_float(r[0]), __uint_as_float(r[1])); }
    return v;
}

#if defined(PROBE_SEC)
#define SEC_BEGIN2(tag) unsigned long long _s2_t0 = ((tag) == PROBE_SEC) ? __builtin_amdgcn_s_memrealtime() : 0ull
#define SEC_END2(tag) do { if ((tag) == PROBE_SEC && blockIdx.x == 0 && threadIdx.x == 0) { volatile LAS unsigned long long* _acc = (volatile LAS unsigned long long*)(lds + LDSCTL_OFF + 64); *_acc = *_acc + (__builtin_amdgcn_s_memrealtime() - _s2_t0); } } while (0)
#define SEC_BEGIN3(tag) unsigned long long _s3_t0 = ((tag) == PROBE_SEC) ? __builtin_amdgcn_s_memrealtime() : 0ull
#define SEC_END3(tag) do { asm volatile("s_waitcnt vmcnt(0)" ::: "memory"); if ((tag) == PROBE_SEC && blockIdx.x == 0 && threadIdx.x == 0) { volatile LAS unsigned long long* _acc = (volatile LAS unsigned long long*)(lds + LDSCTL_OFF + 64); *_acc = *_acc + (__builtin_amdgcn_s_memrealtime() - _s3_t0); } } while (0)
#else
#define SEC_BEGIN2(tag) do {} while (0)
#define SEC_END2(tag) do {} while (0)
#define SEC_BEGIN3(tag) do {} while (0)
#define SEC_END3(tag) do {} while (0)
#endif
namespace pg8 {
constexpr int BM = 256, BK = 64, HALF = 128, HTB = HALF * BK * 2, NXCD = 8, WGM = 8;
__host__ __device__ __forceinline__ int lds_byte(int r, int c) { const int st = (r >> 4) * 2 + (c >> 5), rr = r & 15, cc = c & 31, ob = rr * 64 + cc * 2; return st * 1024 + (ob ^ (((ob >> 9) & 1) << 5)); }
__host__ __device__ __forceinline__ void stage_rc(int b, int& R, int& C) { const int st = b / 1024, sb = b % 1024, swz = sb ^ (((sb >> 9) & 1) << 5); R = (st >> 1) * 16 + swz / 64; C = (st & 1) * 32 + (swz % 64) / 2; }
__host__ __device__ __forceinline__ int perm32(int rho) { const int n = rho >> 4, i = rho & 15; return 8 * (i >> 2) + 4 * n + (i & 3); }

constexpr float ACT_PRESCALE = 4.0f, Y_PRESCALE = 4.0f;
struct Unit { int pm, pn, e; };
struct Gemm { const bf16* A; const bf16* Bt; int K; size_t bstride; };

struct StaticOrder {
    int nM, nN, nwg, G, c;
    __device__ void init(int M, int N, int G_, int c_) { nM = M / BM; nN = N / BM; nwg = nM * nN; G = G_; c = c_; }
    __device__ bool next(int i, Unit& u) const {
        const long L = (long)i * G + c; if (L >= nwg) return false;
        int wgid = (int)L; { const int q = nwg / NXCD, r = nwg % NXCD, xcd = wgid % NXCD, off = wgid / NXCD; wgid = (xcd < r ? xcd * (q + 1) : r * (q + 1) + (xcd - r) * q) + off; }
        const int nig = WGM * nN, gid = wgid / nig, fm = gid * WGM, gsz = (nM - fm) < WGM ? (nM - fm) : WGM;
        u.pm = fm + ((wgid % nig) % gsz); u.pn = (wgid % nig) / gsz; u.e = 0; return true;
    }
    __device__ __forceinline__ int arow(const Unit&, int) const { return 0; }
};
struct MoeOrder {
    const LAS int* tsum; const LAS int* cnt; const int* list; int nN, G, c, total; mutable int ehint;
    __device__ bool next(int i, Unit& u) const {
        const int L = i * G + (c & 7) * (G >> 3) + (c >> 3); if (L >= total) return false;
        const int tile = L / nN; u.pn = L - tile * nN;
        int e = ehint; while (tile >= tsum[e + 1]) ++e;
        ehint = e; u.e = e; u.pm = tile; return true;
    }
    __device__ __forceinline__ int arow(const Unit& u, int r) const {
        int p = (u.pm - tsum[u.e]) * BM + r; const int c_ = cnt[u.e]; p = p < c_ ? p : c_ - 1; return list[(size_t)u.e * ECAP + p];
    }
};

using ::cvt_pk_bf16;

struct EpiBf16S {
    typedef f32x4 AccT; static constexpr int SEC = 50;
    static constexpr bool PERM = true;
    bf16* O; int ldc; int scale_cols; float scale0;
    __device__ __forceinline__ void operator()(const f32x4 (&acc)[2][2][4][2], const Unit& u, int wr, int wc, int fr, int fq) const {
        const int row0 = u.pm * BM + wr * 64 + fr, col0 = u.pn * BM + wc * 32 + 8 * fq; const float sc = (u.pn * BM < scale_cols) ? scale0 : 1.f;
#pragma unroll
        for (int ai = 0; ai < 2; ++ai)
#pragma unroll
            for (int m = 0; m < 4; ++m) { bf16* rowp = O + (size_t)(row0 + ai * HALF + m * 16) * ldc + col0;
#pragma unroll
                for (int bj = 0; bj < 2; ++bj) { const f32x4 v0 = acc[ai][bj][m][0] * sc, v1 = acc[ai][bj][m][1] * sc;
                    u32x4 w; w.x = cvt_pk_bf16(v0[0], v0[1]); w.y = cvt_pk_bf16(v0[2], v0[3]); w.z = cvt_pk_bf16(v1[0], v1[1]); w.w = cvt_pk_bf16(v1[2], v1[3]);
                    *(GAS u32x4*)(rowp + bj * HALF) = w; } }
    }
};
template <bool IN_BF16>
struct EpiResid {
    typedef f32x4 AccT; static constexpr int SEC = 40;
    static constexpr bool PERM = true;
    const void* xin; bf16* out; const float* gate;
    __device__ __forceinline__ void operator()(const f32x4 (&acc)[2][2][4][2], const Unit& u, int wr, int wc, int fr, int fq) const {
        const int row0 = u.pm * BM + wr * 64 + fr, b = u.pm >> 3, col0 = u.pn * BM + wc * 32 + 8 * fq;
#pragma unroll
        for (int bj = 0; bj < 2; ++bj) { const int c = col0 + bj * HALF; const GAS f32x4* gp = (const GAS f32x4*)(gate + (size_t)b * 6144 + c); const f32x4 g0 = gp[0], g1 = gp[1];
#pragma unroll
            for (int ai = 0; ai < 2; ++ai)
#pragma unroll
                for (int m = 0; m < 4; ++m) { const size_t o = (size_t)(row0 + ai * HALF + m * 16) * DM + c; f32x4 x0, x1;
                    if constexpr (IN_BF16) { const u32x4 w = *(const GAS u32x4*)((const bf16*)xin + o); x0 = (f32x4){bflo(w.x), bfhi(w.x), bflo(w.y), bfhi(w.y)}; x1 = (f32x4){bflo(w.z), bfhi(w.z), bflo(w.w), bfhi(w.w)}; }
                    else { const GAS f32x4* xp = (const GAS f32x4*)((const float*)xin + o); x0 = xp[0]; x1 = xp[1]; }
                    const f32x4 r0 = x0 + g0 * acc[ai][bj][m][0], r1 = x1 + g1 * acc[ai][bj][m][1];
                    *(GAS u32x4*)(out + o) = (u32x4){cvt_pk_bf16(r0[0], r0[1]), cvt_pk_bf16(r0[2], r0[3]), cvt_pk_bf16(r1[0], r1[1]), cvt_pk_bf16(r1[2], r1[3])}; } }
    }
};

__device__ __forceinline__ float swiglu1(float g, float u) {
    g = fminf(g, 7.0f); u = fminf(fmaxf(u, -7.0f), 7.0f);
    const float e = __builtin_amdgcn_exp2f(g * (-1.702f * LOG2E));
    return (u + 1.0f) * g * __builtin_amdgcn_rcpf(1.0f + e);
}
__device__ __forceinline__ f32x2 swiglu_pk(f32x2 g, f32x2 u) {
    g.x = fminf(g.x, 7.0f); g.y = fminf(g.y, 7.0f); u.x = __builtin_amdgcn_fmed3f(u.x, -6.0f, 8.0f); u.y = __builtin_amdgcn_fmed3f(u.y, -6.0f, 8.0f);
    const f32x2 t = g * (-1.702f * LOG2E);
    f32x2 e; e.x = __builtin_amdgcn_exp2f(t.x); e.y = __builtin_amdgcn_exp2f(t.y);
    const f32x2 d = e * (1.0f / ACT_PRESCALE) + (1.0f / ACT_PRESCALE);
    f32x2 r; r.x = __builtin_amdgcn_rcpf(d.x); r.y = __builtin_amdgcn_rcpf(d.y);
    return u * (g * r);
}
struct EpiSwiglu {
    typedef f32x4 AccT; static constexpr int SEC = 60;
    static constexpr bool PERM = true;
    bf16* ACT; const float* bgu;
    __device__ __forceinline__ void operator()(const f32x4 (&acc)[2][2][4][2], const Unit& u, int wr, int wc, int fr, int fq) const {
        const int row0 = u.pm * BM + wr * 64 + fr, jl0 = wc * 32 + 8 * fq, colA = u.pn * HALF + jl0;
        const GAS f32x4* bp = (const GAS f32x4*)(bgu + (size_t)u.e * 2048 + 2 * (u.pn * HALF + jl0));
        const f32x4 b0 = bp[0], b1 = bp[1], b2 = bp[2], b3 = bp[3];
        const f32x4 bg[2] = {(f32x4){b0[0], b0[2], b1[0], b1[2]}, (f32x4){b2[0], b2[2], b3[0], b3[2]}};
        const f32x4 bu[2] = {(f32x4){b0[1], b0[3], b1[1], b1[3]}, (f32x4){b2[1], b2[3], b3[1], b3[3]}};
#pragma unroll
        for (int ai = 0; ai < 2; ++ai)
#pragma unroll
            for (int m = 0; m < 4; ++m) { float o[8];
#pragma unroll
                for (int n = 0; n < 2; ++n) { const f32x4 g4 = acc[ai][0][m][n] + bg[n], u4 = acc[ai][1][m][n] + bu[n];
#pragma unroll
                    for (int i = 0; i < 4; ++i) o[4 * n + i] = swiglu1(g4[i], u4[i]); }
                u32x4 w; w.x = cvt_pk_bf16(o[0], o[1]); w.y = cvt_pk_bf16(o[2], o[3]); w.z = cvt_pk_bf16(o[4], o[5]); w.w = cvt_pk_bf16(o[6], o[7]);
                *(GAS u32x4*)(ACT + (size_t)(row0 + ai * HALF + m * 16) * DM + colA) = w; }
    }
};
struct EpiDown {
    typedef f32x4 AccT; static constexpr int SEC = 20;
    static constexpr bool PERM = true;
    bf16* Y; const float* bd; const float* gate_e; const LAS int* tsum;
    __device__ __forceinline__ void operator()(const f32x4 (&acc)[2][2][4][2], const Unit& u, int wr, int wc, int fr, int fq) const {
        const int row0 = u.pm * BM + wr * 64 + fr, col0 = u.pn * BM + wc * 32 + 8 * fq, lrow0 = (u.pm - tsum[u.e]) * BM + wr * 64 + fr;
        f32x4 bv[2][2];
#pragma unroll
        for (int bj = 0; bj < 2; ++bj)
#pragma unroll
            for (int n = 0; n < 2; ++n) bv[bj][n] = *(const GAS f32x4*)(bd + (size_t)u.e * DM + col0 + bj * HALF + 4 * n);
#pragma unroll
        for (int ai = 0; ai < 2; ++ai)
#pragma unroll
            for (int m = 0; m < 4; ++m) { const float gt = gate_e[(size_t)u.e * ECAP + lrow0 + ai * HALF + m * 16]; bf16* rowp = Y + (size_t)(row0 + ai * HALF + m * 16) * DM + col0;
#pragma unroll
                for (int bj = 0; bj < 2; ++bj) { const f32x4 v0 = (acc[ai][bj][m][0] + bv[bj][0]) * gt, v1 = (acc[ai][bj][m][1] + bv[bj][1]) * gt;
                    u32x4 w; w.x = cvt_pk_bf16(v0[0], v0[1]); w.y = cvt_pk_bf16(v0[2], v0[3]); w.z = cvt_pk_bf16(v1[0], v1[1]); w.w = cvt_pk_bf16(v1[2], v1[3]);
                    *(GAS u32x4*)(rowp + bj * HALF) = w; } }
    }
};
struct EpiDownF8 {
    typedef f32x4 AccT; static constexpr int SEC = 22;
    static constexpr bool PERM = true;
    unsigned char* Y; const float* bd; const float* gate_e; const LAS int* tsum; const float* wsd;
    __device__ __forceinline__ void operator()(const f32x4 (&acc)[2][2][4][2], const Unit& u, int wr, int wc, int fr, int fq) const {
        const int row0 = u.pm * BM + wr * 64 + fr, col0 = u.pn * BM + wc * 32 + 8 * fq, lrow0 = (u.pm - tsum[u.e]) * BM + wr * 64 + fr;
        float gt[2][4];
#pragma unroll
        for (int ai = 0; ai < 2; ++ai)
#pragma unroll
            for (int m = 0; m < 4; ++m) gt[ai][m] = gate_e[(size_t)u.e * ECAP + lrow0 + ai * HALF + m * 16] * Y_PRESCALE;
#pragma unroll
        for (int bj = 0; bj < 2; ++bj) {
            const GAS f32x4* bp = (const GAS f32x4*)(bd + (size_t)u.e * DM + col0 + bj * HALF); const GAS f32x4* sp = (const GAS f32x4*)(wsd + (size_t)u.e * DM + col0 + bj * HALF);
            const f32x4 b0 = bp[0], b1 = bp[1], s0 = sp[0] * (1.0f / ACT_PRESCALE), s1 = sp[1] * (1.0f / ACT_PRESCALE);
#pragma unroll
            for (int ai = 0; ai < 2; ++ai)
#pragma unroll
                for (int m = 0; m < 4; ++m) { const f32x4 a0 = acc[ai][bj][m][0], a1 = acc[ai][bj][m][1]; const float g4 = gt[ai][m];
                    const f32x2 p0 = ((f32x2){a0[0], a0[1]} * (f32x2){s0[0], s0[1]} + (f32x2){b0[0], b0[1]}) * g4, p1 = ((f32x2){a0[2], a0[3]} * (f32x2){s0[2], s0[3]} + (f32x2){b0[2], b0[3]}) * g4;
                    const f32x2 p2 = ((f32x2){a1[0], a1[1]} * (f32x2){s1[0], s1[1]} + (f32x2){b1[0], b1[1]}) * g4, p3 = ((f32x2){a1[2], a1[3]} * (f32x2){s1[2], s1[3]} + (f32x2){b1[2], b1[3]}) * g4;
#define MK_CL(x) __builtin_amdgcn_fmed3f((x), -448.f, 448.f)
                    unsigned w0 = 0u, w1 = 0u;
                    w0 = __builtin_amdgcn_cvt_pk_fp8_f32(MK_CL(p0.x), MK_CL(p0.y), w0, false); w0 = __builtin_amdgcn_cvt_pk_fp8_f32(MK_CL(p1.x), MK_CL(p1.y), w0, true);
                    w1 = __builtin_amdgcn_cvt_pk_fp8_f32(MK_CL(p2.x), MK_CL(p2.y), w1, false); w1 = __builtin_amdgcn_cvt_pk_fp8_f32(MK_CL(p3.x), MK_CL(p3.y), w1, true);
#undef MK_CL
                    *(GAS u32x2*)(Y + (size_t)(row0 + ai * HALF + m * 16) * DM + col0 + bj * HALF) = (u32x2){w0, w1}; }
        }
    }
};


typedef int i32x4e __attribute__((ext_vector_type(4)));
__device__ __forceinline__ f32x4 cvt4(const i32x4e v) { return (f32x4){(float)v[0], (float)v[1], (float)v[2], (float)v[3]}; }
struct EpiBf16S8 {   static constexpr int SEC = 30;
    typedef i32x4e AccT;
    static constexpr bool PERM = true;
    bf16* O; int ldc; int scale_cols; float scale0; const float* sa; const float* sb;
    __device__ __forceinline__ void operator()(const i32x4e (&acc)[2][2][4][2], const Unit& u, int wr, int wc, int fr, int fq) const {
        const int row0 = u.pm * BM + wr * 64 + fr, col0 = u.pn * BM + wc * 32 + 8 * fq; const float sc = (u.pn * BM < scale_cols) ? scale0 : 1.f;
        f32x4 bs[2][2];
#pragma unroll
        for (int bj = 0; bj < 2; ++bj)
#pragma unroll
            for (int n = 0; n < 2; ++n) bs[bj][n] = *(const GAS f32x4*)(sb + col0 + bj * HALF + 4 * n) * sc;
#pragma unroll
        for (int ai = 0; ai < 2; ++ai)
#pragma unroll
            for (int m = 0; m < 4; ++m) { const int r = row0 + ai * HALF + m * 16; const float ra = sa[r]; bf16* rowp = O + (size_t)r * ldc + col0;
#pragma unroll
                for (int bj = 0; bj < 2; ++bj) { const f32x4 v0 = cvt4(acc[ai][bj][m][0]) * bs[bj][0] * ra, v1 = cvt4(acc[ai][bj][m][1]) * bs[bj][1] * ra;
                    u32x4 w; w.x = cvt_pk_bf16(v0[0], v0[1]); w.y = cvt_pk_bf16(v0[2], v0[3]); w.z = cvt_pk_bf16(v1[0], v1[1]); w.w = cvt_pk_bf16(v1[2], v1[3]);
                    *(GAS u32x4*)(rowp + bj * HALF) = w; } }
    }
};
struct EpiSwiglu8 {   static constexpr int SEC = 10;
    typedef i32x4e AccT;
    static constexpr bool PERM = true;
    unsigned char* ACT; const float* bgu; const float* hs; const float* ws  ; const MoeOrder* S;
    __device__ __forceinline__ void operator()(const i32x4e (&acc)[2][2][4][2], const Unit& u, int wr, int wc, int fr, int fq) const {
        const int row0 = u.pm * BM + wr * 64 + fr, jl0 = wc * 32 + 8 * fq, colA = u.pn * HALF + jl0, lrow0 = (u.pm - S->tsum[u.e]) * BM + wr * 64 + fr;
        const GAS f32x4* bp = (const GAS f32x4*)(bgu + (size_t)u.e * 2048 + 2 * (u.pn * HALF + jl0));
        const f32x4 b0 = bp[0], b1 = bp[1], b2 = bp[2], b3 = bp[3];
        const f32x4 bg[2] = {(f32x4){b0[0], b0[2], b1[0], b1[2]}, (f32x4){b2[0], b2[2], b3[0], b3[2]}};
        const f32x4 bu[2] = {(f32x4){b0[1], b0[3], b1[1], b1[3]} + 1.0f, (f32x4){b2[1], b2[3], b3[1], b3[3]} + 1.0f};
        const GAS f32x4* wp = (const GAS f32x4*)(ws + (size_t)u.e * 2048 + u.pn * BM + jl0);
        const f32x4 wg[2] = {wp[0], wp[1]}, wu[2] = {wp[32], wp[33]};
#pragma unroll
        for (int ai = 0; ai < 2; ++ai)
#pragma unroll
            for (int m = 0; m < 4; ++m) { const float ra = hs[(size_t)u.e * ECAP + lrow0 + ai * HALF + m * 16]; f32x2 o[4];
#pragma unroll
                for (int n = 0; n < 2; ++n)
#pragma unroll
                    for (int h = 0; h < 2; ++h) { const i32x4e ag = acc[ai][0][m][n], au = acc[ai][1][m][n];
                        const f32x2 cg = {(float)ag[2 * h], (float)ag[2 * h + 1]}, cu = {(float)au[2 * h], (float)au[2 * h + 1]};
                        const f32x2 wgp = {wg[n][2 * h], wg[n][2 * h + 1]}, wup = {wu[n][2 * h], wu[n][2 * h + 1]}, bgp = {bg[n][2 * h], bg[n][2 * h + 1]}, bup = {bu[n][2 * h], bu[n][2 * h + 1]};
                        o[2 * n + h] = swiglu_pk((cg * wgp) * ra + bgp, (cu * wup) * ra + bup); }
                unsigned w0 = 0u, w1 = 0u;
                w0 = __builtin_amdgcn_cvt_pk_fp8_f32(o[0].x, o[0].y, w0, false); w0 = __builtin_amdgcn_cvt_pk_fp8_f32(o[1].x, o[1].y, w0, true);
                w1 = __builtin_amdgcn_cvt_pk_fp8_f32(o[2].x, o[2].y, w1, false); w1 = __builtin_amdgcn_cvt_pk_fp8_f32(o[3].x, o[3].y, w1, true);
                *(GAS u32x2*)(ACT + (size_t)(row0 + ai * HALF + m * 16) * DM + colA) = (u32x2){w0, w1}; }
    }
};
typedef int i32x4 __attribute__((ext_vector_type(4)));
typedef int i32x8 __attribute__((ext_vector_type(8)));
template <class Epi, class Sched, bool GATHER, bool ALIGN_EPI, int MODE = 0>
__device__ __forceinline__ void gemm_phase(LAS unsigned char* lds, const Gemm g, const Sched& S, const Epi& E) {
    const int tid = threadIdx.x, wid = __builtin_amdgcn_readfirstlane(tid >> 6), lane = tid & 63, wr = wid >> 2, wc = wid & 3, fr = lane & 15, fq = lane >> 4;
    constexpr int ESZ = MODE ? 1 : 2; constexpr bool INT8 = (MODE == 1);
    const int K = g.K, KB = K * ESZ  , nt = KB / (BK * 2);
    int Rr[2], Cc[2]; unsigned voffB[2];
#pragma unroll
    for (int i = 0; i < 2; ++i) { stage_rc(tid * 16 + i * 8192, Rr[i], Cc[i]); const int Rb = Epi::PERM ? ((Rr[i] & ~31) + perm32(Rr[i] & 31)) : Rr[i]; voffB[i] = (unsigned)(Rb * KB + Cc[i] * 2); }
    const size_t kstep = (size_t)(BK * 2), hstep = (size_t)HALF * KB, tstep = 2 * hstep;
    const unsigned ldsw = (unsigned)wid * 1024u;
    const int aoff = lds_byte(wr * 64 + fr, fq * 8), boff = lds_byte(wc * 32 + fr, fq * 8);
#define PG8_SA(b, h) (((b) * 2 + (h)) * HTB)
#define PG8_SB(b, h) ((4 + (b) * 2 + (h)) * HTB)
#define PG8_STAGE(bufoff, gbase, voff) do { _Pragma("unroll") for (int _i = 0; _i < 2; ++_i) \
        __builtin_amdgcn_global_load_lds((const GAS unsigned*)((const char*)(gbase) + (voff)[_i]), (LAS unsigned*)(lds + (bufoff) + ldsw + _i * 8192), 16, 0, 0); } while (0)
#define PG8_RD(off) (*(const LAS i32x4*)(lds + (off)))
#define PG8_LDA(dst, b, h) do { _Pragma("unroll") for (int m = 0; m < 4; ++m) { const i32x4 r0_ = PG8_RD(PG8_SA(b, h) + aoff + m * 2048), r1_ = PG8_RD(PG8_SA(b, h) + aoff + m * 2048 + 1024); \
        if constexpr (MODE == 2) dst##8[m] = __builtin_shufflevector(r0_, r1_, 0, 1, 2, 3, 4, 5, 6, 7); else { dst[m][0] = __builtin_bit_cast(bf16x8, r0_); dst[m][1] = __builtin_bit_cast(bf16x8, r1_); } } } while (0)
#define PG8_LDB(dst, b, h) do { _Pragma("unroll") for (int n = 0; n < 2; ++n) { const i32x4 r0_ = PG8_RD(PG8_SB(b, h) + boff + n * 2048), r1_ = PG8_RD(PG8_SB(b, h) + boff + n * 2048 + 1024); \
        if constexpr (MODE == 2) dst##8[n] = __builtin_shufflevector(r0_, r1_, 0, 1, 2, 3, 4, 5, 6, 7); else { dst[n][0] = __builtin_bit_cast(bf16x8, r0_); dst[n][1] = __builtin_bit_cast(bf16x8, r1_); } } } while (0)
#define PG8_CAT(lo, hi) __builtin_shufflevector(__builtin_bit_cast(i32x4, lo), __builtin_bit_cast(i32x4, hi), 0, 1, 2, 3, 4, 5, 6, 7)
#define PG8_MMA(ai, bj, At, Bt) do { __builtin_amdgcn_s_setprio(1); _Pragma("unroll") for (int m = 0; m < 4; ++m) _Pragma("unroll") for (int n = 0; n < 2; ++n) _Pragma("unroll") for (int k = 0; k < 2; ++k) { \
        if constexpr (MODE == 2) { if (k == 0) asm volatile("v_mfma_scale_f32_16x16x128_f8f6f4 %0, %1, %2, %0, %3, %3 op_sel_hi:[0,0,0]" : "+v"(acc[ai][bj][m][n]) : "v"(Bt##8[n]), "v"(At##8[m]), "v"(f8scale)); } \
        else if constexpr (INT8) acc[ai][bj][m][n] = __builtin_bit_cast(AccT, __builtin_amdgcn_mfma_i32_16x16x64_i8(__builtin_bit_cast(i32x4, Bt[n][k]), __builtin_bit_cast(i32x4, At[m][k]), __builtin_bit_cast(i32x4, acc[ai][bj][m][n]), 0, 0, 0)); \
        else acc[ai][bj][m][n] = __builtin_bit_cast(AccT, __builtin_amdgcn_mfma_f32_16x16x32_bf16(Bt[n][k], At[m][k], __builtin_bit_cast(f32x4, acc[ai][bj][m][n]), 0, 0, 0)); } __builtin_amdgcn_s_setprio(0); } while (0)
#define PG8_WAIT_V(n) asm volatile("s_waitcnt vmcnt(" #n ")" ::: "memory")
#define PG8_WAIT_L(n) asm volatile("s_waitcnt lgkmcnt(" #n ")" ::: "memory")
#define PG8_BAR __builtin_amdgcn_s_barrier()
#define PG8_SCHED __builtin_amdgcn_sched_barrier(0)
    Unit cur, nxt; int ui = 0;
    if (!S.next(0, cur)) return;
    typedef typename Epi::AccT AccT;
    AccT acc[2][2][4][2];
#pragma unroll
    for (int a = 0; a < 2; ++a)
#pragma unroll
        for (int b = 0; b < 2; ++b)
#pragma unroll
            for (int m = 0; m < 4; ++m)
#pragma unroll
                for (int n = 0; n < 2; ++n) acc[a][b][m][n] = AccT{};
    const int f8scale = 0x7F7F7F7F;
    bf16x8 At[4][2], B0[2][2], B1[2][2]; i32x8 At8[4], B08[2], B18[2];
    unsigned vA0[2], vA1[2];
#pragma unroll
    for (int i = 0; i < 2; ++i) {
        if constexpr (GATHER) { vA0[i] = (unsigned)(S.arow(cur, Rr[i]) * KB + Cc[i] * 2); vA1[i] = (unsigned)(S.arow(cur, HALF + Rr[i]) * KB + Cc[i] * 2); }
        else { vA0[i] = (unsigned)(Rr[i] * KB + Cc[i] * 2); vA1[i] = vA0[i] + (unsigned)hstep; }
    }
    const char* cA = GATHER ? (const char*)g.A : (const char*)g.A + (size_t)cur.pm * tstep;
    const char* cB = (const char*)g.Bt + (size_t)cur.e * g.bstride + (size_t)cur.pn * tstep;
    PG8_STAGE(PG8_SB(0, 0), cB, voffB); PG8_STAGE(PG8_SB(0, 1), cB + hstep, voffB); PG8_STAGE(PG8_SA(0, 0), cA, vA0); PG8_STAGE(PG8_SA(0, 1), cA, vA1);
    if (wr == 1) PG8_BAR;
    PG8_WAIT_V(2); PG8_BAR;
    PG8_STAGE(PG8_SB(1, 0), cB + kstep, voffB); PG8_STAGE(PG8_SA(1, 0), cA + kstep, vA0); PG8_STAGE(PG8_SB(1, 1), cB + hstep + kstep, voffB);
    PG8_WAIT_V(6); PG8_BAR;
    for (;;) {
        const bool has_next = S.next(ui + 1, nxt);
        const char* nA = has_next ? (GATHER ? (const char*)g.A : (const char*)g.A + (size_t)nxt.pm * tstep) : cA;
        const char* nB = has_next ? (const char*)g.Bt + (size_t)nxt.e * g.bstride + (size_t)nxt.pn * tstep : cB;
        int nr0[2] = {0, 0}, nr1[2] = {0, 0};
        if constexpr (GATHER) { if (has_next) {
#pragma unroll
            for (int i = 0; i < 2; ++i) { nr0[i] = S.arow(nxt, Rr[i]); nr1[i] = S.arow(nxt, HALF + Rr[i]); } } }
        SEC_BEGIN2(Epi::SEC);
        for (int t = 0; t < nt; t += 2) {
            const bool last = (t == nt - 2);
            const char* a1 = cA + (size_t)(t + 1) * kstep;
            const char* a2 = last ? nA : cA + (size_t)(t + 2) * kstep; const char* b2 = last ? nB : cB + (size_t)(t + 2) * kstep;
            const char* a3 = a2 + kstep; const char* b3 = b2 + kstep;
            if constexpr (GATHER) { if (last && has_next) {
                asm volatile("" : "+v"(nr0[0]), "+v"(nr0[1]), "+v"(nr1[0]), "+v"(nr1[1]));
#pragma unroll
                for (int i = 0; i < 2; ++i) { vA0[i] = (unsigned)(nr0[i] * KB + Cc[i] * 2); nr1[i] = (int)(unsigned)(nr1[i] * KB + Cc[i] * 2); } } }
            unsigned w0[2], w1[2];
#pragma unroll
            for (int i = 0; i < 2; ++i) { w0[i] = vA0[i]; w1[i] = (GATHER && last && has_next) ? (unsigned)nr1[i] : vA1[i]; }
            PG8_LDB(B0, 0, 0); PG8_LDB(B1, 0, 1); PG8_SCHED; PG8_LDA(At, 0, 0); PG8_STAGE(PG8_SA(1, 1), a1, vA1);
            PG8_WAIT_V(8); PG8_WAIT_L(0); PG8_BAR; PG8_MMA(0, 0, At, B0); PG8_MMA(0, 1, At, B1); PG8_BAR; PG8_SCHED;
            PG8_LDA(At, 0, 1); PG8_STAGE(PG8_SB(0, 0), b2, voffB); PG8_STAGE(PG8_SB(0, 1), b2 + hstep, voffB); PG8_STAGE(PG8_SA(0, 0), a2, w0);
            PG8_WAIT_V(8); PG8_WAIT_L(0); PG8_BAR; PG8_MMA(1, 0, At, B0); PG8_MMA(1, 1, At, B1); PG8_BAR; PG8_SCHED;
            PG8_LDB(B0, 1, 0); PG8_LDB(B1, 1, 1); PG8_SCHED; PG8_LDA(At, 1, 0); PG8_STAGE(PG8_SA(0, 1), a2, w1);
            PG8_WAIT_V(8); PG8_WAIT_L(0); PG8_BAR; PG8_MMA(0, 0, At, B0); PG8_MMA(0, 1, At, B1); PG8_BAR; PG8_SCHED;
            PG8_LDA(At, 1, 1); PG8_STAGE(PG8_SB(1, 0), b3, voffB); PG8_STAGE(PG8_SB(1, 1), b3 + hstep, voffB); PG8_STAGE(PG8_SA(1, 0), a3, w0);
            PG8_WAIT_V(8); PG8_WAIT_L(0); PG8_BAR; PG8_MMA(1, 0, At, B0); PG8_MMA(1, 1, At, B1); PG8_BAR; PG8_SCHED;
        }
        if constexpr (ALIGN_EPI) { if (wr == 0) PG8_BAR; }
        SEC_END2(Epi::SEC);
        SEC_BEGIN3(Epi::SEC + 1);
        if constexpr (MODE == 2) {
            asm volatile("s_nop 15\n\ts_nop 15" : "+v"(acc[0][0][0][0]), "+v"(acc[0][0][0][1]), "+v"(acc[0][0][1][0]), "+v"(acc[0][0][1][1]), "+v"(acc[0][0][2][0]), "+v"(acc[0][0][2][1]), "+v"(acc[0][0][3][0]), "+v"(acc[0][0][3][1]),
                         "+v"(acc[0][1][0][0]), "+v"(acc[0][1][0][1]), "+v"(acc[0][1][1][0]), "+v"(acc[0][1][1][1]), "+v"(acc[0][1][2][0]), "+v"(acc[0][1][2][1]), "+v"(acc[0][1][3][0]), "+v"(acc[0][1][3][1]) :: "memory");
            asm volatile("" : "+v"(acc[1][0][0][0]), "+v"(acc[1][0][0][1]), "+v"(acc[1][0][1][0]), "+v"(acc[1][0][1][1]), "+v"(acc[1][0][2][0]), "+v"(acc[1][0][2][1]), "+v"(acc[1][0][3][0]), "+v"(acc[1][0][3][1]),
                         "+v"(acc[1][1][0][0]), "+v"(acc[1][1][0][1]), "+v"(acc[1][1][1][0]), "+v"(acc[1][1][1][1]), "+v"(acc[1][1][2][0]), "+v"(acc[1][1][2][1]), "+v"(acc[1][1][3][0]), "+v"(acc[1][1][3][1]) :: "memory");
        }
        E(acc, cur, wr, wc, fr, fq);
        SEC_END3(Epi::SEC + 1);
        if (!has_next) break;
#pragma unroll
        for (int a = 0; a < 2; ++a)
#pragma unroll
            for (int b = 0; b < 2; ++b)
#pragma unroll
                for (int m = 0; m < 4; ++m)
#pragma unroll
                    for (int n = 0; n < 2; ++n) acc[a][b][m][n] = AccT{};
        cur = nxt; cA = nA; cB = nB; ++ui;
        if constexpr (GATHER) {
#pragma unroll
            for (int i = 0; i < 2; ++i) vA1[i] = (unsigned)nr1[i]; }
        if constexpr (ALIGN_EPI) { if (wr == 1) PG8_BAR; }
    }
    PG8_WAIT_V(0);
    if constexpr (!ALIGN_EPI) { if (wr == 0) PG8_BAR; }
    PG8_BAR;
#undef PG8_SA
#undef PG8_SB
#undef PG8_STAGE
#undef PG8_LDA
#undef PG8_RD
#undef PG8_LDB
#undef PG8_MMA
#undef PG8_CAT
#undef PG8_WAIT_V
#undef PG8_WAIT_L
#undef PG8_BAR
#undef PG8_SCHED
}
}

#define XB_TMO      128
#define XB_XCNT(j)  (256  + 64 * (j))
#define XB_XSUB(j)  (1280 + 64 * (j))
#define XB_XGEN(j)  (2304 + 64 * (j))
#define XB_TOP      3328
#define XB_TOPGEN   3392
#define XCD_BAR_WORDS 3456
#define XB_SPIN_CAP (1u << 22)
__device__ __forceinline__ unsigned xb_ld(unsigned* p)              { return __hip_atomic_load(p, __ATOMIC_RELAXED, __HIP_MEMORY_SCOPE_AGENT); }
__device__ __forceinline__ unsigned xb_add(unsigned* p, unsigned v) { return __hip_atomic_fetch_add(p, v, __ATOMIC_RELAXED, __HIP_MEMORY_SCOPE_AGENT); }
__device__ __forceinline__ unsigned xb_xcc_id() { return (unsigned)__builtin_amdgcn_s_getreg((3 << 11) | 20) & 0xFu; }
#define XB_SPIN(cond, bar) do { unsigned _sp = 0; while (cond) { __builtin_amdgcn_s_sleep(1); \
    if ((++_sp & 255u) == 0u) { if (xb_ld(&(bar)[XB_TMO])) break; if (_sp > XB_SPIN_CAP) { atomicAdd(&(bar)[XB_TMO], 1u); break; } } } } while (0)
struct XcdBarrier { unsigned* bar; unsigned x; volatile LAS unsigned* st; };
__device__ __forceinline__ XcdBarrier xcd_barrier_post(unsigned* bar, volatile LAS unsigned* st) {
    XcdBarrier b; b.bar = bar; b.x = xb_xcc_id(); b.st = st;
    if (threadIdx.x == 0) (void)xb_add(&bar[XB_XCNT(b.x)], 1u);
    return b;
}
__device__ __forceinline__ void xcd_barrier_complete(unsigned* bar, unsigned x, unsigned& nloc, unsigned& nx) {
    const unsigned G = gridDim.x * gridDim.y * gridDim.z;
    unsigned sum, cnt, mine, sp = 0u;
    for (;;) {
        sum = 0u; cnt = 0u; mine = 0u;
#pragma unroll
        for (unsigned j = 0; j < 16; ++j) { const unsigned c = xb_ld(&bar[XB_XCNT(j)]); sum += c; cnt += (c > 0u) ? 1u : 0u; mine = (j == x) ? c : mine; }
        if (sum == G) break;
        __builtin_amdgcn_s_sleep(1);
        if ((++sp & 255u) == 0u) { if (xb_ld(&bar[XB_TMO])) break; if (sp > XB_SPIN_CAP) { atomicAdd(&bar[XB_TMO], 1u); break; } }
    }
    nloc = mine > 0u ? mine : 1u; nx = cnt > 0u ? cnt : 1u;
}
__device__ __forceinline__ void xcd_barrier(const XcdBarrier& b) {
    asm volatile("s_waitcnt vmcnt(0)" ::: "memory");
    __syncthreads();
    if (threadIdx.x == 0) {
        unsigned* bar = b.bar;
        __builtin_amdgcn_s_waitcnt(0);
        unsigned nloc = b.st[0], nx = b.st[1];
        if (nloc == 0u) { xcd_barrier_complete(bar, b.x, nloc, nx); b.st[0] = nloc; b.st[1] = nx; }
        const unsigned old = xb_add(&bar[XB_XSUB(b.x)], 1u);
        const unsigned gen = old / nloc;
        if (old + 1u == (gen + 1u) * nloc) {
            __builtin_amdgcn_fence(__ATOMIC_RELEASE, "agent");
            asm volatile("s_waitcnt vmcnt(0)" ::: "memory");
            const unsigned og = xb_add(&bar[XB_TOP], 1u);
            const unsigned tg = og / nx;
            if (og + 1u == (tg + 1u) * nx) xb_add(&bar[XB_TOPGEN], 1u);
            else XB_SPIN(xb_ld(&bar[XB_TOPGEN]) == tg, bar);
            __builtin_amdgcn_fence(__ATOMIC_ACQUIRE, "agent");
            xb_add(&bar[XB_XGEN(b.x)], 1u);
            asm volatile("s_waitcnt vmcnt(0)" ::: "memory");
        } else {
            XB_SPIN(xb_ld(&bar[XB_XGEN(b.x)]) == gen, bar);
            __builtin_amdgcn_fence(__ATOMIC_ACQUIRE, "agent");
            asm volatile("s_waitcnt vmcnt(0)" ::: "memory");
        }
    }
    __syncthreads();
}


#if defined(PROBE_SEC)
#define SEC_BEGIN(tag) unsigned long long _sec_t0_##tag = ((tag) == PROBE_SEC) ? __builtin_amdgcn_s_memrealtime() : 0ull
#define SEC_END(tag) do { if ((tag) == PROBE_SEC && blockIdx.x == 0 && threadIdx.x == 0) { volatile LAS unsigned long long* _acc = (volatile LAS unsigned long long*)(X.lds + LDSCTL_OFF + 64); *_acc = *_acc + (__builtin_amdgcn_s_memrealtime() - _sec_t0_##tag); } } while (0)
#else
#define SEC_BEGIN(tag) do {} while (0)
#define SEC_END(tag) do {} while (0)
#endif
struct Ctx { LAS unsigned char* lds; int tid, lane, wave, G, vcu, gw, NGW; };

__device__ __forceinline__ void p0_transpose_item(const float* W, int Nsrc, int Ndst, int mode, bf16* WT, LAS float* scr, int item, int lane) {
    const int nblk = Ndst / 32, kb = item / nblk, nb = item - kb * nblk, k0 = 64 * kb, n0 = 32 * nb;
    const int nd = n0 + (lane & 31);
    const int sc = mode ? (2 * (128 * (nd >> 8) + (nd & 127)) + ((nd >> 7) & 1)) : nd;
    const bool ok = sc < Nsrc;
    const GAS float* Wg = (const GAS float*)W;
#pragma unroll 8
    for (int i = 0; i < 32; ++i) { const int kk = 2 * i + (lane >> 5); scr[kk * 33 + (lane & 31)] = ok ? Wg[(size_t)(k0 + kk) * Nsrc + sc] : 0.f; }
    LDS_WAIT(); asm volatile("" ::: "memory");
    const int c = lane & 7;
#pragma unroll
    for (int j = 0; j < 4; ++j) { const int n = (lane >> 3) + 8 * j; const LAS float* s = scr + (8 * c) * 33 + n;
        u32x4 o; o.x = pk2(s[0 * 33], s[1 * 33]); o.y = pk2(s[2 * 33], s[3 * 33]); o.z = pk2(s[4 * 33], s[5 * 33]); o.w = pk2(s[6 * 33], s[7 * 33]);
        *(GAS u32x4*)(WT + (size_t)(n0 + n) * DM + k0 + 8 * c) = o; }
    LDS_WAIT(); asm volatile("" ::: "memory");
}
struct P0Item { const float* W; int Nsrc, c0, mode, q; signed char* W8; float* wsc; };
__device__ __forceinline__ void p0_item_dma(const Ctx& X, const P0Item& d) {
    const int tid = X.tid, chunk = tid & 7; int sc = d.c0 + 4 * chunk; if (sc > d.Nsrc - 4) sc = d.Nsrc - 4;
    const GAS float* src = (const GAS float*)d.W + (size_t)(tid >> 3) * d.Nsrc + sc;
#pragma unroll
    for (int r = 0; r < 16; ++r) __builtin_amdgcn_global_load_lds((const GAS unsigned*)(src + (size_t)(64 * r) * d.Nsrc), (LAS unsigned*)(X.lds + r * 8192 + X.wave * 1024), 16, 0, 0);
}
template <int Q>
__device__ __forceinline__ void p0_item_process(const Ctx& X, const P0Item& d, const P0Item* next) {
    LAS float* T = (LAS float*)X.lds;
    LAS float* part = (LAS float*)(X.lds + EXTRA_OFF);
    const int tid = X.tid, col = tid & 31, kg = tid >> 5;
    WAITV(0); __syncthreads();
    const bool ok = (d.c0 + col) < d.Nsrc;
    float v[64]; float am = 0.f;
#pragma unroll
    for (int i = 0; i < 64; ++i) { v[i] = T[(kg * 64 + i) * 32 + col]; am = fmaxf(am, fabsf(v[i])); }
    part[kg * 32 + col] = ok ? am : 0.f;
    asm volatile("s_waitcnt lgkmcnt(0)" ::: "memory");
    __syncthreads();
    if (next) p0_item_dma(X, *next);
    const int cs = d.c0 + col, j = cs >> 1, nd = d.mode ? (256 * (j >> 7) + 128 * (cs & 1) + (j & 127)) : cs;
    if (tid < 32) { float a = 0.f;
#pragma unroll
        for (int g = 0; g < 16; ++g) a = fmaxf(a, part[g * 32 + tid]);
        constexpr float QMAX = (Q == 2) ? 384.0f : 127.0f; part[512 + tid] = a > 0.f ? QMAX / a : 0.f; d.wsc[nd] = a * (1.0f / QMAX); }
    __syncthreads();
    const float inv = part[512 + col];
    GAS u32x4* dst = (GAS u32x4*)(d.W8 + (size_t)nd * DM + kg * 64);
    if constexpr (Q == 2) {
#pragma unroll
        for (int q = 0; q < 4; ++q) { unsigned w[4];
#pragma unroll
            for (int e = 0; e < 4; ++e) { unsigned x = 0u; x = __builtin_amdgcn_cvt_pk_fp8_f32(v[16 * q + 4 * e] * inv, v[16 * q + 4 * e + 1] * inv, x, false); x = __builtin_amdgcn_cvt_pk_fp8_f32(v[16 * q + 4 * e + 2] * inv, v[16 * q + 4 * e + 3] * inv, x, true); w[e] = x; }
            dst[q] = (u32x4){w[0], w[1], w[2], w[3]}; }
    } else {
#pragma unroll
        for (int q = 0; q < 4; ++q) { u32x4 w;
            w.x = pack4i(rintf(v[16 * q + 0] * inv), rintf(v[16 * q + 1] * inv), rintf(v[16 * q + 2] * inv), rintf(v[16 * q + 3] * inv));
            w.y = pack4i(rintf(v[16 * q + 4] * inv), rintf(v[16 * q + 5] * inv), rintf(v[16 * q + 6] * inv), rintf(v[16 * q + 7] * inv));
            w.z = pack4i(rintf(v[16 * q + 8] * inv), rintf(v[16 * q + 9] * inv), rintf(v[16 * q + 10] * inv), rintf(v[16 * q + 11] * inv));
            w.w = pack4i(rintf(v[16 * q + 12] * inv), rintf(v[16 * q + 13] * inv), rintf(v[16 * q + 14] * inv), rintf(v[16 * q + 15] * inv));
            dst[q] = w; }
    }
    __syncthreads();
}
__device__ __forceinline__ void phase_prologue(const Ctx& X, const float* c_in, const float* ada_w, const float* ada_b, float* mod,
                                               const float* w_qkv, const float* w_o0, const float* w_in, const float* w_o1, const float* w_gu, const float* w_down,
                                               signed char* Wqkv8, bf16* Wo0_t, signed char* Win8, bf16* Wo1_t, signed char* Wgu8, bf16* Wd_t, float* wsc, unsigned* ada_flag, unsigned* item_ctr) {
    if (blockIdx.x < 192) {
        const int l = blockIdx.x / 96, j0 = (blockIdx.x % 96) * 64;
        LAS float* cs = (LAS float*)X.lds;
        for (int i = 0; i < 64; ++i) { const int idx = i * NTHREADS + X.tid, b = idx >> 10, k = idx & 1023; const float v = c_in[idx]; cs[k * 32 + b] = v / (1.0f + __expf(-v)); }
        __syncthreads();
        float acc[32];
#pragma unroll
        for (int b = 0; b < 32; ++b) acc[b] = 0.f;
        const GAS float* wp = (const GAS float*)ada_w + ((size_t)l * DM + X.wave * 128) * 6144 + j0 + X.lane;
#pragma unroll 4
        for (int k = 0; k < 128; ++k) { const float w = wp[(size_t)k * 6144]; const LAS f32x4* c4 = (const LAS f32x4*)(cs + (X.wave * 128 + k) * 32);
#pragma unroll
            for (int b4 = 0; b4 < 8; ++b4) { const f32x4 cv = c4[b4]; acc[4 * b4 + 0] += w * cv[0]; acc[4 * b4 + 1] += w * cv[1]; acc[4 * b4 + 2] += w * cv[2]; acc[4 * b4 + 3] += w * cv[3]; } }
        __syncthreads();
        LAS float* red = (LAS float*)X.lds;
#pragma unroll
        for (int b = 0; b < 32; ++b) red[(X.wave * 32 + b) * 64 + X.lane] = acc[b];
        __syncthreads();
        for (int i = 0; i < 4; ++i) { const int o = i * NTHREADS + X.tid, b = o >> 6, ln = o & 63; float s = 0.f;
#pragma unroll
            for (int w = 0; w < 8; ++w) s += red[(w * 32 + b) * 64 + ln];
            mod[((size_t)l * NB + b) * 6144 + j0 + ln] = s + ada_b[l * 6144 + j0 + ln]; }
        asm volatile("s_waitcnt vmcnt(0)" ::: "memory");
        __syncthreads();
        if (X.tid == 0) { __builtin_amdgcn_fence(__ATOMIC_RELEASE, "agent"); asm volatile("s_waitcnt vmcnt(0)" ::: "memory"); (void)xb_add(ada_flag, 1u); }
    }
    LAS float* scr = (LAS float*)(X.lds + X.wave * 16384);
    constexpr int Q_GU = 64 * 64, Q_QKV = NQKV / 32, Q_IN = NPROJ / 32, N_ITEMS = Q_GU + Q_QKV + Q_IN + 64 * 32;
    auto describe = [&](int it) -> P0Item {
        int r = it;
        if (r < Q_GU) { const int mat = r >> 6; return P0Item{w_gu + (size_t)mat * DM * 2048, 2048, 32 * (r & 63), 1, 1, Wgu8 + (size_t)mat * 2048 * DM, wsc + NQKV + NPROJ + mat * 2048}; } r -= Q_GU;
        if (r < Q_QKV) return P0Item{w_qkv, NQKV, 32 * r, 0, 1, Wqkv8, wsc}; r -= Q_QKV;
        if (r < Q_IN) return P0Item{w_in, NPROJ_REAL, 32 * r, 0, 1, Win8, wsc + NQKV}; r -= Q_IN;
        const int mat = r >> 5; return P0Item{w_down + (size_t)mat * DM * DM, DM, 32 * (r & 31), 0, 2, (signed char*)Wd_t + (size_t)mat * DM * DM, wsc + NQKV + NPROJ + 64 * 2048 + mat * DM};
    };
    SEC_BEGIN(6);
    { volatile LAS int* slot = (volatile LAS int*)(X.lds + LDSCTL_OFF + 128);
      auto fetch = [&](int par) -> int { if (X.tid == 0) slot[par] = (int)xb_add(item_ctr, 1u); __syncthreads(); return __builtin_amdgcn_readfirstlane(slot[par]); };
      int par = 0;
      int it = fetch(par); par ^= 1;
      P0Item cur = describe(it < N_ITEMS ? it : 0);
      if (it < N_ITEMS) p0_item_dma(X, cur);
      while (it < N_ITEMS) {
          const int nxt = fetch(par); par ^= 1;
          const bool hn = nxt < N_ITEMS; const P0Item nx = describe(hn ? nxt : it);
          if (cur.q == 2) p0_item_process<2>(X, cur, hn ? &nx : nullptr); else p0_item_process<1>(X, cur, hn ? &nx : nullptr);
          cur = nx; it = nxt; } }
    { LAS float* scr = (LAS float*)(X.lds + X.wave * 16384);
      for (int r = X.gw; r < 2 * 16 * 32; r += X.NGW) { if (r < 512) p0_transpose_item(w_o0, DM, DM, 0, Wo0_t, scr, r, X.lane); else p0_transpose_item(w_o1, DM, DM, 0, Wo1_t, scr, r - 512, X.lane); } }
    SEC_END(6);

}

__device__ __forceinline__ void norm_mod_store(const f32x4 (&v)[4], const float* gnorm, const float* modb, int shi, int sci, bf16* hrow, int lane, f32x4 (&h)[4]) {
    float ss = 0.f;
#pragma unroll
    for (int j = 0; j < 4; ++j) ss += (v[j][0] * v[j][0] + v[j][1] * v[j][1]) + (v[j][2] * v[j][2] + v[j][3] * v[j][3]);
    const float rstd = 1.0f / sqrtf(wave_sum(ss) * (1.0f / DM) + EPS);
#pragma unroll
    for (int j = 0; j < 4; ++j) {
        const f32x4 g4 = ((const GAS f32x4*)gnorm)[64 * j + lane], sc4 = ((const GAS f32x4*)(modb + sci * DM))[64 * j + lane], sh4 = ((const GAS f32x4*)(modb + shi * DM))[64 * j + lane];
        h[j] = (v[j] * rstd) * g4 * (1.0f + sc4) + sh4;
    }
    (void)hrow;
}
__device__ __forceinline__ void norm_mod_coef(const float* gnorm, const float* modb, int shi, int sci, int lane, f32x4 (&A)[4], f32x4 (&B)[4]) {
#pragma unroll
    for (int j = 0; j < 4; ++j) { const f32x4 g4 = ((const GAS f32x4*)gnorm)[64 * j + lane], sc4 = ((const GAS f32x4*)(modb + sci * DM))[64 * j + lane]; A[j] = g4 * (1.0f + sc4); B[j] = ((const GAS f32x4*)(modb + shi * DM))[64 * j + lane]; }
}
__device__ __forceinline__ void norm_mod_apply(const f32x4 (&v)[4], const f32x4 (&A)[4], const f32x4 (&B)[4], f32x4 (&h)[4]) {
    float ss = 0.f;
#pragma unroll
    for (int j = 0; j < 4; ++j) ss += (v[j][0] * v[j][0] + v[j][1] * v[j][1]) + (v[j][2] * v[j][2] + v[j][3] * v[j][3]);
    const float rstd = 1.0f / sqrtf(wave_sum(ss) * (1.0f / DM) + EPS);
#pragma unroll
    for (int j = 0; j < 4; ++j) h[j] = (v[j] * rstd) * A[j] + B[j];
}
__device__ __forceinline__ float quant_row_store(const f32x4 (&h)[4], signed char* qrow, float* hs, int lane) {
    float am = 0.f;
#pragma unroll
    for (int j = 0; j < 4; ++j) am = fmaxf(am, fmaxf(fmaxf(fabsf(h[j][0]), fabsf(h[j][1])), fmaxf(fabsf(h[j][2]), fabsf(h[j][3]))));
    am = wave_max(am);
    const float inv = am > 0.f ? 127.0f / am : 0.f;
    GAS unsigned* q4 = (GAS unsigned*)qrow + lane;
#pragma unroll
    for (int j = 0; j < 4; ++j) q4[64 * j] = pack4i(rintf(h[j][0] * inv), rintf(h[j][1] * inv), rintf(h[j][2] * inv), rintf(h[j][3] * inv));
    if (lane == 0) *hs = am * (1.0f / 127.0f);
    return am * (1.0f / 127.0f);
}

__device__ __forceinline__ void load_row_f32(const float* p, int lane, f32x4 (&v)[4]) { const GAS f32x4* xr = (const GAS f32x4*)p + lane;
#pragma unroll
    for (int j = 0; j < 4; ++j) v[j] = xr[64 * j]; }
__device__ __forceinline__ void load_row_bf16(const bf16* p, int lane, f32x4 (&v)[4]) { const GAS u32x2* xr = (const GAS u32x2*)p + lane;
#pragma unroll
    for (int j = 0; j < 4; ++j) { const u32x2 w = xr[64 * j]; v[j] = (f32x4){bflo(w.x), bfhi(w.x), bflo(w.y), bfhi(w.y)}; } }
__device__ __forceinline__ void store_row_bf16(bf16* p, int lane, const f32x4 (&v)[4]) { GAS u32x2* xr = (GAS u32x2*)p + lane;
#pragma unroll
    for (int j = 0; j < 4; ++j) xr[64 * j] = (u32x2){pk2(v[j][0], v[j][1]), pk2(v[j][2], v[j][3])}; }
__device__ __forceinline__ void phase_norm1(const Ctx& X, const float* xin, const float* gnorm, const float* mod_l, signed char* H8, float* HS) {
    const int per = NTOK / X.NGW, m0 = X.gw * per;
    f32x4 A[4], B[4]; norm_mod_coef(gnorm, mod_l + (size_t)(m0 >> 11) * 6144, 0, 1, X.lane, A, B);
    f32x4 v[4], vn[4], h[4];
    load_row_f32(xin + (size_t)m0 * DM, X.lane, v);
    for (int m = m0; m < m0 + per; ++m) {
        load_row_f32(xin + (size_t)((m + 1 < m0 + per) ? m + 1 : m) * DM, X.lane, vn);
        norm_mod_apply(v, A, B, h);
        quant_row_store(h, H8 + (size_t)m * DM, HS + m, X.lane);
#pragma unroll
        for (int j = 0; j < 4; ++j) v[j] = vn[j];
    }
}
__device__ __forceinline__ void moe_tables(const Ctx& X, const unsigned* gcnt, LAS int* cntL, LAS int* tsum) {
    __syncthreads();
    if (X.tid < NE) cntL[X.tid] = (int)__hip_atomic_load(gcnt + X.tid, __ATOMIC_RELAXED, __HIP_MEMORY_SCOPE_AGENT);
    __syncthreads();
    if (X.tid == 0) { int s = 0; for (int e = 0; e < NE; ++e) { tsum[e] = s; s += (cntL[e] + 255) >> 8; } tsum[NE] = s; }
    __syncthreads();
}
__device__ __forceinline__ void phase_combine(const Ctx& X, bf16* xr_io, float* out_f32  , const unsigned char* Y, const int* tok_e, const int* tok_p, const unsigned* gcnt, const float* mod_l  ,
                                              bool do_norm, const float* gnorm_next, const float* mod_next, signed char* H8, float* HS) {
    LAS int* cntL = (LAS int*)(X.lds + EXTRA_OFF); LAS int* tsum = cntL + 32;
    moe_tables(X, gcnt, cntL, tsum);
    const int per = NTOK / X.NGW, m0 = X.gw * per, b = m0 >> 11;
    f32x4 G2[4], A[4], B[4];
#pragma unroll
    for (int j = 0; j < 4; ++j) { G2[j] = ((const GAS f32x4*)(mod_l + (size_t)b * 6144 + 5 * DM))[64 * j + X.lane] * (1.0f / pg8::Y_PRESCALE); A[j] = G2[j]; B[j] = G2[j]; }
    if (do_norm) norm_mod_coef(gnorm_next, mod_next + (size_t)b * 6144, 0, 1, X.lane, A, B);
    for (int m = m0; m < m0 + per; ++m) {
        f32x4 v[4], a[4], h[4];
        load_row_bf16(xr_io + (size_t)m * DM, X.lane, v);
#pragma unroll
        for (int j = 0; j < 4; ++j) a[j] = (f32x4){0.f, 0.f, 0.f, 0.f};
#pragma unroll
        for (int k = 0; k < TOPK; ++k) { const int e = tok_e[m * 4 + k], p = tok_p[m * 4 + k]; const GAS unsigned* yr = (const GAS unsigned*)(Y + ((size_t)tsum[e] * 256 + p) * DM) + X.lane;
#pragma unroll
            for (int j = 0; j < 4; ++j) { const unsigned w = yr[64 * j]; const f32x2 lo = __builtin_amdgcn_cvt_pk_f32_fp8(w, false), hi = __builtin_amdgcn_cvt_pk_f32_fp8(w, true);
                a[j][0] += lo[0]; a[j][1] += lo[1]; a[j][2] += hi[0]; a[j][3] += hi[1]; } }
#pragma unroll
        for (int j = 0; j < 4; ++j) v[j] = v[j] + G2[j] * a[j];
        if (out_f32) { GAS f32x4* orow = (GAS f32x4*)(out_f32 + (size_t)m * DM) + X.lane;
#pragma unroll
            for (int j = 0; j < 4; ++j) orow[64 * j] = v[j]; }
        else store_row_bf16(xr_io + (size_t)m * DM, X.lane, v);
        if (do_norm) { norm_mod_apply(v, A, B, h); quant_row_store(h, H8 + (size_t)m * DM, HS + m, X.lane); }
    }
}
__device__ __forceinline__ void phase_norm2_router(const Ctx& X, const bf16* xin, const float* gnorm, const float* mod_l, const float* rw, const float* rb, signed char* H8, float* HS,
                                                   int* tok_e, int* tok_p, unsigned* gcnt, int* list, float* gate_e, float* hs_e) {
    constexpr int HROW = 2064;
    LAS unsigned char* hhi = X.lds; LAS unsigned char* hlo = X.lds + 16 * HROW; LAS float* part = (LAS float*)(X.lds + 2 * 16 * HROW);
    LAS int* cntL = (LAS int*)(X.lds + EXTRA_OFF); LAS int* baseL = cntL + 32; LAS int* selE = baseL + 32; LAS int* selR = selE + 1024; LAS float* selG = (LAS float*)(selR + 1024); LAS float* selH = selG + 1024;
    const int lane = X.lane, fr = lane & 15, fq = lane >> 4, half = lane >> 5, l32 = lane & 31, wave = X.wave;
    bf16x8 bhi[4][2], blo[4][2];
#pragma unroll
    for (int s4 = 0; s4 < 4; ++s4)
#pragma unroll
        for (int nt = 0; nt < 2; ++nt)
#pragma unroll
            for (int j = 0; j < 8; ++j) { const float w = rw[(size_t)(128 * wave + 32 * s4 + 8 * fq + j) * NE + 16 * nt + fr]; const unsigned hb = f2bf(w); const float lo = w - __uint_as_float(hb << 16);
                bhi[s4][nt][j] = (short)hb; blo[s4][nt][j] = (short)f2bf(lo); }
    if (X.tid < NE) cntL[X.tid] = 0;
    const float rbias = rb[l32];
    __syncthreads();
    const int t0 = blockIdx.x * 256;
    f32x4 nA[4], nB[4]; norm_mod_coef(gnorm, mod_l + (size_t)(t0 >> 11) * 6144, 3, 4, lane, nA, nB);
    f32x4 xv[2][4], xn[2][4];
#pragma unroll
    for (int q = 0; q < 2; ++q) load_row_bf16(xin + (size_t)(t0 + 2 * wave + q) * DM, lane, xv[q]);
    for (int it = 0; it < 16; ++it) {
        { const int itn = it < 15 ? it + 1 : it;
#pragma unroll
          for (int q = 0; q < 2; ++q) load_row_bf16(xin + (size_t)(t0 + itn * 16 + 2 * wave + q) * DM, lane, xn[q]); }
#pragma unroll
        for (int q = 0; q < 2; ++q) {
            const int lt = it * 16 + 2 * wave + q, m = t0 + lt; f32x4 v[4], h[4];
#pragma unroll
            for (int j = 0; j < 4; ++j) v[j] = xv[q][j];
            norm_mod_apply(v, nA, nB, h);
            const float hsv = quant_row_store(h, H8 + (size_t)m * DM, HS + m, lane); if (lane == 0) selH[lt] = hsv;
#pragma unroll
            for (int j = 0; j < 4; ++j) { const unsigned w01 = pk2(h[j][0], h[j][1]), w23 = pk2(h[j][2], h[j][3]);
                const int off = (2 * wave + q) * HROW + (256 * j + 4 * lane) * 2;
                *(LAS u32x2*)(hhi + off) = (u32x2){w01, w23};
                *(LAS u32x2*)(hlo + off) = (u32x2){pk2(h[j][0] - bflo(w01), h[j][1] - bfhi(w01)), pk2(h[j][2] - bflo(w23), h[j][3] - bfhi(w23))}; }
        }
        __syncthreads();
        f32x4 acc0 = {0.f, 0.f, 0.f, 0.f}, acc1 = {0.f, 0.f, 0.f, 0.f};
#pragma unroll
        for (int s4 = 0; s4 < 4; ++s4) { const int off = fr * HROW + (128 * wave + 32 * s4 + 8 * fq) * 2;
            const bf16x8 ah = *(const LAS bf16x8*)(hhi + off), al = *(const LAS bf16x8*)(hlo + off);
            acc0 = __builtin_amdgcn_mfma_f32_16x16x32_bf16(ah, bhi[s4][0], acc0, 0, 0, 0); acc1 = __builtin_amdgcn_mfma_f32_16x16x32_bf16(ah, bhi[s4][1], acc1, 0, 0, 0);
            acc0 = __builtin_amdgcn_mfma_f32_16x16x32_bf16(al, bhi[s4][0], acc0, 0, 0, 0); acc1 = __builtin_amdgcn_mfma_f32_16x16x32_bf16(al, bhi[s4][1], acc1, 0, 0, 0);
            acc0 = __builtin_amdgcn_mfma_f32_16x16x32_bf16(ah, blo[s4][0], acc0, 0, 0, 0); acc1 = __builtin_amdgcn_mfma_f32_16x16x32_bf16(ah, blo[s4][1], acc1, 0, 0, 0); }
#pragma unroll
        for (int i = 0; i < 4; ++i) { part[(wave * 16 + 4 * fq + i) * 32 + fr] = acc0[i]; part[(wave * 16 + 4 * fq + i) * 32 + 16 + fr] = acc1[i]; }
        __syncthreads();
        const int lt = it * 16 + 2 * wave + half;
        float logit = rbias;
#pragma unroll
        for (int w8 = 0; w8 < 8; ++w8) logit += part[(w8 * 16 + 2 * wave + half) * 32 + l32];
        float tv[4]; int te[4]; float cur = logit;
#pragma unroll
        for (int k = 0; k < 4; ++k) { const float mx = half_max32(cur);
            const unsigned long long bal = __ballot(cur == mx); const unsigned mine = half ? (unsigned)(bal >> 32) : (unsigned)bal;
            const int e = __ffs(mine) - 1; tv[k] = mx; te[k] = e; if (l32 == e) cur = -INFINITY; }
        const float p1 = __expf(tv[1] - tv[0]), p2 = __expf(tv[2] - tv[0]), p3 = __expf(tv[3] - tv[0]); const float inv = 1.0f / (1.0f + p1 + p2 + p3);
        if (l32 < 4) { const int k = l32; const int e = k == 0 ? te[0] : k == 1 ? te[1] : k == 2 ? te[2] : te[3]; const float gk = (k == 0 ? 1.0f : k == 1 ? p1 : k == 2 ? p2 : p3) * inv;
            const int rank = __hip_atomic_fetch_add(cntL + e, 1, __ATOMIC_RELAXED, __HIP_MEMORY_SCOPE_WORKGROUP);
            const int si = lt * 4 + k; selE[si] = e; selR[si] = rank; selG[si] = gk; }
#pragma unroll
        for (int q = 0; q < 2; ++q)
#pragma unroll
            for (int j = 0; j < 4; ++j) xv[q][j] = xn[q][j];
    }
    __syncthreads();
    if (X.tid < NE) baseL[X.tid] = (int)__hip_atomic_fetch_add(gcnt + X.tid, (unsigned)cntL[X.tid], __ATOMIC_RELAXED, __HIP_MEMORY_SCOPE_AGENT);
    __syncthreads();
    for (int si = X.tid; si < 256 * 4; si += NTHREADS) { const int e = selE[si], p = baseL[e] + selR[si], m = t0 + (si >> 2);
        tok_e[(size_t)m * 4 + (si & 3)] = e; tok_p[(size_t)m * 4 + (si & 3)] = p; list[(size_t)e * ECAP + p] = m; gate_e[(size_t)e * ECAP + p] = selG[si]; hs_e[(size_t)e * ECAP + p] = selH[si >> 2]; }
    __syncthreads();
}

__device__ __forceinline__ void phase_sb_naive(const Ctx& X, const bf16* QKV, bf16* O) {
    for (int item = blockIdx.x; item < NB * NH * 4; item += X.G) {
        const int b = item >> 6, h = (item >> 2) & 15, t = (item & 3) * 512 + X.tid;
        const GAS u32x4* qp = (const GAS u32x4*)(QKV + ((size_t)(b * SEQ + t)) * NQKV + h * HD);
        float q[64], o[64];
#pragma unroll
        for (int i = 0; i < 8; ++i) { const u32x4 w = qp[i]; q[8 * i] = bflo(w.x); q[8 * i + 1] = bfhi(w.x); q[8 * i + 2] = bflo(w.y); q[8 * i + 3] = bfhi(w.y); q[8 * i + 4] = bflo(w.z); q[8 * i + 5] = bfhi(w.z); q[8 * i + 6] = bflo(w.w); q[8 * i + 7] = bfhi(w.w); }
#pragma unroll
        for (int d = 0; d < 64; ++d) o[d] = 0.f;
        float L = 0.f;
        for (int s = t - 1; s >= 0; --s) {
            const GAS u32x4* kp = (const GAS u32x4*)(QKV + ((size_t)(b * SEQ + s)) * NQKV + DM + h * HD);
            float z = 0.f;
#pragma unroll
            for (int i = 0; i < 8; ++i) { const u32x4 w = kp[i]; z += q[8 * i] * bflo(w.x) + q[8 * i + 1] * bfhi(w.x) + q[8 * i + 2] * bflo(w.y) + q[8 * i + 3] * bfhi(w.y) + q[8 * i + 4] * bflo(w.z) + q[8 * i + 5] * bfhi(w.z) + q[8 * i + 6] * bflo(w.w) + q[8 * i + 7] * bfhi(w.w); }
            const float sp = fmaxf(z, 0.f) + __builtin_amdgcn_logf(1.0f + __builtin_amdgcn_exp2f(-fabsf(z)));
            const float a = __builtin_amdgcn_exp2f(z - sp + L);
            const GAS u32x4* vp = kp + (DM * 2 / 16);
#pragma unroll
            for (int i = 0; i < 8; ++i) { const u32x4 w = vp[i]; o[8 * i] += a * bflo(w.x); o[8 * i + 1] += a * bfhi(w.x); o[8 * i + 2] += a * bflo(w.y); o[8 * i + 3] += a * bfhi(w.y); o[8 * i + 4] += a * bflo(w.z); o[8 * i + 5] += a * bfhi(w.z); o[8 * i + 6] += a * bflo(w.w); o[8 * i + 7] += a * bfhi(w.w); }
            L -= sp;
            if (L < -160.f) break;
        }
        GAS u32x4* op = (GAS u32x4*)(O + ((size_t)(b * SEQ + t)) * DM + h * HD);
#pragma unroll
        for (int i = 0; i < 8; ++i) op[i] = (u32x4){pk2(o[8 * i], o[8 * i + 1]), pk2(o[8 * i + 2], o[8 * i + 3]), pk2(o[8 * i + 4], o[8 * i + 5]), pk2(o[8 * i + 6], o[8 * i + 7])};
    }
}

__device__ __forceinline__ void ld16(const bf16* p, float (&x)[16]) {
    const GAS u32x4* q = (const GAS u32x4*)p; const u32x4 a = q[0], b = q[1];
    x[0] = bflo(a.x); x[1] = bfhi(a.x); x[2] = bflo(a.y); x[3] = bfhi(a.y); x[4] = bflo(a.z); x[5] = bfhi(a.z); x[6] = bflo(a.w); x[7] = bfhi(a.w);
    x[8] = bflo(b.x); x[9] = bfhi(b.x); x[10] = bflo(b.y); x[11] = bfhi(b.y); x[12] = bflo(b.z); x[13] = bfhi(b.z); x[14] = bflo(b.w); x[15] = bfhi(b.w);
}
__device__ __forceinline__ void st16(bf16* p, const float (&x)[16]) {
    GAS u32x4* q = (GAS u32x4*)p;
    q[0] = (u32x4){pk2(x[0], x[1]), pk2(x[2], x[3]), pk2(x[4], x[5]), pk2(x[6], x[7])}; q[1] = (u32x4){pk2(x[8], x[9]), pk2(x[10], x[11]), pk2(x[12], x[13]), pk2(x[14], x[15])};
}
__device__ __forceinline__ void up16(const u32x4 a, const u32x4 b, float (&x)[16]) {
    x[0] = bflo(a.x); x[1] = bfhi(a.x); x[2] = bflo(a.y); x[3] = bfhi(a.y); x[4] = bflo(a.z); x[5] = bfhi(a.z); x[6] = bflo(a.w); x[7] = bfhi(a.w);
    x[8] = bflo(b.x); x[9] = bfhi(b.x); x[10] = bflo(b.y); x[11] = bfhi(b.y); x[12] = bflo(b.z); x[13] = bfhi(b.z); x[14] = bflo(b.w); x[15] = bfhi(b.w);
}
struct PostRaw { u32x4 q0, q1, k0, k1, i0, i1; unsigned wi; int pos; };
__device__ __forceinline__ PostRaw post_load(const bf16* P, const int* positions, int m, int lane) {
    PostRaw r; const GAS u32x4* pr = (const GAS u32x4*)(P + (size_t)m * NPROJ);
    r.q0 = pr[2 * lane]; r.q1 = pr[2 * lane + 1];
    const int lk = lane & 15; r.k0 = pr[128 + 2 * lk]; r.k1 = pr[128 + 2 * lk + 1];
    const int li = lane < 36 ? lane : 35; r.i0 = pr[160 + 2 * li]; r.i1 = pr[160 + 2 * li + 1];
    r.wi = (unsigned)P[(size_t)m * NPROJ + 1856 + (lane & 7)]; r.pos = positions[m];
    return r;
}
__device__ __forceinline__ void phase_dsa_post(const Ctx& X, const bf16* P, const int* positions, const float* qgain, const float* kgain, bf16* Q1, bf16* K1, bf16* V1, bf16* QI, bf16* KI, float* WI, float* QN, unsigned* kmax_bits) {
    const int l4 = X.lane & 3;
    float gq[16], gk[16];
#pragma unroll
    for (int i = 0; i < 16; ++i) { gq[i] = qgain[l4 * 16 + i]; gk[i] = kgain[l4 * 16 + i]; }
    const float inv_i = expf(-logf(500000.0f) * (2.0f * (float)(X.lane & 7) / 16.0f));
    const int per = NTOK / X.NGW, m0 = X.gw * per;
    float kmx = 0.f, qmx = 0.f;
    PostRaw cur = post_load(P, positions, m0, X.lane);
    for (int m = m0; m < m0 + per; ++m) {
        const int mn = (m + 1 < m0 + per) ? m + 1 : m;
        const PostRaw nxt = post_load(P, positions, mn, X.lane);
        float cs = 1.f, sn = 0.f;
        sincosf((float)cur.pos * inv_i, &sn, &cs);
        float cz[8], sz[8];
#pragma unroll
        for (int i = 0; i < 8; ++i) { cz[i] = __shfl(cs, i); sz[i] = __shfl(sn, i); }
        float x[16];
        up16(cur.q0, cur.q1, x);
        { float ss = 0.f;
#pragma unroll
          for (int i = 0; i < 16; ++i) ss += x[i] * x[i];
          ss += __shfl_xor(ss, 1); ss += __shfl_xor(ss, 2);
          const float r = 1.0f / sqrtf(ss * (1.0f / 64.0f) + EPS);
#pragma unroll
          for (int i = 0; i < 16; ++i) x[i] = x[i] * r * gq[i];
          if (l4 == 0) {
#pragma unroll
              for (int i = 0; i < 8; ++i) { const float a = x[i], b2 = x[i + 8]; x[i] = a * cz[i] - b2 * sz[i]; x[i + 8] = b2 * cz[i] + a * sz[i]; } }
          float n2 = 0.f;
#pragma unroll
          for (int i = 0; i < 16; ++i) { x[i] *= QSCALE; n2 += x[i] * x[i]; }
#pragma unroll
          for (int o = 1; o < 4; o <<= 1) n2 += __shfl_xor(n2, o);
#pragma unroll
          for (int o = 4; o < 64; o <<= 1) n2 = fmaxf(n2, __shfl_xor(n2, o));
          qmx = fmaxf(qmx, n2);
          if (X.lane == 0) QN[m] = sqrtf(n2) * 1.01f;
          st16(Q1 + (size_t)m * DM + X.lane * 16, x); }
        { up16(cur.k0, cur.k1, x);
          float ss = 0.f;
#pragma unroll
          for (int i = 0; i < 16; ++i) ss += x[i] * x[i];
          ss += __shfl_xor(ss, 1); ss += __shfl_xor(ss, 2);
          if (X.lane < 8) { const float r = 1.0f / sqrtf(ss * (1.0f / 64.0f) + EPS);
#pragma unroll
              for (int i = 0; i < 16; ++i) x[i] = x[i] * r * gk[i];
              if (l4 == 0) {
#pragma unroll
                  for (int i = 0; i < 8; ++i) { const float a = x[i], b2 = x[i + 8]; x[i] = a * cz[i] - b2 * sz[i]; x[i + 8] = b2 * cz[i] + a * sz[i]; } }
              st16(K1 + (size_t)m * 128 + X.lane * 16, x);
          } else if (X.lane < 16) st16(V1 + (size_t)m * 128 + (X.lane - 8) * 16, x);
          float k2 = 0.f;
#pragma unroll
          for (int i = 0; i < 16; ++i) k2 += x[i] * x[i];
          k2 += __shfl_xor(k2, 1); k2 += __shfl_xor(k2, 2); k2 = fmaxf(k2, __shfl_xor(k2, 4));
          kmx = fmaxf(kmx, k2); }
        if (X.lane < 36) { up16(cur.i0, cur.i1, x);
            if (l4 == 0) {
#pragma unroll
                for (int i = 0; i < 8; ++i) { const float a = x[i], b2 = x[i + 8]; x[i] = a * cz[i] - b2 * sz[i]; x[i + 8] = b2 * cz[i] + a * sz[i]; } }
            if (X.lane < 32) st16(QI + (size_t)m * 512 + X.lane * 16, x); else st16(KI + (size_t)m * 64 + (X.lane - 32) * 16, x); }
        if (X.lane < 8) WI[(size_t)m * 8 + X.lane] = bflo(cur.wi) * (0.35355339059327373f * 0.125f);
        cur = nxt;
    }
    if (X.lane == 0) { atomicMax(kmax_bits + (m0 >> 11), __float_as_uint(sqrtf(kmx) * 1.01f)); atomicMax(kmax_bits + 32 + (m0 >> 11), __float_as_uint(sqrtf(qmx) * 1.01f)); }
}
__device__ __forceinline__ void phase_dsa_post2(const Ctx& X, const bf16* P, const int* positions, const float* kgain, bf16* K1, bf16* V1, bf16* KI, float* WI, float* ROPE) {
    const int l16 = X.lane & 15, grp = X.lane >> 4, l4 = X.lane & 3, gbase = X.lane & 48;
    float gk[16];
#pragma unroll
    for (int i = 0; i < 16; ++i) gk[i] = kgain[l4 * 16 + i];
    const float inv_i = expf(-logf(500000.0f) * (2.0f * (float)(l16 & 7) / 16.0f));
    const int per = NTOK / X.NGW, m0 = X.gw * per;
    for (int mm = m0; mm < m0 + per; mm += 4) {
        const int m = mm + grp;
        const GAS u32x4* pr = (const GAS u32x4*)(P + (size_t)m * NPROJ);
        const u32x4 k0 = pr[128 + 2 * l16], k1 = pr[128 + 2 * l16 + 1];
        const int li = l16 & 3; const u32x4 i0 = pr[224 + 2 * li], i1 = pr[224 + 2 * li + 1];
        const unsigned wiw = (unsigned)P[(size_t)m * NPROJ + 1856 + (l16 & 7)];
        float sn, cs; sincosf((float)positions[m] * inv_i, &sn, &cs);
        ROPE[(size_t)m * 16 + l16] = (l16 & 8) ? sn : cs;
        float cz[8], sz[8];
#pragma unroll
        for (int i = 0; i < 8; ++i) { cz[i] = __shfl(cs, gbase + i); sz[i] = __shfl(sn, gbase + i); }
        float x[16];
        up16(k0, k1, x);
        float ss = 0.f;
#pragma unroll
        for (int i = 0; i < 16; ++i) ss += x[i] * x[i];
        ss = quad_sum(ss);
        if (l16 < 8) { const float r = 1.0f / sqrtf(ss * (1.0f / 64.0f) + EPS);
#pragma unroll
            for (int i = 0; i < 16; ++i) x[i] = x[i] * r * gk[i];
            if (l4 == 0) {
#pragma unroll
                for (int i = 0; i < 8; ++i) { const float a = x[i], b2 = x[i + 8]; x[i] = a * cz[i] - b2 * sz[i]; x[i + 8] = b2 * cz[i] + a * sz[i]; } }
            st16(K1 + (size_t)m * 128 + l16 * 16, x);
        } else st16(V1 + (size_t)m * 128 + (l16 - 8) * 16, x);
        if (l16 < 4) { up16(i0, i1, x);
            if (l16 == 0) {
#pragma unroll
                for (int i = 0; i < 8; ++i) { const float a = x[i], b2 = x[i + 8]; x[i] = a * cz[i] - b2 * sz[i]; x[i + 8] = b2 * cz[i] + a * sz[i]; } }
            st16(KI + (size_t)m * 64 + l16 * 16, x); }
        if (l16 < 8) WI[(size_t)m * 8 + l16] = bflo(wiw) * (0.35355339059327373f * 0.125f);
    }
}
__device__ __forceinline__ void phase_idx_naive(const Ctx& X, const bf16* QI, const bf16* KI, const float* WI, float* SC) {
    LAS float* qs = (LAS float*)X.lds;
    const int ntb = NTOK / X.G;
    for (int i = 0; i < ntb; ++i) {
        const int m = blockIdx.x * ntb + i, b = m >> 11, t = m & 2047, nadm = 64 * ((t >> 6) + 1);
        __syncthreads();
        qs[X.tid] = bflo((unsigned)QI[(size_t)m * 512 + X.tid]); if (X.tid < 8) qs[512 + X.tid] = WI[(size_t)m * 8 + X.tid];
        __syncthreads();
        for (int s = X.tid; s < nadm; s += NTHREADS) {
            const GAS u32x4* kp = (const GAS u32x4*)(KI + ((size_t)(b * SEQ + s)) * 64); float k[64];
#pragma unroll
            for (int j = 0; j < 8; ++j) { const u32x4 w = kp[j]; k[8 * j] = bflo(w.x); k[8 * j + 1] = bfhi(w.x); k[8 * j + 2] = bflo(w.y); k[8 * j + 3] = bfhi(w.y); k[8 * j + 4] = bflo(w.z); k[8 * j + 5] = bfhi(w.z); k[8 * j + 6] = bflo(w.w); k[8 * j + 7] = bfhi(w.w); }
            float sc = 0.f;
#pragma unroll 1
            for (int hh = 0; hh < 8; ++hh) { float d = 0.f; asm volatile("" ::: "memory");
#pragma unroll
                for (int j = 0; j < 16; ++j) { const f32x4 q4 = ((const LAS f32x4*)(qs + hh * 64))[j]; d += (q4[0] * k[4 * j] + q4[1] * k[4 * j + 1]) + (q4[2] * k[4 * j + 2] + q4[3] * k[4 * j + 3]); }
                sc += qs[512 + hh] * fmaxf(d, 0.f); }
            SC[(size_t)m * SEQ + s] = sc;
        }
    }
}
__device__ __forceinline__ unsigned ord_key(float x) { const unsigned u = __float_as_uint(x); return (u & 0x80000000u) ? ~u : (u | 0x80000000u); }
__device__ __forceinline__ int wave_count_sum(unsigned v) {
    int t = 0;
#pragma unroll
    for (int b = 0; b < 6; ++b) t += __popcll(__ballot((v >> b) & 1u)) << b;
    return t;
}
template <int NR>
__device__ __forceinline__ void topk_select_nr(const unsigned (&key)[32], int c, unsigned long long* maskrow, int lane) {
    unsigned long long mine = ~0ull;
    if (c >= 4) {
        unsigned T = 0u;
        for (int bit = 31; bit >= 0; --bit) { const unsigned cand = T | (1u << bit); unsigned cl = 0u;
#pragma unroll
            for (int m = 0; m < NR; ++m) cl += (key[m] >= cand) ? 1u : 0u;
            const int cnt = wave_count_sum(cl);
            if (cnt >= 256) { T = cand; if (cnt == 256) break; } }
        unsigned gl = 0u;
#pragma unroll
        for (int m = 0; m < NR; ++m) gl += (key[m] > T) ? 1u : 0u;
        const int gt = wave_count_sum(gl);
        int need = 256 - gt;
        {
#pragma unroll
        for (int m = 0; m < NR; ++m) {
            unsigned long long eq = __ballot(key[m] == T); const unsigned long long g = __ballot(key[m] > T);
            int pe = __popcll(eq);
            while (pe > need) { eq &= ~(1ull << (63 - __clzll(eq))); --pe; }
            need -= pe;
            if (lane == m) mine = g | eq; }
        }
    }
    if (lane <= c) maskrow[lane] = mine;
}
__device__ __forceinline__ void topk_select_store(const unsigned (&key)[32], int c, unsigned long long* maskrow, int lane) {
    if (c < 8) topk_select_nr<8>(key, c, maskrow, lane); else if (c < 16) topk_select_nr<16>(key, c, maskrow, lane); else if (c < 24) topk_select_nr<24>(key, c, maskrow, lane); else topk_select_nr<32>(key, c, maskrow, lane);
}
__device__ __forceinline__ void phase_topk_naive(const Ctx& X, const float* SC, unsigned long long* MASK) {
    for (int m = X.gw; m < NTOK; m += X.NGW) {
        const int c = (m & 2047) >> 6; unsigned key[32];
#pragma unroll
        for (int j = 0; j < 32; ++j) key[j] = (j <= c) ? ord_key(SC[(size_t)m * SEQ + j * 64 + X.lane]) : 0u;
        topk_select_store(key, c, MASK + (size_t)m * 32, X.lane);
    }
}
__device__ __forceinline__ void phase_sparse_naive(const Ctx& X, const bf16* Q1, const bf16* K1, const bf16* V1, const unsigned long long* MASK, bf16* O) {
    for (int item = blockIdx.x; item < NTOK / 32; item += X.G) {
        const int m = item * 32 + (X.tid >> 4), h = X.tid & 15, g = h >> 3, b = m >> 11, c = (m & 2047) >> 6;
        const GAS u32x4* qp = (const GAS u32x4*)(Q1 + (size_t)m * DM + h * HD);
        float q[64], o[64];
#pragma unroll
        for (int i = 0; i < 8; ++i) { const u32x4 w = qp[i]; q[8 * i] = bflo(w.x); q[8 * i + 1] = bfhi(w.x); q[8 * i + 2] = bflo(w.y); q[8 * i + 3] = bfhi(w.y); q[8 * i + 4] = bflo(w.z); q[8 * i + 5] = bfhi(w.z); q[8 * i + 6] = bflo(w.w); q[8 * i + 7] = bfhi(w.w); }
#pragma unroll
        for (int d = 0; d < 64; ++d) o[d] = 0.f;
        float mx = -1e30f, l = 0.f;
        for (int j = 0; j <= c; ++j) {
            unsigned long long bits = MASK[(size_t)m * 32 + j];
            while (bits) { const int s = j * 64 + __ffsll((long long)bits) - 1; bits &= bits - 1;
                const GAS u32x4* kp = (const GAS u32x4*)(K1 + ((size_t)(b * SEQ + s)) * 128 + g * HD); float z = 0.f;
#pragma unroll
                for (int i = 0; i < 8; ++i) { const u32x4 w = kp[i]; z += q[8 * i] * bflo(w.x) + q[8 * i + 1] * bfhi(w.x) + q[8 * i + 2] * bflo(w.y) + q[8 * i + 3] * bfhi(w.y) + q[8 * i + 4] * bflo(w.z) + q[8 * i + 5] * bfhi(w.z) + q[8 * i + 6] * bflo(w.w) + q[8 * i + 7] * bfhi(w.w); }
                const float mn = fmaxf(mx, z), f = __builtin_amdgcn_exp2f(mx - mn), p = __builtin_amdgcn_exp2f(z - mn); mx = mn; l = l * f + p;
                const GAS u32x4* vp = (const GAS u32x4*)(V1 + ((size_t)(b * SEQ + s)) * 128 + g * HD);
#pragma unroll
                for (int i = 0; i < 8; ++i) { const u32x4 w = vp[i]; o[8 * i] = o[8 * i] * f + p * bflo(w.x); o[8 * i + 1] = o[8 * i + 1] * f + p * bfhi(w.x); o[8 * i + 2] = o[8 * i + 2] * f + p * bflo(w.y); o[8 * i + 3] = o[8 * i + 3] * f + p * bfhi(w.y);
                    o[8 * i + 4] = o[8 * i + 4] * f + p * bflo(w.z); o[8 * i + 5] = o[8 * i + 5] * f + p * bfhi(w.z); o[8 * i + 6] = o[8 * i + 6] * f + p * bflo(w.w); o[8 * i + 7] = o[8 * i + 7] * f + p * bfhi(w.w); }
            }
        }
        const float il = 1.0f / l;
        GAS u32x4* op = (GAS u32x4*)(O + (size_t)m * DM + h * HD);
#pragma unroll
        for (int i = 0; i < 8; ++i) op[i] = (u32x4){pk2(o[8 * i] * il, o[8 * i + 1] * il), pk2(o[8 * i + 2] * il, o[8 * i + 3] * il), pk2(o[8 * i + 4] * il, o[8 * i + 5] * il), pk2(o[8 * i + 6] * il, o[8 * i + 7] * il)};
    }
}


typedef float f32x16 __attribute__((ext_vector_type(16)));
typedef short v4i16_t __attribute__((ext_vector_type(4)));
__device__ __forceinline__ int crow16(int r, int hi) { return (r & 3) + 8 * (r >> 2) + 4 * hi; }
__device__ __forceinline__ float half_sum(float v) { const auto rr = __builtin_amdgcn_permlane32_swap(__float_as_uint(v), __float_as_uint(v), false, false); return __uint_as_float(rr[0]) + __uint_as_float(rr[1]); }
__device__ __forceinline__ float half_max(float v) { const auto rr = __builtin_amdgcn_permlane32_swap(__float_as_uint(v), __float_as_uint(v), false, false); return fmaxf(__uint_as_float(rr[0]), __uint_as_float(rr[1])); }
__device__ __forceinline__ float qk_bound(const float* qgain, const float* kgain, int lane) {
    float a = fabsf(qgain[lane]), b = fabsf(kgain[lane]);
    a = wave_max(a); b = wave_max(b);
    return 64.0f * a * b * QSCALE * 1.02f;
}
__device__ __forceinline__ void rope_frag0(float (&x)[8], const f32x4 (&cs)[2], const f32x4 (&sn)[2], int hi) {
#pragma unroll
    for (int j = 0; j < 8; ++j) { const auto rr = __builtin_amdgcn_permlane32_swap(__float_as_uint(x[j]), __float_as_uint(x[j]), false, false);
        const float p = __uint_as_float(hi ? rr[0] : rr[1]); const float c = cs[j >> 2][j & 3], s_ = sn[j >> 2][j & 3];
        x[j] = hi ? (x[j] * c + p * s_) : (x[j] * c - p * s_); }
}
__device__ __forceinline__ void unpack8(const u32x4 w, float (&x)[8]) { x[0] = bflo(w.x); x[1] = bfhi(w.x); x[2] = bflo(w.y); x[3] = bfhi(w.y); x[4] = bflo(w.z); x[5] = bfhi(w.z); x[6] = bflo(w.w); x[7] = bfhi(w.w); }
__device__ __forceinline__ bf16x8 packf8(const float (&x)[8]) { u32x4 w; w.x = pg8::cvt_pk_bf16(x[0], x[1]); w.y = pg8::cvt_pk_bf16(x[2], x[3]); w.z = pg8::cvt_pk_bf16(x[4], x[5]); w.w = pg8::cvt_pk_bf16(x[6], x[7]); return __builtin_bit_cast(bf16x8, w); }
struct RawFr { u32x4 w[4]; };
__device__ __forceinline__ RawFr raw_frags(const bf16* prow, int hi) { RawFr r;
#pragma unroll
    for (int d0 = 0; d0 < 4; ++d0) r.w[d0] = *(const GAS u32x4*)(prow + 16 * d0 + 8 * hi);
    return r; }
__device__ __forceinline__ void q_frags_from_raw(const RawFr& raw, const float* gq, const f32x4 (&cs)[2], const f32x4 (&sn)[2], int hi, bf16x8 (&qf)[4]) {
    float x[4][8]; float ss = 0.f;
#pragma unroll
    for (int d0 = 0; d0 < 4; ++d0) { unpack8(raw.w[d0], x[d0]);
#pragma unroll
        for (int j = 0; j < 8; ++j) ss += x[d0][j] * x[d0][j]; }
    ss = half_sum(ss);
    const float r = QSCALE / sqrtf(ss * (1.0f / 64.0f) + EPS);
#pragma unroll
    for (int d0 = 0; d0 < 4; ++d0) { const f32x4 g0 = *(const GAS f32x4*)(gq + 16 * d0 + 8 * hi), g1 = *(const GAS f32x4*)(gq + 16 * d0 + 8 * hi + 4);
#pragma unroll
        for (int j = 0; j < 4; ++j) { x[d0][j] *= r * g0[j]; x[d0][4 + j] *= r * g1[j]; } }
    rope_frag0(x[0], cs, sn, hi);
#pragma unroll
    for (int d0 = 0; d0 < 4; ++d0) qf[d0] = packf8(x[d0]);
}
__device__ __forceinline__ void load_q_frags(const bf16* prow, const float* gq, const f32x4 (&cs)[2], const f32x4 (&sn)[2], int hi, bf16x8 (&qf)[4]) { const RawFr raw = raw_frags(prow, hi); q_frags_from_raw(raw, gq, cs, sn, hi, qf); }
__device__ __forceinline__ void qi_frags_from_raw(const RawFr& raw, const f32x4 (&cs)[2], const f32x4 (&sn)[2], int hi, bf16x8 (&qf)[4]) {
    float x0[8]; unpack8(raw.w[0], x0);
    rope_frag0(x0, cs, sn, hi);
    qf[0] = packf8(x0);
#pragma unroll
    for (int d0 = 1; d0 < 4; ++d0) qf[d0] = __builtin_bit_cast(bf16x8, raw.w[d0]);
}
__device__ __forceinline__ bf16x8 pack8(const f32x16& v, int s) {
    u32x4 w; w.x = pg8::cvt_pk_bf16(v[8 * s + 0], v[8 * s + 1]); w.y = pg8::cvt_pk_bf16(v[8 * s + 2], v[8 * s + 3]); w.z = pg8::cvt_pk_bf16(v[8 * s + 4], v[8 * s + 5]); w.w = pg8::cvt_pk_bf16(v[8 * s + 6], v[8 * s + 7]);
    return __builtin_bit_cast(bf16x8, w);
}
__device__ __forceinline__ void vtile_write(LAS unsigned char* vl, const u32x4 (&vr)[4], int lane) {
#pragma unroll
    for (int i = 0; i < 4; ++i) *(LAS u32x4*)(vl + (i * 2 + ((lane & 7) >> 2)) * 512 + (lane >> 3) * 64 + (lane & 3) * 16) = vr[i];
}
__device__ __forceinline__ bf16x8 vtile_frag(const LAS unsigned char* vl, int trbase, int s, int d0) {
    const v4i16_t lo = __builtin_amdgcn_ds_read_tr16_b64_v4i16((LAS v4i16_t*)(vl + trbase + ((2 * s + 0) * 2 + d0) * 512));
    const v4i16_t hi = __builtin_amdgcn_ds_read_tr16_b64_v4i16((LAS v4i16_t*)(vl + trbase + ((2 * s + 1) * 2 + d0) * 512));
    return (bf16x8){lo[0], lo[1], lo[2], lo[3], hi[0], hi[1], hi[2], hi[3]};
}
__device__ __forceinline__ void store_ot(bf16* orow, const f32x16& o0, const f32x16& o1, float sc, int hi) {
#pragma unroll
    for (int rg = 0; rg < 4; ++rg) {
        *(GAS u32x2*)(orow + 8 * rg + 4 * hi) = (u32x2){pg8::cvt_pk_bf16(o0[4 * rg] * sc, o0[4 * rg + 1] * sc), pg8::cvt_pk_bf16(o0[4 * rg + 2] * sc, o0[4 * rg + 3] * sc)};
        *(GAS u32x2*)(orow + 32 + 8 * rg + 4 * hi) = (u32x2){pg8::cvt_pk_bf16(o1[4 * rg] * sc, o1[4 * rg + 1] * sc), pg8::cvt_pk_bf16(o1[4 * rg + 2] * sc, o1[4 * rg + 3] * sc)};
    }
}

__device__ __forceinline__ void phase_sb_fast(const Ctx& X, const bf16* QKV, bf16* O) {
    const int lane = X.lane, r32 = lane & 31, hi = lane >> 5;
    LAS unsigned char* vl = X.lds + X.wave * 4096;
    const int trbase = (4 * hi + ((lane & 15) >> 2)) * 64 + (16 * ((lane >> 4) & 1) + 4 * (lane & 3)) * 2;
    bf16x8 uf[2];
#pragma unroll
    for (int s = 0; s < 2; ++s)
#pragma unroll
        for (int j = 0; j < 8; ++j) uf[s][j] = ((16 * s + 8 * (j >> 2) + 4 * hi + (j & 3)) > r32) ? (short)0x3F80 : (short)0;
    for (int u = X.gw; u < NB * NH * 64; u += X.NGW) {
        const int b = u >> 10, h = (u >> 6) & 15, qb = u & 63, t0 = qb * 32;
        const bf16* base = QKV + (size_t)b * SEQ * NQKV + h * HD;
        bf16x8 qf[4];
#pragma unroll
        for (int d0 = 0; d0 < 4; ++d0) qf[d0] = *(const GAS bf16x8*)(base + (size_t)(t0 + r32) * NQKV + 16 * d0 + 8 * hi);
        f32x16 o0 = {}, o1 = {}; float run = 0.f;
        bf16x8 kf[4], kn[4]; u32x4 vr[4], vn[4];
#pragma unroll
        for (int d0 = 0; d0 < 4; ++d0) kf[d0] = *(const GAS bf16x8*)(base + (size_t)(t0 + r32) * NQKV + DM + 16 * d0 + 8 * hi);
#pragma unroll
        for (int i = 0; i < 4; ++i) vr[i] = *(const GAS u32x4*)(base + (size_t)(t0 + i * 8 + (lane >> 3)) * NQKV + 2 * DM + 8 * (lane & 7));
        for (int kt = qb; kt >= 0; --kt) {
            { const int keyn = (kt > 0 ? kt - 1 : 0) * 32;
#pragma unroll
              for (int d0 = 0; d0 < 4; ++d0) kn[d0] = *(const GAS bf16x8*)(base + (size_t)(keyn + r32) * NQKV + DM + 16 * d0 + 8 * hi);
#pragma unroll
              for (int i = 0; i < 4; ++i) vn[i] = *(const GAS u32x4*)(base + (size_t)(keyn + i * 8 + (lane >> 3)) * NQKV + 2 * DM + 8 * (lane & 7)); }
            asm volatile("" ::: "memory");
            vtile_write(vl, vr, lane);
            f32x16 S = {};
#pragma unroll
            for (int d0 = 0; d0 < 4; ++d0) S = __builtin_amdgcn_mfma_f32_32x32x16_bf16(kf[d0], qf[d0], S, 0, 0, 0);
            const bool diag = (kt == qb);
            f32x16 xm, ls; float cs = 0.f;
#pragma unroll
            for (int r = 0; r < 16; ++r) { const float z = S[r]; const float sp = fmaxf(z, 0.f) + __builtin_amdgcn_logf(1.0f + __builtin_amdgcn_exp2f(-fabsf(z)));
                const bool valid = !diag || (crow16(r, hi) < r32);
                xm[r] = valid ? -sp : 0.f; ls[r] = valid ? z - sp : -INFINITY; cs += xm[r]; }
            cs = half_sum(cs);
            f32x16 T;
#pragma unroll
            for (int r = 0; r < 16; ++r) T[r] = run;
            T = __builtin_amdgcn_mfma_f32_32x32x16_bf16(uf[0], pack8(xm, 0), T, 0, 0, 0);
            T = __builtin_amdgcn_mfma_f32_32x32x16_bf16(uf[1], pack8(xm, 1), T, 0, 0, 0);
            f32x16 a;
#pragma unroll
            for (int r = 0; r < 16; ++r) a[r] = __builtin_amdgcn_exp2f(ls[r] + T[r]);
            const bf16x8 p0 = pack8(a, 0), p1 = pack8(a, 1);
            asm volatile("" ::: "memory");
            o0 = __builtin_amdgcn_mfma_f32_32x32x16_bf16(vtile_frag(vl, trbase, 0, 0), p0, o0, 0, 0, 0);
            o1 = __builtin_amdgcn_mfma_f32_32x32x16_bf16(vtile_frag(vl, trbase, 0, 1), p0, o1, 0, 0, 0);
            o0 = __builtin_amdgcn_mfma_f32_32x32x16_bf16(vtile_frag(vl, trbase, 1, 0), p1, o0, 0, 0, 0);
            o1 = __builtin_amdgcn_mfma_f32_32x32x16_bf16(vtile_frag(vl, trbase, 1, 1), p1, o1, 0, 0, 0);
            asm volatile("" ::: "memory");
            run += cs;
            if (__all(run < -160.f)) break;
#pragma unroll
            for (int d0 = 0; d0 < 4; ++d0) { kf[d0] = kn[d0]; vr[d0] = vn[d0]; }
        }
        store_ot(O + (size_t)(b * SEQ + t0 + r32) * DM + h * HD, o0, o1, 1.0f, hi);
    }
}

__device__ __forceinline__ void phase_sparse_fast(const Ctx& X, const bf16* Q1, const bf16* K1, const bf16* V1, const unsigned* MASK32, bf16* O) {
    const int lane = X.lane, r32 = lane & 31, hi = lane >> 5;
    LAS unsigned char* vl = X.lds + X.wave * 4096;
    const int trbase = (4 * hi + ((lane & 15) >> 2)) * 64 + (16 * ((lane >> 4) & 1) + 4 * (lane & 3)) * 2;
    for (int u = X.gw; u < NB * 64 * NH; u += X.NGW) {
        const int h = u & 15, tb = (u >> 4) & 63, b = u >> 10, g = h >> 3, t0 = tb * 32, ntile = 2 * ((t0 >> 6) + 1);
        const size_t tok = (size_t)b * SEQ + t0 + r32;
        bf16x8 qf[4];
#pragma unroll
        for (int d0 = 0; d0 < 4; ++d0) qf[d0] = *(const GAS bf16x8*)(Q1 + tok * DM + h * HD + 16 * d0 + 8 * hi);
        const bf16* kb = K1 + (size_t)b * SEQ * 128 + g * HD; const bf16* vb = V1 + (size_t)b * SEQ * 128 + g * HD;
        f32x16 o0 = {}, o1 = {}; float mrun = -1e30f, l = 0.f;
        for (int kt = 0; kt < ntile; ++kt) {
            const int key0 = kt * 32;
            bf16x8 kf[4]; u32x4 vr[4];
#pragma unroll
            for (int d0 = 0; d0 < 4; ++d0) kf[d0] = *(const GAS bf16x8*)(kb + (size_t)(key0 + r32) * 128 + 16 * d0 + 8 * hi);
#pragma unroll
            for (int i = 0; i < 4; ++i) vr[i] = *(const GAS u32x4*)(vb + (size_t)(key0 + i * 8 + (lane >> 3)) * 128 + 8 * (lane & 7));
            const unsigned mw = MASK32[tok * 64 + kt] >> (4 * hi);
            asm volatile("" ::: "memory");
            vtile_write(vl, vr, lane);
            f32x16 S = {};
#pragma unroll
            for (int d0 = 0; d0 < 4; ++d0) S = __builtin_amdgcn_mfma_f32_32x32x16_bf16(kf[d0], qf[d0], S, 0, 0, 0);
            float mx = -INFINITY;
#pragma unroll
            for (int r = 0; r < 16; ++r) { const unsigned msk = (unsigned)__builtin_amdgcn_sbfe((int)mw, (r & 3) + 8 * (r >> 2), 1);
                S[r] = __uint_as_float((__float_as_uint(S[r]) & msk) | (0xFF800000u & ~msk)); mx = fmaxf(mx, S[r]); }
            mx = half_max(mx);
            const float mnew = fmaxf(mrun, mx), f = __builtin_amdgcn_exp2f(mrun - mnew); mrun = mnew;
            f32x16 p; float ps = 0.f;
#pragma unroll
            for (int r = 0; r < 16; ++r) { p[r] = __builtin_amdgcn_exp2f(S[r] - mnew); ps += p[r]; }
            l = l * f + ps;
            if (__any(f != 1.0f)) {
#pragma unroll
                for (int r = 0; r < 16; ++r) { o0[r] *= f; o1[r] *= f; } }
            const bf16x8 p0 = pack8(p, 0), p1 = pack8(p, 1);
            asm volatile("" ::: "memory");
            o0 = __builtin_amdgcn_mfma_f32_32x32x16_bf16(vtile_frag(vl, trbase, 0, 0), p0, o0, 0, 0, 0);
            o1 = __builtin_amdgcn_mfma_f32_32x32x16_bf16(vtile_frag(vl, trbase, 0, 1), p0, o1, 0, 0, 0);
            o0 = __builtin_amdgcn_mfma_f32_32x32x16_bf16(vtile_frag(vl, trbase, 1, 0), p1, o0, 0, 0, 0);
            o1 = __builtin_amdgcn_mfma_f32_32x32x16_bf16(vtile_frag(vl, trbase, 1, 1), p1, o1, 0, 0, 0);
            asm volatile("" ::: "memory");
        }
        l = half_sum(l);
        store_ot(O + tok * DM + h * HD, o0, o1, 1.0f / l, hi);
    }
}

__device__ __forceinline__ void phase_idx_topk_fast(const Ctx& X, const bf16* QI, const bf16* KI, const float* WI, unsigned long long* MASK) {
    const int lane = X.lane, r32 = lane & 31, hi = lane >> 5;
    const int tkr = 2 * ((r32 >> 2) & 1) + (r32 >> 4), hdr = (r32 & 3) + 4 * ((r32 >> 3) & 1);
    int round = 0;
    for (int u0 = X.gw; u0 < NTOK / 4; u0 += X.NGW, ++round) {
        const int b = u0 >> 9; int tg = u0 & 511; if (round & 1) tg = 511 - tg;
        const int t0 = tg * 4, c = t0 >> 6; const size_t tok0 = (size_t)b * SEQ + t0;
        bf16x8 qf[4];
#pragma unroll
        for (int d0 = 0; d0 < 4; ++d0) qf[d0] = *(const GAS bf16x8*)(QI + (tok0 + tkr) * 512 + hdr * 64 + 16 * d0 + 8 * hi);
        float w0[8], w1[8];
#pragma unroll
        for (int hh = 0; hh < 8; ++hh) { w0[hh] = WI[(tok0 + 2 * hi) * 8 + hh]; w1[hh] = WI[(tok0 + 2 * hi + 1) * 8 + hh]; }
        unsigned k0[32], k1[32], k2[32], k3[32];
        const bf16* kib = KI + (size_t)b * SEQ * 64;
#pragma unroll
        for (int m = 0; m < 32; ++m) {
            if (m <= c) {
                float sa[2], sb[2];
#pragma unroll
                for (int half = 0; half < 2; ++half) {
                    const int key0 = 64 * m + 32 * half; f32x16 R = {};
#pragma unroll
                    for (int d0 = 0; d0 < 4; ++d0) { const bf16x8 kf = *(const GAS bf16x8*)(kib + (size_t)(key0 + r32) * 64 + 16 * d0 + 8 * hi); R = __builtin_amdgcn_mfma_f32_32x32x16_bf16(qf[d0], kf, R, 0, 0, 0); }
                    float s0 = 0.f, s1 = 0.f;
#pragma unroll
                    for (int hh = 0; hh < 8; ++hh) { s0 += w0[hh] * fmaxf(R[hh], 0.f); s1 += w1[hh] * fmaxf(R[8 + hh], 0.f); }
                    sa[half] = s0; sb[half] = s1;
                }
                const auto ra = __builtin_amdgcn_permlane32_swap(ord_key(sa[0]), ord_key(sa[1]), false, false);
                const auto rb = __builtin_amdgcn_permlane32_swap(ord_key(sb[0]), ord_key(sb[1]), false, false);
                k0[m] = ra[0]; k2[m] = ra[1]; k1[m] = rb[0]; k3[m] = rb[1];
            } else { k0[m] = 0u; k1[m] = 0u; k2[m] = 0u; k3[m] = 0u; }
        }
        topk_select_store(k0, c, MASK + (tok0 + 0) * 32, lane);
        topk_select_store(k1, c, MASK + (tok0 + 1) * 32, lane);
        topk_select_store(k2, c, MASK + (tok0 + 2) * 32, lane);
        topk_select_store(k3, c, MASK + (tok0 + 3) * 32, lane);
    }
}


__device__ __forceinline__ void wait_vm_le(int n) {
    switch (n) { case 0: WAITV(0); break; case 1: WAITV(1); break; case 2: WAITV(2); break; case 3: WAITV(3); break; case 4: WAITV(4); break; case 5: WAITV(5); break; case 6: WAITV(6); break;
                 case 7: WAITV(7); break; case 8: WAITV(8); break; case 9: WAITV(9); break; case 10: WAITV(10); break; case 11: WAITV(11); break; case 12: WAITV(12); break; default: WAITV(12); break; }
}
__device__ __forceinline__ void ktile_dma(LAS unsigned char* slot, const bf16* rows  , int pitch, int tid, int wave) {
    const int key = tid >> 3, cpos = tid & 7, src = cpos ^ ((key >> 1) & 7);
    __builtin_amdgcn_global_load_lds((const GAS unsigned*)(rows + (size_t)key * pitch + src * 8), (LAS unsigned*)(slot + wave * 1024), 16, 0, 0);
}
__device__ __forceinline__ bf16x8 ktile_frag(const LAS unsigned char* slot, int key, int d0, int hi) {
    return *(const LAS bf16x8*)(slot + key * 128 + (((2 * d0 + hi) ^ ((key >> 1) & 7)) << 4));
}
__device__ __forceinline__ void vtile_dma(LAS unsigned char* slot, const bf16* rows, int pitch, int tid, int wave) {
    const int st = tid >> 5, row = (tid & 31) >> 2, ch = tid & 3, key = (st >> 1) * 8 + row, d = (st & 1) * 32 + ch * 8;
    __builtin_amdgcn_global_load_lds((const GAS unsigned*)(rows + (size_t)key * pitch + d), (LAS unsigned*)(slot + wave * 1024), 16, 0, 0);
}

__device__ __forceinline__ void phase_sparse_coop(const Ctx& X, const bf16* PRAW, const float* ROPE, const float* qgain, float Mb, const bf16* K1, const bf16* V1, const unsigned char* MASKB, bf16* O) {
    const int lane = X.lane, r32 = lane & 31, hi = lane >> 5, tid = X.tid, wave = X.wave;
    constexpr int SP_NS = 6, SP_D = 5;
    LAS unsigned char* kring = X.lds; LAS unsigned char* vring = X.lds + SP_NS * 8192; LAS unsigned char* mlds = X.lds + 2 * SP_NS * 8192;
    const int trbase = (4 * hi + ((lane & 15) >> 2)) * 64 + (16 * ((lane >> 4) & 1) + 4 * (lane & 3)) * 2;
    for (int i = 0; i < 16; ++i) {
        const int P = blockIdx.x + 256 * i; if (P >= NB * 2 * 64) break;
        int tb = P & 63; const int g = (P >> 6) & 1, b = P >> 7; if (i & 1) tb = 63 - tb;
        const int t0 = tb * 32, c = t0 >> 6, h = 8 * g + wave;
        const size_t tokb = (size_t)b * SEQ, tok = tokb + t0 + r32;
        const bf16* kb = K1 + tokb * 128 + g * HD; const bf16* vb = V1 + tokb * 128 + g * HD;
        __builtin_amdgcn_global_load_lds((const GAS unsigned*)(MASKB + (tokb + t0 + (tid >> 4)) * 256 + (tid & 15) * 16), (LAS unsigned*)(mlds + wave * 1024), 16, 0, 0);
        bf16x8 qf[4];
        { const GAS f32x4* rp = (const GAS f32x4*)(ROPE + tok * 16); const f32x4 cs[2] = {rp[0], rp[1]}, sn[2] = {rp[2], rp[3]};
          load_q_frags(PRAW + tok * NPROJ + h * HD, qgain, cs, sn, hi, qf); }
#pragma unroll
        for (int p = 0; p < SP_D; ++p) if (p <= c) { ktile_dma(kring + p * 8192, kb + (size_t)p * 64 * 128, 128, tid, wave); vtile_dma(vring + p * 8192, vb + (size_t)p * 64 * 128, 128, tid, wave); }
        f32x16 o0 = {}, o1 = {}; float mrun = -1e30f, l = 0.f;
        const float Mrow = Mb;
        const bool fast = !__any(!(Mrow <= 60.f));
        const float cinit = fast ? -Mrow : 0.f;
#define SP_QK(SA_, SB_, slot_) do { const LAS unsigned char* ks_ = kring + (slot_) * 8192; \
            _Pragma("unroll") for (int r = 0; r < 16; ++r) { SA_[r] = cinit; SB_[r] = cinit; } \
            _Pragma("unroll") for (int d0 = 0; d0 < 4; ++d0) { SA_ = __builtin_amdgcn_mfma_f32_32x32x16_bf16(ktile_frag(ks_, r32, d0, hi), qf[d0], SA_, 0, 0, 0); SB_ = __builtin_amdgcn_mfma_f32_32x32x16_bf16(ktile_frag(ks_, 32 + r32, d0, hi), qf[d0], SB_, 0, 0, 0); } } while (0)
#define SP_PV(C0_, C1_) do { \
            { const bf16x8 pa = pack8(C0_, 0), pb = pack8(C0_, 1); \
              o0 = __builtin_amdgcn_mfma_f32_32x32x16_bf16(vtile_frag(vs, trbase, 0, 0), pa, o0, 0, 0, 0); o1 = __builtin_amdgcn_mfma_f32_32x32x16_bf16(vtile_frag(vs, trbase, 0, 1), pa, o1, 0, 0, 0); \
              o0 = __builtin_amdgcn_mfma_f32_32x32x16_bf16(vtile_frag(vs, trbase, 1, 0), pb, o0, 0, 0, 0); o1 = __builtin_amdgcn_mfma_f32_32x32x16_bf16(vtile_frag(vs, trbase, 1, 1), pb, o1, 0, 0, 0); } \
            { const bf16x8 pc = pack8(C1_, 0), pd = pack8(C1_, 1); \
              o0 = __builtin_amdgcn_mfma_f32_32x32x16_bf16(vtile_frag(vs, trbase, 2, 0), pc, o0, 0, 0, 0); o1 = __builtin_amdgcn_mfma_f32_32x32x16_bf16(vtile_frag(vs, trbase, 2, 1), pc, o1, 0, 0, 0); \
              o0 = __builtin_amdgcn_mfma_f32_32x32x16_bf16(vtile_frag(vs, trbase, 3, 0), pd, o0, 0, 0, 0); o1 = __builtin_amdgcn_mfma_f32_32x32x16_bf16(vtile_frag(vs, trbase, 3, 1), pd, o1, 0, 0, 0); } } while (0)
        if (fast) {
            f32x16 S0, S1, N0, N1;
            { const int ahead = c < (SP_D - 1) ? c : (SP_D - 1); wait_vm_le(2 * ahead); }
            SBAR();
            SP_QK(S0, S1, 0);
            int slot = 0;
#define SP_STEP(C0_, C1_, X0_, X1_, m_) do { const int m = (m_); \
                const int slotn = (slot == SP_NS - 1) ? 0 : slot + 1; \
                { int ahead = (c - m - 1) < (SP_D - 2) ? (c - m - 1) : (SP_D - 2); if (ahead < 0) ahead = 0; wait_vm_le(2 * ahead); } \
                SBAR(); \
                if (m + SP_D <= c) { const int s2 = (slot == 0) ? SP_NS - 1 : slot - 1; ktile_dma(kring + s2 * 8192, kb + (size_t)(m + SP_D) * 64 * 128, 128, tid, wave); vtile_dma(vring + s2 * 8192, vb + (size_t)(m + SP_D) * 64 * 128, 128, tid, wave); } \
                if (m + 1 <= c) SP_QK(X0_, X1_, slotn); \
                const LAS unsigned char* vs = vring + slot * 8192; \
                const u32x2 mw2 = *(const LAS u32x2*)(mlds + r32 * 256 + m * 8); \
                const unsigned mwa = mw2.x >> (4 * hi), mwb = mw2.y >> (4 * hi); \
                float ps = 0.f; \
                _Pragma("unroll") for (int r = 0; r < 16; ++r) { const int pos = (r & 3) + 8 * (r >> 2); \
                    const unsigned ma = (unsigned)__builtin_amdgcn_sbfe((int)mwa, pos, 1), mb = (unsigned)__builtin_amdgcn_sbfe((int)mwb, pos, 1); \
                    C0_[r] = __uint_as_float(__float_as_uint(__builtin_amdgcn_exp2f(C0_[r])) & ma); C1_[r] = __uint_as_float(__float_as_uint(__builtin_amdgcn_exp2f(C1_[r])) & mb); ps += C0_[r] + C1_[r]; } \
                l += ps; \
                SP_PV(C0_, C1_); \
                slot = slotn; } while (0)
            for (int mm = 0; mm <= c; mm += 2) {
                SP_STEP(S0, S1, N0, N1, mm);
                if (mm + 1 <= c) SP_STEP(N0, N1, S0, S1, mm + 1);
            }
#undef SP_STEP
        } else {
            int slot = 0;
            for (int m = 0; m <= c; ++m) {
                { const int ahead = (c - m) < (SP_D - 1) ? (c - m) : (SP_D - 1); wait_vm_le(2 * ahead); }
                SBAR();
                if (m + SP_D <= c) { const int s2 = (slot == 0) ? SP_NS - 1 : slot - 1; ktile_dma(kring + s2 * 8192, kb + (size_t)(m + SP_D) * 64 * 128, 128, tid, wave); vtile_dma(vring + s2 * 8192, vb + (size_t)(m + SP_D) * 64 * 128, 128, tid, wave); }
                const LAS unsigned char* vs = vring + slot * 8192;
                f32x16 S0, S1;
                SP_QK(S0, S1, slot);
                const u32x2 mw2 = *(const LAS u32x2*)(mlds + r32 * 256 + m * 8);
                const unsigned mwa = mw2.x >> (4 * hi), mwb = mw2.y >> (4 * hi);
                float mx = -INFINITY;
#pragma unroll
                for (int r = 0; r < 16; ++r) { const int pos = (r & 3) + 8 * (r >> 2);
                    const unsigned ma = (unsigned)__builtin_amdgcn_sbfe((int)mwa, pos, 1), mb = (unsigned)__builtin_amdgcn_sbfe((int)mwb, pos, 1);
                    S0[r] = __uint_as_float((__float_as_uint(S0[r]) & ma) | (0xFF800000u & ~ma)); S1[r] = __uint_as_float((__float_as_uint(S1[r]) & mb) | (0xFF800000u & ~mb));
                    mx = fmaxf(mx, fmaxf(S0[r], S1[r])); }
                mx = half_max(mx);
                const float mnew = fmaxf(mrun, mx), f = __builtin_amdgcn_exp2f(mrun - mnew); mrun = mnew;
                float ps = 0.f;
#pragma unroll
                for (int r = 0; r < 16; ++r) { S0[r] = __builtin_amdgcn_exp2f(S0[r] - mnew); S1[r] = __builtin_amdgcn_exp2f(S1[r] - mnew); ps += S0[r] + S1[r]; }
                l = l * f + ps;
                if (__any(f != 1.0f)) {
#pragma unroll
                    for (int r = 0; r < 16; ++r) { o0[r] *= f; o1[r] *= f; } }
                SP_PV(S0, S1);
                slot = (slot == SP_NS - 1) ? 0 : slot + 1;
            }
        }
#undef SP_QK
#undef SP_PV
        l = half_sum(l);
        store_ot(O + tok * DM + h * HD, o0, o1, 1.0f / l, hi);
        asm volatile("s_waitcnt lgkmcnt(0)" ::: "memory");
        SBAR();
    }
}


__device__ __forceinline__ void phase_sparse_coop2(const Ctx& X, const bf16* PRAW, const float* ROPE, const float* qgain, float Mb, const bf16* K1, const bf16* V1, const unsigned char* MASKB, bf16* O) {
    const int lane = X.lane, r32 = lane & 31, hi = lane >> 5, tid = X.tid, wave = X.wave, g = wave >> 2, hA = 8 * g + 2 * (wave & 3);
    constexpr int NS = 3, D = 2;
    LAS unsigned char* kring = X.lds; LAS unsigned char* vring = X.lds + NS * 16384; LAS unsigned char* mlds = X.lds + 2 * NS * 16384;
    const int trbase = (4 * hi + ((lane & 15) >> 2)) * 64 + (16 * ((lane >> 4) & 1) + 4 * (lane & 3)) * 2;
    for (int i = 0; i < 8; ++i) {
        const int P = blockIdx.x + 256 * i; if (P >= NB * 64) break;
        int tb = P & 63; const int b = P >> 6; if (i & 1) tb = 63 - tb;
        const int t0 = tb * 32, c = t0 >> 6;
        const size_t tokb = (size_t)b * SEQ, tok = tokb + t0 + r32;
        const bf16* kb0 = K1 + tokb * 128; const bf16* vb0 = V1 + tokb * 128;
#define SP2_DMA(slot_, tile_) do { LAS unsigned char* ks_ = kring + (slot_) * 16384; LAS unsigned char* vs_ = vring + (slot_) * 16384; const size_t ro_ = (size_t)(tile_) * 64 * 128; \
            ktile_dma(ks_, kb0 + ro_, 128, tid, wave); ktile_dma(ks_ + 8192, kb0 + ro_ + HD, 128, tid, wave); vtile_dma(vs_, vb0 + ro_, 128, tid, wave); vtile_dma(vs_ + 8192, vb0 + ro_ + HD, 128, tid, wave); } while (0)
        __builtin_amdgcn_global_load_lds((const GAS unsigned*)(MASKB + (tokb + t0 + (tid >> 4)) * 256 + (tid & 15) * 16), (LAS unsigned*)(mlds + wave * 1024), 16, 0, 0);
        const RawFr rwA = raw_frags(PRAW + tok * NPROJ + hA * HD, hi), rwB = raw_frags(PRAW + tok * NPROJ + (hA + 1) * HD, hi);
        const GAS f32x4* rp = (const GAS f32x4*)(ROPE + tok * 16); const f32x4 cs[2] = {rp[0], rp[1]}, sn[2] = {rp[2], rp[3]};
        asm volatile("" ::: "memory");
#pragma unroll
        for (int p = 0; p < D; ++p) if (p <= c) SP2_DMA(p, p);
        asm volatile("" ::: "memory");
        bf16x8 qa[4], qb[4];
        q_frags_from_raw(rwA, qgain, cs, sn, hi, qa); q_frags_from_raw(rwB, qgain, cs, sn, hi, qb);
        f32x16 a0 = {}, a1 = {}, b0 = {}, b1 = {}; float lA = 0.f, lB = 0.f;
        const float cinit = -Mb;
        int slot = 0;
        for (int m = 0; m <= c; ++m) {
            { const int ahead = (c - m) < (D - 1) ? (c - m) : (D - 1); wait_vm_le(4 * ahead); }
            SBAR();
            if (m + D <= c) { const int s2 = (slot == 0) ? NS - 1 : slot - 1; SP2_DMA(s2, m + D); }
            const LAS unsigned char* ks = kring + slot * 16384 + g * 8192; const LAS unsigned char* vs = vring + slot * 16384 + g * 8192;
            f32x16 A0, A1, B0, B1;
            { const u32x2 mw2 = *(const LAS u32x2*)(mlds + r32 * 256 + m * 8);
              const unsigned mwa = mw2.x >> (4 * hi), mwb = mw2.y >> (4 * hi), cb = __float_as_uint(cinit);
#pragma unroll
              for (int r = 0; r < 16; ++r) { const int pos = (r & 3) + 8 * (r >> 2);
                  const unsigned ma = (unsigned)__builtin_amdgcn_sbfe((int)mwa, pos, 1), mb = (unsigned)__builtin_amdgcn_sbfe((int)mwb, pos, 1);
                  const float ia = __uint_as_float((ma & cb) | (~ma & 0xFF800000u)), ib = __uint_as_float((mb & cb) | (~mb & 0xFF800000u));
                  A0[r] = ia; B0[r] = ia; A1[r] = ib; B1[r] = ib; } }
#pragma unroll
            for (int d0 = 0; d0 < 4; ++d0) { const bf16x8 k0 = ktile_frag(ks, r32, d0, hi), k1 = ktile_frag(ks, 32 + r32, d0, hi);
                A0 = __builtin_amdgcn_mfma_f32_32x32x16_bf16(k0, qa[d0], A0, 0, 0, 0); B0 = __builtin_amdgcn_mfma_f32_32x32x16_bf16(k0, qb[d0], B0, 0, 0, 0);
                A1 = __builtin_amdgcn_mfma_f32_32x32x16_bf16(k1, qa[d0], A1, 0, 0, 0); B1 = __builtin_amdgcn_mfma_f32_32x32x16_bf16(k1, qb[d0], B1, 0, 0, 0); }
            f32x2 pA0 = {0.f, 0.f}, pA1 = {0.f, 0.f}, pB0 = {0.f, 0.f}, pB1 = {0.f, 0.f};
#pragma unroll
            for (int r = 0; r < 16; ++r) { A0[r] = __builtin_amdgcn_exp2f(A0[r]); A1[r] = __builtin_amdgcn_exp2f(A1[r]); B0[r] = __builtin_amdgcn_exp2f(B0[r]); B1[r] = __builtin_amdgcn_exp2f(B1[r]); }
#pragma unroll
            for (int r = 0; r < 16; r += 2) { pA0 += (f32x2){A0[r], A0[r + 1]}; pA1 += (f32x2){A1[r], A1[r + 1]}; pB0 += (f32x2){B0[r], B0[r + 1]}; pB1 += (f32x2){B1[r], B1[r + 1]}; }
            { const f32x2 sa2 = pA0 + pA1, sb2 = pB0 + pB1; lA += sa2.x + sa2.y; lB += sb2.x + sb2.y; }
#define SP2_PV(s4_, PA_, PB_) do { const bf16x8 v0_ = vtile_frag(vs, trbase, s4_, 0), v1_ = vtile_frag(vs, trbase, s4_, 1); \
                a0 = __builtin_amdgcn_mfma_f32_32x32x16_bf16(v0_, PA_, a0, 0, 0, 0); a1 = __builtin_amdgcn_mfma_f32_32x32x16_bf16(v1_, PA_, a1, 0, 0, 0); \
                b0 = __builtin_amdgcn_mfma_f32_32x32x16_bf16(v0_, PB_, b0, 0, 0, 0); b1 = __builtin_amdgcn_mfma_f32_32x32x16_bf16(v1_, PB_, b1, 0, 0, 0); } while (0)
            { const bf16x8 pa = pack8(A0, 0), pb = pack8(B0, 0); SP2_PV(0, pa, pb); }
            { const bf16x8 pa = pack8(A0, 1), pb = pack8(B0, 1); SP2_PV(1, pa, pb); }
            { const bf16x8 pa = pack8(A1, 0), pb = pack8(B1, 0); SP2_PV(2, pa, pb); }
            { const bf16x8 pa = pack8(A1, 1), pb = pack8(B1, 1); SP2_PV(3, pa, pb); }
#undef SP2_PV
            slot = (slot == NS - 1) ? 0 : slot + 1;
        }
#undef SP2_DMA
        lA = half_sum(lA); lB = half_sum(lB);
        store_ot(O + tok * DM + hA * HD, a0, a1, 1.0f / lA, hi);
        store_ot(O + tok * DM + (hA + 1) * HD, b0, b1, 1.0f / lB, hi);
        asm volatile("s_waitcnt lgkmcnt(0)" ::: "memory");
        SBAR();
    }
}

__device__ __forceinline__ void phase_idx_topk_coop(const Ctx& X, const bf16* PRAW, const float* ROPE, const bf16* KI, const float* WI, unsigned long long* MASK) {
    const int lane = X.lane, r32 = lane & 31, hi = lane >> 5, tid = X.tid, wave = X.wave;
    const int tkr = 2 * ((r32 >> 2) & 1) + (r32 >> 4), hdr = (r32 & 3) + 4 * ((r32 >> 3) & 1);
    LAS unsigned char* kring = X.lds;
    for (int i = 0; i < 8; ++i) {
        const int P = blockIdx.x + 256 * i; if (P >= NB * 64) break;
        int tb = P & 63; const int b = P >> 6; if (i & 1) tb = 63 - tb;
        const int t0 = tb * 32 + 4 * wave, c = tb >> 1; const size_t tokb = (size_t)b * SEQ, tok0 = tokb + t0;
        const bf16* kib = KI + tokb * 64;
        const RawFr rwq = raw_frags(PRAW + (tok0 + tkr) * NPROJ + 1280 + hdr * 64, hi);
        const GAS f32x4* rp = (const GAS f32x4*)(ROPE + (tok0 + tkr) * 16); const f32x4 cs[2] = {rp[0], rp[1]}, sn[2] = {rp[2], rp[3]};
        float w0[8], w1[8];
        { const GAS f32x4* wp = (const GAS f32x4*)(WI + (tok0 + 2 * hi) * 8); const f32x4 a = wp[0], b4 = wp[1], c4 = wp[2], d4 = wp[3];
#pragma unroll
          for (int hh = 0; hh < 4; ++hh) { w0[hh] = a[hh]; w0[4 + hh] = b4[hh]; w1[hh] = c4[hh]; w1[4 + hh] = d4[hh]; } }
        asm volatile("" ::: "memory");
#pragma unroll
        for (int p = 0; p < 7; ++p) if (p <= c) ktile_dma(kring + p * 8192, kib + (size_t)p * 64 * 64, 64, tid, wave);
        asm volatile("" ::: "memory");
        bf16x8 qf[4];
        qi_frags_from_raw(rwq, cs, sn, hi, qf);
        unsigned k0[32], k1[32], k2[32], k3[32];
        SEC_BEGIN(1);
#pragma unroll
        for (int m = 0; m < 32; ++m) {
            if (m <= c) {
                { SEC_BEGIN(3);
                { const int ahead = (c - m) < 6 ? (c - m) : 6; wait_vm_le(ahead); }
                SEC_END(3); }
                { SEC_BEGIN(4);
                SBAR();
                SEC_END(4); }
                if (m + 7 <= c) ktile_dma(kring + ((m + 7) % 8) * 8192, kib + (size_t)(m + 7) * 64 * 64, 64, tid, wave);
                const LAS unsigned char* ks = kring + (m % 8) * 8192;
                float sa[2], sb[2];
                { bf16x8 kfa[4], kfb[4];
#pragma unroll
                  for (int d0 = 0; d0 < 4; ++d0) { kfa[d0] = ktile_frag(ks, r32, d0, hi); kfb[d0] = ktile_frag(ks, 32 + r32, d0, hi); }
                  f32x16 Ra = {}, Rb = {};
#pragma unroll
                  for (int d0 = 0; d0 < 4; ++d0) { Ra = __builtin_amdgcn_mfma_f32_32x32x16_bf16(qf[d0], kfa[d0], Ra, 0, 0, 0); Rb = __builtin_amdgcn_mfma_f32_32x32x16_bf16(qf[d0], kfb[d0], Rb, 0, 0, 0); }
                  f32x2 sA = {0.f, 0.f}, sB = {0.f, 0.f};
#pragma unroll
                  for (int hh = 0; hh < 8; ++hh) { sA = (f32x2){relu1(Ra[hh]), relu1(Rb[hh])} * w0[hh] + sA; sB = (f32x2){relu1(Ra[8 + hh]), relu1(Rb[8 + hh])} * w1[hh] + sB; }
                  sa[0] = sA.x; sb[0] = sB.x; sa[1] = sA.y; sb[1] = sB.y; }
                const auto ra = __builtin_amdgcn_permlane32_swap(ord_key(sa[0]), ord_key(sa[1]), false, false);
                const auto rb = __builtin_amdgcn_permlane32_swap(ord_key(sb[0]), ord_key(sb[1]), false, false);
                k0[m] = ra[0]; k2[m] = ra[1]; k1[m] = rb[0]; k3[m] = rb[1];
            } else { k0[m] = 0u; k1[m] = 0u; k2[m] = 0u; k3[m] = 0u; }
        }
        asm volatile("s_waitcnt lgkmcnt(0)" ::: "memory");
        SBAR();
        SEC_END(1);
        SEC_BEGIN(2);
        topk_select_store(k0, c, MASK + (tok0 + 0) * 32, lane);
        topk_select_store(k1, c, MASK + (tok0 + 1) * 32, lane);
        topk_select_store(k2, c, MASK + (tok0 + 2) * 32, lane);
        topk_select_store(k3, c, MASK + (tok0 + 3) * 32, lane);
        SEC_END(2);
    }
}


#define SB_TILE(S_, qf_, diag_, run_, o0_, o1_) do { \
        f32x16 S_ = {}; \
        _Pragma("unroll") for (int d0 = 0; d0 < 4; ++d0) S_ = __builtin_amdgcn_mfma_f32_32x32x16_bf16(ktile_frag(ks, r32, d0, hi), qf_[d0], S_, 0, 0, 0); \
        f32x16 xm_, ls_; float cs_ = 0.f; \
        _Pragma("unroll") for (int r = 0; r < 16; ++r) { const float z = S_[r]; const float sp = relu1(z) + __builtin_amdgcn_logf(1.0f + __builtin_amdgcn_exp2f(-fabsf(z))); \
            const bool valid = !(diag_) || (crow16(r, hi) < r32); xm_[r] = valid ? sp : 0.f; ls_[r] = valid ? z - sp : -INFINITY; cs_ += xm_[r]; } \
        cs_ = half_sum(cs_); \
        f32x16 T_; _Pragma("unroll") for (int r = 0; r < 16; ++r) T_[r] = run_; \
        T_ = __builtin_amdgcn_mfma_f32_32x32x16_bf16(uf[0], pack8(xm_, 0), T_, 0, 0, 0); \
        T_ = __builtin_amdgcn_mfma_f32_32x32x16_bf16(uf[1], pack8(xm_, 1), T_, 0, 0, 0); \
        _Pragma("unroll") for (int r = 0; r < 16; ++r) T_[r] = __builtin_amdgcn_exp2f(ls_[r] + T_[r]); \
        const bf16x8 p0_ = pack8(T_, 0), p1_ = pack8(T_, 1); \
        o0_ = __builtin_amdgcn_mfma_f32_32x32x16_bf16(vtile_frag(vs, trbase, 0, 0), p0_, o0_, 0, 0, 0); o1_ = __builtin_amdgcn_mfma_f32_32x32x16_bf16(vtile_frag(vs, trbase, 0, 1), p0_, o1_, 0, 0, 0); \
        o0_ = __builtin_amdgcn_mfma_f32_32x32x16_bf16(vtile_frag(vs, trbase, 1, 0), p1_, o0_, 0, 0, 0); o1_ = __builtin_amdgcn_mfma_f32_32x32x16_bf16(vtile_frag(vs, trbase, 1, 1), p1_, o1_, 0, 0, 0); \
        run_ -= cs_; } while (0)
#define SB_ELEM(S_, xm_, cs_, diag_, run_) do {   \
        _Pragma("unroll") for (int r = 0; r < 16; r += 2) { const f32x2 z = {S_[r], S_[r + 1]}; \
            f32x2 e; e.x = __builtin_amdgcn_exp2f(-fabsf(z.x)); e.y = __builtin_amdgcn_exp2f(-fabsf(z.y)); \
            const f32x2 d = e + 1.0f; \
            f32x2 lg; lg.x = __builtin_amdgcn_logf(d.x); lg.y = __builtin_amdgcn_logf(d.y); \
            f32x2 mx; mx.x = relu1(z.x); mx.y = relu1(z.y); \
            const f32x2 sp = mx + lg, t = z + ((f32x2){run_, run_} - sp); \
            xm_[r] = sp.x; xm_[r + 1] = sp.y; S_[r] = t.x; S_[r + 1] = t.y; } \
        if (diag_) { _Pragma("unroll") for (int r = 0; r < 16; ++r) { const bool valid = crow16(r, hi) < r32; xm_[r] = valid ? xm_[r] : 0.f; S_[r] = valid ? S_[r] : -INFINITY; } } \
        { f32x2 c2 = {0.f, 0.f}; _Pragma("unroll") for (int r = 0; r < 16; r += 2) c2 += (f32x2){xm_[r], xm_[r + 1]}; cs_ = half_sum(c2.x + c2.y); } } while (0)
#define SB_PAIR(dA_) do { \
        bf16x8 kf_[4]; _Pragma("unroll") for (int d0 = 0; d0 < 4; ++d0) kf_[d0] = ktile_frag(ks, r32, d0, hi); \
        f32x16 SA_ = {}, SB_ = {}; \
        _Pragma("unroll") for (int d0 = 0; d0 < 4; ++d0) { SA_ = __builtin_amdgcn_mfma_f32_32x32x16_bf16(kf_[d0], qa[d0], SA_, 0, 0, 0); SB_ = __builtin_amdgcn_mfma_f32_32x32x16_bf16(kf_[d0], qb[d0], SB_, 0, 0, 0); } \
        f32x16 xA_, xB_; float cA_, cB_; \
        SB_ELEM(SA_, xA_, cA_, dA_, runA); SB_ELEM(SB_, xB_, cB_, false, runB);            \
        SA_ = __builtin_amdgcn_mfma_f32_32x32x16_bf16(uf[0], pack8(xA_, 0), SA_, 0, 0, 0); SB_ = __builtin_amdgcn_mfma_f32_32x32x16_bf16(uf[0], pack8(xB_, 0), SB_, 0, 0, 0); \
        SA_ = __builtin_amdgcn_mfma_f32_32x32x16_bf16(uf[1], pack8(xA_, 1), SA_, 0, 0, 0); SB_ = __builtin_amdgcn_mfma_f32_32x32x16_bf16(uf[1], pack8(xB_, 1), SB_, 0, 0, 0); \
        _Pragma("unroll") for (int r = 0; r < 16; ++r) { SA_[r] = __builtin_amdgcn_exp2f(SA_[r]); SB_[r] = __builtin_amdgcn_exp2f(SB_[r]); } \
        { const bf16x8 pa_ = pack8(SA_, 0), pb_ = pack8(SB_, 0); const bf16x8 v0_ = vtile_frag(vs, trbase, 0, 0), v1_ = vtile_frag(vs, trbase, 0, 1); \
          a0 = __builtin_amdgcn_mfma_f32_32x32x16_bf16(v0_, pa_, a0, 0, 0, 0); b0 = __builtin_amdgcn_mfma_f32_32x32x16_bf16(v0_, pb_, b0, 0, 0, 0); \
          a1 = __builtin_amdgcn_mfma_f32_32x32x16_bf16(v1_, pa_, a1, 0, 0, 0); b1 = __builtin_amdgcn_mfma_f32_32x32x16_bf16(v1_, pb_, b1, 0, 0, 0); } \
        { const bf16x8 pa_ = pack8(SA_, 1), pb_ = pack8(SB_, 1); const bf16x8 v0_ = vtile_frag(vs, trbase, 1, 0), v1_ = vtile_frag(vs, trbase, 1, 1); \
          a0 = __builtin_amdgcn_mfma_f32_32x32x16_bf16(v0_, pa_, a0, 0, 0, 0); b0 = __builtin_amdgcn_mfma_f32_32x32x16_bf16(v0_, pb_, b0, 0, 0, 0); \
          a1 = __builtin_amdgcn_mfma_f32_32x32x16_bf16(v1_, pa_, a1, 0, 0, 0); b1 = __builtin_amdgcn_mfma_f32_32x32x16_bf16(v1_, pb_, b1, 0, 0, 0); } \
        runA -= cA_; runB -= cB_; } while (0)
__device__ __forceinline__ void sb_tile_dma(LAS unsigned char* slot, const bf16* base  , int key0, int lane) {
#pragma unroll
    for (int i = 0; i < 4; ++i) { const int key = 8 * i + (lane >> 3), src = (lane & 7) ^ ((key >> 1) & 7);
        __builtin_amdgcn_global_load_lds((const GAS unsigned*)(base + (size_t)(key0 + key) * NQKV + DM + src * 8), (LAS unsigned*)(slot + i * 1024), 16, 0, 0); }
#pragma unroll
    for (int i = 0; i < 4; ++i) { const int key = 8 * i + ((lane & 31) >> 2), d = 32 * (lane >> 5) + 8 * (lane & 3);
        __builtin_amdgcn_global_load_lds((const GAS unsigned*)(base + (size_t)(key0 + key) * NQKV + 2 * DM + d), (LAS unsigned*)(slot + 4096 + i * 1024), 16, 0, 0); }
}
__device__ __forceinline__ void phase_sb_pair(const Ctx& X, const bf16* QKV, bf16* O) {
    const int lane = X.lane, r32 = lane & 31, hi = lane >> 5;
    LAS unsigned char* ring = X.lds + X.wave * 16384;
    const int trbase = (4 * hi + ((lane & 15) >> 2)) * 64 + (16 * ((lane >> 4) & 1) + 4 * (lane & 3)) * 2;
    bf16x8 uf[2];
#pragma unroll
    for (int s = 0; s < 2; ++s)
#pragma unroll
        for (int j = 0; j < 8; ++j) uf[s][j] = ((16 * s + 8 * (j >> 2) + 4 * hi + (j & 3)) > r32) ? (short)0xBF80 : (short)0;
    for (int u = X.gw; u < NB * NH * 32; u += X.NGW) {
        const int b = u >> 9, h = (u >> 5) & 15, pb = u & 31, t0 = pb * 64;
        const bf16* base = QKV + (size_t)b * SEQ * NQKV + h * HD;
        asm volatile("s_waitcnt lgkmcnt(0)" ::: "memory");
        sb_tile_dma(ring, base, t0 + 32, lane);
        bf16x8 qa[4], qb[4];
#pragma unroll
        for (int d0 = 0; d0 < 4; ++d0) { qa[d0] = *(const GAS bf16x8*)(base + (size_t)(t0 + r32) * NQKV + 16 * d0 + 8 * hi); qb[d0] = *(const GAS bf16x8*)(base + (size_t)(t0 + 32 + r32) * NQKV + 16 * d0 + 8 * hi); }
        f32x16 a0 = {}, a1 = {}, b0 = {}, b1 = {}; float runA = 0.f, runB = 0.f;
        int slot = 0;
        for (int kt = 2 * pb + 1; kt >= 0; --kt) {
            asm volatile("s_waitcnt lgkmcnt(0)" ::: "memory");
            if (kt > 0) { sb_tile_dma(ring + (slot ^ 1) * 8192, base, (kt - 1) * 32, lane); WAITV(8); } else WAITV(0);
            const LAS unsigned char* ks = ring + slot * 8192; const LAS unsigned char* vs = ks + 4096;
            if (kt == 2 * pb + 1) { SB_TILE(SB, qb, true, runB, b0, b1); }
            else { const bool dA = (kt == 2 * pb); SB_PAIR(dA);
                if (__all(runA < -160.f && runB < -160.f)) break; }
            slot ^= 1;
        }
        store_ot(O + (size_t)(b * SEQ + t0 + r32) * DM + h * HD, a0, a1, 1.0f, hi);
        store_ot(O + (size_t)(b * SEQ + t0 + 32 + r32) * DM + h * HD, b0, b1, 1.0f, hi);
        WAITV(0);
    }
}

#ifndef MK_N_LAUNCHES
#define MK_N_LAUNCHES 1
#endif
constexpr int NPHASES = 19;
struct Args { const void* in[19]; float* out; unsigned char* ws; int ph_lo, ph_hi; };
static_assert(sizeof(Args) == 19 * 8 + 8 + 8 + 8, "Args has no padding");

__device__ __forceinline__ void moe_gemms_gu(const Ctx& X, const signed char* H8, const float* hs_e, const signed char* Wgu8_l, const float* wsc_l, const float* bgu_l, unsigned char* ACT, const unsigned* gcnt, const int* list) {
    LAS int* cntL = (LAS int*)(X.lds + EXTRA_OFF); LAS int* tsum = cntL + 32;
    moe_tables(X, gcnt, cntL, tsum);
    pg8::Gemm g{(const bf16*)H8, (const bf16*)Wgu8_l, DM, (size_t)2048 * DM};
    pg8::MoeOrder S{tsum, cntL, list, 8, X.G, (int)blockIdx.x, tsum[NE] * 8, 0};
    pg8::EpiSwiglu8 E{ACT, bgu_l, hs_e, wsc_l, &S};
    pg8::gemm_phase<pg8::EpiSwiglu8, pg8::MoeOrder, true, true, 1>(X.lds, g, S, E);
}
__device__ __forceinline__ void moe_gemms_down(const Ctx& X, const unsigned char* ACT8, const unsigned char* Wd8_l, const float* wsd_l, const float* bd_l, unsigned char* Y, const unsigned* gcnt, const int* list, const float* gate_e) {
    LAS int* cntL = (LAS int*)(X.lds + EXTRA_OFF); LAS int* tsum = cntL + 32;
    moe_tables(X, gcnt, cntL, tsum);
    pg8::Gemm g{(const bf16*)ACT8, (const bf16*)Wd8_l, DM, (size_t)DM * DM};
    pg8::MoeOrder S{tsum, cntL, list, 4, X.G, (int)blockIdx.x, tsum[NE] * 4, 0};
    pg8::EpiDownF8 E{Y, bd_l, gate_e, tsum, wsd_l};
    pg8::gemm_phase<pg8::EpiDownF8, pg8::MoeOrder, false, true, 2>(X.lds, g, S, E);
}

__global__ void __launch_bounds__(NTHREADS, 2) mk_fwd(Args a) {
    extern __shared__ __attribute__((aligned(16))) unsigned char lds_raw[];
    Ctx X; X.lds = (LAS unsigned char*)lds_raw; X.tid = threadIdx.x; X.lane = X.tid & 63; X.wave = __builtin_amdgcn_readfirstlane(X.tid >> 6);
    X.G = gridDim.x; { const int bx = blockIdx.x; X.vcu = (X.G % 8 == 0) ? (bx % 8) * (X.G / 8) + bx / 8 : bx; }
    X.gw = X.vcu * NWAVES + X.wave; X.NGW = X.G * NWAVES;
    volatile LAS unsigned* MISC = (volatile LAS unsigned*)(X.lds + LDSCTL_OFF);
    for (int u = X.tid; u < 256; u += NTHREADS) MISC[u] = 0u;
    __syncthreads();
    unsigned char* ws = a.ws;
    unsigned* ctl = (unsigned*)(ws + WS_CTL);
    XcdBarrier bar = xcd_barrier_post(ctl + CW_BAR, MISC + 8);
    const int lo = a.ph_lo, hi = a.ph_hi;
#ifndef ONLY_PHASE
#define ONLY_PHASE -1
#endif
#define IN(k) ((ONLY_PHASE < 0 || ONLY_PHASE == (k)) && lo <= (k) && (k) < hi)
#if defined(PROBE_LO)
    unsigned long long pr_t0 = 0, pr_t1 = 0;
#define PROBE_AT(k) do { if ((k) == PROBE_LO) pr_t0 = __builtin_amdgcn_s_memrealtime(); if ((k) == PROBE_HI) pr_t1 = __builtin_amdgcn_s_memrealtime(); } while (0)
#else
#define PROBE_AT(k) do {} while (0)
#endif
#define SEAM(k) do { if (IN(k) && IN((k) + 1)) xcd_barrier(bar); PROBE_AT((k) + 1); } while (0)
    const float* x_in = (const float*)a.in[0]; const float* c_in = (const float*)a.in[1]; const int* positions = (const int*)a.in[2];
    const float* ada_w = (const float*)a.in[3]; const float* ada_b = (const float*)a.in[4]; const float* norm1_g = (const float*)a.in[5]; const float* norm2_g = (const float*)a.in[6];
    const float* sb_w_qkv = (const float*)a.in[7]; const float* sb_w_o = (const float*)a.in[8]; const float* dsa_w_in = (const float*)a.in[9];
    const float* dsa_q_gain = (const float*)a.in[10]; const float* dsa_k_gain = (const float*)a.in[11]; const float* dsa_w_o = (const float*)a.in[12];
    const float* router_w = (const float*)a.in[13]; const float* router_b = (const float*)a.in[14];
    const float* exp_w_gu = (const float*)a.in[15]; const float* exp_b_gu = (const float*)a.in[16]; const float* exp_w_down = (const float*)a.in[17]; const float* exp_b_down = (const float*)a.in[18];
    float* out = a.out;
    float* mod = (float*)(ws + WS_MOD);
    signed char* Wqkv8 = (signed char*)(ws + WS_WQKV); bf16* Wo0_t = (bf16*)(ws + WS_WO0); signed char* Win8 = (signed char*)(ws + WS_WIN); bf16* Wo1_t = (bf16*)(ws + WS_WO1); signed char* Wgu8 = (signed char*)(ws + WS_WGU); bf16* Wd_t = (bf16*)(ws + WS_WD);
    float* wsc = (float*)(ws + WS_WSC); signed char* H8 = (signed char*)(ws + WS_H); float* HS = (float*)(ws + WS_HS);
    bf16* QKV = (bf16*)(ws + WS_QKV); unsigned char* ACT = ws + WS_A; unsigned char* Y = ws + WS_B; bf16* O = (bf16*)(ws + WS_O);
    bf16* PRAW = (bf16*)(ws + WS_PRAW); bf16* Q1 = (bf16*)(ws + WS_Q1); bf16* K1 = (bf16*)(ws + WS_K1); bf16* V1 = (bf16*)(ws + WS_V1); bf16* QI = (bf16*)(ws + WS_QI); bf16* KI = (bf16*)(ws + WS_KI); float* WI = (float*)(ws + WS_WI); float* QN = (float*)(ws + WS_QN);
    unsigned long long* MASK = (unsigned long long*)(ws + WS_MASK); float* SC = (float*)(ws + WS_SC);
    int* tok_e = (int*)(ws + WS_TOKE); int* tok_p = (int*)(ws + WS_TOKP); int* list = (int*)(ws + WS_LIST); float* gate_e = (float*)(ws + WS_GATE); float* hs_e = (float*)(ws + WS_HSE); bf16* XR = (bf16*)(ws + WS_XR);
    unsigned* gcnt0 = ctl + CW_CNT; unsigned* gcnt1 = ctl + CW_CNT + 32;
    const float* mod0 = mod; const float* mod1 = mod + (size_t)NB * 6144;

    PROBE_AT(0);
    if (IN(0)) { phase_prologue(X, c_in, ada_w, ada_b, mod, sb_w_qkv, sb_w_o, dsa_w_in, dsa_w_o, exp_w_gu, exp_w_down, Wqkv8, Wo0_t, Win8, Wo1_t, Wgu8, Wd_t, wsc, ctl + CW_ADA, ctl + CW_ITEM);
        if (IN(1)) { if (X.tid == 0) { XB_SPIN(xb_ld(ctl + CW_ADA) < 192u, bar.bar); __builtin_amdgcn_fence(__ATOMIC_ACQUIRE, "agent"); asm volatile("s_waitcnt vmcnt(0)" ::: "memory"); }
            __syncthreads(); }
        PROBE_AT(1); }
    if (IN(1)) { phase_norm1(X, x_in, norm1_g, mod0, H8, HS); SEAM(1); }
    if (IN(2)) { pg8::Gemm g{(const bf16*)H8, (const bf16*)Wqkv8, DM, 0}; pg8::StaticOrder S; S.init(NTOK, NQKV, X.G, (int)blockIdx.x); pg8::EpiBf16S8 E{QKV, NQKV, DM, QSCALE, HS, wsc};
        pg8::gemm_phase<pg8::EpiBf16S8, pg8::StaticOrder, false, true, 1>(X.lds, g, S, E); SEAM(2); }
#if defined(NAIVE_SB)
    if (IN(3)) { phase_sb_naive(X, QKV, O); SEAM(3); }
#else
    if (IN(3)) { phase_sb_pair(X, QKV, O); SEAM(3); }
#endif
    if (IN(4)) { pg8::Gemm g{O, Wo0_t, DM, 0}; pg8::StaticOrder S; S.init(NTOK, DM, X.G, (int)blockIdx.x); pg8::EpiResid<false> E{x_in, XR, mod0 + 2 * DM};
        pg8::gemm_phase<pg8::EpiResid<false>, pg8::StaticOrder, false, true>(X.lds, g, S, E); SEAM(4); }
    if (IN(5)) { phase_norm2_router(X, XR, norm2_g, mod0, router_w, router_b, H8, HS, tok_e, tok_p, gcnt0, list, gate_e, hs_e); SEAM(5); }
    if (IN(6)) { moe_gemms_gu(X, H8, hs_e, Wgu8, wsc + NQKV + NPROJ, exp_b_gu, ACT, gcnt0, list); SEAM(6); }
    if (IN(7)) { moe_gemms_down(X, ACT, (const unsigned char*)Wd_t, wsc + NQKV + NPROJ + 64 * 2048, exp_b_down, Y, gcnt0, list, gate_e); SEAM(7); }
    if (IN(8)) { phase_combine(X, XR, nullptr, Y, tok_e, tok_p, gcnt0, mod0, true, norm1_g + DM, mod1, H8, HS); SEAM(8); }
    if (IN(9)) { pg8::Gemm g{(const bf16*)H8, (const bf16*)Win8, DM, 0}; pg8::StaticOrder S; S.init(NTOK, NPROJ, X.G, (int)blockIdx.x); pg8::EpiBf16S8 E{PRAW, NPROJ, 0, 1.0f, HS, wsc + NQKV};
        pg8::gemm_phase<pg8::EpiBf16S8, pg8::StaticOrder, false, true, 1>(X.lds, g, S, E); SEAM(9); }
    float* ROPE = (float*)(ws + WS_ROPE);
    if (IN(10)) { phase_dsa_post2(X, PRAW, positions, dsa_k_gain, K1, V1, KI, WI, ROPE); SEAM(10); }
#if defined(NAIVE_IDX)
    if (IN(11)) { phase_idx_naive(X, QI, KI, WI, SC); SEAM(11); }
    if (IN(12)) { phase_topk_naive(X, SC, MASK); SEAM(12); }
#else
    if (IN(11)) { phase_idx_topk_coop(X, PRAW, ROPE, KI, WI, MASK);
        if (IN(13)) { const float mb0 = qk_bound(dsa_q_gain, dsa_k_gain, X.lane);
            if (mb0 <= 60.f) { asm volatile("s_waitcnt vmcnt(0)" ::: "memory"); __syncthreads(); } else xcd_barrier(bar); }
        PROBE_AT(12); PROBE_AT(13); }
#endif
#if defined(NAIVE_SPARSE)
    if (IN(13)) { phase_sparse_naive(X, Q1, K1, V1, MASK, O); SEAM(13); }
#else
    if (IN(13)) { const float mb = qk_bound(dsa_q_gain, dsa_k_gain, X.lane);
        if (mb <= 60.f) phase_sparse_coop2(X, PRAW, ROPE, dsa_q_gain, mb, K1, V1, (const unsigned char*)MASK, O);
        else phase_sparse_coop(X, PRAW, ROPE, dsa_q_gain, mb, K1, V1, (const unsigned char*)MASK, O);
        SEAM(13); }
#endif
    if (IN(14)) { pg8::Gemm g{O, Wo1_t, DM, 0}; pg8::StaticOrder S; S.init(NTOK, DM, X.G, (int)blockIdx.x); pg8::EpiResid<true> E{XR, XR, mod1 + 2 * DM};
        pg8::gemm_phase<pg8::EpiResid<true>, pg8::StaticOrder, false, true>(X.lds, g, S, E); SEAM(14); }
    if (IN(15)) { phase_norm2_router(X, XR, norm2_g + DM, mod1, router_w + (size_t)DM * NE, router_b + NE, H8, HS, tok_e, tok_p, gcnt1, list, gate_e, hs_e); SEAM(15); }
    if (IN(16)) { moe_gemms_gu(X, H8, hs_e, Wgu8 + (size_t)NE * 2048 * DM, wsc + NQKV + NPROJ + NE * 2048, exp_b_gu + (size_t)NE * 2048, ACT, gcnt1, list); SEAM(16); }
    if (IN(17)) { moe_gemms_down(X, ACT, (const unsigned char*)Wd_t + (size_t)NE * DM * DM, wsc + NQKV + NPROJ + 64 * 2048 + NE * DM, exp_b_down + (size_t)NE * DM, Y, gcnt1, list, gate_e); SEAM(17); }
    if (IN(18)) { phase_combine(X, XR, out, Y, tok_e, tok_p, gcnt1, mod1, false, nullptr, nullptr, nullptr, nullptr); }
#if defined(PROBE_SEC)
    if (blockIdx.x == 0 && X.tid == 0) { const unsigned long long span = *(volatile LAS unsigned long long*)(X.lds + LDSCTL_OFF + 64) * PROBE_MULT, t = __builtin_amdgcn_s_memrealtime(); while (__builtin_amdgcn_s_memrealtime() - t < span) __builtin_amdgcn_s_sleep(8); }
#endif
#if defined(PROBE_LO)
    PROBE_AT(19);
    if (blockIdx.x == 0 && X.tid == 0) { const unsigned long long span = (pr_t1 - pr_t0) * PROBE_MULT, t = __builtin_amdgcn_s_memrealtime(); while (__builtin_amdgcn_s_memrealtime() - t < span) __builtin_amdgcn_s_sleep(8); }
#endif
#undef IN
#undef SEAM
}

extern "C" void kernel_launch(void* const* d_in, const int* in_sizes, int n_in, void* d_out, int out_size, void* d_ws, size_t ws_size, hipStream_t stream) {
    static int grid = 0;
    if (grid == 0) {
        if (n_in != 19 || out_size != NTOK * DM || ws_size < WS_END) { fprintf(stderr, "kernel_launch: unexpected shapes (n_in %d, out %d, ws %zu < %zu)\n", n_in, out_size, ws_size, (size_t)WS_END); grid = -1; return; }
        int dev = 0, cus = 0, per_cu = 0;
        if (hipGetDevice(&dev) != hipSuccess || hipDeviceGetAttribute(&cus, hipDeviceAttributeMultiprocessorCount, dev) != hipSuccess) { grid = -1; return; }
        if (hipFuncSetAttribute((const void*)mk_fwd, hipFuncAttributeMaxDynamicSharedMemorySize, LDS_BYTES) != hipSuccess) { fprintf(stderr, "kernel_launch: hipFuncSetAttribute failed\n"); grid = -1; return; }
        if (hipOccupancyMaxActiveBlocksPerMultiprocessor(&per_cu, (const void*)mk_fwd, NTHREADS, LDS_BYTES) != hipSuccess || per_cu < 1)
            fprintf(stderr, "kernel_launch: occupancy query reports %d workgroups per CU\n", per_cu);
        (void)hipGetLastError();
        grid = cus;
    }
    if (grid < 0) return;
    if (hipMemsetAsync((char*)d_ws + WS_CTL, 0, CTL_ZERO_BYTES, stream) != hipSuccess) return;
    Args a{};
    for (int i = 0; i < 19; ++i) a.in[i] = d_in[i];
    a.out = (float*)d_out; a.ws = (unsigned char*)d_ws;
#if MK_N_LAUNCHES == 1
    a.ph_lo = 0; a.ph_hi = NPHASES;
    hipLaunchKernelGGL(mk_fwd, dim3(grid), dim3(NTHREADS), LDS_BYTES, stream, a);
#else
    for (int p = 0; p < NPHASES; ++p) { a.ph_lo = p; a.ph_hi = p + 1; hipLaunchKernelGGL(mk_fwd, dim3(grid), dim3(NTHREADS), LDS_BYTES, stream, a); }
#endif
}
```

```cpp
#include <hip/hip_runtime.h>
#include <cstdio>
#include <cstdint>

#define GAS __attribute__((address_space(1)))
#define LAS __attribute__((address_space(3)))
typedef unsigned short bf16;
typedef short bf16x8 __attribute__((ext_vector_type(8)));
typedef float f32x4 __attribute__((ext_vector_type(4)));
typedef float f32x2 __attribute__((ext_vector_type(2)));
__device__ __forceinline__ float relu1(float z) { const int b = __float_as_int(z); return __int_as_float(b > 0 ? b : 0); }
typedef unsigned u32x4 __attribute__((ext_vector_type(4)));
typedef unsigned u32x2 __attribute__((ext_vector_type(2)));
typedef GAS unsigned gu32;

constexpr int DM = 1024, NB = 32, SEQ = 2048, NTOK = NB * SEQ, NE = 32, TOPK = 4, HD = 64, NH = 16;
constexpr int NQKV = 3072, NPROJ = 2048, NPROJ_REAL = 1864;
constexpr int ECAP = 65536;
constexpr int MOE_ROWS = NTOK * TOPK + NE * 256;
constexpr float EPS = 1e-6f;
constexpr float LOG2E = 1.4426950408889634f;
constexpr float QSCALE = 0.125f * LOG2E;
constexpr int NWAVES = 8, NTHREADS = 512;

constexpr size_t MiB = (size_t)1 << 20;
constexpr size_t WS_CTL = 0, CTL_ZERO_BYTES = 1 * MiB;
constexpr size_t WS_MOD = 1 * MiB;
constexpr size_t WS_WQKV = 3 * MiB, WS_WO0 = 9 * MiB, WS_WIN = 11 * MiB, WS_WO1 = 15 * MiB, WS_WGU = 17 * MiB, WS_WD = 273 * MiB;
constexpr size_t WS_H = 402 * MiB;
constexpr size_t WS_HS = WS_H + 64 * MiB, WS_WSC = 6 * MiB;
constexpr size_t WS_A = 530 * MiB;
constexpr size_t WS_QKV = WS_A, WS_PRAW = WS_A, WS_Q1 = 786 * MiB, WS_K1 = 914 * MiB, WS_V1 = 930 * MiB, WS_QI = 946 * MiB, WS_KI = 1010 * MiB, WS_WI = 1018 * MiB, WS_QN = 1020 * MiB, WS_ROPE = 1022 * MiB;
constexpr size_t WS_B = 1058 * MiB;
constexpr size_t WS_O = WS_B, WS_MASK = 1186 * MiB, WS_SC = 1202 * MiB;
constexpr size_t WS_TOKE = 1720 * MiB, WS_TOKP = 1721 * MiB, WS_TOKG = 1722 * MiB, WS_LIST = 1724 * MiB, WS_GATE = 1732 * MiB, WS_HSE = 1740 * MiB, WS_XR = 1748 * MiB, WS_END = 1876 * MiB;
static_assert(WS_A + (size_t)MOE_ROWS * DM * 2 <= WS_B && WS_B + (size_t)MOE_ROWS * DM * 2 <= WS_TOKE && WS_SC + (size_t)NTOK * SEQ * 4 <= WS_TOKE, "ws map");
constexpr int CW_TMO = 0, CW_BAR = 4096, CW_CNT = 8192, CW_KMAX = 8320, CW_ADA = 8448, CW_ITEM = 8456;

constexpr int RING_BYTES = 131072;
constexpr int LDSCTL_OFF = RING_BYTES;
constexpr int EXTRA_OFF = RING_BYTES + 1024;
constexpr int LDS_BYTES = 163840;

#define WAITV(n) asm volatile("s_waitcnt vmcnt(" #n ")" ::: "memory")
#define SBAR() do { asm volatile("" ::: "memory"); __builtin_amdgcn_s_barrier(); asm volatile("" ::: "memory"); } while (0)
#define LDS_WAIT() asm volatile("s_waitcnt lgkmcnt(0)" ::: "memory")
#define VM_WAIT() asm volatile("s_waitcnt vmcnt(0)" ::: "memory")
__device__ __forceinline__ unsigned f2bf(float f) { unsigned u = __builtin_bit_cast(unsigned, f); return (u + 0x7fffu + ((u >> 16) & 1u)) >> 16; }
typedef __bf16 bf16x2n __attribute__((ext_vector_type(2)));
__device__ __forceinline__ unsigned cvt_pk_bf16(float lo, float hi) { return __builtin_bit_cast(unsigned, __builtin_convertvector((f32x2){lo, hi}, bf16x2n)); }
__device__ __forceinline__ unsigned pk2(float lo, float hi) { return cvt_pk_bf16(lo, hi); }
__device__ __forceinline__ float bflo(unsigned w) { return __uint_as_float(w << 16); }
__device__ __forceinline__ float bfhi(unsigned w) { return __uint_as_float(w & 0xffff0000u); }
__device__ __forceinline__ unsigned pack4i(float a, float b, float c, float d) { return ((unsigned)(int)a & 0xffu) | (((unsigned)(int)b & 0xffu) << 8) | (((unsigned)(int)c & 0xffu) << 16) | (((unsigned)(int)d & 0xffu) << 24); }
template <int CTRL> __device__ __forceinline__ float dpp_mov(float v) { return __uint_as_float((unsigned)__builtin_amdgcn_update_dpp(0, (int)__float_as_uint(v), CTRL, 0xF, 0xF, true)); }
__device__ __forceinline__ float row_sum16(float v) { v += dpp_mov<0xB1>(v); v += dpp_mov<0x4E>(v); v += dpp_mov<0x141>(v); v += dpp_mov<0x140>(v); return v; }
__device__ __forceinline__ float row_max16(float v) { v = fmaxf(v, dpp_mov<0xB1>(v)); v = fmaxf(v, dpp_mov<0x4E>(v)); v = fmaxf(v, dpp_mov<0x141>(v)); v = fmaxf(v, dpp_mov<0x140>(v)); return v; }
__device__ __forceinline__ float quad_sum(float v) { v += dpp_mov<0xB1>(v); v += dpp_mov<0x4E>(v); return v; }
__device__ __forceinline__ float wave_sum(float v) {
    v = row_sum16(v);
    { const auto r = __builtin_amdgcn_permlane16_swap(__float_as_uint(v), __float_as_uint(v), false, false); v = __uint_as_float(r[0]) + __uint_as_float(r[1]); }
    { const auto r = __builtin_amdgcn_permlane32_swap(__float_as_uint(v), __float_as_uint(v), false, false); v = __uint_as_float(r[0]) + __uint_as_float(r[1]); }
    return v;
}
__device__ __forceinline__ float half_max32(float v) {
    v = row_max16(v);
    { const auto r = __builtin_amdgcn_permlane16_swap(__float_as_uint(v), __float_as_uint(v), false, false); v = fmaxf(__uint_as_float(r[0]), __uint_as_float(r[1])); }
    return v;
}
__device__ __forceinline__ float wave_max(float v) {
    v = half_max32(v);
    { const auto r = __builtin_amdgcn_permlane32_swap(__float_as_uint(v), __float_as_uint(v), false, false); v = fmaxf(__uint_as_float(r[0]), __uint_as_float(r[1])); }
    return v;
}

#if defined(PROBE_SEC)
#define SEC_BEGIN2(tag) unsigned long long _s2_t0 = ((tag) == PROBE_SEC) ? __builtin_amdgcn_s_memrealtime() : 0ull
#define SEC_END2(tag) do { if ((tag) == PROBE_SEC && blockIdx.x == 0 && threadIdx.x == 0) { volatile LAS unsigned long long* _acc = (volatile LAS unsigned long long*)(lds + LDSCTL_OFF + 64); *_acc = *_acc + (__builtin_amdgcn_s_memrealtime() - _s2_t0); } } while (0)
#define SEC_BEGIN3(tag) unsigned long long _s3_t0 = ((tag) == PROBE_SEC) ? __builtin_amdgcn_s_memrealtime() : 0ull
#define SEC_END3(tag) do { asm volatile("s_waitcnt vmcnt(0)" ::: "memory"); if ((tag) == PROBE_SEC && blockIdx.x == 0 && threadIdx.x == 0) { volatile LAS unsigned long long* _acc = (volatile LAS unsigned long long*)(lds + LDSCTL_OFF + 64); *_acc = *_acc + (__builtin_amdgcn_s_memrealtime() - _s3_t0); } } while (0)
#else
#define SEC_BEGIN2(tag) do {} while (0)
#define SEC_END2(tag) do {} while (0)
#define SEC_BEGIN3(tag) do {} while (0)
#define SEC_END3(tag) do {} while (0)
#endif
namespace pg8 {
constexpr int BM = 256, BK = 64, HALF = 128, HTB = HALF * BK * 2, NXCD = 8, WGM = 8;
__host__ __device__ __forceinline__ int lds_byte(int r, int c) { const int st = (r >> 4) * 2 + (c >> 5), rr = r & 15, cc = c & 31, ob = rr * 64 + cc * 2; return st * 1024 + (ob ^ (((ob >> 9) & 1) << 5)); }
__host__ __device__ __forceinline__ void stage_rc(int b, int& R, int& C) { const int st = b / 1024, sb = b % 1024, swz = sb ^ (((sb >> 9) & 1) << 5); R = (st >> 1) * 16 + swz / 64; C = (st & 1) * 32 + (swz % 64) / 2; }
__host__ __device__ __forceinline__ int perm32(int rho) { const int n = rho >> 4, i = rho & 15; return 8 * (i >> 2) + 4 * n + (i & 3); }

constexpr float ACT_PRESCALE = 4.0f, Y_PRESCALE = 4.0f;
struct Unit { int pm, pn, e; };
struct Gemm { const bf16* A; const bf16* Bt; int K; size_t bstride; };

struct StaticOrder {
    int nM, nN, nwg, G, c;
    __device__ void init(int M, int N, int G_, int c_) { nM = M / BM; nN = N / BM; nwg = nM * nN; G = G_; c = c_; }
    __device__ bool next(int i, Unit& u) const {
        const long L = (long)i * G + c; if (L >= nwg) return false;
        int wgid = (int)L; { const int q = nwg / NXCD, r = nwg % NXCD, xcd = wgid % NXCD, off = wgid / NXCD; wgid = (xcd < r ? xcd * (q + 1) : r * (q + 1) + (xcd - r) * q) + off; }
        const int nig = WGM * nN, gid = wgid / nig, fm = gid * WGM, gsz = (nM - fm) < WGM ? (nM - fm) : WGM;
        u.pm = fm + ((wgid % nig) % gsz); u.pn = (wgid % nig) / gsz; u.e = 0; return true;
    }
    __device__ __forceinline__ int arow(const Unit&, int) const { return 0; }
};
struct MoeOrder {
    const LAS int* tsum; const LAS int* cnt; const int* list; int nN, G, c, total; mutable int ehint;
    __device__ bool next(int i, Unit& u) const {
        const int L = i * G + (c & 7) * (G >> 3) + (c >> 3); if (L >= total) return false;
        const int tile = L / nN; u.pn = L - tile * nN;
        int e = ehint; while (tile >= tsum[e + 1]) ++e;
        ehint = e; u.e = e; u.pm = tile; return true;
    }
    __device__ __forceinline__ int arow(const Unit& u, int r) const {
        int p = (u.pm - tsum[u.e]) * BM + r; const int c_ = cnt[u.e]; p = p < c_ ? p : c_ - 1; return list[(size_t)u.e * ECAP + p];
    }
};

using ::cvt_pk_bf16;

struct EpiBf16S {
    typedef f32x4 AccT; static constexpr int SEC = 50;
    static constexpr bool PERM = true;
    bf16* O; int ldc; int scale_cols; float scale0;
    __device__ __forceinline__ void operator()(const f32x4 (&acc)[2][2][4][2], const Unit& u, int wr, int wc, int fr, int fq) const {
        const int row0 = u.pm * BM + wr * 64 + fr, col0 = u.pn * BM + wc * 32 + 8 * fq; const float sc = (u.pn * BM < scale_cols) ? scale0 : 1.f;
#pragma unroll
        for (int ai = 0; ai < 2; ++ai)
#pragma unroll
            for (int m = 0; m < 4; ++m) { bf16* rowp = O + (size_t)(row0 + ai * HALF + m * 16) * ldc + col0;
#pragma unroll
                for (int bj = 0; bj < 2; ++bj) { const f32x4 v0 = acc[ai][bj][m][0] * sc, v1 = acc[ai][bj][m][1] * sc;
                    u32x4 w; w.x = cvt_pk_bf16(v0[0], v0[1]); w.y = cvt_pk_bf16(v0[2], v0[3]); w.z = cvt_pk_bf16(v1[0], v1[1]); w.w = cvt_pk_bf16(v1[2], v1[3]);
                    *(GAS u32x4*)(rowp + bj * HALF) = w; } }
    }
};
template <bool IN_BF16>
struct EpiResid {
    typedef f32x4 AccT; static constexpr int SEC = 40;
    static constexpr bool PERM = true;
    const void* xin; bf16* out; const float* gate;
    __device__ __forceinline__ void operator()(const f32x4 (&acc)[2][2][4][2], const Unit& u, int wr, int wc, int fr, int fq) const {
        const int row0 = u.pm * BM + wr * 64 + fr, b = u.pm >> 3, col0 = u.pn * BM + wc * 32 + 8 * fq;
#pragma unroll
        for (int bj = 0; bj < 2; ++bj) { const int c = col0 + bj * HALF; const GAS f32x4* gp = (const GAS f32x4*)(gate + (size_t)b * 6144 + c); const f32x4 g0 = gp[0], g1 = gp[1];
#pragma unroll
            for (int ai = 0; ai < 2; ++ai)
#pragma unroll
                for (int m = 0; m < 4; ++m) { const size_t o = (size_t)(row0 + ai * HALF + m * 16) * DM + c; f32x4 x0, x1;
                    if constexpr (IN_BF16) { const u32x4 w = *(const GAS u32x4*)((const bf16*)xin + o); x0 = (f32x4){bflo(w.x), bfhi(w.x), bflo(w.y), bfhi(w.y)}; x1 = (f32x4){bflo(w.z), bfhi(w.z), bflo(w.w), bfhi(w.w)}; }
                    else { const GAS f32x4* xp = (const GAS f32x4*)((const float*)xin + o); x0 = xp[0]; x1 = xp[1]; }
                    const f32x4 r0 = x0 + g0 * acc[ai][bj][m][0], r1 = x1 + g1 * acc[ai][bj][m][1];
                    *(GAS u32x4*)(out + o) = (u32x4){cvt_pk_bf16(r0[0], r0[1]), cvt_pk_bf16(r0[2], r0[3]), cvt_pk_bf16(r1[0], r1[1]), cvt_pk_bf16(r1[2], r1[3])}; } }
    }
};

__device__ __forceinline__ float swiglu1(float g, float u) {
    g = fminf(g, 7.0f); u = fminf(fmaxf(u, -7.0f), 7.0f);
    const float e = __builtin_amdgcn_exp2f(g * (-1.702f * LOG2E));
    return (u + 1.0f) * g * __builtin_amdgcn_rcpf(1.0f + e);
}
__device__ __forceinline__ f32x2 swiglu_pk(f32x2 g, f32x2 u) {
    g.x = fminf(g.x, 7.0f); g.y = fminf(g.y, 7.0f); u.x = __builtin_amdgcn_fmed3f(u.x, -6.0f, 8.0f); u.y = __builtin_amdgcn_fmed3f(u.y, -6.0f, 8.0f);
    const f32x2 t = g * (-1.702f * LOG2E);
    f32x2 e; e.x = __builtin_amdgcn_exp2f(t.x); e.y = __builtin_amdgcn_exp2f(t.y);
    const f32x2 d = e * (1.0f / ACT_PRESCALE) + (1.0f / ACT_PRESCALE);
    f32x2 r; r.x = __builtin_amdgcn_rcpf(d.x); r.y = __builtin_amdgcn_rcpf(d.y);
    return u * (g * r);
}
struct EpiSwiglu {
    typedef f32x4 AccT; static constexpr int SEC = 60;
    static constexpr bool PERM = true;
    bf16* ACT; const float* bgu;
    __device__ __forceinline__ void operator()(const f32x4 (&acc)[2][2][4][2], const Unit& u, int wr, int wc, int fr, int fq) const {
        const int row0 = u.pm * BM + wr * 64 + fr, jl0 = wc * 32 + 8 * fq, colA = u.pn * HALF + jl0;
        const GAS f32x4* bp = (const GAS f32x4*)(bgu + (size_t)u.e * 2048 + 2 * (u.pn * HALF + jl0));
        const f32x4 b0 = bp[0], b1 = bp[1], b2 = bp[2], b3 = bp[3];
        const f32x4 bg[2] = {(f32x4){b0[0], b0[2], b1[0], b1[2]}, (f32x4){b2[0], b2[2], b3[0], b3[2]}};
        const f32x4 bu[2] = {(f32x4){b0[1], b0[3], b1[1], b1[3]}, (f32x4){b2[1], b2[3], b3[1], b3[3]}};
#pragma unroll
        for (int ai = 0; ai < 2; ++ai)
#pragma unroll
            for (int m = 0; m < 4; ++m) { float o[8];
#pragma unroll
                for (int n = 0; n < 2; ++n) { const f32x4 g4 = acc[ai][0][m][n] + bg[n], u4 = acc[ai][1][m][n] + bu[n];
#pragma unroll
                    for (int i = 0; i < 4; ++i) o[4 * n + i] = swiglu1(g4[i], u4[i]); }
                u32x4 w; w.x = cvt_pk_bf16(o[0], o[1]); w.y = cvt_pk_bf16(o[2], o[3]); w.z = cvt_pk_bf16(o[4], o[5]); w.w = cvt_pk_bf16(o[6], o[7]);
                *(GAS u32x4*)(ACT + (size_t)(row0 + ai * HALF + m * 16) * DM + colA) = w; }
    }
};
struct EpiDown {
    typedef f32x4 AccT; static constexpr int SEC = 20;
    static constexpr bool PERM = true;
    bf16* Y; const float* bd; const float* gate_e; const LAS int* tsum;
    __device__ __forceinline__ void operator()(const f32x4 (&acc)[2][2][4][2], const Unit& u, int wr, int wc, int fr, int fq) const {
        const int row0 = u.pm * BM + wr * 64 + fr, col0 = u.pn * BM + wc * 32 + 8 * fq, lrow0 = (u.pm - tsum[u.e]) * BM + wr * 64 + fr;
        f32x4 bv[2][2];
#pragma unroll
        for (int bj = 0; bj < 2; ++bj)
#pragma unroll
            for (int n = 0; n < 2; ++n) bv[bj][n] = *(const GAS f32x4*)(bd + (size_t)u.e * DM + col0 + bj * HALF + 4 * n);
#pragma unroll
        for (int ai = 0; ai < 2; ++ai)
#pragma unroll
            for (int m = 0; m < 4; ++m) { const float gt = gate_e[(size_t)u.e * ECAP + lrow0 + ai * HALF + m * 16]; bf16* rowp = Y + (size_t)(row0 + ai * HALF + m * 16) * DM + col0;
#pragma unroll
                for (int bj = 0; bj < 2; ++bj) { const f32x4 v0 = (acc[ai][bj][m][0] + bv[bj][0]) * gt, v1 = (acc[ai][bj][m][1] + bv[bj][1]) * gt;
                    u32x4 w; w.x = cvt_pk_bf16(v0[0], v0[1]); w.y = cvt_pk_bf16(v0[2], v0[3]); w.z = cvt_pk_bf16(v1[0], v1[1]); w.w = cvt_pk_bf16(v1[2], v1[3]);
                    *(GAS u32x4*)(rowp + bj * HALF) = w; } }
    }
};
struct EpiDownF8 {
    typedef f32x4 AccT; static constexpr int SEC = 22;
    static constexpr bool PERM = true;
    unsigned char* Y; const float* bd; const float* gate_e; const LAS int* tsum; const float* wsd;
    __device__ __forceinline__ void operator()(const f32x4 (&acc)[2][2][4][2], const Unit& u, int wr, int wc, int fr, int fq) const {
        const int row0 = u.pm * BM + wr * 64 + fr, col0 = u.pn * BM + wc * 32 + 8 * fq, lrow0 = (u.pm - tsum[u.e]) * BM + wr * 64 + fr;
        float gt[2][4];
#pragma unroll
        for (int ai = 0; ai < 2; ++ai)
#pragma unroll
            for (int m = 0; m < 4; ++m) gt[ai][m] = gate_e[(size_t)u.e * ECAP + lrow0 + ai * HALF + m * 16] * Y_PRESCALE;
#pragma unroll
        for (int bj = 0; bj < 2; ++bj) {
            const GAS f32x4* bp = (const GAS f32x4*)(bd + (size_t)u.e * DM + col0 + bj * HALF); const GAS f32x4* sp = (const GAS f32x4*)(wsd + (size_t)u.e * DM + col0 + bj * HALF);
            const f32x4 b0 = bp[0], b1 = bp[1], s0 = sp[0] * (1.0f / ACT_PRESCALE), s1 = sp[1] * (1.0f / ACT_PRESCALE);
#pragma unroll
            for (int ai = 0; ai < 2; ++ai)
#pragma unroll
                for (int mp = 0; mp < 4; mp += 2) { unsigned wq[2][2];
#pragma unroll
                    for (int mm = 0; mm < 2; ++mm) { const int m = mp + mm; const f32x4 a0 = acc[ai][bj][m][0], a1 = acc[ai][bj][m][1]; const float g4 = gt[ai][m];
                        const f32x2 p0 = ((f32x2){a0[0], a0[1]} * (f32x2){s0[0], s0[1]} + (f32x2){b0[0], b0[1]}) * g4, p1 = ((f32x2){a0[2], a0[3]} * (f32x2){s0[2], s0[3]} + (f32x2){b0[2], b0[3]}) * g4;
                        const f32x2 p2 = ((f32x2){a1[0], a1[1]} * (f32x2){s1[0], s1[1]} + (f32x2){b1[0], b1[1]}) * g4, p3 = ((f32x2){a1[2], a1[3]} * (f32x2){s1[2], s1[3]} + (f32x2){b1[2], b1[3]}) * g4;
#define MK_CL(x) __builtin_amdgcn_fmed3f((x), -448.f, 448.f)
                        unsigned w0 = 0u, w1 = 0u;
                        w0 = __builtin_amdgcn_cvt_pk_fp8_f32(MK_CL(p0.x), MK_CL(p0.y), w0, false); w0 = __builtin_amdgcn_cvt_pk_fp8_f32(MK_CL(p1.x), MK_CL(p1.y), w0, true);
                        w1 = __builtin_amdgcn_cvt_pk_fp8_f32(MK_CL(p2.x), MK_CL(p2.y), w1, false); w1 = __builtin_amdgcn_cvt_pk_fp8_f32(MK_CL(p3.x), MK_CL(p3.y), w1, true);
#undef MK_CL
                        wq[mm][0] = w0; wq[mm][1] = w1; }
                    const auto e0 = __builtin_amdgcn_permlane16_swap(wq[0][0], wq[1][0], false, false), e1 = __builtin_amdgcn_permlane16_swap(wq[0][1], wq[1][1], false, false);
                    *(GAS u32x4*)(Y + (size_t)(row0 + ai * HALF + (mp + (fq & 1)) * 16) * DM + (col0 - 8 * (fq & 1)) + bj * HALF) = (u32x4){e0[0], e1[0], e0[1], e1[1]}; }
        }
    }
};


typedef int i32x4e __attribute__((ext_vector_type(4)));
__device__ __forceinline__ f32x4 cvt4(const i32x4e v) { return (f32x4){(float)v[0], (float)v[1], (float)v[2], (float)v[3]}; }
struct EpiBf16S8 {   static constexpr int SEC = 30;
    typedef i32x4e AccT;
    static constexpr bool PERM = true;
    bf16* O; int ldc; int scale_cols; float scale0; const float* sa; const float* sb;
    __device__ __forceinline__ void operator()(const i32x4e (&acc)[2][2][4][2], const Unit& u, int wr, int wc, int fr, int fq) const {
        const int row0 = u.pm * BM + wr * 64 + fr, col0 = u.pn * BM + wc * 32 + 8 * fq; const float sc = (u.pn * BM < scale_cols) ? scale0 : 1.f;
        f32x4 bs[2][2];
#pragma unroll
        for (int bj = 0; bj < 2; ++bj)
#pragma unroll
            for (int n = 0; n < 2; ++n) bs[bj][n] = *(const GAS f32x4*)(sb + col0 + bj * HALF + 4 * n) * sc;
#pragma unroll
        for (int ai = 0; ai < 2; ++ai)
#pragma unroll
            for (int m = 0; m < 4; ++m) { const int r = row0 + ai * HALF + m * 16; const float ra = sa[r]; bf16* rowp = O + (size_t)r * ldc + col0;
#pragma unroll
                for (int bj = 0; bj < 2; ++bj) { const f32x4 v0 = cvt4(acc[ai][bj][m][0]) * bs[bj][0] * ra, v1 = cvt4(acc[ai][bj][m][1]) * bs[bj][1] * ra;
                    u32x4 w; w.x = cvt_pk_bf16(v0[0], v0[1]); w.y = cvt_pk_bf16(v0[2], v0[3]); w.z = cvt_pk_bf16(v1[0], v1[1]); w.w = cvt_pk_bf16(v1[2], v1[3]);
                    *(GAS u32x4*)(rowp + bj * HALF) = w; } }
    }
};
struct EpiSwiglu8 {   static constexpr int SEC = 10;
    typedef i32x4e AccT;
    static constexpr bool PERM = true;
    unsigned char* ACT; const float* bgu; const float* hs; const float* ws  ; const MoeOrder* S;
    __device__ __forceinline__ void operator()(const i32x4e (&acc)[2][2][4][2], const Unit& u, int wr, int wc, int fr, int fq) const {
        const int row0 = u.pm * BM + wr * 64 + fr, jl0 = wc * 32 + 8 * fq, colA = u.pn * HALF + jl0, lrow0 = (u.pm - S->tsum[u.e]) * BM + wr * 64 + fr;
        const GAS f32x4* bp = (const GAS f32x4*)(bgu + (size_t)u.e * 2048 + 2 * (u.pn * HALF + jl0));
        const f32x4 b0 = bp[0], b1 = bp[1], b2 = bp[2], b3 = bp[3];
        const f32x4 bg[2] = {(f32x4){b0[0], b0[2], b1[0], b1[2]}, (f32x4){b2[0], b2[2], b3[0], b3[2]}};
        const f32x4 bu[2] = {(f32x4){b0[1], b0[3], b1[1], b1[3]} + 1.0f, (f32x4){b2[1], b2[3], b3[1], b3[3]} + 1.0f};
        const GAS f32x4* wp = (const GAS f32x4*)(ws + (size_t)u.e * 2048 + u.pn * BM + jl0);
        const f32x4 wg[2] = {wp[0], wp[1]}, wu[2] = {wp[32], wp[33]};
#pragma unroll
        for (int ai = 0; ai < 2; ++ai)
#pragma unroll
            for (int mp = 0; mp < 4; mp += 2) { unsigned wq[2][2];
#pragma unroll
                for (int mm = 0; mm < 2; ++mm) { const int m = mp + mm; const float ra = hs[(size_t)u.e * ECAP + lrow0 + ai * HALF + m * 16]; f32x2 o[4];
#pragma unroll
                for (int n = 0; n < 2; ++n)
#pragma unroll
                    for (int h = 0; h < 2; ++h) { const i32x4e ag = acc[ai][0][m][n], au = acc[ai][1][m][n];
                        const f32x2 cg = {(float)ag[2 * h], (float)ag[2 * h + 1]}, cu = {(float)au[2 * h], (float)au[2 * h + 1]};
                        const f32x2 wgp = {wg[n][2 * h], wg[n][2 * h + 1]}, wup = {wu[n][2 * h], wu[n][2 * h + 1]}, bgp = {bg[n][2 * h], bg[n][2 * h + 1]}, bup = {bu[n][2 * h], bu[n][2 * h + 1]};
                        o[2 * n + h] = swiglu_pk((cg * wgp) * ra + bgp, (cu * wup) * ra + bup); }
                unsigned w0 = 0u, w1 = 0u;
                w0 = __builtin_amdgcn_cvt_pk_fp8_f32(o[0].x, o[0].y, w0, false); w0 = __builtin_amdgcn_cvt_pk_fp8_f32(o[1].x, o[1].y, w0, true);
                w1 = __builtin_amdgcn_cvt_pk_fp8_f32(o[2].x, o[2].y, w1, false); w1 = __builtin_amdgcn_cvt_pk_fp8_f32(o[3].x, o[3].y, w1, true);
                wq[mm][0] = w0; wq[mm][1] = w1; }
                const auto e0 = __builtin_amdgcn_permlane16_swap(wq[0][0], wq[1][0], false, false), e1 = __builtin_amdgcn_permlane16_swap(wq[0][1], wq[1][1], false, false);
                *(GAS u32x4*)(ACT + (size_t)(row0 + ai * HALF + (mp + (fq & 1)) * 16) * DM + (colA - 8 * (fq & 1))) = (u32x4){e0[0], e1[0], e0[1], e1[1]}; }
    }
};
typedef int i32x4 __attribute__((ext_vector_type(4)));
typedef int i32x8 __attribute__((ext_vector_type(8)));
template <class Epi, class Sched, bool GATHER, bool ALIGN_EPI, int MODE = 0>
__device__ __forceinline__ void gemm_phase(LAS unsigned char* lds, const Gemm g, const Sched& S, const Epi& E) {
    const int tid = threadIdx.x, wid = __builtin_amdgcn_readfirstlane(tid >> 6), lane = tid & 63, wr = wid >> 2, wc = wid & 3, fr = lane & 15, fq = lane >> 4;
    constexpr int ESZ = MODE ? 1 : 2; constexpr bool INT8 = (MODE == 1);
    const int K = g.K, KB = K * ESZ  , nt = KB / (BK * 2);
    int Rr[2], Cc[2]; unsigned voffB[2];
#pragma unroll
    for (int i = 0; i < 2; ++i) { stage_rc(tid * 16 + i * 8192, Rr[i], Cc[i]); const int Rb = Epi::PERM ? ((Rr[i] & ~31) + perm32(Rr[i] & 31)) : Rr[i]; voffB[i] = (unsigned)(Rb * KB + Cc[i] * 2); }
    const size_t kstep = (size_t)(BK * 2), hstep = (size_t)HALF * KB, tstep = 2 * hstep;
    const unsigned ldsw = (unsigned)wid * 1024u;
    const int aoff = lds_byte(wr * 64 + fr, fq * 8), boff = lds_byte(wc * 32 + fr, fq * 8);
#define PG8_SA(b, h) (((b) * 2 + (h)) * HTB)
#define PG8_SB(b, h) ((4 + (b) * 2 + (h)) * HTB)
#define PG8_STAGE(bufoff, gbase, voff) do { _Pragma("unroll") for (int _i = 0; _i < 2; ++_i) \
        __builtin_amdgcn_global_load_lds((const GAS unsigned*)((const char*)(gbase) + (voff)[_i]), (LAS unsigned*)(lds + (bufoff) + ldsw + _i * 8192), 16, 0, 0); } while (0)
#define PG8_RD(off) (*(const LAS i32x4*)(lds + (off)))
#define PG8_LDA(dst, b, h) do { _Pragma("unroll") for (int m = 0; m < 4; ++m) { const i32x4 r0_ = PG8_RD(PG8_SA(b, h) + aoff + m * 2048), r1_ = PG8_RD(PG8_SA(b, h) + aoff + m * 2048 + 1024); \
        if constexpr (MODE == 2) dst##8[m] = __builtin_shufflevector(r0_, r1_, 0, 1, 2, 3, 4, 5, 6, 7); else { dst[m][0] = __builtin_bit_cast(bf16x8, r0_); dst[m][1] = __builtin_bit_cast(bf16x8, r1_); } } } while (0)
#define PG8_LDB(dst, b, h) do { _Pragma("unroll") for (int n = 0; n < 2; ++n) { const i32x4 r0_ = PG8_RD(PG8_SB(b, h) + boff + n * 2048), r1_ = PG8_RD(PG8_SB(b, h) + boff + n * 2048 + 1024); \
        if constexpr (MODE == 2) dst##8[n] = __builtin_shufflevector(r0_, r1_, 0, 1, 2, 3, 4, 5, 6, 7); else { dst[n][0] = __builtin_bit_cast(bf16x8, r0_); dst[n][1] = __builtin_bit_cast(bf16x8, r1_); } } } while (0)
#define PG8_CAT(lo, hi) __builtin_shufflevector(__builtin_bit_cast(i32x4, lo), __builtin_bit_cast(i32x4, hi), 0, 1, 2, 3, 4, 5, 6, 7)
#define PG8_MMA(ai, bj, At, Bt) do { __builtin_amdgcn_s_setprio(1); _Pragma("unroll") for (int m = 0; m < 4; ++m) _Pragma("unroll") for (int n = 0; n < 2; ++n) _Pragma("unroll") for (int k = 0; k < 2; ++k) { \
        if constexpr (MODE == 2) { if (k == 0) asm volatile("v_mfma_scale_f32_16x16x128_f8f6f4 %0, %1, %2, %0, %3, %3 op_sel_hi:[0,0,0]" : "+v"(acc[ai][bj][m][n]) : "v"(Bt##8[n]), "v"(At##8[m]), "v"(f8scale)); } \
        else if constexpr (INT8) acc[ai][bj][m][n] = __builtin_bit_cast(AccT, __builtin_amdgcn_mfma_i32_16x16x64_i8(__builtin_bit_cast(i32x4, Bt[n][k]), __builtin_bit_cast(i32x4, At[m][k]), __builtin_bit_cast(i32x4, acc[ai][bj][m][n]), 0, 0, 0)); \
        else acc[ai][bj][m][n] = __builtin_bit_cast(AccT, __builtin_amdgcn_mfma_f32_16x16x32_bf16(Bt[n][k], At[m][k], __builtin_bit_cast(f32x4, acc[ai][bj][m][n]), 0, 0, 0)); } __builtin_amdgcn_s_setprio(0); } while (0)
#define PG8_WAIT_V(n) asm volatile("s_waitcnt vmcnt(" #n ")" ::: "memory")
#define PG8_WAIT_L(n) asm volatile("s_waitcnt lgkmcnt(" #n ")" ::: "memory")
#define PG8_BAR __builtin_amdgcn_s_barrier()
#define PG8_SCHED __builtin_amdgcn_sched_barrier(0)
    Unit cur, nxt; int ui = 0;
    if (!S.next(0, cur)) return;
    typedef typename Epi::AccT AccT;
    AccT acc[2][2][4][2];
#pragma unroll
    for (int a = 0; a < 2; ++a)
#pragma unroll
        for (int b = 0; b < 2; ++b)
#pragma unroll
            for (int m = 0; m < 4; ++m)
#pragma unroll
                for (int n = 0; n < 2; ++n) acc[a][b][m][n] = AccT{};
    const int f8scale = 0x7F7F7F7F;
    bf16x8 At[4][2], B0[2][2], B1[2][2]; i32x8 At8[4], B08[2], B18[2];
    unsigned vA0[2], vA1[2];
#pragma unroll
    for (int i = 0; i < 2; ++i) {
        if constexpr (GATHER) { vA0[i] = (unsigned)(S.arow(cur, Rr[i]) * KB + Cc[i] * 2); vA1[i] = (unsigned)(S.arow(cur, HALF + Rr[i]) * KB + Cc[i] * 2); }
        else { vA0[i] = (unsigned)(Rr[i] * KB + Cc[i] * 2); vA1[i] = vA0[i] + (unsigned)hstep; }
    }
    const char* cA = GATHER ? (const char*)g.A : (const char*)g.A + (size_t)cur.pm * tstep;
    const char* cB = (const char*)g.Bt + (size_t)cur.e * g.bstride + (size_t)cur.pn * tstep;
    PG8_STAGE(PG8_SB(0, 0), cB, voffB); PG8_STAGE(PG8_SB(0, 1), cB + hstep, voffB); PG8_STAGE(PG8_SA(0, 0), cA, vA0); PG8_STAGE(PG8_SA(0, 1), cA, vA1);
    if (wr == 1) PG8_BAR;
    PG8_WAIT_V(2); PG8_BAR;
    PG8_STAGE(PG8_SB(1, 0), cB + kstep, voffB); PG8_STAGE(PG8_SA(1, 0), cA + kstep, vA0); PG8_STAGE(PG8_SB(1, 1), cB + hstep + kstep, voffB);
    PG8_WAIT_V(6); PG8_BAR;
    for (;;) {
        const bool has_next = S.next(ui + 1, nxt);
        const char* nA = has_next ? (GATHER ? (const char*)g.A : (const char*)g.A + (size_t)nxt.pm * tstep) : cA;
        const char* nB = has_next ? (const char*)g.Bt + (size_t)nxt.e * g.bstride + (size_t)nxt.pn * tstep : cB;
        int nr0[2] = {0, 0}, nr1[2] = {0, 0};
        if constexpr (GATHER) { if (has_next) {
#pragma unroll
            for (int i = 0; i < 2; ++i) { nr0[i] = S.arow(nxt, Rr[i]); nr1[i] = S.arow(nxt, HALF + Rr[i]); } } }
        SEC_BEGIN2(Epi::SEC);
        for (int t = 0; t < nt; t += 2) {
            const bool last = (t == nt - 2);
            const char* a1 = cA + (size_t)(t + 1) * kstep;
            const char* a2 = last ? nA : cA + (size_t)(t + 2) * kstep; const char* b2 = last ? nB : cB + (size_t)(t + 2) * kstep;
            const char* a3 = a2 + kstep; const char* b3 = b2 + kstep;
            if constexpr (GATHER) { if (last && has_next) {
                asm volatile("" : "+v"(nr0[0]), "+v"(nr0[1]), "+v"(nr1[0]), "+v"(nr1[1]));
#pragma unroll
                for (int i = 0; i < 2; ++i) { vA0[i] = (unsigned)(nr0[i] * KB + Cc[i] * 2); nr1[i] = (int)(unsigned)(nr1[i] * KB + Cc[i] * 2); } } }
            unsigned w0[2], w1[2];
#pragma unroll
            for (int i = 0; i < 2; ++i) { w0[i] = vA0[i]; w1[i] = (GATHER && last && has_next) ? (unsigned)nr1[i] : vA1[i]; }
            PG8_LDB(B0, 0, 0); PG8_LDB(B1, 0, 1); PG8_SCHED; PG8_LDA(At, 0, 0); PG8_STAGE(PG8_SA(1, 1), a1, vA1);
            PG8_WAIT_V(8); PG8_WAIT_L(0); PG8_BAR; PG8_MMA(0, 0, At, B0); PG8_MMA(0, 1, At, B1); PG8_BAR; PG8_SCHED;
            PG8_LDA(At, 0, 1); PG8_STAGE(PG8_SB(0, 0), b2, voffB); PG8_STAGE(PG8_SB(0, 1), b2 + hstep, voffB); PG8_STAGE(PG8_SA(0, 0), a2, w0);
            PG8_WAIT_V(8); PG8_WAIT_L(0); PG8_BAR; PG8_MMA(1, 0, At, B0); PG8_MMA(1, 1, At, B1); PG8_BAR; PG8_SCHED;
            PG8_LDB(B0, 1, 0); PG8_LDB(B1, 1, 1); PG8_SCHED; PG8_LDA(At, 1, 0); PG8_STAGE(PG8_SA(0, 1), a2, w1);
            PG8_WAIT_V(8); PG8_WAIT_L(0); PG8_BAR; PG8_MMA(0, 0, At, B0); PG8_MMA(0, 1, At, B1); PG8_BAR; PG8_SCHED;
            PG8_LDA(At, 1, 1); PG8_STAGE(PG8_SB(1, 0), b3, voffB); PG8_STAGE(PG8_SB(1, 1), b3 + hstep, voffB); PG8_STAGE(PG8_SA(1, 0), a3, w0);
            PG8_WAIT_V(8); PG8_WAIT_L(0); PG8_BAR; PG8_MMA(1, 0, At, B0); PG8_MMA(1, 1, At, B1); PG8_BAR; PG8_SCHED;
        }
        if constexpr (ALIGN_EPI) { if (wr == 0) PG8_BAR; }
        SEC_END2(Epi::SEC);
        SEC_BEGIN3(Epi::SEC + 1);
        if constexpr (MODE == 2) {
            asm volatile("s_nop 15\n\ts_nop 15" : "+v"(acc[0][0][0][0]), "+v"(acc[0][0][0][1]), "+v"(acc[0][0][1][0]), "+v"(acc[0][0][1][1]), "+v"(acc[0][0][2][0]), "+v"(acc[0][0][2][1]), "+v"(acc[0][0][3][0]), "+v"(acc[0][0][3][1]),
                         "+v"(acc[0][1][0][0]), "+v"(acc[0][1][0][1]), "+v"(acc[0][1][1][0]), "+v"(acc[0][1][1][1]), "+v"(acc[0][1][2][0]), "+v"(acc[0][1][2][1]), "+v"(acc[0][1][3][0]), "+v"(acc[0][1][3][1]) :: "memory");
            asm volatile("" : "+v"(acc[1][0][0][0]), "+v"(acc[1][0][0][1]), "+v"(acc[1][0][1][0]), "+v"(acc[1][0][1][1]), "+v"(acc[1][0][2][0]), "+v"(acc[1][0][2][1]), "+v"(acc[1][0][3][0]), "+v"(acc[1][0][3][1]),
                         "+v"(acc[1][1][0][0]), "+v"(acc[1][1][0][1]), "+v"(acc[1][1][1][0]), "+v"(acc[1][1][1][1]), "+v"(acc[1][1][2][0]), "+v"(acc[1][1][2][1]), "+v"(acc[1][1][3][0]), "+v"(acc[1][1][3][1]) :: "memory");
        }
        E(acc, cur, wr, wc, fr, fq);
        SEC_END3(Epi::SEC + 1);
        if (!has_next) break;
#pragma unroll
        for (int a = 0; a < 2; ++a)
#pragma unroll
            for (int b = 0; b < 2; ++b)
#pragma unroll
                for (int m = 0; m < 4; ++m)
#pragma unroll
                    for (int n = 0; n < 2; ++n) acc[a][b][m][n] = AccT{};
        cur = nxt; cA = nA; cB = nB; ++ui;
        if constexpr (GATHER) {
#pragma unroll
            for (int i = 0; i < 2; ++i) vA1[i] = (unsigned)nr1[i]; }
        if constexpr (ALIGN_EPI) { if (wr == 1) PG8_BAR; }
    }
    PG8_WAIT_V(0);
    if constexpr (!ALIGN_EPI) { if (wr == 0) PG8_BAR; }
    PG8_BAR;
#undef PG8_SA
#undef PG8_SB
#undef PG8_STAGE
#undef PG8_LDA
#undef PG8_RD
#undef PG8_LDB
#undef PG8_MMA
#undef PG8_CAT
#undef PG8_WAIT_V
#undef PG8_WAIT_L
#undef PG8_BAR
#undef PG8_SCHED
}
}

#define XB_TMO      128
#define XB_XCNT(j)  (256  + 64 * (j))
#define XB_XSUB(j)  (1280 + 64 * (j))
#define XB_XGEN(j)  (2304 + 64 * (j))
#define XB_TOP      3328
#define XB_TOPGEN   3392
#define XCD_BAR_WORDS 3456
#define XB_SPIN_CAP (1u << 22)
__device__ __forceinline__ unsigned xb_ld(unsigned* p)              { return __hip_atomic_load(p, __ATOMIC_RELAXED, __HIP_MEMORY_SCOPE_AGENT); }
__device__ __forceinline__ unsigned xb_add(unsigned* p, unsigned v) { return __hip_atomic_fetch_add(p, v, __ATOMIC_RELAXED, __HIP_MEMORY_SCOPE_AGENT); }
__device__ __forceinline__ unsigned xb_xcc_id() { return (unsigned)__builtin_amdgcn_s_getreg((3 << 11) | 20) & 0xFu; }
#define XB_SPIN(cond, bar) do { unsigned _sp = 0; while (cond) { __builtin_amdgcn_s_sleep(1); \
    if ((++_sp & 255u) == 0u) { if (xb_ld(&(bar)[XB_TMO])) break; if (_sp > XB_SPIN_CAP) { atomicAdd(&(bar)[XB_TMO], 1u); break; } } } } while (0)
struct XcdBarrier { unsigned* bar; unsigned x; volatile LAS unsigned* st; };
__device__ __forceinline__ XcdBarrier xcd_barrier_post(unsigned* bar, volatile LAS unsigned* st) {
    XcdBarrier b; b.bar = bar; b.x = xb_xcc_id(); b.st = st;
    if (threadIdx.x == 0) (void)xb_add(&bar[XB_XCNT(b.x)], 1u);
    return b;
}
__device__ __forceinline__ void xcd_barrier_complete(unsigned* bar, unsigned x, unsigned& nloc, unsigned& nx) {
    const unsigned G = gridDim.x * gridDim.y * gridDim.z;
    unsigned sum, cnt, mine, sp = 0u;
    for (;;) {
        sum = 0u; cnt = 0u; mine = 0u;
#pragma unroll
        for (unsigned j = 0; j < 16; ++j) { const unsigned c = xb_ld(&bar[XB_XCNT(j)]); sum += c; cnt += (c > 0u) ? 1u : 0u; mine = (j == x) ? c : mine; }
        if (sum == G) break;
        __builtin_amdgcn_s_sleep(1);
        if ((++sp & 255u) == 0u) { if (xb_ld(&bar[XB_TMO])) break; if (sp > XB_SPIN_CAP) { atomicAdd(&bar[XB_TMO], 1u); break; } }
    }
    nloc = mine > 0u ? mine : 1u; nx = cnt > 0u ? cnt : 1u;
}
__device__ __forceinline__ void xcd_barrier(const XcdBarrier& b) {
    asm volatile("s_waitcnt vmcnt(0)" ::: "memory");
    __syncthreads();
    if (threadIdx.x == 0) {
        unsigned* bar = b.bar;
        __builtin_amdgcn_s_waitcnt(0);
        unsigned nloc = b.st[0], nx = b.st[1];
        if (nloc == 0u) { xcd_barrier_complete(bar, b.x, nloc, nx); b.st[0] = nloc; b.st[1] = nx; }
        const unsigned old = xb_add(&bar[XB_XSUB(b.x)], 1u);
        const unsigned gen = old / nloc;
        if (old + 1u == (gen + 1u) * nloc) {
            __builtin_amdgcn_fence(__ATOMIC_RELEASE, "agent");
            asm volatile("s_waitcnt vmcnt(0)" ::: "memory");
            const unsigned og = xb_add(&bar[XB_TOP], 1u);
            const unsigned tg = og / nx;
            if (og + 1u == (tg + 1u) * nx) xb_add(&bar[XB_TOPGEN], 1u);
            else XB_SPIN(xb_ld(&bar[XB_TOPGEN]) == tg, bar);
            __builtin_amdgcn_fence(__ATOMIC_ACQUIRE, "agent");
            xb_add(&bar[XB_XGEN(b.x)], 1u);
            asm volatile("s_waitcnt vmcnt(0)" ::: "memory");
        } else {
            XB_SPIN(xb_ld(&bar[XB_XGEN(b.x)]) == gen, bar);
            __builtin_amdgcn_fence(__ATOMIC_ACQUIRE, "agent");
            asm volatile("s_waitcnt vmcnt(0)" ::: "memory");
        }
    }
    __syncthreads();
}


#if defined(PROBE_SEC)
#define SEC_BEGIN(tag) unsigned long long _sec_t0_##tag = ((tag) == PROBE_SEC) ? __builtin_amdgcn_s_memrealtime() : 0ull
#define SEC_END(tag) do { if ((tag) == PROBE_SEC && blockIdx.x == 0 && threadIdx.x == 0) { volatile LAS unsigned long long* _acc = (volatile LAS unsigned long long*)(X.lds + LDSCTL_OFF + 64); *_acc = *_acc + (__builtin_amdgcn_s_memrealtime() - _sec_t0_##tag); } } while (0)
#else
#define SEC_BEGIN(tag) do {} while (0)
#define SEC_END(tag) do {} while (0)
#endif
struct Ctx { LAS unsigned char* lds; int tid, lane, wave, G, vcu, gw, NGW; };

__device__ __forceinline__ void p0_transpose_item(const float* W, int Nsrc, int Ndst, int mode, bf16* WT, LAS float* scr, int item, int lane) {
    const int nblk = Ndst / 32, kb = item / nblk, nb = item - kb * nblk, k0 = 64 * kb, n0 = 32 * nb;
    const int nd = n0 + (lane & 31);
    const int sc = mode ? (2 * (128 * (nd >> 8) + (nd & 127)) + ((nd >> 7) & 1)) : nd;
    const bool ok = sc < Nsrc;
    const GAS float* Wg = (const GAS float*)W;
#pragma unroll 8
    for (int i = 0; i < 32; ++i) { const int kk = 2 * i + (lane >> 5); scr[kk * 33 + (lane & 31)] = ok ? Wg[(size_t)(k0 + kk) * Nsrc + sc] : 0.f; }
    LDS_WAIT(); asm volatile("" ::: "memory");
    const int c = lane & 7;
#pragma unroll
    for (int j = 0; j < 4; ++j) { const int n = (lane >> 3) + 8 * j; const LAS float* s = scr + (8 * c) * 33 + n;
        u32x4 o; o.x = pk2(s[0 * 33], s[1 * 33]); o.y = pk2(s[2 * 33], s[3 * 33]); o.z = pk2(s[4 * 33], s[5 * 33]); o.w = pk2(s[6 * 33], s[7 * 33]);
        *(GAS u32x4*)(WT + (size_t)(n0 + n) * DM + k0 + 8 * c) = o; }
    LDS_WAIT(); asm volatile("" ::: "memory");
}
struct P0Item { const float* W; int Nsrc, c0, mode, q; signed char* W8; float* wsc; };
__device__ __forceinline__ void p0_item_dma(const Ctx& X, const P0Item& d) {
    const int tid = X.tid, chunk = tid & 7; int sc = d.c0 + 4 * chunk; if (sc > d.Nsrc - 4) sc = d.Nsrc - 4;
    const GAS float* src = (const GAS float*)d.W + (size_t)(tid >> 3) * d.Nsrc + sc;
#pragma unroll
    for (int r = 0; r < 16; ++r) __builtin_amdgcn_global_load_lds((const GAS unsigned*)(src + (size_t)(64 * r) * d.Nsrc), (LAS unsigned*)(X.lds + r * 8192 + X.wave * 1024), 16, 0, 0);
}
template <int Q>
__device__ __forceinline__ void p0_item_process(const Ctx& X, const P0Item& d, const P0Item* next) {
    LAS float* T = (LAS float*)X.lds;
    LAS float* part = (LAS float*)(X.lds + EXTRA_OFF);
    const int tid = X.tid, col = tid & 31, kg = tid >> 5;
    WAITV(0); __syncthreads();
    const bool ok = (d.c0 + col) < d.Nsrc;
    float v[64]; float am = 0.f;
#pragma unroll
    for (int i = 0; i < 64; ++i) { v[i] = T[(kg * 64 + i) * 32 + col]; am = fmaxf(am, fabsf(v[i])); }
    part[kg * 32 + col] = ok ? am : 0.f;
    asm volatile("s_waitcnt lgkmcnt(0)" ::: "memory");
    __syncthreads();
    if (next) p0_item_dma(X, *next);
    const int cs = d.c0 + col, j = cs >> 1, nd = d.mode ? (256 * (j >> 7) + 128 * (cs & 1) + (j & 127)) : cs;
    if (tid < 32) { float a = 0.f;
#pragma unroll
        for (int g = 0; g < 16; ++g) a = fmaxf(a, part[g * 32 + tid]);
        constexpr float QMAX = (Q == 2) ? 384.0f : 127.0f; part[512 + tid] = a > 0.f ? QMAX / a : 0.f; d.wsc[nd] = a * (1.0f / QMAX); }
    __syncthreads();
    const float inv = part[512 + col];
    GAS u32x4* dst = (GAS u32x4*)(d.W8 + (size_t)nd * DM + kg * 64);
    if constexpr (Q == 2) {
#pragma unroll
        for (int q = 0; q < 4; ++q) { unsigned w[4];
#pragma unroll
            for (int e = 0; e < 4; ++e) { unsigned x = 0u; x = __builtin_amdgcn_cvt_pk_fp8_f32(v[16 * q + 4 * e] * inv, v[16 * q + 4 * e + 1] * inv, x, false); x = __builtin_amdgcn_cvt_pk_fp8_f32(v[16 * q + 4 * e + 2] * inv, v[16 * q + 4 * e + 3] * inv, x, true); w[e] = x; }
            dst[q] = (u32x4){w[0], w[1], w[2], w[3]}; }
    } else {
#pragma unroll
        for (int q = 0; q < 4; ++q) { u32x4 w;
            w.x = pack4i(rintf(v[16 * q + 0] * inv), rintf(v[16 * q + 1] * inv), rintf(v[16 * q + 2] * inv), rintf(v[16 * q + 3] * inv));
            w.y = pack4i(rintf(v[16 * q + 4] * inv), rintf(v[16 * q + 5] * inv), rintf(v[16 * q + 6] * inv), rintf(v[16 * q + 7] * inv));
            w.z = pack4i(rintf(v[16 * q + 8] * inv), rintf(v[16 * q + 9] * inv), rintf(v[16 * q + 10] * inv), rintf(v[16 * q + 11] * inv));
            w.w = pack4i(rintf(v[16 * q + 12] * inv), rintf(v[16 * q + 13] * inv), rintf(v[16 * q + 14] * inv), rintf(v[16 * q + 15] * inv));
            dst[q] = w; }
    }
    __syncthreads();
}
__device__ __forceinline__ void phase_prologue(const Ctx& X, const float* c_in, const float* ada_w, const float* ada_b, float* mod,
                                               const float* w_qkv, const float* w_o0, const float* w_in, const float* w_o1, const float* w_gu, const float* w_down,
                                               signed char* Wqkv8, bf16* Wo0_t, signed char* Win8, bf16* Wo1_t, signed char* Wgu8, bf16* Wd_t, float* wsc, unsigned* ada_flag, unsigned* item_ctr) {
    if (blockIdx.x < 192) {
        const int l = blockIdx.x / 96, j0 = (blockIdx.x % 96) * 64;
        LAS float* cs = (LAS float*)X.lds;
        for (int i = 0; i < 64; ++i) { const int idx = i * NTHREADS + X.tid, b = idx >> 10, k = idx & 1023; const float v = c_in[idx]; cs[k * 32 + b] = v / (1.0f + __expf(-v)); }
        __syncthreads();
        float acc[32];
#pragma unroll
        for (int b = 0; b < 32; ++b) acc[b] = 0.f;
        const GAS float* wp = (const GAS float*)ada_w + ((size_t)l * DM + X.wave * 128) * 6144 + j0 + X.lane;
#pragma unroll 4
        for (int k = 0; k < 128; ++k) { const float w = wp[(size_t)k * 6144]; const LAS f32x4* c4 = (const LAS f32x4*)(cs + (X.wave * 128 + k) * 32);
#pragma unroll
            for (int b4 = 0; b4 < 8; ++b4) { const f32x4 cv = c4[b4]; acc[4 * b4 + 0] += w * cv[0]; acc[4 * b4 + 1] += w * cv[1]; acc[4 * b4 + 2] += w * cv[2]; acc[4 * b4 + 3] += w * cv[3]; } }
        __syncthreads();
        LAS float* red = (LAS float*)X.lds;
#pragma unroll
        for (int b = 0; b < 32; ++b) red[(X.wave * 32 + b) * 64 + X.lane] = acc[b];
        __syncthreads();
        for (int i = 0; i < 4; ++i) { const int o = i * NTHREADS + X.tid, b = o >> 6, ln = o & 63; float s = 0.f;
#pragma unroll
            for (int w = 0; w < 8; ++w) s += red[(w * 32 + b) * 64 + ln];
            mod[((size_t)l * NB + b) * 6144 + j0 + ln] = s + ada_b[l * 6144 + j0 + ln]; }
        asm volatile("s_waitcnt vmcnt(0)" ::: "memory");
        __syncthreads();
        if (X.tid == 0) { __builtin_amdgcn_fence(__ATOMIC_RELEASE, "agent"); asm volatile("s_waitcnt vmcnt(0)" ::: "memory"); (void)xb_add(ada_flag, 1u); }
    }
    LAS float* scr = (LAS float*)(X.lds + X.wave * 16384);
    constexpr int Q_GU = 64 * 64, Q_QKV = NQKV / 32, Q_IN = NPROJ / 32, N_ITEMS = Q_GU + Q_QKV + Q_IN + 64 * 32;
    auto describe = [&](int it) -> P0Item {
        int r = it;
        if (r < Q_GU) { const int mat = r >> 6; return P0Item{w_gu + (size_t)mat * DM * 2048, 2048, 32 * (r & 63), 1, 1, Wgu8 + (size_t)mat * 2048 * DM, wsc + NQKV + NPROJ + mat * 2048}; } r -= Q_GU;
        if (r < Q_QKV) return P0Item{w_qkv, NQKV, 32 * r, 0, 1, Wqkv8, wsc}; r -= Q_QKV;
        if (r < Q_IN) return P0Item{w_in, NPROJ_REAL, 32 * r, 0, 1, Win8, wsc + NQKV}; r -= Q_IN;
        const int mat = r >> 5; return P0Item{w_down + (size_t)mat * DM * DM, DM, 32 * (r & 31), 0, 2, (signed char*)Wd_t + (size_t)mat * DM * DM, wsc + NQKV + NPROJ + 64 * 2048 + mat * DM};
    };
    SEC_BEGIN(6);
    { volatile LAS int* slot = (volatile LAS int*)(X.lds + LDSCTL_OFF + 128);
      auto fetch = [&](int par) -> int { if (X.tid == 0) slot[par] = (int)xb_add(item_ctr, 1u); __syncthreads(); return __builtin_amdgcn_readfirstlane(slot[par]); };
      int par = 0;
      int it = fetch(par); par ^= 1;
      P0Item cur = describe(it < N_ITEMS ? it : 0);
      if (it < N_ITEMS) p0_item_dma(X, cur);
      while (it < N_ITEMS) {
          const int nxt = fetch(par); par ^= 1;
          const bool hn = nxt < N_ITEMS; const P0Item nx = describe(hn ? nxt : it);
          if (cur.q == 2) p0_item_process<2>(X, cur, hn ? &nx : nullptr); else p0_item_process<1>(X, cur, hn ? &nx : nullptr);
          cur = nx; it = nxt; } }
    { LAS float* scr = (LAS float*)(X.lds + X.wave * 16384);
      for (int r = X.gw; r < 2 * 16 * 32; r += X.NGW) { if (r < 512) p0_transpose_item(w_o0, DM, DM, 0, Wo0_t, scr, r, X.lane); else p0_transpose_item(w_o1, DM, DM, 0, Wo1_t, scr, r - 512, X.lane); } }
    SEC_END(6);

}

__device__ __forceinline__ void norm_mod_store(const f32x4 (&v)[4], const float* gnorm, const float* modb, int shi, int sci, bf16* hrow, int lane, f32x4 (&h)[4]) {
    float ss = 0.f;
#pragma unroll
    for (int j = 0; j < 4; ++j) ss += (v[j][0] * v[j][0] + v[j][1] * v[j][1]) + (v[j][2] * v[j][2] + v[j][3] * v[j][3]);
    const float rstd = 1.0f / sqrtf(wave_sum(ss) * (1.0f / DM) + EPS);
#pragma unroll
    for (int j = 0; j < 4; ++j) {
        const f32x4 g4 = ((const GAS f32x4*)gnorm)[64 * j + lane], sc4 = ((const GAS f32x4*)(modb + sci * DM))[64 * j + lane], sh4 = ((const GAS f32x4*)(modb + shi * DM))[64 * j + lane];
        h[j] = (v[j] * rstd) * g4 * (1.0f + sc4) + sh4;
    }
    (void)hrow;
}
__device__ __forceinline__ void norm_mod_coef(const float* gnorm, const float* modb, int shi, int sci, int lane, f32x4 (&A)[4], f32x4 (&B)[4]) {
#pragma unroll
    for (int j = 0; j < 4; ++j) { const f32x4 g4 = ((const GAS f32x4*)gnorm)[64 * j + lane], sc4 = ((const GAS f32x4*)(modb + sci * DM))[64 * j + lane]; A[j] = g4 * (1.0f + sc4); B[j] = ((const GAS f32x4*)(modb + shi * DM))[64 * j + lane]; }
}
__device__ __forceinline__ void norm_mod_apply(const f32x4 (&v)[4], const f32x4 (&A)[4], const f32x4 (&B)[4], f32x4 (&h)[4]) {
    float ss = 0.f;
#pragma unroll
    for (int j = 0; j < 4; ++j) ss += (v[j][0] * v[j][0] + v[j][1] * v[j][1]) + (v[j][2] * v[j][2] + v[j][3] * v[j][3]);
    const float rstd = 1.0f / sqrtf(wave_sum(ss) * (1.0f / DM) + EPS);
#pragma unroll
    for (int j = 0; j < 4; ++j) h[j] = (v[j] * rstd) * A[j] + B[j];
}
__device__ __forceinline__ float quant_row_store(const f32x4 (&h)[4], signed char* qrow, float* hs, int lane) {
    float am = 0.f;
#pragma unroll
    for (int j = 0; j < 4; ++j) am = fmaxf(am, fmaxf(fmaxf(fabsf(h[j][0]), fabsf(h[j][1])), fmaxf(fabsf(h[j][2]), fabsf(h[j][3]))));
    am = wave_max(am);
    const float inv = am > 0.f ? 127.0f / am : 0.f;
    GAS unsigned* q4 = (GAS unsigned*)qrow + lane;
#pragma unroll
    for (int j = 0; j < 4; ++j) q4[64 * j] = pack4i(rintf(h[j][0] * inv), rintf(h[j][1] * inv), rintf(h[j][2] * inv), rintf(h[j][3] * inv));
    if (lane == 0) *hs = am * (1.0f / 127.0f);
    return am * (1.0f / 127.0f);
}

__device__ __forceinline__ void load_row_f32(const float* p, int lane, f32x4 (&v)[4]) { const GAS f32x4* xr = (const GAS f32x4*)p + lane;
#pragma unroll
    for (int j = 0; j < 4; ++j) v[j] = xr[64 * j]; }
__device__ __forceinline__ void load_row_bf16(const bf16* p, int lane, f32x4 (&v)[4]) { const GAS u32x2* xr = (const GAS u32x2*)p + lane;
#pragma unroll
    for (int j = 0; j < 4; ++j) { const u32x2 w = xr[64 * j]; v[j] = (f32x4){bflo(w.x), bfhi(w.x), bflo(w.y), bfhi(w.y)}; } }
__device__ __forceinline__ void store_row_bf16(bf16* p, int lane, const f32x4 (&v)[4]) { GAS u32x2* xr = (GAS u32x2*)p + lane;
#pragma unroll
    for (int j = 0; j < 4; ++j) xr[64 * j] = (u32x2){pk2(v[j][0], v[j][1]), pk2(v[j][2], v[j][3])}; }
__device__ __forceinline__ void phase_norm1(const Ctx& X, const float* xin, const float* gnorm, const float* mod_l, signed char* H8, float* HS) {
    const int per = NTOK / X.NGW, m0 = X.gw * per;
    f32x4 A[4], B[4]; norm_mod_coef(gnorm, mod_l + (size_t)(m0 >> 11) * 6144, 0, 1, X.lane, A, B);
    f32x4 v[4], vn[4], h[4];
    load_row_f32(xin + (size_t)m0 * DM, X.lane, v);
    for (int m = m0; m < m0 + per; ++m) {
        load_row_f32(xin + (size_t)((m + 1 < m0 + per) ? m + 1 : m) * DM, X.lane, vn);
        norm_mod_apply(v, A, B, h);
        quant_row_store(h, H8 + (size_t)m * DM, HS + m, X.lane);
#pragma unroll
        for (int j = 0; j < 4; ++j) v[j] = vn[j];
    }
}
__device__ __forceinline__ void moe_tables(const Ctx& X, const unsigned* gcnt, LAS int* cntL, LAS int* tsum) {
    __syncthreads();
    if (X.tid < NE) cntL[X.tid] = (int)__hip_atomic_load(gcnt + X.tid, __ATOMIC_RELAXED, __HIP_MEMORY_SCOPE_AGENT);
    __syncthreads();
    if (X.tid == 0) { int s = 0; for (int e = 0; e < NE; ++e) { tsum[e] = s; s += (cntL[e] + 255) >> 8; } tsum[NE] = s; }
    __syncthreads();
}
__device__ __forceinline__ void phase_combine(const Ctx& X, bf16* xr_io, float* out_f32  , const unsigned char* Y, const int* tok_e, const int* tok_p, const unsigned* gcnt, const float* mod_l  ,
                                              bool do_norm, const float* gnorm_next, const float* mod_next, signed char* H8, float* HS) {
    LAS int* cntL = (LAS int*)(X.lds + EXTRA_OFF); LAS int* tsum = cntL + 32;
    moe_tables(X, gcnt, cntL, tsum);
    const int per = NTOK / X.NGW, m0 = X.gw * per, b = m0 >> 11;
    f32x4 G2[4], A[4], B[4];
#pragma unroll
    for (int j = 0; j < 4; ++j) { G2[j] = ((const GAS f32x4*)(mod_l + (size_t)b * 6144 + 5 * DM))[64 * j + X.lane] * (1.0f / pg8::Y_PRESCALE); A[j] = G2[j]; B[j] = G2[j]; }
    if (do_norm) norm_mod_coef(gnorm_next, mod_next + (size_t)b * 6144, 0, 1, X.lane, A, B);
    for (int m = m0; m < m0 + per; ++m) {
        f32x4 v[4], a[4], h[4];
        load_row_bf16(xr_io + (size_t)m * DM, X.lane, v);
#pragma unroll
        for (int j = 0; j < 4; ++j) a[j] = (f32x4){0.f, 0.f, 0.f, 0.f};
#pragma unroll
        for (int k = 0; k < TOPK; ++k) { const int e = tok_e[m * 4 + k], p = tok_p[m * 4 + k]; const GAS unsigned* yr = (const GAS unsigned*)(Y + ((size_t)tsum[e] * 256 + p) * DM) + X.lane;
#pragma unroll
            for (int j = 0; j < 4; ++j) { const unsigned w = yr[64 * j]; const f32x2 lo = __builtin_amdgcn_cvt_pk_f32_fp8(w, false), hi = __builtin_amdgcn_cvt_pk_f32_fp8(w, true);
                a[j][0] += lo[0]; a[j][1] += lo[1]; a[j][2] += hi[0]; a[j][3] += hi[1]; } }
#pragma unroll
        for (int j = 0; j < 4; ++j) v[j] = v[j] + G2[j] * a[j];
        if (out_f32) { GAS f32x4* orow = (GAS f32x4*)(out_f32 + (size_t)m * DM) + X.lane;
#pragma unroll
            for (int j = 0; j < 4; ++j) orow[64 * j] = v[j]; }
        else store_row_bf16(xr_io + (size_t)m * DM, X.lane, v);
        if (do_norm) { norm_mod_apply(v, A, B, h); quant_row_store(h, H8 + (size_t)m * DM, HS + m, X.lane); }
    }
}
__device__ __forceinline__ void phase_norm2_router(const Ctx& X, const bf16* xin, const float* gnorm, const float* mod_l, const float* rw, const float* rb, signed char* H8, float* HS,
                                                   int* tok_e, int* tok_p, unsigned* gcnt, int* list, float* gate_e, float* hs_e) {
    constexpr int HROW = 2064;
    LAS unsigned char* hhi = X.lds; LAS unsigned char* hlo = X.lds + 16 * HROW; LAS float* part = (LAS float*)(X.lds + 2 * 16 * HROW);
    LAS int* cntL = (LAS int*)(X.lds + EXTRA_OFF); LAS int* baseL = cntL + 32; LAS int* selE = baseL + 32; LAS int* selR = selE + 1024; LAS float* selG = (LAS float*)(selR + 1024); LAS float* selH = selG + 1024;
    const int lane = X.lane, fr = lane & 15, fq = lane >> 4, half = lane >> 5, l32 = lane & 31, wave = X.wave;
    bf16x8 bhi[4][2], blo[4][2];
#pragma unroll
    for (int s4 = 0; s4 < 4; ++s4)
#pragma unroll
        for (int nt = 0; nt < 2; ++nt)
#pragma unroll
            for (int j = 0; j < 8; ++j) { const float w = rw[(size_t)(128 * wave + 32 * s4 + 8 * fq + j) * NE + 16 * nt + fr]; const unsigned hb = f2bf(w); const float lo = w - __uint_as_float(hb << 16);
                bhi[s4][nt][j] = (short)hb; blo[s4][nt][j] = (short)f2bf(lo); }
    if (X.tid < NE) cntL[X.tid] = 0;
    const float rbias = rb[l32];
    __syncthreads();
    const int t0 = blockIdx.x * 256;
    f32x4 nA[4], nB[4]; norm_mod_coef(gnorm, mod_l + (size_t)(t0 >> 11) * 6144, 3, 4, lane, nA, nB);
    f32x4 xv[2][4], xn[2][4];
#pragma unroll
    for (int q = 0; q < 2; ++q) load_row_bf16(xin + (size_t)(t0 + 2 * wave + q) * DM, lane, xv[q]);
    for (int it = 0; it < 16; ++it) {
        { const int itn = it < 15 ? it + 1 : it;
#pragma unroll
          for (int q = 0; q < 2; ++q) load_row_bf16(xin + (size_t)(t0 + itn * 16 + 2 * wave + q) * DM, lane, xn[q]); }
#pragma unroll
        for (int q = 0; q < 2; ++q) {
            const int lt = it * 16 + 2 * wave + q, m = t0 + lt; f32x4 v[4], h[4];
#pragma unroll
            for (int j = 0; j < 4; ++j) v[j] = xv[q][j];
            norm_mod_apply(v, nA, nB, h);
            const float hsv = quant_row_store(h, H8 + (size_t)m * DM, HS + m, lane); if (lane == 0) selH[lt] = hsv;
#pragma unroll
            for (int j = 0; j < 4; ++j) { const unsigned w01 = pk2(h[j][0], h[j][1]), w23 = pk2(h[j][2], h[j][3]);
                const int off = (2 * wave + q) * HROW + (256 * j + 4 * lane) * 2;
                *(LAS u32x2*)(hhi + off) = (u32x2){w01, w23};
                *(LAS u32x2*)(hlo + off) = (u32x2){pk2(h[j][0] - bflo(w01), h[j][1] - bfhi(w01)), pk2(h[j][2] - bflo(w23), h[j][3] - bfhi(w23))}; }
        }
        __syncthreads();
        f32x4 acc0 = {0.f, 0.f, 0.f, 0.f}, acc1 = {0.f, 0.f, 0.f, 0.f};
#pragma unroll
        for (int s4 = 0; s4 < 4; ++s4) { const int off = fr * HROW + (128 * wave + 32 * s4 + 8 * fq) * 2;
            const bf16x8 ah = *(const LAS bf16x8*)(hhi + off), al = *(const LAS bf16x8*)(hlo + off);
            acc0 = __builtin_amdgcn_mfma_f32_16x16x32_bf16(ah, bhi[s4][0], acc0, 0, 0, 0); acc1 = __builtin_amdgcn_mfma_f32_16x16x32_bf16(ah, bhi[s4][1], acc1, 0, 0, 0);
            acc0 = __builtin_amdgcn_mfma_f32_16x16x32_bf16(al, bhi[s4][0], acc0, 0, 0, 0); acc1 = __builtin_amdgcn_mfma_f32_16x16x32_bf16(al, bhi[s4][1], acc1, 0, 0, 0);
            acc0 = __builtin_amdgcn_mfma_f32_16x16x32_bf16(ah, blo[s4][0], acc0, 0, 0, 0); acc1 = __builtin_amdgcn_mfma_f32_16x16x32_bf16(ah, blo[s4][1], acc1, 0, 0, 0); }
#pragma unroll
        for (int i = 0; i < 4; ++i) { part[(wave * 16 + 4 * fq + i) * 32 + fr] = acc0[i]; part[(wave * 16 + 4 * fq + i) * 32 + 16 + fr] = acc1[i]; }
        __syncthreads();
        const int lt = it * 16 + 2 * wave + half;
        float logit = rbias;
#pragma unroll
        for (int w8 = 0; w8 < 8; ++w8) logit += part[(w8 * 16 + 2 * wave + half) * 32 + l32];
        float tv[4]; int te[4]; float cur = logit;
#pragma unroll
        for (int k = 0; k < 4; ++k) { const float mx = half_max32(cur);
            const unsigned long long bal = __ballot(cur == mx); const unsigned mine = half ? (unsigned)(bal >> 32) : (unsigned)bal;
            const int e = __ffs(mine) - 1; tv[k] = mx; te[k] = e; if (l32 == e) cur = -INFINITY; }
        const float p1 = __expf(tv[1] - tv[0]), p2 = __expf(tv[2] - tv[0]), p3 = __expf(tv[3] - tv[0]); const float inv = 1.0f / (1.0f + p1 + p2 + p3);
        if (l32 < 4) { const int k = l32; const int e = k == 0 ? te[0] : k == 1 ? te[1] : k == 2 ? te[2] : te[3]; const float gk = (k == 0 ? 1.0f : k == 1 ? p1 : k == 2 ? p2 : p3) * inv;
            const int rank = __hip_atomic_fetch_add(cntL + e, 1, __ATOMIC_RELAXED, __HIP_MEMORY_SCOPE_WORKGROUP);
            const int si = lt * 4 + k; selE[si] = e; selR[si] = rank; selG[si] = gk; }
#pragma unroll
        for (int q = 0; q < 2; ++q)
#pragma unroll
            for (int j = 0; j < 4; ++j) xv[q][j] = xn[q][j];
    }
    __syncthreads();
    if (X.tid < NE) baseL[X.tid] = (int)__hip_atomic_fetch_add(gcnt + X.tid, (unsigned)cntL[X.tid], __ATOMIC_RELAXED, __HIP_MEMORY_SCOPE_AGENT);
    __syncthreads();
    for (int si = X.tid; si < 256 * 4; si += NTHREADS) { const int e = selE[si], p = baseL[e] + selR[si], m = t0 + (si >> 2);
        tok_e[(size_t)m * 4 + (si & 3)] = e; tok_p[(size_t)m * 4 + (si & 3)] = p; list[(size_t)e * ECAP + p] = m; gate_e[(size_t)e * ECAP + p] = selG[si]; hs_e[(size_t)e * ECAP + p] = selH[si >> 2]; }
    __syncthreads();
}

__device__ __forceinline__ void phase_sb_naive(const Ctx& X, const bf16* QKV, bf16* O) {
    for (int item = blockIdx.x; item < NB * NH * 4; item += X.G) {
        const int b = item >> 6, h = (item >> 2) & 15, t = (item & 3) * 512 + X.tid;
        const GAS u32x4* qp = (const GAS u32x4*)(QKV + ((size_t)(b * SEQ + t)) * NQKV + h * HD);
        float q[64], o[64];
#pragma unroll
        for (int i = 0; i < 8; ++i) { const u32x4 w = qp[i]; q[8 * i] = bflo(w.x); q[8 * i + 1] = bfhi(w.x); q[8 * i + 2] = bflo(w.y); q[8 * i + 3] = bfhi(w.y); q[8 * i + 4] = bflo(w.z); q[8 * i + 5] = bfhi(w.z); q[8 * i + 6] = bflo(w.w); q[8 * i + 7] = bfhi(w.w); }
#pragma unroll
        for (int d = 0; d < 64; ++d) o[d] = 0.f;
        float L = 0.f;
        for (int s = t - 1; s >= 0; --s) {
            const GAS u32x4* kp = (const GAS u32x4*)(QKV + ((size_t)(b * SEQ + s)) * NQKV + DM + h * HD);
            float z = 0.f;
#pragma unroll
            for (int i = 0; i < 8; ++i) { const u32x4 w = kp[i]; z += q[8 * i] * bflo(w.x) + q[8 * i + 1] * bfhi(w.x) + q[8 * i + 2] * bflo(w.y) + q[8 * i + 3] * bfhi(w.y) + q[8 * i + 4] * bflo(w.z) + q[8 * i + 5] * bfhi(w.z) + q[8 * i + 6] * bflo(w.w) + q[8 * i + 7] * bfhi(w.w); }
            const float sp = fmaxf(z, 0.f) + __builtin_amdgcn_logf(1.0f + __builtin_amdgcn_exp2f(-fabsf(z)));
            const float a = __builtin_amdgcn_exp2f(z - sp + L);
            const GAS u32x4* vp = kp + (DM * 2 / 16);
#pragma unroll
            for (int i = 0; i < 8; ++i) { const u32x4 w = vp[i]; o[8 * i] += a * bflo(w.x); o[8 * i + 1] += a * bfhi(w.x); o[8 * i + 2] += a * bflo(w.y); o[8 * i + 3] += a * bfhi(w.y); o[8 * i + 4] += a * bflo(w.z); o[8 * i + 5] += a * bfhi(w.z); o[8 * i + 6] += a * bflo(w.w); o[8 * i + 7] += a * bfhi(w.w); }
            L -= sp;
            if (L < -160.f) break;
        }
        GAS u32x4* op = (GAS u32x4*)(O + ((size_t)(b * SEQ + t)) * DM + h * HD);
#pragma unroll
        for (int i = 0; i < 8; ++i) op[i] = (u32x4){pk2(o[8 * i], o[8 * i + 1]), pk2(o[8 * i + 2], o[8 * i + 3]), pk2(o[8 * i + 4], o[8 * i + 5]), pk2(o[8 * i + 6], o[8 * i + 7])};
    }
}

__device__ __forceinline__ void ld16(const bf16* p, float (&x)[16]) {
    const GAS u32x4* q = (const GAS u32x4*)p; const u32x4 a = q[0], b = q[1];
    x[0] = bflo(a.x); x[1] = bfhi(a.x); x[2] = bflo(a.y); x[3] = bfhi(a.y); x[4] = bflo(a.z); x[5] = bfhi(a.z); x[6] = bflo(a.w); x[7] = bfhi(a.w);
    x[8] = bflo(b.x); x[9] = bfhi(b.x); x[10] = bflo(b.y); x[11] = bfhi(b.y); x[12] = bflo(b.z); x[13] = bfhi(b.z); x[14] = bflo(b.w); x[15] = bfhi(b.w);
}
__device__ __forceinline__ void st16(bf16* p, const float (&x)[16]) {
    GAS u32x4* q = (GAS u32x4*)p;
    q[0] = (u32x4){pk2(x[0], x[1]), pk2(x[2], x[3]), pk2(x[4], x[5]), pk2(x[6], x[7])}; q[1] = (u32x4){pk2(x[8], x[9]), pk2(x[10], x[11]), pk2(x[12], x[13]), pk2(x[14], x[15])};
}
__device__ __forceinline__ void up16(const u32x4 a, const u32x4 b, float (&x)[16]) {
    x[0] = bflo(a.x); x[1] = bfhi(a.x); x[2] = bflo(a.y); x[3] = bfhi(a.y); x[4] = bflo(a.z); x[5] = bfhi(a.z); x[6] = bflo(a.w); x[7] = bfhi(a.w);
    x[8] = bflo(b.x); x[9] = bfhi(b.x); x[10] = bflo(b.y); x[11] = bfhi(b.y); x[12] = bflo(b.z); x[13] = bfhi(b.z); x[14] = bflo(b.w); x[15] = bfhi(b.w);
}
struct PostRaw { u32x4 q0, q1, k0, k1, i0, i1; unsigned wi; int pos; };
__device__ __forceinline__ PostRaw post_load(const bf16* P, const int* positions, int m, int lane) {
    PostRaw r; const GAS u32x4* pr = (const GAS u32x4*)(P + (size_t)m * NPROJ);
    r.q0 = pr[2 * lane]; r.q1 = pr[2 * lane + 1];
    const int lk = lane & 15; r.k0 = pr[128 + 2 * lk]; r.k1 = pr[128 + 2 * lk + 1];
    const int li = lane < 36 ? lane : 35; r.i0 = pr[160 + 2 * li]; r.i1 = pr[160 + 2 * li + 1];
    r.wi = (unsigned)P[(size_t)m * NPROJ + 1856 + (lane & 7)]; r.pos = positions[m];
    return r;
}
__device__ __forceinline__ void phase_dsa_post(const Ctx& X, const bf16* P, const int* positions, const float* qgain, const float* kgain, bf16* Q1, bf16* K1, bf16* V1, bf16* QI, bf16* KI, float* WI, float* QN, unsigned* kmax_bits) {
    const int l4 = X.lane & 3;
    float gq[16], gk[16];
#pragma unroll
    for (int i = 0; i < 16; ++i) { gq[i] = qgain[l4 * 16 + i]; gk[i] = kgain[l4 * 16 + i]; }
    const float inv_i = expf(-logf(500000.0f) * (2.0f * (float)(X.lane & 7) / 16.0f));
    const int per = NTOK / X.NGW, m0 = X.gw * per;
    float kmx = 0.f, qmx = 0.f;
    PostRaw cur = post_load(P, positions, m0, X.lane);
    for (int m = m0; m < m0 + per; ++m) {
        const int mn = (m + 1 < m0 + per) ? m + 1 : m;
        const PostRaw nxt = post_load(P, positions, mn, X.lane);
        float cs = 1.f, sn = 0.f;
        sincosf((float)cur.pos * inv_i, &sn, &cs);
        float cz[8], sz[8];
#pragma unroll
        for (int i = 0; i < 8; ++i) { cz[i] = __shfl(cs, i); sz[i] = __shfl(sn, i); }
        float x[16];
        up16(cur.q0, cur.q1, x);
        { float ss = 0.f;
#pragma unroll
          for (int i = 0; i < 16; ++i) ss += x[i] * x[i];
          ss += __shfl_xor(ss, 1); ss += __shfl_xor(ss, 2);
          const float r = 1.0f / sqrtf(ss * (1.0f / 64.0f) + EPS);
#pragma unroll
          for (int i = 0; i < 16; ++i) x[i] = x[i] * r * gq[i];
          if (l4 == 0) {
#pragma unroll
              for (int i = 0; i < 8; ++i) { const float a = x[i], b2 = x[i + 8]; x[i] = a * cz[i] - b2 * sz[i]; x[i + 8] = b2 * cz[i] + a * sz[i]; } }
          float n2 = 0.f;
#pragma unroll
          for (int i = 0; i < 16; ++i) { x[i] *= QSCALE; n2 += x[i] * x[i]; }
#pragma unroll
          for (int o = 1; o < 4; o <<= 1) n2 += __shfl_xor(n2, o);
#pragma unroll
          for (int o = 4; o < 64; o <<= 1) n2 = fmaxf(n2, __shfl_xor(n2, o));
          qmx = fmaxf(qmx, n2);
          if (X.lane == 0) QN[m] = sqrtf(n2) * 1.01f;
          st16(Q1 + (size_t)m * DM + X.lane * 16, x); }
        { up16(cur.k0, cur.k1, x);
          float ss = 0.f;
#pragma unroll
          for (int i = 0; i < 16; ++i) ss += x[i] * x[i];
          ss += __shfl_xor(ss, 1); ss += __shfl_xor(ss, 2);
          if (X.lane < 8) { const float r = 1.0f / sqrtf(ss * (1.0f / 64.0f) + EPS);
#pragma unroll
              for (int i = 0; i < 16; ++i) x[i] = x[i] * r * gk[i];
              if (l4 == 0) {
#pragma unroll
                  for (int i = 0; i < 8; ++i) { const float a = x[i], b2 = x[i + 8]; x[i] = a * cz[i] - b2 * sz[i]; x[i + 8] = b2 * cz[i] + a * sz[i]; } }
              st16(K1 + (size_t)m * 128 + X.lane * 16, x);
          } else if (X.lane < 16) st16(V1 + (size_t)m * 128 + (X.lane - 8) * 16, x);
          float k2 = 0.f;
#pragma unroll
          for (int i = 0; i < 16; ++i) k2 += x[i] * x[i];
          k2 += __shfl_xor(k2, 1); k2 += __shfl_xor(k2, 2); k2 = fmaxf(k2, __shfl_xor(k2, 4));
          kmx = fmaxf(kmx, k2); }
        if (X.lane < 36) { up16(cur.i0, cur.i1, x);
            if (l4 == 0) {
#pragma unroll
                for (int i = 0; i < 8; ++i) { const float a = x[i], b2 = x[i + 8]; x[i] = a * cz[i] - b2 * sz[i]; x[i + 8] = b2 * cz[i] + a * sz[i]; } }
            if (X.lane < 32) st16(QI + (size_t)m * 512 + X.lane * 16, x); else st16(KI + (size_t)m * 64 + (X.lane - 32) * 16, x); }
        if (X.lane < 8) WI[(size_t)m * 8 + X.lane] = bflo(cur.wi) * (0.35355339059327373f * 0.125f);
        cur = nxt;
    }
    if (X.lane == 0) { atomicMax(kmax_bits + (m0 >> 11), __float_as_uint(sqrtf(kmx) * 1.01f)); atomicMax(kmax_bits + 32 + (m0 >> 11), __float_as_uint(sqrtf(qmx) * 1.01f)); }
}
__device__ __forceinline__ void phase_dsa_post2(const Ctx& X, const bf16* P, const int* positions, const float* kgain, bf16* K1, bf16* V1, bf16* KI, float* WI, float* ROPE) {
    const int l16 = X.lane & 15, grp = X.lane >> 4, l4 = X.lane & 3, gbase = X.lane & 48;
    float gk[16];
#pragma unroll
    for (int i = 0; i < 16; ++i) gk[i] = kgain[l4 * 16 + i];
    const float inv_i = expf(-logf(500000.0f) * (2.0f * (float)(l16 & 7) / 16.0f));
    const int per = NTOK / X.NGW, m0 = X.gw * per;
    for (int mm = m0; mm < m0 + per; mm += 4) {
        const int m = mm + grp;
        const GAS u32x4* pr = (const GAS u32x4*)(P + (size_t)m * NPROJ);
        const u32x4 k0 = pr[128 + 2 * l16], k1 = pr[128 + 2 * l16 + 1];
        const int li = l16 & 3; const u32x4 i0 = pr[224 + 2 * li], i1 = pr[224 + 2 * li + 1];
        const unsigned wiw = (unsigned)P[(size_t)m * NPROJ + 1856 + (l16 & 7)];
        float sn, cs; sincosf((float)positions[m] * inv_i, &sn, &cs);
        ROPE[(size_t)m * 16 + l16] = (l16 & 8) ? sn : cs;
        float cz[8], sz[8];
#pragma unroll
        for (int i = 0; i < 8; ++i) { cz[i] = __shfl(cs, gbase + i); sz[i] = __shfl(sn, gbase + i); }
        float x[16];
        up16(k0, k1, x);
        float ss = 0.f;
#pragma unroll
        for (int i = 0; i < 16; ++i) ss += x[i] * x[i];
        ss = quad_sum(ss);
        if (l16 < 8) { const float r = 1.0f / sqrtf(ss * (1.0f / 64.0f) + EPS);
#pragma unroll
            for (int i = 0; i < 16; ++i) x[i] = x[i] * r * gk[i];
            if (l4 == 0) {
#pragma unroll
                for (int i = 0; i < 8; ++i) { const float a = x[i], b2 = x[i + 8]; x[i] = a * cz[i] - b2 * sz[i]; x[i + 8] = b2 * cz[i] + a * sz[i]; } }
            st16(K1 + (size_t)m * 128 + l16 * 16, x);
        } else st16(V1 + (size_t)m * 128 + (l16 - 8) * 16, x);
        if (l16 < 4) { up16(i0, i1, x);
            if (l16 == 0) {
#pragma unroll
                for (int i = 0; i < 8; ++i) { const float a = x[i], b2 = x[i + 8]; x[i] = a * cz[i] - b2 * sz[i]; x[i + 8] = b2 * cz[i] + a * sz[i]; } }
            st16(KI + (size_t)m * 64 + l16 * 16, x); }
        if (l16 < 8) WI[(size_t)m * 8 + l16] = bflo(wiw) * (0.35355339059327373f * 0.125f);
    }
}
__device__ __forceinline__ void phase_idx_naive(const Ctx& X, const bf16* QI, const bf16* KI, const float* WI, float* SC) {
    LAS float* qs = (LAS float*)X.lds;
    const int ntb = NTOK / X.G;
    for (int i = 0; i < ntb; ++i) {
        const int m = blockIdx.x * ntb + i, b = m >> 11, t = m & 2047, nadm = 64 * ((t >> 6) + 1);
        __syncthreads();
        qs[X.tid] = bflo((unsigned)QI[(size_t)m * 512 + X.tid]); if (X.tid < 8) qs[512 + X.tid] = WI[(size_t)m * 8 + X.tid];
        __syncthreads();
        for (int s = X.tid; s < nadm; s += NTHREADS) {
            const GAS u32x4* kp = (const GAS u32x4*)(KI + ((size_t)(b * SEQ + s)) * 64); float k[64];
#pragma unroll
            for (int j = 0; j < 8; ++j) { const u32x4 w = kp[j]; k[8 * j] = bflo(w.x); k[8 * j + 1] = bfhi(w.x); k[8 * j + 2] = bflo(w.y); k[8 * j + 3] = bfhi(w.y); k[8 * j + 4] = bflo(w.z); k[8 * j + 5] = bfhi(w.z); k[8 * j + 6] = bflo(w.w); k[8 * j + 7] = bfhi(w.w); }
            float sc = 0.f;
#pragma unroll 1
            for (int hh = 0; hh < 8; ++hh) { float d = 0.f; asm volatile("" ::: "memory");
#pragma unroll
                for (int j = 0; j < 16; ++j) { const f32x4 q4 = ((const LAS f32x4*)(qs + hh * 64))[j]; d += (q4[0] * k[4 * j] + q4[1] * k[4 * j + 1]) + (q4[2] * k[4 * j + 2] + q4[3] * k[4 * j + 3]); }
                sc += qs[512 + hh] * fmaxf(d, 0.f); }
            SC[(size_t)m * SEQ + s] = sc;
        }
    }
}
__device__ __forceinline__ unsigned ord_key(float x) { const unsigned u = __float_as_uint(x); return (u & 0x80000000u) ? ~u : (u | 0x80000000u); }
__device__ __forceinline__ int wave_count_sum(unsigned v) {
    int t = 0;
#pragma unroll
    for (int b = 0; b < 6; ++b) t += __popcll(__ballot((v >> b) & 1u)) << b;
    return t;
}
template <int NR>
__device__ __forceinline__ void topk_select_nr(const unsigned (&key)[32], int c, unsigned long long* maskrow, int lane) {
    unsigned long long mine = ~0ull;
    if (c >= 4) {
        unsigned T = 0u;
        for (int bit = 31; bit >= 0; --bit) { const unsigned cand = T | (1u << bit); unsigned cl = 0u;
#pragma unroll
            for (int m = 0; m < NR; ++m) cl += (key[m] >= cand) ? 1u : 0u;
            const int cnt = wave_count_sum(cl);
            if (cnt >= 256) { T = cand; if (cnt == 256) break; } }
        unsigned gl = 0u;
#pragma unroll
        for (int m = 0; m < NR; ++m) gl += (key[m] > T) ? 1u : 0u;
        const int gt = wave_count_sum(gl);
        int need = 256 - gt;
        {
#pragma unroll
        for (int m = 0; m < NR; ++m) {
            unsigned long long eq = __ballot(key[m] == T); const unsigned long long g = __ballot(key[m] > T);
            int pe = __popcll(eq);
            while (pe > need) { eq &= ~(1ull << (63 - __clzll(eq))); --pe; }
            need -= pe;
            if (lane == m) mine = g | eq; }
        }
    }
    if (lane <= c) maskrow[lane] = mine;
}
__device__ __forceinline__ void topk_select_store(const unsigned (&key)[32], int c, unsigned long long* maskrow, int lane) {
    if (c < 8) topk_select_nr<8>(key, c, maskrow, lane); else if (c < 16) topk_select_nr<16>(key, c, maskrow, lane); else if (c < 24) topk_select_nr<24>(key, c, maskrow, lane); else topk_select_nr<32>(key, c, maskrow, lane);
}
__device__ __forceinline__ void phase_topk_naive(const Ctx& X, const float* SC, unsigned long long* MASK) {
    for (int m = X.gw; m < NTOK; m += X.NGW) {
        const int c = (m & 2047) >> 6; unsigned key[32];
#pragma unroll
        for (int j = 0; j < 32; ++j) key[j] = (j <= c) ? ord_key(SC[(size_t)m * SEQ + j * 64 + X.lane]) : 0u;
        topk_select_store(key, c, MASK + (size_t)m * 32, X.lane);
    }
}
__device__ __forceinline__ void phase_sparse_naive(const Ctx& X, const bf16* Q1, const bf16* K1, const bf16* V1, const unsigned long long* MASK, bf16* O) {
    for (int item = blockIdx.x; item < NTOK / 32; item += X.G) {
        const int m = item * 32 + (X.tid >> 4), h = X.tid & 15, g = h >> 3, b = m >> 11, c = (m & 2047) >> 6;
        const GAS u32x4* qp = (const GAS u32x4*)(Q1 + (size_t)m * DM + h * HD);
        float q[64], o[64];
#pragma unroll
        for (int i = 0; i < 8; ++i) { const u32x4 w = qp[i]; q[8 * i] = bflo(w.x); q[8 * i + 1] = bfhi(w.x); q[8 * i + 2] = bflo(w.y); q[8 * i + 3] = bfhi(w.y); q[8 * i + 4] = bflo(w.z); q[8 * i + 5] = bfhi(w.z); q[8 * i + 6] = bflo(w.w); q[8 * i + 7] = bfhi(w.w); }
#pragma unroll
        for (int d = 0; d < 64; ++d) o[d] = 0.f;
        float mx = -1e30f, l = 0.f;
        for (int j = 0; j <= c; ++j) {
            unsigned long long bits = MASK[(size_t)m * 32 + j];
            while (bits) { const int s = j * 64 + __ffsll((long long)bits) - 1; bits &= bits - 1;
                const GAS u32x4* kp = (const GAS u32x4*)(K1 + ((size_t)(b * SEQ + s)) * 128 + g * HD); float z = 0.f;
#pragma unroll
                for (int i = 0; i < 8; ++i) { const u32x4 w = kp[i]; z += q[8 * i] * bflo(w.x) + q[8 * i + 1] * bfhi(w.x) + q[8 * i + 2] * bflo(w.y) + q[8 * i + 3] * bfhi(w.y) + q[8 * i + 4] * bflo(w.z) + q[8 * i + 5] * bfhi(w.z) + q[8 * i + 6] * bflo(w.w) + q[8 * i + 7] * bfhi(w.w); }
                const float mn = fmaxf(mx, z), f = __builtin_amdgcn_exp2f(mx - mn), p = __builtin_amdgcn_exp2f(z - mn); mx = mn; l = l * f + p;
                const GAS u32x4* vp = (const GAS u32x4*)(V1 + ((size_t)(b * SEQ + s)) * 128 + g * HD);
#pragma unroll
                for (int i = 0; i < 8; ++i) { const u32x4 w = vp[i]; o[8 * i] = o[8 * i] * f + p * bflo(w.x); o[8 * i + 1] = o[8 * i + 1] * f + p * bfhi(w.x); o[8 * i + 2] = o[8 * i + 2] * f + p * bflo(w.y); o[8 * i + 3] = o[8 * i + 3] * f + p * bfhi(w.y);
                    o[8 * i + 4] = o[8 * i + 4] * f + p * bflo(w.z); o[8 * i + 5] = o[8 * i + 5] * f + p * bfhi(w.z); o[8 * i + 6] = o[8 * i + 6] * f + p * bflo(w.w); o[8 * i + 7] = o[8 * i + 7] * f + p * bfhi(w.w); }
            }
        }
        const float il = 1.0f / l;
        GAS u32x4* op = (GAS u32x4*)(O + (size_t)m * DM + h * HD);
#pragma unroll
        for (int i = 0; i < 8; ++i) op[i] = (u32x4){pk2(o[8 * i] * il, o[8 * i + 1] * il), pk2(o[8 * i + 2] * il, o[8 * i + 3] * il), pk2(o[8 * i + 4] * il, o[8 * i + 5] * il), pk2(o[8 * i + 6] * il, o[8 * i + 7] * il)};
    }
}


typedef float f32x16 __attribute__((ext_vector_type(16)));
typedef short v4i16_t __attribute__((ext_vector_type(4)));
__device__ __forceinline__ int crow16(int r, int hi) { return (r & 3) + 8 * (r >> 2) + 4 * hi; }
__device__ __forceinline__ float half_sum(float v) { const auto rr = __builtin_amdgcn_permlane32_swap(__float_as_uint(v), __float_as_uint(v), false, false); return __uint_as_float(rr[0]) + __uint_as_float(rr[1]); }
__device__ __forceinline__ float half_max(float v) { const auto rr = __builtin_amdgcn_permlane32_swap(__float_as_uint(v), __float_as_uint(v), false, false); return fmaxf(__uint_as_float(rr[0]), __uint_as_float(rr[1])); }
__device__ __forceinline__ float qk_bound(const float* qgain, const float* kgain, int lane) {
    float a = fabsf(qgain[lane]), b = fabsf(kgain[lane]);
    a = wave_max(a); b = wave_max(b);
    return 64.0f * a * b * QSCALE * 1.02f;
}
__device__ __forceinline__ void rope_frag0(float (&x)[8], const f32x4 (&cs)[2], const f32x4 (&sn)[2], int hi) {
#pragma unroll
    for (int j = 0; j < 8; ++j) { const auto rr = __builtin_amdgcn_permlane32_swap(__float_as_uint(x[j]), __float_as_uint(x[j]), false, false);
        const float p = __uint_as_float(hi ? rr[0] : rr[1]); const float c = cs[j >> 2][j & 3], s_ = sn[j >> 2][j & 3];
        x[j] = hi ? (x[j] * c + p * s_) : (x[j] * c - p * s_); }
}
__device__ __forceinline__ void unpack8(const u32x4 w, float (&x)[8]) { x[0] = bflo(w.x); x[1] = bfhi(w.x); x[2] = bflo(w.y); x[3] = bfhi(w.y); x[4] = bflo(w.z); x[5] = bfhi(w.z); x[6] = bflo(w.w); x[7] = bfhi(w.w); }
__device__ __forceinline__ bf16x8 packf8(const float (&x)[8]) { u32x4 w; w.x = pg8::cvt_pk_bf16(x[0], x[1]); w.y = pg8::cvt_pk_bf16(x[2], x[3]); w.z = pg8::cvt_pk_bf16(x[4], x[5]); w.w = pg8::cvt_pk_bf16(x[6], x[7]); return __builtin_bit_cast(bf16x8, w); }
struct RawFr { u32x4 w[4]; };
__device__ __forceinline__ RawFr raw_frags(const bf16* prow, int hi) { RawFr r;
#pragma unroll
    for (int d0 = 0; d0 < 4; ++d0) r.w[d0] = *(const GAS u32x4*)(prow + 16 * d0 + 8 * hi);
    return r; }
__device__ __forceinline__ void q_frags_from_raw(const RawFr& raw, const float* gq, const f32x4 (&cs)[2], const f32x4 (&sn)[2], int hi, bf16x8 (&qf)[4]) {
    float x[4][8]; float ss = 0.f;
#pragma unroll
    for (int d0 = 0; d0 < 4; ++d0) { unpack8(raw.w[d0], x[d0]);
#pragma unroll
        for (int j = 0; j < 8; ++j) ss += x[d0][j] * x[d0][j]; }
    ss = half_sum(ss);
    const float r = QSCALE / sqrtf(ss * (1.0f / 64.0f) + EPS);
#pragma unroll
    for (int d0 = 0; d0 < 4; ++d0) { const f32x4 g0 = *(const GAS f32x4*)(gq + 16 * d0 + 8 * hi), g1 = *(const GAS f32x4*)(gq + 16 * d0 + 8 * hi + 4);
#pragma unroll
        for (int j = 0; j < 4; ++j) { x[d0][j] *= r * g0[j]; x[d0][4 + j] *= r * g1[j]; } }
    rope_frag0(x[0], cs, sn, hi);
#pragma unroll
    for (int d0 = 0; d0 < 4; ++d0) qf[d0] = packf8(x[d0]);
}
__device__ __forceinline__ void load_q_frags(const bf16* prow, const float* gq, const f32x4 (&cs)[2], const f32x4 (&sn)[2], int hi, bf16x8 (&qf)[4]) { const RawFr raw = raw_frags(prow, hi); q_frags_from_raw(raw, gq, cs, sn, hi, qf); }
__device__ __forceinline__ void qi_frags_from_raw(const RawFr& raw, const f32x4 (&cs)[2], const f32x4 (&sn)[2], int hi, bf16x8 (&qf)[4]) {
    float x0[8]; unpack8(raw.w[0], x0);
    rope_frag0(x0, cs, sn, hi);
    qf[0] = packf8(x0);
#pragma unroll
    for (int d0 = 1; d0 < 4; ++d0) qf[d0] = __builtin_bit_cast(bf16x8, raw.w[d0]);
}
__device__ __forceinline__ bf16x8 pack8(const f32x16& v, int s) {
    u32x4 w; w.x = pg8::cvt_pk_bf16(v[8 * s + 0], v[8 * s + 1]); w.y = pg8::cvt_pk_bf16(v[8 * s + 2], v[8 * s + 3]); w.z = pg8::cvt_pk_bf16(v[8 * s + 4], v[8 * s + 5]); w.w = pg8::cvt_pk_bf16(v[8 * s + 6], v[8 * s + 7]);
    return __builtin_bit_cast(bf16x8, w);
}
__device__ __forceinline__ void vtile_write(LAS unsigned char* vl, const u32x4 (&vr)[4], int lane) {
#pragma unroll
    for (int i = 0; i < 4; ++i) *(LAS u32x4*)(vl + (i * 2 + ((lane & 7) >> 2)) * 512 + (lane >> 3) * 64 + (lane & 3) * 16) = vr[i];
}
__device__ __forceinline__ bf16x8 vtile_frag(const LAS unsigned char* vl, int trbase, int s, int d0) {
    const v4i16_t lo = __builtin_amdgcn_ds_read_tr16_b64_v4i16((LAS v4i16_t*)(vl + trbase + ((2 * s + 0) * 2 + d0) * 512));
    const v4i16_t hi = __builtin_amdgcn_ds_read_tr16_b64_v4i16((LAS v4i16_t*)(vl + trbase + ((2 * s + 1) * 2 + d0) * 512));
    return (bf16x8){lo[0], lo[1], lo[2], lo[3], hi[0], hi[1], hi[2], hi[3]};
}
__device__ __forceinline__ void store_ot(bf16* orow, const f32x16& o0, const f32x16& o1, float sc, int hi) {
#pragma unroll
    for (int rg = 0; rg < 4; rg += 2) {
#pragma unroll
        for (int t = 0; t < 2; ++t) { const f32x16& o = t ? o1 : o0;
            const unsigned a0 = pg8::cvt_pk_bf16(o[4 * rg] * sc, o[4 * rg + 1] * sc), a1 = pg8::cvt_pk_bf16(o[4 * rg + 2] * sc, o[4 * rg + 3] * sc);
            const unsigned b0 = pg8::cvt_pk_bf16(o[4 * rg + 4] * sc, o[4 * rg + 5] * sc), b1 = pg8::cvt_pk_bf16(o[4 * rg + 6] * sc, o[4 * rg + 7] * sc);
            const auto e0 = __builtin_amdgcn_permlane32_swap(a0, b0, false, false), e1 = __builtin_amdgcn_permlane32_swap(a1, b1, false, false);
            *(GAS u32x4*)(orow + 32 * t + 8 * (rg + hi)) = (u32x4){e0[0], e1[0], e0[1], e1[1]}; }
    }
}

__device__ __forceinline__ void phase_sb_fast(const Ctx& X, const bf16* QKV, bf16* O) {
    const int lane = X.lane, r32 = lane & 31, hi = lane >> 5;
    LAS unsigned char* vl = X.lds + X.wave * 4096;
    const int trbase = (4 * hi + ((lane & 15) >> 2)) * 64 + (16 * ((lane >> 4) & 1) + 4 * (lane & 3)) * 2;
    bf16x8 uf[2];
#pragma unroll
    for (int s = 0; s < 2; ++s)
#pragma unroll
        for (int j = 0; j < 8; ++j) uf[s][j] = ((16 * s + 8 * (j >> 2) + 4 * hi + (j & 3)) > r32) ? (short)0x3F80 : (short)0;
    for (int u = X.gw; u < NB * NH * 64; u += X.NGW) {
        const int b = u >> 10, h = (u >> 6) & 15, qb = u & 63, t0 = qb * 32;
        const bf16* base = QKV + (size_t)b * SEQ * NQKV + h * HD;
        bf16x8 qf[4];
#pragma unroll
        for (int d0 = 0; d0 < 4; ++d0) qf[d0] = *(const GAS bf16x8*)(base + (size_t)(t0 + r32) * NQKV + 16 * d0 + 8 * hi);
        f32x16 o0 = {}, o1 = {}; float run = 0.f;
        bf16x8 kf[4], kn[4]; u32x4 vr[4], vn[4];
#pragma unroll
        for (int d0 = 0; d0 < 4; ++d0) kf[d0] = *(const GAS bf16x8*)(base + (size_t)(t0 + r32) * NQKV + DM + 16 * d0 + 8 * hi);
#pragma unroll
        for (int i = 0; i < 4; ++i) vr[i] = *(const GAS u32x4*)(base + (size_t)(t0 + i * 8 + (lane >> 3)) * NQKV + 2 * DM + 8 * (lane & 7));
        for (int kt = qb; kt >= 0; --kt) {
            { const int keyn = (kt > 0 ? kt - 1 : 0) * 32;
#pragma unroll
              for (int d0 = 0; d0 < 4; ++d0) kn[d0] = *(const GAS bf16x8*)(base + (size_t)(keyn + r32) * NQKV + DM + 16 * d0 + 8 * hi);
#pragma unroll
              for (int i = 0; i < 4; ++i) vn[i] = *(const GAS u32x4*)(base + (size_t)(keyn + i * 8 + (lane >> 3)) * NQKV + 2 * DM + 8 * (lane & 7)); }
            asm volatile("" ::: "memory");
            vtile_write(vl, vr, lane);
            f32x16 S = {};
#pragma unroll
            for (int d0 = 0; d0 < 4; ++d0) S = __builtin_amdgcn_mfma_f32_32x32x16_bf16(kf[d0], qf[d0], S, 0, 0, 0);
            const bool diag = (kt == qb);
            f32x16 xm, ls; float cs = 0.f;
#pragma unroll
            for (int r = 0; r < 16; ++r) { const float z = S[r]; const float sp = fmaxf(z, 0.f) + __builtin_amdgcn_logf(1.0f + __builtin_amdgcn_exp2f(-fabsf(z)));
                const bool valid = !diag || (crow16(r, hi) < r32);
                xm[r] = valid ? -sp : 0.f; ls[r] = valid ? z - sp : -INFINITY; cs += xm[r]; }
            cs = half_sum(cs);
            f32x16 T;
#pragma unroll
            for (int r = 0; r < 16; ++r) T[r] = run;
            T = __builtin_amdgcn_mfma_f32_32x32x16_bf16(uf[0], pack8(xm, 0), T, 0, 0, 0);
            T = __builtin_amdgcn_mfma_f32_32x32x16_bf16(uf[1], pack8(xm, 1), T, 0, 0, 0);
            f32x16 a;
#pragma unroll
            for (int r = 0; r < 16; ++r) a[r] = __builtin_amdgcn_exp2f(ls[r] + T[r]);
            const bf16x8 p0 = pack8(a, 0), p1 = pack8(a, 1);
            asm volatile("" ::: "memory");
            o0 = __builtin_amdgcn_mfma_f32_32x32x16_bf16(vtile_frag(vl, trbase, 0, 0), p0, o0, 0, 0, 0);
            o1 = __builtin_amdgcn_mfma_f32_32x32x16_bf16(vtile_frag(vl, trbase, 0, 1), p0, o1, 0, 0, 0);
            o0 = __builtin_amdgcn_mfma_f32_32x32x16_bf16(vtile_frag(vl, trbase, 1, 0), p1, o0, 0, 0, 0);
            o1 = __builtin_amdgcn_mfma_f32_32x32x16_bf16(vtile_frag(vl, trbase, 1, 1), p1, o1, 0, 0, 0);
            asm volatile("" ::: "memory");
            run += cs;
            if (__all(run < -160.f)) break;
#pragma unroll
            for (int d0 = 0; d0 < 4; ++d0) { kf[d0] = kn[d0]; vr[d0] = vn[d0]; }
        }
        store_ot(O + (size_t)(b * SEQ + t0 + r32) * DM + h * HD, o0, o1, 1.0f, hi);
    }
}

__device__ __forceinline__ void phase_sparse_fast(const Ctx& X, const bf16* Q1, const bf16* K1, const bf16* V1, const unsigned* MASK32, bf16* O) {
    const int lane = X.lane, r32 = lane & 31, hi = lane >> 5;
    LAS unsigned char* vl = X.lds + X.wave * 4096;
    const int trbase = (4 * hi + ((lane & 15) >> 2)) * 64 + (16 * ((lane >> 4) & 1) + 4 * (lane & 3)) * 2;
    for (int u = X.gw; u < NB * 64 * NH; u += X.NGW) {
        const int h = u & 15, tb = (u >> 4) & 63, b = u >> 10, g = h >> 3, t0 = tb * 32, ntile = 2 * ((t0 >> 6) + 1);
        const size_t tok = (size_t)b * SEQ + t0 + r32;
        bf16x8 qf[4];
#pragma unroll
        for (int d0 = 0; d0 < 4; ++d0) qf[d0] = *(const GAS bf16x8*)(Q1 + tok * DM + h * HD + 16 * d0 + 8 * hi);
        const bf16* kb = K1 + (size_t)b * SEQ * 128 + g * HD; const bf16* vb = V1 + (size_t)b * SEQ * 128 + g * HD;
        f32x16 o0 = {}, o1 = {}; float mrun = -1e30f, l = 0.f;
        for (int kt = 0; kt < ntile; ++kt) {
            const int key0 = kt * 32;
            bf16x8 kf[4]; u32x4 vr[4];
#pragma unroll
            for (int d0 = 0; d0 < 4; ++d0) kf[d0] = *(const GAS bf16x8*)(kb + (size_t)(key0 + r32) * 128 + 16 * d0 + 8 * hi);
#pragma unroll
            for (int i = 0; i < 4; ++i) vr[i] = *(const GAS u32x4*)(vb + (size_t)(key0 + i * 8 + (lane >> 3)) * 128 + 8 * (lane & 7));
            const unsigned mw = MASK32[tok * 64 + kt] >> (4 * hi);
            asm volatile("" ::: "memory");
            vtile_write(vl, vr, lane);
            f32x16 S = {};
#pragma unroll
            for (int d0 = 0; d0 < 4; ++d0) S = __builtin_amdgcn_mfma_f32_32x32x16_bf16(kf[d0], qf[d0], S, 0, 0, 0);
            float mx = -INFINITY;
#pragma unroll
            for (int r = 0; r < 16; ++r) { const unsigned msk = (unsigned)__builtin_amdgcn_sbfe((int)mw, (r & 3) + 8 * (r >> 2), 1);
                S[r] = __uint_as_float((__float_as_uint(S[r]) & msk) | (0xFF800000u & ~msk)); mx = fmaxf(mx, S[r]); }
            mx = half_max(mx);
            const float mnew = fmaxf(mrun, mx), f = __builtin_amdgcn_exp2f(mrun - mnew); mrun = mnew;
            f32x16 p; float ps = 0.f;
#pragma unroll
            for (int r = 0; r < 16; ++r) { p[r] = __builtin_amdgcn_exp2f(S[r] - mnew); ps += p[r]; }
            l = l * f + ps;
            if (__any(f != 1.0f)) {
#pragma unroll
                for (int r = 0; r < 16; ++r) { o0[r] *= f; o1[r] *= f; } }
            const bf16x8 p0 = pack8(p, 0), p1 = pack8(p, 1);
            asm volatile("" ::: "memory");
            o0 = __builtin_amdgcn_mfma_f32_32x32x16_bf16(vtile_frag(vl, trbase, 0, 0), p0, o0, 0, 0, 0);
            o1 = __builtin_amdgcn_mfma_f32_32x32x16_bf16(vtile_frag(vl, trbase, 0, 1), p0, o1, 0, 0, 0);
            o0 = __builtin_amdgcn_mfma_f32_32x32x16_bf16(vtile_frag(vl, trbase, 1, 0), p1, o0, 0, 0, 0);
            o1 = __builtin_amdgcn_mfma_f32_32x32x16_bf16(vtile_frag(vl, trbase, 1, 1), p1, o1, 0, 0, 0);
            asm volatile("" ::: "memory");
        }
        l = half_sum(l);
        store_ot(O + tok * DM + h * HD, o0, o1, 1.0f / l, hi);
    }
}

__device__ __forceinline__ void phase_idx_topk_fast(const Ctx& X, const bf16* QI, const bf16* KI, const float* WI, unsigned long long* MASK) {
    const int lane = X.lane, r32 = lane & 31, hi = lane >> 5;
    const int tkr = 2 * ((r32 >> 2) & 1) + (r32 >> 4), hdr = (r32 & 3) + 4 * ((r32 >> 3) & 1);
    int round = 0;
    for (int u0 = X.gw; u0 < NTOK / 4; u0 += X.NGW, ++round) {
        const int b = u0 >> 9; int tg = u0 & 511; if (round & 1) tg = 511 - tg;
        const int t0 = tg * 4, c = t0 >> 6; const size_t tok0 = (size_t)b * SEQ + t0;
        bf16x8 qf[4];
#pragma unroll
        for (int d0 = 0; d0 < 4; ++d0) qf[d0] = *(const GAS bf16x8*)(QI + (tok0 + tkr) * 512 + hdr * 64 + 16 * d0 + 8 * hi);
        float w0[8], w1[8];
#pragma unroll
        for (int hh = 0; hh < 8; ++hh) { w0[hh] = WI[(tok0 + 2 * hi) * 8 + hh]; w1[hh] = WI[(tok0 + 2 * hi + 1) * 8 + hh]; }
        unsigned k0[32], k1[32], k2[32], k3[32];
        const bf16* kib = KI + (size_t)b * SEQ * 64;
#pragma unroll
        for (int m = 0; m < 32; ++m) {
            if (m <= c) {
                float sa[2], sb[2];
#pragma unroll
                for (int half = 0; half < 2; ++half) {
                    const int key0 = 64 * m + 32 * half; f32x16 R = {};
#pragma unroll
                    for (int d0 = 0; d0 < 4; ++d0) { const bf16x8 kf = *(const GAS bf16x8*)(kib + (size_t)(key0 + r32) * 64 + 16 * d0 + 8 * hi); R = __builtin_amdgcn_mfma_f32_32x32x16_bf16(qf[d0], kf, R, 0, 0, 0); }
                    float s0 = 0.f, s1 = 0.f;
#pragma unroll
                    for (int hh = 0; hh < 8; ++hh) { s0 += w0[hh] * fmaxf(R[hh], 0.f); s1 += w1[hh] * fmaxf(R[8 + hh], 0.f); }
                    sa[half] = s0; sb[half] = s1;
                }
                const auto ra = __builtin_amdgcn_permlane32_swap(ord_key(sa[0]), ord_key(sa[1]), false, false);
                const auto rb = __builtin_amdgcn_permlane32_swap(ord_key(sb[0]), ord_key(sb[1]), false, false);
                k0[m] = ra[0]; k2[m] = ra[1]; k1[m] = rb[0]; k3[m] = rb[1];
            } else { k0[m] = 0u; k1[m] = 0u; k2[m] = 0u; k3[m] = 0u; }
        }
        topk_select_store(k0, c, MASK + (tok0 + 0) * 32, lane);
        topk_select_store(k1, c, MASK + (tok0 + 1) * 32, lane);
        topk_select_store(k2, c, MASK + (tok0 + 2) * 32, lane);
        topk_select_store(k3, c, MASK + (tok0 + 3) * 32, lane);
    }
}


__device__ __forceinline__ void wait_vm_le(int n) {
    switch (n) { case 0: WAITV(0); break; case 1: WAITV(1); break; case 2: WAITV(2); break; case 3: WAITV(3); break; case 4: WAITV(4); break; case 5: WAITV(5); break; case 6: WAITV(6); break;
                 case 7: WAITV(7); break; case 8: WAITV(8); break; case 9: WAITV(9); break; case 10: WAITV(10); break; case 11: WAITV(11); break; case 12: WAITV(12); break; default: WAITV(12); break; }
}
__device__ __forceinline__ void ktile_dma(LAS unsigned char* slot, const bf16* rows  , int pitch, int tid, int wave) {
    const int key = tid >> 3, cpos = tid & 7, src = cpos ^ ((key >> 1) & 7);
    __builtin_amdgcn_global_load_lds((const GAS unsigned*)(rows + (size_t)key * pitch + src * 8), (LAS unsigned*)(slot + wave * 1024), 16, 0, 0);
}
__device__ __forceinline__ bf16x8 ktile_frag(const LAS unsigned char* slot, int key, int d0, int hi) {
    return *(const LAS bf16x8*)(slot + key * 128 + (((2 * d0 + hi) ^ ((key >> 1) & 7)) << 4));
}
__device__ __forceinline__ void vtile_dma(LAS unsigned char* slot, const bf16* rows, int pitch, int tid, int wave) {
    const int st = tid >> 5, row = (tid & 31) >> 2, ch = tid & 3, key = (st >> 1) * 8 + row, d = (st & 1) * 32 + ch * 8;
    __builtin_amdgcn_global_load_lds((const GAS unsigned*)(rows + (size_t)key * pitch + d), (LAS unsigned*)(slot + wave * 1024), 16, 0, 0);
}

__device__ __forceinline__ void phase_sparse_coop(const Ctx& X, const bf16* PRAW, const float* ROPE, const float* qgain, float Mb, const bf16* K1, const bf16* V1, const unsigned char* MASKB, bf16* O) {
    const int lane = X.lane, r32 = lane & 31, hi = lane >> 5, tid = X.tid, wave = X.wave;
    constexpr int SP_NS = 6, SP_D = 5;
    LAS unsigned char* kring = X.lds; LAS unsigned char* vring = X.lds + SP_NS * 8192; LAS unsigned char* mlds = X.lds + 2 * SP_NS * 8192;
    const int trbase = (4 * hi + ((lane & 15) >> 2)) * 64 + (16 * ((lane >> 4) & 1) + 4 * (lane & 3)) * 2;
    for (int i = 0; i < 16; ++i) {
        const int P = blockIdx.x + 256 * i; if (P >= NB * 2 * 64) break;
        int tb = P & 63; const int g = (P >> 6) & 1, b = P >> 7; if (i & 1) tb = 63 - tb;
        const int t0 = tb * 32, c = t0 >> 6, h = 8 * g + wave;
        const size_t tokb = (size_t)b * SEQ, tok = tokb + t0 + r32;
        const bf16* kb = K1 + tokb * 128 + g * HD; const bf16* vb = V1 + tokb * 128 + g * HD;
        __builtin_amdgcn_global_load_lds((const GAS unsigned*)(MASKB + (tokb + t0 + (tid >> 4)) * 256 + (tid & 15) * 16), (LAS unsigned*)(mlds + wave * 1024), 16, 0, 0);
        bf16x8 qf[4];
        { const GAS f32x4* rp = (const GAS f32x4*)(ROPE + tok * 16); const f32x4 cs[2] = {rp[0], rp[1]}, sn[2] = {rp[2], rp[3]};
          load_q_frags(PRAW + tok * NPROJ + h * HD, qgain, cs, sn, hi, qf); }
#pragma unroll
        for (int p = 0; p < SP_D; ++p) if (p <= c) { ktile_dma(kring + p * 8192, kb + (size_t)p * 64 * 128, 128, tid, wave); vtile_dma(vring + p * 8192, vb + (size_t)p * 64 * 128, 128, tid, wave); }
        f32x16 o0 = {}, o1 = {}; float mrun = -1e30f, l = 0.f;
        const float Mrow = Mb;
        const bool fast = !__any(!(Mrow <= 60.f));
        const float cinit = fast ? -Mrow : 0.f;
#define SP_QK(SA_, SB_, slot_) do { const LAS unsigned char* ks_ = kring + (slot_) * 8192; \
            _Pragma("unroll") for (int r = 0; r < 16; ++r) { SA_[r] = cinit; SB_[r] = cinit; } \
            _Pragma("unroll") for (int d0 = 0; d0 < 4; ++d0) { SA_ = __builtin_amdgcn_mfma_f32_32x32x16_bf16(ktile_frag(ks_, r32, d0, hi), qf[d0], SA_, 0, 0, 0); SB_ = __builtin_amdgcn_mfma_f32_32x32x16_bf16(ktile_frag(ks_, 32 + r32, d0, hi), qf[d0], SB_, 0, 0, 0); } } while (0)
#define SP_PV(C0_, C1_) do { \
            { const bf16x8 pa = pack8(C0_, 0), pb = pack8(C0_, 1); \
              o0 = __builtin_amdgcn_mfma_f32_32x32x16_bf16(vtile_frag(vs, trbase, 0, 0), pa, o0, 0, 0, 0); o1 = __builtin_amdgcn_mfma_f32_32x32x16_bf16(vtile_frag(vs, trbase, 0, 1), pa, o1, 0, 0, 0); \
              o0 = __builtin_amdgcn_mfma_f32_32x32x16_bf16(vtile_frag(vs, trbase, 1, 0), pb, o0, 0, 0, 0); o1 = __builtin_amdgcn_mfma_f32_32x32x16_bf16(vtile_frag(vs, trbase, 1, 1), pb, o1, 0, 0, 0); } \
            { const bf16x8 pc = pack8(C1_, 0), pd = pack8(C1_, 1); \
              o0 = __builtin_amdgcn_mfma_f32_32x32x16_bf16(vtile_frag(vs, trbase, 2, 0), pc, o0, 0, 0, 0); o1 = __builtin_amdgcn_mfma_f32_32x32x16_bf16(vtile_frag(vs, trbase, 2, 1), pc, o1, 0, 0, 0); \
              o0 = __builtin_amdgcn_mfma_f32_32x32x16_bf16(vtile_frag(vs, trbase, 3, 0), pd, o0, 0, 0, 0); o1 = __builtin_amdgcn_mfma_f32_32x32x16_bf16(vtile_frag(vs, trbase, 3, 1), pd, o1, 0, 0, 0); } } while (0)
        if (fast) {
            f32x16 S0, S1, N0, N1;
            { const int ahead = c < (SP_D - 1) ? c : (SP_D - 1); wait_vm_le(2 * ahead); }
            SBAR();
            SP_QK(S0, S1, 0);
            int slot = 0;
#define SP_STEP(C0_, C1_, X0_, X1_, m_) do { const int m = (m_); \
                const int slotn = (slot == SP_NS - 1) ? 0 : slot + 1; \
                { int ahead = (c - m - 1) < (SP_D - 2) ? (c - m - 1) : (SP_D - 2); if (ahead < 0) ahead = 0; wait_vm_le(2 * ahead); } \
                SBAR(); \
                if (m + SP_D <= c) { const int s2 = (slot == 0) ? SP_NS - 1 : slot - 1; ktile_dma(kring + s2 * 8192, kb + (size_t)(m + SP_D) * 64 * 128, 128, tid, wave); vtile_dma(vring + s2 * 8192, vb + (size_t)(m + SP_D) * 64 * 128, 128, tid, wave); } \
                if (m + 1 <= c) SP_QK(X0_, X1_, slotn); \
                const LAS unsigned char* vs = vring + slot * 8192; \
                const u32x2 mw2 = *(const LAS u32x2*)(mlds + r32 * 256 + m * 8); \
                const unsigned mwa = mw2.x >> (4 * hi), mwb = mw2.y >> (4 * hi); \
                float ps = 0.f; \
                _Pragma("unroll") for (int r = 0; r < 16; ++r) { const int pos = (r & 3) + 8 * (r >> 2); \
                    const unsigned ma = (unsigned)__builtin_amdgcn_sbfe((int)mwa, pos, 1), mb = (unsigned)__builtin_amdgcn_sbfe((int)mwb, pos, 1); \
                    C0_[r] = __uint_as_float(__float_as_uint(__builtin_amdgcn_exp2f(C0_[r])) & ma); C1_[r] = __uint_as_float(__float_as_uint(__builtin_amdgcn_exp2f(C1_[r])) & mb); ps += C0_[r] + C1_[r]; } \
                l += ps; \
                SP_PV(C0_, C1_); \
                slot = slotn; } while (0)
            for (int mm = 0; mm <= c; mm += 2) {
                SP_STEP(S0, S1, N0, N1, mm);
                if (mm + 1 <= c) SP_STEP(N0, N1, S0, S1, mm + 1);
            }
#undef SP_STEP
        } else {
            int slot = 0;
            for (int m = 0; m <= c; ++m) {
                { const int ahead = (c - m) < (SP_D - 1) ? (c - m) : (SP_D - 1); wait_vm_le(2 * ahead); }
                SBAR();
                if (m + SP_D <= c) { const int s2 = (slot == 0) ? SP_NS - 1 : slot - 1; ktile_dma(kring + s2 * 8192, kb + (size_t)(m + SP_D) * 64 * 128, 128, tid, wave); vtile_dma(vring + s2 * 8192, vb + (size_t)(m + SP_D) * 64 * 128, 128, tid, wave); }
                const LAS unsigned char* vs = vring + slot * 8192;
                f32x16 S0, S1;
                SP_QK(S0, S1, slot);
                const u32x2 mw2 = *(const LAS u32x2*)(mlds + r32 * 256 + m * 8);
                const unsigned mwa = mw2.x >> (4 * hi), mwb = mw2.y >> (4 * hi);
                float mx = -INFINITY;
#pragma unroll
                for (int r = 0; r < 16; ++r) { const int pos = (r & 3) + 8 * (r >> 2);
                    const unsigned ma = (unsigned)__builtin_amdgcn_sbfe((int)mwa, pos, 1), mb = (unsigned)__builtin_amdgcn_sbfe((int)mwb, pos, 1);
                    S0[r] = __uint_as_float((__float_as_uint(S0[r]) & ma) | (0xFF800000u & ~ma)); S1[r] = __uint_as_float((__float_as_uint(S1[r]) & mb) | (0xFF800000u & ~mb));
                    mx = fmaxf(mx, fmaxf(S0[r], S1[r])); }
                mx = half_max(mx);
                const float mnew = fmaxf(mrun, mx), f = __builtin_amdgcn_exp2f(mrun - mnew); mrun = mnew;
                float ps = 0.f;
#pragma unroll
                for (int r = 0; r < 16; ++r) { S0[r] = __builtin_amdgcn_exp2f(S0[r] - mnew); S1[r] = __builtin_amdgcn_exp2f(S1[r] - mnew); ps += S0[r] + S1[r]; }
                l = l * f + ps;
                if (__any(f != 1.0f)) {
#pragma unroll
                    for (int r = 0; r < 16; ++r) { o0[r] *= f; o1[r] *= f; } }
                SP_PV(S0, S1);
                slot = (slot == SP_NS - 1) ? 0 : slot + 1;
            }
        }
#undef SP_QK
#undef SP_PV
        l = half_sum(l);
        store_ot(O + tok * DM + h * HD, o0, o1, 1.0f / l, hi);
        asm volatile("s_waitcnt lgkmcnt(0)" ::: "memory");
        SBAR();
    }
}


__device__ __forceinline__ void phase_sparse_coop2(const Ctx& X, const bf16* PRAW, const float* ROPE, const float* qgain, float Mb, const bf16* K1, const bf16* V1, const unsigned char* MASKB, bf16* O) {
    const int lane = X.lane, r32 = lane & 31, hi = lane >> 5, tid = X.tid, wave = X.wave, g = wave >> 2, hA = 8 * g + 2 * (wave & 3);
    constexpr int NS = 3, D = 2;
    LAS unsigned char* kring = X.lds; LAS unsigned char* vring = X.lds + NS * 16384; LAS unsigned char* mlds = X.lds + 2 * NS * 16384;
    const int trbase = (4 * hi + ((lane & 15) >> 2)) * 64 + (16 * ((lane >> 4) & 1) + 4 * (lane & 3)) * 2;
    for (int i = 0; i < 8; ++i) {
        const int P = blockIdx.x + 256 * i; if (P >= NB * 64) break;
        int tb = P & 63; const int b = P >> 6; if (i & 1) tb = 63 - tb;
        const int t0 = tb * 32, c = t0 >> 6;
        const size_t tokb = (size_t)b * SEQ, tok = tokb + t0 + r32;
        const bf16* kb0 = K1 + tokb * 128; const bf16* vb0 = V1 + tokb * 128;
#define SP2_DMA(slot_, tile_) do { LAS unsigned char* ks_ = kring + (slot_) * 16384; LAS unsigned char* vs_ = vring + (slot_) * 16384; const size_t ro_ = (size_t)(tile_) * 64 * 128; \
            ktile_dma(ks_, kb0 + ro_, 128, tid, wave); ktile_dma(ks_ + 8192, kb0 + ro_ + HD, 128, tid, wave); vtile_dma(vs_, vb0 + ro_, 128, tid, wave); vtile_dma(vs_ + 8192, vb0 + ro_ + HD, 128, tid, wave); } while (0)
        __builtin_amdgcn_global_load_lds((const GAS unsigned*)(MASKB + (tokb + t0 + (tid >> 4)) * 256 + (tid & 15) * 16), (LAS unsigned*)(mlds + wave * 1024), 16, 0, 0);
        const RawFr rwA = raw_frags(PRAW + tok * NPROJ + hA * HD, hi), rwB = raw_frags(PRAW + tok * NPROJ + (hA + 1) * HD, hi);
        const GAS f32x4* rp = (const GAS f32x4*)(ROPE + tok * 16); const f32x4 cs[2] = {rp[0], rp[1]}, sn[2] = {rp[2], rp[3]};
        asm volatile("" ::: "memory");
#pragma unroll
        for (int p = 0; p < D; ++p) if (p <= c) SP2_DMA(p, p);
        asm volatile("" ::: "memory");
        bf16x8 qa[4], qb[4];
        q_frags_from_raw(rwA, qgain, cs, sn, hi, qa); q_frags_from_raw(rwB, qgain, cs, sn, hi, qb);
        f32x16 a0 = {}, a1 = {}, b0 = {}, b1 = {}; float lA = 0.f, lB = 0.f;
        const float cinit = -Mb;
        int slot = 0;
        for (int m = 0; m <= c; ++m) {
            { const int ahead = (c - m) < (D - 1) ? (c - m) : (D - 1); wait_vm_le(4 * ahead); }
            SBAR();
            if (m + D <= c) { const int s2 = (slot == 0) ? NS - 1 : slot - 1; SP2_DMA(s2, m + D); }
            const LAS unsigned char* ks = kring + slot * 16384 + g * 8192; const LAS unsigned char* vs = vring + slot * 16384 + g * 8192;
            f32x16 A0, A1, B0, B1;
            { const u32x2 mw2 = *(const LAS u32x2*)(mlds + r32 * 256 + m * 8);
              const unsigned mwa = mw2.x >> (4 * hi), mwb = mw2.y >> (4 * hi), cb = __float_as_uint(cinit);
#pragma unroll
              for (int r = 0; r < 16; ++r) { const int pos = (r & 3) + 8 * (r >> 2);
                  const unsigned ma = (unsigned)__builtin_amdgcn_sbfe((int)mwa, pos, 1), mb = (unsigned)__builtin_amdgcn_sbfe((int)mwb, pos, 1);
                  const float ia = __uint_as_float((ma & cb) | (~ma & 0xFF800000u)), ib = __uint_as_float((mb & cb) | (~mb & 0xFF800000u));
                  A0[r] = ia; B0[r] = ia; A1[r] = ib; B1[r] = ib; } }
#pragma unroll
            for (int d0 = 0; d0 < 4; ++d0) { const bf16x8 k0 = ktile_frag(ks, r32, d0, hi), k1 = ktile_frag(ks, 32 + r32, d0, hi);
                A0 = __builtin_amdgcn_mfma_f32_32x32x16_bf16(k0, qa[d0], A0, 0, 0, 0); B0 = __builtin_amdgcn_mfma_f32_32x32x16_bf16(k0, qb[d0], B0, 0, 0, 0);
                A1 = __builtin_amdgcn_mfma_f32_32x32x16_bf16(k1, qa[d0], A1, 0, 0, 0); B1 = __builtin_amdgcn_mfma_f32_32x32x16_bf16(k1, qb[d0], B1, 0, 0, 0); }
            f32x2 pA0 = {0.f, 0.f}, pA1 = {0.f, 0.f}, pB0 = {0.f, 0.f}, pB1 = {0.f, 0.f};
#pragma unroll
            for (int r = 0; r < 16; ++r) { A0[r] = __builtin_amdgcn_exp2f(A0[r]); A1[r] = __builtin_amdgcn_exp2f(A1[r]); B0[r] = __builtin_amdgcn_exp2f(B0[r]); B1[r] = __builtin_amdgcn_exp2f(B1[r]); }
#pragma unroll
            for (int r = 0; r < 16; r += 2) { pA0 += (f32x2){A0[r], A0[r + 1]}; pA1 += (f32x2){A1[r], A1[r + 1]}; pB0 += (f32x2){B0[r], B0[r + 1]}; pB1 += (f32x2){B1[r], B1[r + 1]}; }
            { const f32x2 sa2 = pA0 + pA1, sb2 = pB0 + pB1; lA += sa2.x + sa2.y; lB += sb2.x + sb2.y; }
#define SP2_PV(s4_, PA_, PB_) do { const bf16x8 v0_ = vtile_frag(vs, trbase, s4_, 0), v1_ = vtile_frag(vs, trbase, s4_, 1); \
                a0 = __builtin_amdgcn_mfma_f32_32x32x16_bf16(v0_, PA_, a0, 0, 0, 0); a1 = __builtin_amdgcn_mfma_f32_32x32x16_bf16(v1_, PA_, a1, 0, 0, 0); \
                b0 = __builtin_amdgcn_mfma_f32_32x32x16_bf16(v0_, PB_, b0, 0, 0, 0); b1 = __builtin_amdgcn_mfma_f32_32x32x16_bf16(v1_, PB_, b1, 0, 0, 0); } while (0)
            { const bf16x8 pa = pack8(A0, 0), pb = pack8(B0, 0); SP2_PV(0, pa, pb); }
            { const bf16x8 pa = pack8(A0, 1), pb = pack8(B0, 1); SP2_PV(1, pa, pb); }
            { const bf16x8 pa = pack8(A1, 0), pb = pack8(B1, 0); SP2_PV(2, pa, pb); }
            { const bf16x8 pa = pack8(A1, 1), pb = pack8(B1, 1); SP2_PV(3, pa, pb); }
#undef SP2_PV
            slot = (slot == NS - 1) ? 0 : slot + 1;
        }
#undef SP2_DMA
        lA = half_sum(lA); lB = half_sum(lB);
        store_ot(O + tok * DM + hA * HD, a0, a1, 1.0f / lA, hi);
        store_ot(O + tok * DM + (hA + 1) * HD, b0, b1, 1.0f / lB, hi);
        asm volatile("s_waitcnt lgkmcnt(0)" ::: "memory");
        SBAR();
    }
}

__device__ __forceinline__ void phase_idx_topk_coop(const Ctx& X, const bf16* PRAW, const float* ROPE, const bf16* KI, const float* WI, unsigned long long* MASK) {
    const int lane = X.lane, r32 = lane & 31, hi = lane >> 5, tid = X.tid, wave = X.wave;
    const int tkr = 2 * ((r32 >> 2) & 1) + (r32 >> 4), hdr = (r32 & 3) + 4 * ((r32 >> 3) & 1);
    LAS unsigned char* kring = X.lds;
    for (int i = 0; i < 8; ++i) {
        const int P = blockIdx.x + 256 * i; if (P >= NB * 64) break;
        int tb = P & 63; const int b = P >> 6; if (i & 1) tb = 63 - tb;
        const int t0 = tb * 32 + 4 * wave, c = tb >> 1; const size_t tokb = (size_t)b * SEQ, tok0 = tokb + t0;
        const bf16* kib = KI + tokb * 64;
        const RawFr rwq = raw_frags(PRAW + (tok0 + tkr) * NPROJ + 1280 + hdr * 64, hi);
        const GAS f32x4* rp = (const GAS f32x4*)(ROPE + (tok0 + tkr) * 16); const f32x4 cs[2] = {rp[0], rp[1]}, sn[2] = {rp[2], rp[3]};
        float w0[8], w1[8];
        { const GAS f32x4* wp = (const GAS f32x4*)(WI + (tok0 + 2 * hi) * 8); const f32x4 a = wp[0], b4 = wp[1], c4 = wp[2], d4 = wp[3];
#pragma unroll
          for (int hh = 0; hh < 4; ++hh) { w0[hh] = a[hh]; w0[4 + hh] = b4[hh]; w1[hh] = c4[hh]; w1[4 + hh] = d4[hh]; } }
        asm volatile("" ::: "memory");
#pragma unroll
        for (int p = 0; p < 7; ++p) if (p <= c) ktile_dma(kring + p * 8192, kib + (size_t)p * 64 * 64, 64, tid, wave);
        asm volatile("" ::: "memory");
        bf16x8 qf[4];
        qi_frags_from_raw(rwq, cs, sn, hi, qf);
        unsigned k0[32], k1[32], k2[32], k3[32];
        SEC_BEGIN(1);
#pragma unroll
        for (int m = 0; m < 32; ++m) {
            if (m <= c) {
                { SEC_BEGIN(3);
                { const int ahead = (c - m) < 6 ? (c - m) : 6; wait_vm_le(ahead); }
                SEC_END(3); }
                { SEC_BEGIN(4);
                SBAR();
                SEC_END(4); }
                if (m + 7 <= c) ktile_dma(kring + ((m + 7) % 8) * 8192, kib + (size_t)(m + 7) * 64 * 64, 64, tid, wave);
                const LAS unsigned char* ks = kring + (m % 8) * 8192;
                float sa[2], sb[2];
                { bf16x8 kfa[4], kfb[4];
#pragma unroll
                  for (int d0 = 0; d0 < 4; ++d0) { kfa[d0] = ktile_frag(ks, r32, d0, hi); kfb[d0] = ktile_frag(ks, 32 + r32, d0, hi); }
                  f32x16 Ra = {}, Rb = {};
#pragma unroll
                  for (int d0 = 0; d0 < 4; ++d0) { Ra = __builtin_amdgcn_mfma_f32_32x32x16_bf16(qf[d0], kfa[d0], Ra, 0, 0, 0); Rb = __builtin_amdgcn_mfma_f32_32x32x16_bf16(qf[d0], kfb[d0], Rb, 0, 0, 0); }
                  f32x2 sA = {0.f, 0.f}, sB = {0.f, 0.f};
#pragma unroll
                  for (int hh = 0; hh < 8; ++hh) { sA = (f32x2){relu1(Ra[hh]), relu1(Rb[hh])} * w0[hh] + sA; sB = (f32x2){relu1(Ra[8 + hh]), relu1(Rb[8 + hh])} * w1[hh] + sB; }
                  sa[0] = sA.x; sb[0] = sB.x; sa[1] = sA.y; sb[1] = sB.y; }
                const auto ra = __builtin_amdgcn_permlane32_swap(ord_key(sa[0]), ord_key(sa[1]), false, false);
                const auto rb = __builtin_amdgcn_permlane32_swap(ord_key(sb[0]), ord_key(sb[1]), false, false);
                k0[m] = ra[0]; k2[m] = ra[1]; k1[m] = rb[0]; k3[m] = rb[1];
            } else { k0[m] = 0u; k1[m] = 0u; k2[m] = 0u; k3[m] = 0u; }
        }
        asm volatile("s_waitcnt lgkmcnt(0)" ::: "memory");
        SBAR();
        SEC_END(1);
        SEC_BEGIN(2);
        topk_select_store(k0, c, MASK + (tok0 + 0) * 32, lane);
        topk_select_store(k1, c, MASK + (tok0 + 1) * 32, lane);
        topk_select_store(k2, c, MASK + (tok0 + 2) * 32, lane);
        topk_select_store(k3, c, MASK + (tok0 + 3) * 32, lane);
        SEC_END(2);
    }
}


#define SB_TILE(S_, qf_, diag_, run_, o0_, o1_) do { \
        f32x16 S_ = {}; \
        _Pragma("unroll") for (int d0 = 0; d0 < 4; ++d0) S_ = __builtin_amdgcn_mfma_f32_32x32x16_bf16(ktile_frag(ks, r32, d0, hi), qf_[d0], S_, 0, 0, 0); \
        f32x16 xm_, ls_; float cs_ = 0.f; \
        _Pragma("unroll") for (int r = 0; r < 16; ++r) { const float z = S_[r]; const float sp = relu1(z) + __builtin_amdgcn_logf(1.0f + __builtin_amdgcn_exp2f(-fabsf(z))); \
            const bool valid = !(diag_) || (crow16(r, hi) < r32); xm_[r] = valid ? sp : 0.f; ls_[r] = valid ? z - sp : -INFINITY; cs_ += xm_[r]; } \
        cs_ = half_sum(cs_); \
        f32x16 T_; _Pragma("unroll") for (int r = 0; r < 16; ++r) T_[r] = run_; \
        T_ = __builtin_amdgcn_mfma_f32_32x32x16_bf16(uf[0], pack8(xm_, 0), T_, 0, 0, 0); \
        T_ = __builtin_amdgcn_mfma_f32_32x32x16_bf16(uf[1], pack8(xm_, 1), T_, 0, 0, 0); \
        _Pragma("unroll") for (int r = 0; r < 16; ++r) T_[r] = __builtin_amdgcn_exp2f(ls_[r] + T_[r]); \
        const bf16x8 p0_ = pack8(T_, 0), p1_ = pack8(T_, 1); \
        o0_ = __builtin_amdgcn_mfma_f32_32x32x16_bf16(vtile_frag(vs, trbase, 0, 0), p0_, o0_, 0, 0, 0); o1_ = __builtin_amdgcn_mfma_f32_32x32x16_bf16(vtile_frag(vs, trbase, 0, 1), p0_, o1_, 0, 0, 0); \
        o0_ = __builtin_amdgcn_mfma_f32_32x32x16_bf16(vtile_frag(vs, trbase, 1, 0), p1_, o0_, 0, 0, 0); o1_ = __builtin_amdgcn_mfma_f32_32x32x16_bf16(vtile_frag(vs, trbase, 1, 1), p1_, o1_, 0, 0, 0); \
        run_ -= cs_; } while (0)
#define SB_ELEM(S_, xm_, cs_, diag_, run_) do {   \
        _Pragma("unroll") for (int r = 0; r < 16; r += 2) { const f32x2 z = {S_[r], S_[r + 1]}; \
            f32x2 e; e.x = __builtin_amdgcn_exp2f(-fabsf(z.x)); e.y = __builtin_amdgcn_exp2f(-fabsf(z.y)); \
            const f32x2 d = e + 1.0f; \
            f32x2 lg; lg.x = __builtin_amdgcn_logf(d.x); lg.y = __builtin_amdgcn_logf(d.y); \
            f32x2 mx; mx.x = relu1(z.x); mx.y = relu1(z.y); \
            const f32x2 sp = mx + lg, t = z + ((f32x2){run_, run_} - sp); \
            xm_[r] = sp.x; xm_[r + 1] = sp.y; S_[r] = t.x; S_[r + 1] = t.y; } \
        if (diag_) { _Pragma("unroll") for (int r = 0; r < 16; ++r) { const bool valid = crow16(r, hi) < r32; xm_[r] = valid ? xm_[r] : 0.f; S_[r] = valid ? S_[r] : -INFINITY; } } \
        { f32x2 c2 = {0.f, 0.f}; _Pragma("unroll") for (int r = 0; r < 16; r += 2) c2 += (f32x2){xm_[r], xm_[r + 1]}; cs_ = half_sum(c2.x + c2.y); } } while (0)
#define SB_PAIR(dA_) do { \
        bf16x8 kf_[4]; _Pragma("unroll") for (int d0 = 0; d0 < 4; ++d0) kf_[d0] = ktile_frag(ks, r32, d0, hi); \
        f32x16 SA_ = {}, SB_ = {}; \
        _Pragma("unroll") for (int d0 = 0; d0 < 4; ++d0) { SA_ = __builtin_amdgcn_mfma_f32_32x32x16_bf16(kf_[d0], qa[d0], SA_, 0, 0, 0); SB_ = __builtin_amdgcn_mfma_f32_32x32x16_bf16(kf_[d0], qb[d0], SB_, 0, 0, 0); } \
        f32x16 xA_, xB_; float cA_, cB_; \
        SB_ELEM(SA_, xA_, cA_, dA_, runA); SB_ELEM(SB_, xB_, cB_, false, runB);            \
        SA_ = __builtin_amdgcn_mfma_f32_32x32x16_bf16(uf[0], pack8(xA_, 0), SA_, 0, 0, 0); SB_ = __builtin_amdgcn_mfma_f32_32x32x16_bf16(uf[0], pack8(xB_, 0), SB_, 0, 0, 0); \
        SA_ = __builtin_amdgcn_mfma_f32_32x32x16_bf16(uf[1], pack8(xA_, 1), SA_, 0, 0, 0); SB_ = __builtin_amdgcn_mfma_f32_32x32x16_bf16(uf[1], pack8(xB_, 1), SB_, 0, 0, 0); \
        _Pragma("unroll") for (int r = 0; r < 16; ++r) { SA_[r] = __builtin_amdgcn_exp2f(SA_[r]); SB_[r] = __builtin_amdgcn_exp2f(SB_[r]); } \
        { const bf16x8 pa_ = pack8(SA_, 0), pb_ = pack8(SB_, 0); const bf16x8 v0_ = vtile_frag(vs, trbase, 0, 0), v1_ = vtile_frag(vs, trbase, 0, 1); \
          a0 = __builtin_amdgcn_mfma_f32_32x32x16_bf16(v0_, pa_, a0, 0, 0, 0); b0 = __builtin_amdgcn_mfma_f32_32x32x16_bf16(v0_, pb_, b0, 0, 0, 0); \
          a1 = __builtin_amdgcn_mfma_f32_32x32x16_bf16(v1_, pa_, a1, 0, 0, 0); b1 = __builtin_amdgcn_mfma_f32_32x32x16_bf16(v1_, pb_, b1, 0, 0, 0); } \
        { const bf16x8 pa_ = pack8(SA_, 1), pb_ = pack8(SB_, 1); const bf16x8 v0_ = vtile_frag(vs, trbase, 1, 0), v1_ = vtile_frag(vs, trbase, 1, 1); \
          a0 = __builtin_amdgcn_mfma_f32_32x32x16_bf16(v0_, pa_, a0, 0, 0, 0); b0 = __builtin_amdgcn_mfma_f32_32x32x16_bf16(v0_, pb_, b0, 0, 0, 0); \
          a1 = __builtin_amdgcn_mfma_f32_32x32x16_bf16(v1_, pa_, a1, 0, 0, 0); b1 = __builtin_amdgcn_mfma_f32_32x32x16_bf16(v1_, pb_, b1, 0, 0, 0); } \
        runA -= cA_; runB -= cB_; } while (0)
__device__ __forceinline__ void sb_tile_dma(LAS unsigned char* slot, const bf16* base  , int key0, int lane) {
#pragma unroll
    for (int i = 0; i < 4; ++i) { const int key = 8 * i + (lane >> 3), src = (lane & 7) ^ ((key >> 1) & 7);
        __builtin_amdgcn_global_load_lds((const GAS unsigned*)(base + (size_t)(key0 + key) * NQKV + DM + src * 8), (LAS unsigned*)(slot + i * 1024), 16, 0, 0); }
#pragma unroll
    for (int i = 0; i < 4; ++i) { const int key = 8 * i + ((lane & 31) >> 2), d = 32 * (lane >> 5) + 8 * (lane & 3);
        __builtin_amdgcn_global_load_lds((const GAS unsigned*)(base + (size_t)(key0 + key) * NQKV + 2 * DM + d), (LAS unsigned*)(slot + 4096 + i * 1024), 16, 0, 0); }
}
__device__ __forceinline__ void phase_sb_pair(const Ctx& X, const bf16* QKV, bf16* O) {
    const int lane = X.lane, r32 = lane & 31, hi = lane >> 5;
    LAS unsigned char* ring = X.lds + X.wave * 16384;
    const int trbase = (4 * hi + ((lane & 15) >> 2)) * 64 + (16 * ((lane >> 4) & 1) + 4 * (lane & 3)) * 2;
    bf16x8 uf[2];
#pragma unroll
    for (int s = 0; s < 2; ++s)
#pragma unroll
        for (int j = 0; j < 8; ++j) uf[s][j] = ((16 * s + 8 * (j >> 2) + 4 * hi + (j & 3)) > r32) ? (short)0xBF80 : (short)0;
    for (int u = X.gw; u < NB * NH * 32; u += X.NGW) {
        const int b = u >> 9, h = (u >> 5) & 15, pb = u & 31, t0 = pb * 64;
        const bf16* base = QKV + (size_t)b * SEQ * NQKV + h * HD;
        asm volatile("s_waitcnt lgkmcnt(0)" ::: "memory");
        sb_tile_dma(ring, base, t0 + 32, lane);
        bf16x8 qa[4], qb[4];
#pragma unroll
        for (int d0 = 0; d0 < 4; ++d0) { qa[d0] = *(const GAS bf16x8*)(base + (size_t)(t0 + r32) * NQKV + 16 * d0 + 8 * hi); qb[d0] = *(const GAS bf16x8*)(base + (size_t)(t0 + 32 + r32) * NQKV + 16 * d0 + 8 * hi); }
        f32x16 a0 = {}, a1 = {}, b0 = {}, b1 = {}; float runA = 0.f, runB = 0.f;
        int slot = 0;
        for (int kt = 2 * pb + 1; kt >= 0; --kt) {
            asm volatile("s_waitcnt lgkmcnt(0)" ::: "memory");
            if (kt > 0) { sb_tile_dma(ring + (slot ^ 1) * 8192, base, (kt - 1) * 32, lane); WAITV(8); } else WAITV(0);
            const LAS unsigned char* ks = ring + slot * 8192; const LAS unsigned char* vs = ks + 4096;
            if (kt == 2 * pb + 1) { SB_TILE(SB, qb, true, runB, b0, b1); }
            else { const bool dA = (kt == 2 * pb); SB_PAIR(dA);
                if (__all(runA < -160.f && runB < -160.f)) break; }
            slot ^= 1;
        }
        store_ot(O + (size_t)(b * SEQ + t0 + r32) * DM + h * HD, a0, a1, 1.0f, hi);
        store_ot(O + (size_t)(b * SEQ + t0 + 32 + r32) * DM + h * HD, b0, b1, 1.0f, hi);
        WAITV(0);
    }
}

#ifndef MK_N_LAUNCHES
#define MK_N_LAUNCHES 1
#endif
constexpr int NPHASES = 19;
struct Args { const void* in[19]; float* out; unsigned char* ws; int ph_lo, ph_hi; };
static_assert(sizeof(Args) == 19 * 8 + 8 + 8 + 8, "Args has no padding");

__device__ __forceinline__ void moe_gemms_gu(const Ctx& X, const signed char* H8, const float* hs_e, const signed char* Wgu8_l, const float* wsc_l, const float* bgu_l, unsigned char* ACT, const unsigned* gcnt, const int* list) {
    LAS int* cntL = (LAS int*)(X.lds + EXTRA_OFF); LAS int* tsum = cntL + 32;
    moe_tables(X, gcnt, cntL, tsum);
    pg8::Gemm g{(const bf16*)H8, (const bf16*)Wgu8_l, DM, (size_t)2048 * DM};
    pg8::MoeOrder S{tsum, cntL, list, 8, X.G, (int)blockIdx.x, tsum[NE] * 8, 0};
    pg8::EpiSwiglu8 E{ACT, bgu_l, hs_e, wsc_l, &S};
    pg8::gemm_phase<pg8::EpiSwiglu8, pg8::MoeOrder, true, true, 1>(X.lds, g, S, E);
}
__device__ __forceinline__ void moe_gemms_down(const Ctx& X, const unsigned char* ACT8, const unsigned char* Wd8_l, const float* wsd_l, const float* bd_l, unsigned char* Y, const unsigned* gcnt, const int* list, const float* gate_e) {
    LAS int* cntL = (LAS int*)(X.lds + EXTRA_OFF); LAS int* tsum = cntL + 32;
    moe_tables(X, gcnt, cntL, tsum);
    pg8::Gemm g{(const bf16*)ACT8, (const bf16*)Wd8_l, DM, (size_t)DM * DM};
    pg8::MoeOrder S{tsum, cntL, list, 4, X.G, (int)blockIdx.x, tsum[NE] * 4, 0};
    pg8::EpiDownF8 E{Y, bd_l, gate_e, tsum, wsd_l};
    pg8::gemm_phase<pg8::EpiDownF8, pg8::MoeOrder, false, true, 2>(X.lds, g, S, E);
}

__global__ void __launch_bounds__(NTHREADS, 2) mk_fwd(Args a) {
    extern __shared__ __attribute__((aligned(16))) unsigned char lds_raw[];
    Ctx X; X.lds = (LAS unsigned char*)lds_raw; X.tid = threadIdx.x; X.lane = X.tid & 63; X.wave = __builtin_amdgcn_readfirstlane(X.tid >> 6);
    X.G = gridDim.x; { const int bx = blockIdx.x; X.vcu = (X.G % 8 == 0) ? (bx % 8) * (X.G / 8) + bx / 8 : bx; }
    X.gw = X.vcu * NWAVES + X.wave; X.NGW = X.G * NWAVES;
    volatile LAS unsigned* MISC = (volatile LAS unsigned*)(X.lds + LDSCTL_OFF);
    for (int u = X.tid; u < 256; u += NTHREADS) MISC[u] = 0u;
    __syncthreads();
    unsigned char* ws = a.ws;
    unsigned* ctl = (unsigned*)(ws + WS_CTL);
    XcdBarrier bar = xcd_barrier_post(ctl + CW_BAR, MISC + 8);
    const int lo = a.ph_lo, hi = a.ph_hi;
#ifndef ONLY_PHASE
#define ONLY_PHASE -1
#endif
#define IN(k) ((ONLY_PHASE < 0 || ONLY_PHASE == (k)) && lo <= (k) && (k) < hi)
#if defined(PROBE_LO)
    unsigned long long pr_t0 = 0, pr_t1 = 0;
#define PROBE_AT(k) do { if ((k) == PROBE_LO) pr_t0 = __builtin_amdgcn_s_memrealtime(); if ((k) == PROBE_HI) pr_t1 = __builtin_amdgcn_s_memrealtime(); } while (0)
#else
#define PROBE_AT(k) do {} while (0)
#endif
#define SEAM(k) do { if (IN(k) && IN((k) + 1)) xcd_barrier(bar); PROBE_AT((k) + 1); } while (0)
    const float* x_in = (const float*)a.in[0]; const float* c_in = (const float*)a.in[1]; const int* positions = (const int*)a.in[2];
    const float* ada_w = (const float*)a.in[3]; const float* ada_b = (const float*)a.in[4]; const float* norm1_g = (const float*)a.in[5]; const float* norm2_g = (const float*)a.in[6];
    const float* sb_w_qkv = (const float*)a.in[7]; const float* sb_w_o = (const float*)a.in[8]; const float* dsa_w_in = (const float*)a.in[9];
    const float* dsa_q_gain = (const float*)a.in[10]; const float* dsa_k_gain = (const float*)a.in[11]; const float* dsa_w_o = (const float*)a.in[12];
    const float* router_w = (const float*)a.in[13]; const float* router_b = (const float*)a.in[14];
    const float* exp_w_gu = (const float*)a.in[15]; const float* exp_b_gu = (const float*)a.in[16]; const float* exp_w_down = (const float*)a.in[17]; const float* exp_b_down = (const float*)a.in[18];
    float* out = a.out;
    float* mod = (float*)(ws + WS_MOD);
    signed char* Wqkv8 = (signed char*)(ws + WS_WQKV); bf16* Wo0_t = (bf16*)(ws + WS_WO0); signed char* Win8 = (signed char*)(ws + WS_WIN); bf16* Wo1_t = (bf16*)(ws + WS_WO1); signed char* Wgu8 = (signed char*)(ws + WS_WGU); bf16* Wd_t = (bf16*)(ws + WS_WD);
    float* wsc = (float*)(ws + WS_WSC); signed char* H8 = (signed char*)(ws + WS_H); float* HS = (float*)(ws + WS_HS);
    bf16* QKV = (bf16*)(ws + WS_QKV); unsigned char* ACT = ws + WS_A; unsigned char* Y = ws + WS_B; bf16* O = (bf16*)(ws + WS_O);
    bf16* PRAW = (bf16*)(ws + WS_PRAW); bf16* Q1 = (bf16*)(ws + WS_Q1); bf16* K1 = (bf16*)(ws + WS_K1); bf16* V1 = (bf16*)(ws + WS_V1); bf16* QI = (bf16*)(ws + WS_QI); bf16* KI = (bf16*)(ws + WS_KI); float* WI = (float*)(ws + WS_WI); float* QN = (float*)(ws + WS_QN);
    unsigned long long* MASK = (unsigned long long*)(ws + WS_MASK); float* SC = (float*)(ws + WS_SC);
    int* tok_e = (int*)(ws + WS_TOKE); int* tok_p = (int*)(ws + WS_TOKP); int* list = (int*)(ws + WS_LIST); float* gate_e = (float*)(ws + WS_GATE); float* hs_e = (float*)(ws + WS_HSE); bf16* XR = (bf16*)(ws + WS_XR);
    unsigned* gcnt0 = ctl + CW_CNT; unsigned* gcnt1 = ctl + CW_CNT + 32;
    const float* mod0 = mod; const float* mod1 = mod + (size_t)NB * 6144;

    PROBE_AT(0);
    if (IN(0)) { phase_prologue(X, c_in, ada_w, ada_b, mod, sb_w_qkv, sb_w_o, dsa_w_in, dsa_w_o, exp_w_gu, exp_w_down, Wqkv8, Wo0_t, Win8, Wo1_t, Wgu8, Wd_t, wsc, ctl + CW_ADA, ctl + CW_ITEM);
        if (IN(1)) { if (X.tid == 0) { XB_SPIN(xb_ld(ctl + CW_ADA) < 192u, bar.bar); __builtin_amdgcn_fence(__ATOMIC_ACQUIRE, "agent"); asm volatile("s_waitcnt vmcnt(0)" ::: "memory"); }
            __syncthreads(); }
        PROBE_AT(1); }
    if (IN(1)) { phase_norm1(X, x_in, norm1_g, mod0, H8, HS); SEAM(1); }
    if (IN(2)) { pg8::Gemm g{(const bf16*)H8, (const bf16*)Wqkv8, DM, 0}; pg8::StaticOrder S; S.init(NTOK, NQKV, X.G, (int)blockIdx.x); pg8::EpiBf16S8 E{QKV, NQKV, DM, QSCALE, HS, wsc};
        pg8::gemm_phase<pg8::EpiBf16S8, pg8::StaticOrder, false, true, 1>(X.lds, g, S, E); SEAM(2); }
#if defined(NAIVE_SB)
    if (IN(3)) { phase_sb_naive(X, QKV, O); SEAM(3); }
#else
    if (IN(3)) { phase_sb_pair(X, QKV, O); SEAM(3); }
#endif
    if (IN(4)) { pg8::Gemm g{O, Wo0_t, DM, 0}; pg8::StaticOrder S; S.init(NTOK, DM, X.G, (int)blockIdx.x); pg8::EpiResid<false> E{x_in, XR, mod0 + 2 * DM};
        pg8::gemm_phase<pg8::EpiResid<false>, pg8::StaticOrder, false, true>(X.lds, g, S, E); SEAM(4); }
    if (IN(5)) { phase_norm2_router(X, XR, norm2_g, mod0, router_w, router_b, H8, HS, tok_e, tok_p, gcnt0, list, gate_e, hs_e); SEAM(5); }
    if (IN(6)) { moe_gemms_gu(X, H8, hs_e, Wgu8, wsc + NQKV + NPROJ, exp_b_gu, ACT, gcnt0, list); SEAM(6); }
    if (IN(7)) { moe_gemms_down(X, ACT, (const unsigned char*)Wd_t, wsc + NQKV + NPROJ + 64 * 2048, exp_b_down, Y, gcnt0, list, gate_e); SEAM(7); }
    if (IN(8)) { phase_combine(X, XR, nullptr, Y, tok_e, tok_p, gcnt0, mod0, true, norm1_g + DM, mod1, H8, HS); SEAM(8); }
    if (IN(9)) { pg8::Gemm g{(const bf16*)H8, (const bf16*)Win8, DM, 0}; pg8::StaticOrder S; S.init(NTOK, NPROJ, X.G, (int)blockIdx.x); pg8::EpiBf16S8 E{PRAW, NPROJ, 0, 1.0f, HS, wsc + NQKV};
        pg8::gemm_phase<pg8::EpiBf16S8, pg8::StaticOrder, false, true, 1>(X.lds, g, S, E); SEAM(9); }
    float* ROPE = (float*)(ws + WS_ROPE);
    if (IN(10)) { phase_dsa_post2(X, PRAW, positions, dsa_k_gain, K1, V1, KI, WI, ROPE); SEAM(10); }
#if defined(NAIVE_IDX)
    if (IN(11)) { phase_idx_naive(X, QI, KI, WI, SC); SEAM(11); }
    if (IN(12)) { phase_topk_naive(X, SC, MASK); SEAM(12); }
#else
    if (IN(11)) { phase_idx_topk_coop(X, PRAW, ROPE, KI, WI, MASK);
        if (IN(13)) { const float mb0 = qk_bound(dsa_q_gain, dsa_k_gain, X.lane);
            if (mb0 <= 60.f) { asm volatile("s_waitcnt vmcnt(0)" ::: "memory"); __syncthreads(); } else xcd_barrier(bar); }
        PROBE_AT(12); PROBE_AT(13); }
#endif
#if defined(NAIVE_SPARSE)
    if (IN(13)) { phase_sparse_naive(X, Q1, K1, V1, MASK, O); SEAM(13); }
#else
    if (IN(13)) { const float mb = qk_bound(dsa_q_gain, dsa_k_gain, X.lane);
        if (mb <= 60.f) phase_sparse_coop2(X, PRAW, ROPE, dsa_q_gain, mb, K1, V1, (const unsigned char*)MASK, O);
        else phase_sparse_coop(X, PRAW, ROPE, dsa_q_gain, mb, K1, V1, (const unsigned char*)MASK, O);
        SEAM(13); }
#endif
    if (IN(14)) { pg8::Gemm g{O, Wo1_t, DM, 0}; pg8::StaticOrder S; S.init(NTOK, DM, X.G, (int)blockIdx.x); pg8::EpiResid<true> E{XR, XR, mod1 + 2 * DM};
        pg8::gemm_phase<pg8::EpiResid<true>, pg8::StaticOrder, false, true>(X.lds, g, S, E); SEAM(14); }
    if (IN(15)) { phase_norm2_router(X, XR, norm2_g + DM, mod1, router_w + (size_t)DM * NE, router_b + NE, H8, HS, tok_e, tok_p, gcnt1, list, gate_e, hs_e); SEAM(15); }
    if (IN(16)) { moe_gemms_gu(X, H8, hs_e, Wgu8 + (size_t)NE * 2048 * DM, wsc + NQKV + NPROJ + NE * 2048, exp_b_gu + (size_t)NE * 2048, ACT, gcnt1, list); SEAM(16); }
    if (IN(17)) { moe_gemms_down(X, ACT, (const unsigned char*)Wd_t + (size_t)NE * DM * DM, wsc + NQKV + NPROJ + 64 * 2048 + NE * DM, exp_b_down + (size_t)NE * DM, Y, gcnt1, list, gate_e); SEAM(17); }
    if (IN(18)) { phase_combine(X, XR, out, Y, tok_e, tok_p, gcnt1, mod1, false, nullptr, nullptr, nullptr, nullptr); }
#if defined(PROBE_SEC)
    if (blockIdx.x == 0 && X.tid == 0) { const unsigned long long span = *(volatile LAS unsigned long long*)(X.lds + LDSCTL_OFF + 64) * PROBE_MULT, t = __builtin_amdgcn_s_memrealtime(); while (__builtin_amdgcn_s_memrealtime() - t < span) __builtin_amdgcn_s_sleep(8); }
#endif
#if defined(PROBE_LO)
    PROBE_AT(19);
    if (blockIdx.x == 0 && X.tid == 0) { const unsigned long long span = (pr_t1 - pr_t0) * PROBE_MULT, t = __builtin_amdgcn_s_memrealtime(); while (__builtin_amdgcn_s_memrealtime() - t < span) __builtin_amdgcn_s_sleep(8); }
#endif
#undef IN
#undef SEAM
}

extern "C" void kernel_launch(void* const* d_in, const int* in_sizes, int n_in, void* d_out, int out_size, void* d_ws, size_t ws_size, hipStream_t stream) {
    static int grid = 0;
    if (grid == 0) {
        if (n_in != 19 || out_size != NTOK * DM || ws_size < WS_END) { fprintf(stderr, "kernel_launch: unexpected shapes (n_in %d, out %d, ws %zu < %zu)\n", n_in, out_size, ws_size, (size_t)WS_END); grid = -1; return; }
        int dev = 0, cus = 0, per_cu = 0;
        if (hipGetDevice(&dev) != hipSuccess || hipDeviceGetAttribute(&cus, hipDeviceAttributeMultiprocessorCount, dev) != hipSuccess) { grid = -1; return; }
        if (hipFuncSetAttribute((const void*)mk_fwd, hipFuncAttributeMaxDynamicSharedMemorySize, LDS_BYTES) != hipSuccess) { fprintf(stderr, "kernel_launch: hipFuncSetAttribute failed\n"); grid = -1; return; }
        if (hipOccupancyMaxActiveBlocksPerMultiprocessor(&per_cu, (const void*)mk_fwd, NTHREADS, LDS_BYTES) != hipSuccess || per_cu < 1)
            fprintf(stderr, "kernel_launch: occupancy query reports %d workgroups per CU\n", per_cu);
        (void)hipGetLastError();
        grid = cus;
    }
    if (grid < 0) return;
    if (hipMemsetAsync((char*)d_ws + WS_CTL, 0, CTL_ZERO_BYTES, stream) != hipSuccess) return;
    Args a{};
    for (int i = 0; i < 19; ++i) a.in[i] = d_in[i];
    a.out = (float*)d_out; a.ws = (unsigned char*)d_ws;
#if MK_N_LAUNCHES == 1
    a.ph_lo = 0; a.ph_hi = NPHASES;
    hipLaunchKernelGGL(mk_fwd, dim3(grid), dim3(NTHREADS), LDS_BYTES, stream, a);
#else
    for (int p = 0; p < NPHASES; ++p) { a.ph_lo = p; a.ph_hi = p + 1; hipLaunchKernelGGL(mk_fwd, dim3(grid), dim3(NTHREADS), LDS_BYTES, stream, a); }
#endif
}
```
